# Optimizing an MI355X kernel written in HIP

```python
import jax
import jax.numpy as jnp
from jax import lax
import numpy as np


D_MODEL = 2048
BATCH = 1
SEQ = 16384
DEPTH = 1

SB_HEADS = 16
SB_HEAD_DIM = 64
SB_WIDTH = SB_HEADS * SB_HEAD_DIM
SB_BLOCK = 128
RWKV_HEADS = 16
RWKV_HEAD_DIM = 64
RWKV_WIDTH = RWKV_HEADS * RWKV_HEAD_DIM
DECAY_LORA = 64
ICLR_LORA = 64
GATE_LORA = 160
N_SHIFT_MIX = 6
GN_EPS = 64e-5
IN_COLS = 3 * SB_WIDTH + 4 * RWKV_WIDTH + 2 * D_MODEL
IN_SPLITS = (SB_WIDTH, 2 * SB_WIDTH, 3 * SB_WIDTH,
             3 * SB_WIDTH + RWKV_WIDTH, 3 * SB_WIDTH + 2 * RWKV_WIDTH,
             3 * SB_WIDTH + 3 * RWKV_WIDTH, 3 * SB_WIDTH + 4 * RWKV_WIDTH,
             3 * SB_WIDTH + 4 * RWKV_WIDTH + D_MODEL)
PEER_HEADS = 8
PEER_TOPK = 16
N_KEYS = 128
N_EXPERTS = N_KEYS * N_KEYS
PEER_KEY_DIM = 256
PEER_CHUNK = 128
PLE_DIM = 256
LN_EPS = 1e-5
DEEPNORM_ALPHA = (2 * DEPTH) ** 0.25
DEEPNORM_BETA = (8 * DEPTH) ** -0.25

kernel_name = 'hybrid_stickbreak_rwkv7_peer_block'


def _layer_norm(x, g, b):
    xf = x.astype(jnp.float32)
    mu = jnp.mean(xf, axis=-1, keepdims=True)
    var = jnp.mean(jnp.square(xf - mu), axis=-1, keepdims=True)
    return ((xf - mu) * lax.rsqrt(var + LN_EPS) * g + b).astype(x.dtype)


def _shift_lerp(z, mu):
    prev = jnp.pad(z, ((0, 0), (1, 0), (0, 0)))[:, :-1]
    return z + (prev - z) * mu


def _stick_breaking_attention(q, k, v):
    b, t, h, dh = q.shape
    n_blocks = t // SB_BLOCK
    scale = dh ** -0.5
    q_blocks = q.reshape(b, n_blocks, SB_BLOCK, h, dh).transpose(1, 0, 3, 2, 4)
    k_t = k.transpose(0, 2, 1, 3)
    v_t = v.transpose(0, 2, 1, 3)
    key_pos = jnp.arange(t)
    starts = jnp.arange(n_blocks) * SB_BLOCK

    def block(args):
        q_blk, start = args
        z = jnp.einsum('bhqd,bhkd->bhqk', q_blk, k_t).astype(jnp.float32) * scale
        q_pos = start + jnp.arange(SB_BLOCK)
        causal = key_pos[None, :] < q_pos[:, None]
        log_keep = jnp.where(causal, jax.nn.log_sigmoid(-z), 0.0)
        log_later = lax.cumsum(log_keep, axis=3, reverse=True) - log_keep
        w = jnp.where(causal, jnp.exp(jax.nn.log_sigmoid(z) + log_later), 0.0)
        return jnp.einsum('bhqk,bhkd->bhqd', w.astype(v_t.dtype), v_t)

    out = lax.map(block, (q_blocks, starts))
    return out.transpose(1, 0, 3, 2, 4).reshape(b, t, h * dh)


def _rwkv7_scan(r, log_w, k, v, a_vec, b_vec):
    bsz, _, h, n = r.shape

    def step(state, inp):
        r_t, lw_t, k_t, v_t, a_t, b_t = inp
        sa = jnp.einsum('bhvk,bhk->bhv', state, a_t)
        state = (state * jnp.exp(lw_t)[:, :, None, :]
                 + sa[..., None] * b_t[:, :, None, :]
                 + v_t[..., None] * k_t[:, :, None, :])
        return state, jnp.einsum('bhvk,bhk->bhv', state, r_t)

    xs = tuple(z.astype(jnp.float32).transpose(1, 0, 2, 3) for z in (r, log_w, k, v, a_vec, b_vec))
    _, y = lax.scan(step, jnp.zeros((bsz, h, n, n), jnp.float32), xs)
    return y.transpose(1, 0, 2, 3)


def _rwkv7_time_mix(r_in, k_in, v_in, c_in, mu, w0, w_lora1, w_lora2, a0, a_lora1, a_lora2,
                    g_lora1, g_lora2, k_k, k_a, r_k, lnx_w, lnx_b):
    bsz, t, _ = r_in.shape

    def heads(z):
        return z.reshape(bsz, t, RWKV_HEADS, RWKV_HEAD_DIM)

    r = _shift_lerp(r_in, mu[0])
    k = _shift_lerp(k_in, mu[1])
    v = _shift_lerp(v_in, mu[2])
    xw = _shift_lerp(c_in, mu[3])
    xa = _shift_lerp(c_in, mu[4])
    xg = _shift_lerp(c_in, mu[5])
    w = -jax.nn.softplus(-(w0 + jnp.tanh(xw @ w_lora1) @ w_lora2)) - 0.5
    log_decay = -jnp.exp(w.astype(jnp.float32))
    a = jax.nn.sigmoid(a0 + (xa @ a_lora1) @ a_lora2)
    g = jax.nn.sigmoid(xg @ g_lora1) @ g_lora2
    kk = heads(k * k_k).astype(jnp.float32)
    kk = kk / jnp.maximum(jnp.sqrt(jnp.sum(kk * kk, axis=-1, keepdims=True)), 1e-12)
    k = k * (1.0 + (a - 1.0) * k_a)
    rh, kh, vh, ah = heads(r), heads(k), heads(v), heads(a)
    y = _rwkv7_scan(rh, heads(log_decay), kh, vh, -kk, kk * ah)
    mean = jnp.mean(y, axis=-1, keepdims=True)
    var = jnp.mean(jnp.square(y - mean), axis=-1, keepdims=True)
    y = ((y - mean) * lax.rsqrt(var + GN_EPS)).reshape(bsz, t, RWKV_WIDTH) * lnx_w + lnx_b
    bonus = jnp.sum(rh * kh * r_k, axis=-1, keepdims=True) * vh
    y = y.astype(r_in.dtype) + bonus.reshape(bsz, t, RWKV_WIDTH)
    return y * g


def _peer_ffn(x, w_q, sub_keys, expert_u, expert_v):
    bsz, t, d = x.shape
    q = (x @ w_q).reshape(bsz, t, PEER_HEADS, 2, PEER_KEY_DIM // 2)
    s = jnp.einsum('bthcd,cnd->bthcn', q, sub_keys).astype(jnp.float32)
    top_s, top_i = lax.top_k(s, PEER_TOPK)
    cand_s = top_s[..., 0, :, None] + top_s[..., 1, None, :]
    cand_i = top_i[..., 0, :, None] * N_KEYS + top_i[..., 1, None, :]
    cand_s = cand_s.reshape(bsz, t, PEER_HEADS, PEER_TOPK * PEER_TOPK)
    cand_i = cand_i.reshape(bsz, t, PEER_HEADS, PEER_TOPK * PEER_TOPK)
    best_s, best_pos = lax.top_k(cand_s, PEER_TOPK)
    expert_idx = jnp.take_along_axis(cand_i, best_pos, axis=-1)
    gate = jax.nn.softmax(best_s, axis=-1)
    n_chunks = (bsz * t) // PEER_CHUNK
    n_sel = PEER_HEADS * PEER_TOPK
    xs = x.reshape(n_chunks, PEER_CHUNK, d)
    idx = expert_idx.reshape(n_chunks, PEER_CHUNK, n_sel)
    gs = gate.reshape(n_chunks, PEER_CHUNK, n_sel).astype(x.dtype)

    def chunk(args):
        xc, ic, gc = args
        u = jnp.take(expert_u, ic, axis=0)
        act = jax.nn.gelu(jnp.einsum('cd,cjd->cj', xc, u), approximate=False) * gc
        return jnp.einsum('cj,cjd->cd', act, jnp.take(expert_v, ic, axis=0))

    return lax.map(chunk, (xs, idx, gs)).reshape(bsz, t, d)


def setup_inputs(seed: int = 0) -> dict:
    key = jax.random.key(seed)
    ks = jax.random.split(key, 32)
    f32 = jnp.float32
    L = DEPTH

    def nrm(k, shape, scale):
        return jax.random.normal(k, shape, f32) * scale

    return {
        'x': nrm(ks[0], (BATCH, SEQ, D_MODEL), 1.0),
        'p': nrm(ks[1], (DEPTH, BATCH, SEQ, PLE_DIM), 1.0),
        'w_in': nrm(ks[2], (L, D_MODEL, IN_COLS), D_MODEL ** -0.5),
        'rwkv_mu': jax.random.uniform(ks[3], (L, N_SHIFT_MIX, RWKV_WIDTH), f32),
        'rwkv_w0': jax.random.uniform(ks[4], (L, RWKV_WIDTH), f32, -2.0, 1.0),
        'rwkv_w_lora1': nrm(ks[5], (L, RWKV_WIDTH, DECAY_LORA), RWKV_WIDTH ** -0.5),
        'rwkv_w_lora2': nrm(ks[6], (L, DECAY_LORA, RWKV_WIDTH), 0.1 * DECAY_LORA ** -0.5),
        'rwkv_a0': nrm(ks[7], (L, RWKV_WIDTH), 0.1),
        'rwkv_a_lora1': nrm(ks[8], (L, RWKV_WIDTH, ICLR_LORA), RWKV_WIDTH ** -0.5),
        'rwkv_a_lora2': nrm(ks[9], (L, ICLR_LORA, RWKV_WIDTH), 0.5 * ICLR_LORA ** -0.5),
        'rwkv_g_lora1': nrm(ks[10], (L, RWKV_WIDTH, GATE_LORA), RWKV_WIDTH ** -0.5),
        'rwkv_g_lora2': nrm(ks[11], (L, GATE_LORA, RWKV_WIDTH), GATE_LORA ** -0.5),
        'rwkv_k_k': 0.85 + nrm(ks[12], (L, RWKV_WIDTH), 0.05),
        'rwkv_k_a': 1.0 + nrm(ks[13], (L, RWKV_WIDTH), 0.05),
        'rwkv_r_k': nrm(ks[14], (L, RWKV_HEADS, RWKV_HEAD_DIM), 0.1),
        'rwkv_lnx_w': 1.0 + nrm(ks[15], (L, RWKV_WIDTH), 0.02),
        'rwkv_lnx_b': nrm(ks[16], (L, RWKV_WIDTH), 0.02),
        'w_up_a': nrm(ks[17], (L, SB_WIDTH, D_MODEL), SB_WIDTH ** -0.5),
        'w_up_b': nrm(ks[18], (L, RWKV_WIDTH, D_MODEL), RWKV_WIDTH ** -0.5),
        'w_o': nrm(ks[19], (L, D_MODEL, D_MODEL), DEEPNORM_BETA * D_MODEL ** -0.5),
        'ln1_w': 1.0 + nrm(ks[20], (L, D_MODEL), 0.02),
        'ln1_b': nrm(ks[21], (L, D_MODEL), 0.02),
        'peer_w_q': nrm(ks[22], (L, D_MODEL, PEER_HEADS * PEER_KEY_DIM), D_MODEL ** -0.5),
        'peer_sub_keys': nrm(ks[23], (L, 2, N_KEYS, PEER_KEY_DIM // 2), (PEER_KEY_DIM // 2) ** -0.5),
        'peer_u': nrm(ks[24], (L, N_EXPERTS, D_MODEL), D_MODEL ** -0.5),
        'peer_v': nrm(ks[25], (L, N_EXPERTS, D_MODEL), DEEPNORM_BETA),
        'ple_w_gate': nrm(ks[26], (L, D_MODEL, D_MODEL), D_MODEL ** -0.5),
        'ple_w_proj': nrm(ks[27], (L, PLE_DIM, D_MODEL), DEEPNORM_BETA * PLE_DIM ** -0.5),
        'ln2_w': 1.0 + nrm(ks[28], (L, D_MODEL), 0.02),
        'ln2_b': nrm(ks[29], (L, D_MODEL), 0.02),
    }


def reference(x, p, w_in, rwkv_mu, rwkv_w0, rwkv_w_lora1, rwkv_w_lora2, rwkv_a0, rwkv_a_lora1,
              rwkv_a_lora2, rwkv_g_lora1, rwkv_g_lora2, rwkv_k_k, rwkv_k_a, rwkv_r_k, rwkv_lnx_w,
              rwkv_lnx_b, w_up_a, w_up_b, w_o, ln1_w, ln1_b, peer_w_q, peer_sub_keys, peer_u, peer_v,
              ple_w_gate, ple_w_proj, ln2_w, ln2_b):
    bsz, t, _ = x.shape
    for i in range(DEPTH):
        proj = x @ w_in[i]
        sb_q, sb_k, sb_v, rw_r, rw_k, rw_v, rw_c, gate_a, gate_b = jnp.split(proj, IN_SPLITS, axis=-1)
        y_a = _stick_breaking_attention(
            sb_q.reshape(bsz, t, SB_HEADS, SB_HEAD_DIM),
            sb_k.reshape(bsz, t, SB_HEADS, SB_HEAD_DIM),
            sb_v.reshape(bsz, t, SB_HEADS, SB_HEAD_DIM)) @ w_up_a[i]
        y_b = _rwkv7_time_mix(
            rw_r, rw_k, rw_v, rw_c, rwkv_mu[i], rwkv_w0[i], rwkv_w_lora1[i], rwkv_w_lora2[i],
            rwkv_a0[i], rwkv_a_lora1[i], rwkv_a_lora2[i], rwkv_g_lora1[i], rwkv_g_lora2[i],
            rwkv_k_k[i], rwkv_k_a[i], rwkv_r_k[i], rwkv_lnx_w[i], rwkv_lnx_b[i]) @ w_up_b[i]
        mixed = (jax.nn.sigmoid(gate_a) * y_a + jax.nn.sigmoid(gate_b) * y_b) @ w_o[i]
        x = _layer_norm(DEEPNORM_ALPHA * x + mixed, ln1_w[i], ln1_b[i])
        ffn = _peer_ffn(x, peer_w_q[i], peer_sub_keys[i], peer_u[i], peer_v[i])
        ple = jax.nn.sigmoid(x @ ple_w_gate[i]) * (p[i] @ ple_w_proj[i])
        x = _layer_norm(DEEPNORM_ALPHA * x + ffn + ple, ln2_w[i], ln2_b[i])
    return x
```

```cpp
#define MK_ONE_LAUNCH 1
#include <hip/hip_runtime.h>
#include <cstdio>
#include <cstdint>
namespace pg8 {
#define PG8_LAS __attribute__((address_space(3)))
typedef unsigned short bf16_t;
typedef short bf16x8 __attribute__((ext_vector_type(8)));
typedef float f32x4 __attribute__((ext_vector_type(4)));
typedef unsigned u32x4 __attribute__((ext_vector_type(4)));
constexpr int BM = 256, BK = 64, HALF = 128, HTB = HALF * BK * 2  , STAGE_BYTES = 8 * HTB, NXCD = 8, WGM = 8;

__host__ __device__ __forceinline__ int lds_byte(int r, int c) { const int st = (r >> 4) * 2 + (c >> 5), rr = r & 15, cc = c & 31, ob = rr * 64 + cc * 2; return st * 1024 + (ob ^ (((ob >> 9) & 1) << 5)); }
__host__ __device__ __forceinline__ void stage_rc(int b, int& R, int& C) { const int st = b / 1024, sb = b % 1024, swz = sb ^ (((sb >> 9) & 1) << 5); R = (st >> 1) * 16 + swz / 64; C = (st & 1) * 32 + (swz % 64) / 2; }
__host__ __device__ __forceinline__ int perm32(int rho) { const int n = rho >> 4, i = rho & 15; return 8 * (i >> 2) + 4 * n + (i & 3); }

struct Unit { int pm, pn; };
struct Gemm { const bf16_t* A; const bf16_t* Bt; int M, N, K; };

struct StaticOrder {
    int nM, nN, nwg, G, c;
    __host__ __device__ void init(int M, int N, int G_, int c_) { nM = M / BM; nN = N / BM; nwg = nM * nN; G = G_; c = c_; }
    __host__ __device__ bool next(int i, Unit& u) const {
        const long L = (long)i * G + c; if (L >= nwg) return false;
        int wgid = (int)L; { const int q = nwg / NXCD, r = nwg % NXCD, xcd = wgid % NXCD, off = wgid / NXCD; wgid = (xcd < r ? xcd * (q + 1) : r * (q + 1) + (xcd - r) * q) + off; }
        const int nig = WGM * nN, gid = wgid / nig, fm = gid * WGM, gsz = (nM - fm) < WGM ? (nM - fm) : WGM;
        u.pm = fm + ((wgid % nig) % gsz); u.pn = (wgid % nig) / gsz; return true;
    }
    __device__ __forceinline__ void a_ready(const Unit&) const {}
    __device__ __forceinline__ void done(const Unit&) const {}
};

typedef float cvt_f32x2 __attribute__((ext_vector_type(2))); typedef __bf16 cvt_bf16x2 __attribute__((ext_vector_type(2)));
__device__ __forceinline__ unsigned cvt_pk_bf16(float lo, float hi) { const cvt_f32x2 v = {lo, hi}; return __builtin_bit_cast(unsigned, __builtin_convertvector(v, cvt_bf16x2)); }
typedef float f32x2 __attribute__((ext_vector_type(2)));
__device__ __forceinline__ f32x2 gelu_pk(f32x2 v) {
    const f32x2 av = __builtin_elementwise_abs(v), d = av * 0.2316418882f + 1.0f;
    f32x2 t; t.x = __builtin_amdgcn_rcpf(d.x); t.y = __builtin_amdgcn_rcpf(d.y);
    f32x2 q = t * 0.5307027145f + (-0.7265760135f); q = q * t + 0.7107068705f; q = q * t + (-0.142248368f); q = q * t + 0.127414796f; q = q * t;
    const f32x2 s = (v * v) * (-0.72134752044f);
    f32x2 e; e.x = __builtin_amdgcn_exp2f(s.x); e.y = __builtin_amdgcn_exp2f(s.y);
    const f32x2 m = v * (q * e), r = v - m;
    f32x2 o; o.x = v.x < 0.f ? m.x : r.x; o.y = v.y < 0.f ? m.y : r.y; return o;
}


__device__ __forceinline__ float bf_lo(unsigned w) { return __uint_as_float(w << 16); }
__device__ __forceinline__ float bf_hi(unsigned w) { return __uint_as_float(w & 0xffff0000u); }
__device__ __forceinline__ float fsigmoid(float x) { return __builtin_amdgcn_rcpf(1.0f + __expf(-x)); }
__device__ __forceinline__ float ftanh(float x) { return 1.0f - 2.0f * __builtin_amdgcn_rcpf(__expf(2.0f * x) + 1.0f); }
__device__ __forceinline__ float fsoftplus(float x) { return fmaxf(x, 0.f) + __logf(1.0f + __expf(-fabsf(x))); }
__device__ __forceinline__ u32x4 pack8(const f32x4& a, const f32x4& b) { u32x4 w; w.x = cvt_pk_bf16(a[0], a[1]); w.y = cvt_pk_bf16(a[2], a[3]); w.z = cvt_pk_bf16(b[0], b[1]); w.w = cvt_pk_bf16(b[2], b[3]); return w; }
__device__ __forceinline__ void unpack8(const u32x4& w, f32x4& a, f32x4& b) { a = (f32x4){bf_lo(w.x), bf_hi(w.x), bf_lo(w.y), bf_hi(w.y)}; b = (f32x4){bf_lo(w.z), bf_hi(w.z), bf_lo(w.w), bf_hi(w.w)}; }

template <class Fn> struct EpiB16 {
    static constexpr bool PERM = true, AFTER_DRAIN = false;
    Fn f;
    __device__ __forceinline__ void operator()(const f32x4 (&acc)[2][2][4][2], const Unit& u, int wr, int wc, int fr, int fq) const {
        const int row0 = u.pm * BM + wr * 64 + fr, col0 = u.pn * BM + wc * 32 + 8 * fq;
#pragma unroll
        for (int ai = 0; ai < 2; ++ai)
#pragma unroll
            for (int m = 0; m < 4; ++m)
#pragma unroll
                for (int bj = 0; bj < 2; ++bj) f(row0 + ai * HALF + m * 16, col0 + bj * HALF, acc[ai][bj][m][0], acc[ai][bj][m][1]);
    }
};
template <class Fn> struct EpiF32x {
    static constexpr bool PERM = false, AFTER_DRAIN = false;
    Fn f;
    __device__ __forceinline__ void operator()(const f32x4 (&acc)[2][2][4][2], const Unit& u, int wr, int wc, int fr, int fq) const {
        const int row0 = u.pm * BM + wr * 64 + fr, col0 = u.pn * BM + wc * 32 + 4 * fq;
#pragma unroll
        for (int ai = 0; ai < 2; ++ai)
#pragma unroll
            for (int m = 0; m < 4; ++m)
#pragma unroll
                for (int bj = 0; bj < 2; ++bj)
#pragma unroll
                    for (int n = 0; n < 2; ++n) f(row0 + ai * HALF + m * 16, col0 + bj * HALF + n * 16, acc[ai][bj][m][n]);
    }
};
constexpr int TT = 16384;
struct FnProj { bf16_t* base;
    __device__ __forceinline__ void operator()(int row, int col, f32x4 a, f32x4 b) const {
        const int reg = col >> 10, c = col & 1023; const float sc = reg == 0 ? 0.125f : 1.0f; a = a * sc; b = b * sc;
        *(u32x4*)(base + (size_t)reg * ((size_t)TT * 1024) + (size_t)row * 1024 + c) = pack8(a, b); } };
struct FnGate { bf16_t* base;
    __device__ __forceinline__ void operator()(int row, int col, f32x4 a, f32x4 b) const {
        const int reg = col >> 11, c = col & 2047;
#pragma unroll
        for (int j = 0; j < 4; ++j) {
#ifndef DIAG_RAWGATE
            a[j] = fsigmoid(a[j]); b[j] = fsigmoid(b[j]);
#endif
        }
        *(u32x4*)(base + (size_t)reg * ((size_t)TT * 2048) + (size_t)row * 2048 + c) = pack8(a, b); } };
struct FnLora1 { bf16_t* out; int act;
    __device__ __forceinline__ void operator()(int row, int col, f32x4 a, f32x4 b) const {
#pragma unroll
        for (int j = 0; j < 4; ++j) { if (act == 0) { a[j] = ftanh(a[j]); b[j] = ftanh(b[j]); } else if (act == 2) { a[j] = fsigmoid(a[j]); b[j] = fsigmoid(b[j]); } }
        *(u32x4*)(out + (size_t)row * 256 + col) = pack8(a, b); } };
struct FnLora2 { float* lw; bf16_t* aa; bf16_t* gg; const float* w0; const float* a0;
    __device__ __forceinline__ void operator()(int row, int col, f32x4 a, f32x4 b) const {
        const int which = col >> 10, c = col & 1023, t = row - which * TT;
        if (which == 0) { a = a + *(const f32x4*)(w0 + c); b = b + *(const f32x4*)(w0 + c + 4);
            *(f32x4*)(lw + (size_t)t * 1024 + c) = a; *(f32x4*)(lw + (size_t)t * 1024 + c + 4) = b; }
        else if (which == 1) { a = a + *(const f32x4*)(a0 + c); b = b + *(const f32x4*)(a0 + c + 4);
            *(u32x4*)(aa + (size_t)t * 1024 + c) = pack8(a, b); }
        else { *(u32x4*)(gg + (size_t)t * 1024 + c) = pack8(a, b); } } };

template <int W> struct FnLora2S { float* lw; bf16_t* aa; bf16_t* gg; const float* w0; const float* a0;
    __device__ __forceinline__ void operator()(int row, int col, f32x4 a, f32x4 b) const { const FnLora2 f{lw, aa, gg, w0, a0}; f(row + W * TT, col + W * 1024, a, b); } };
template <int ADD> struct FnMix { const bf16_t* gate; bf16_t* mix;
    __device__ __forceinline__ void operator()(int row, int col, f32x4 a, f32x4 b) const {
        const size_t o = (size_t)row * 2048 + col; f32x4 g0, g1; unpack8(*(const u32x4*)(gate + o), g0, g1); a = a * g0; b = b * g1;
        if (ADD) { f32x4 m0, m1; unpack8(*(const u32x4*)(mix + o), m0, m1); a = a + m0; b = b + m1; }
        *(u32x4*)(mix + o) = pack8(a, b); } };
struct FnWo { const float* x; float* h1; float alpha;
    __device__ __forceinline__ void operator()(int row, int col, f32x4 a) const {
        const size_t o = (size_t)row * 2048 + col; *(f32x4*)(h1 + o) = *(const f32x4*)(x + o) * alpha + a; } };
struct FnPlain16 { bf16_t* out; int ld;
    __device__ __forceinline__ void operator()(int row, int col, f32x4 a, f32x4 b) const { *(u32x4*)(out + (size_t)row * ld + col) = pack8(a, b); } };
struct FnPle { bf16_t* pe;
    __device__ __forceinline__ void operator()(int row, int col, f32x4 a, f32x4 b) const {
        const size_t o = (size_t)row * 2048 + col; f32x4 p0, p1; unpack8(*(const u32x4*)(pe + o), p0, p1);
#pragma unroll
        for (int j = 0; j < 4; ++j) { a[j] = fsigmoid(a[j]) * p0[j]; b[j] = fsigmoid(b[j]) * p1[j]; }
        *(u32x4*)(pe + o) = pack8(a, b); } };
struct DiagOrder { int G, c;
    __device__ __forceinline__ bool next(int i, Unit& u) const { const int L = i * G + c; if (L >= 768) return false; const int which = L >> 8, r = L & 255; u.pm = which * 64 + (r & 63); u.pn = which * 4 + (r >> 6); return true; }
    __device__ __forceinline__ void a_ready(const Unit&) const {}
    __device__ __forceinline__ void done(const Unit&) const {}
};
template <class Epi, class Sched, bool ALIGN_EPI = false, bool SP2 = false>
__device__ __forceinline__ void gemm_phase(PG8_LAS unsigned char* lds, const Gemm g, const Sched& S, const Epi& E) {
    const int tid = threadIdx.x, wid = __builtin_amdgcn_readfirstlane(tid >> 6), lane = tid & 63, wr = wid >> 2, wc = wid & 3, fr = lane & 15, fq = lane >> 4;
    const int K = g.K, nt = K / BK;
    unsigned voffA[2], voffB[2];
#pragma unroll
    for (int i = 0; i < 2; ++i) { int R, C; stage_rc(tid * 16 + i * 8192, R, C); const int Rb = Epi::PERM ? ((R & ~31) + perm32(R & 31)) : R;
        voffA[i] = (unsigned)(R * K + C) * 2u; voffB[i] = (unsigned)(Rb * K + C) * 2u; }
    const size_t kstep = (size_t)(BK * 2);
    const size_t hstep = (size_t)HALF * K * 2;
    const size_t tstep = 2 * hstep;
    const unsigned ldsw = (unsigned)wid * 1024u;
    const int aoff = lds_byte(wr * 64 + fr, fq * 8), boff = lds_byte(wc * 32 + fr, fq * 8);
#define PG8_SA(b, h) (((b) * 2 + (h)) * HTB)
#define PG8_SB(b, h) ((4 + (b) * 2 + (h)) * HTB)
#define PG8_STAGE(bufoff, gbase, voff) do { _Pragma("unroll") for (int _i = 0; _i < 2; ++_i) \
        __builtin_amdgcn_global_load_lds((const unsigned*)((const char*)(gbase) + (voff)[_i]), (PG8_LAS unsigned*)(lds + (bufoff) + ldsw + _i * 8192), 16, 0, 0); } while (0)
#define PG8_LDA(dst, b, h) do { _Pragma("unroll") for (int m = 0; m < 4; ++m) _Pragma("unroll") for (int k = 0; k < 2; ++k) dst[m][k] = *(const PG8_LAS bf16x8*)(lds + PG8_SA(b, h) + aoff + m * 2048 + k * 1024); } while (0)
#define PG8_LDB(dst, b, h) do { _Pragma("unroll") for (int n = 0; n < 2; ++n) _Pragma("unroll") for (int k = 0; k < 2; ++k) dst[n][k] = *(const PG8_LAS bf16x8*)(lds + PG8_SB(b, h) + boff + n * 2048 + k * 1024); } while (0)
#define PG8_MMA(ai, bj, At, Bt) do { __builtin_amdgcn_s_setprio(1); _Pragma("unroll") for (int m = 0; m < 4; ++m) _Pragma("unroll") for (int n = 0; n < 2; ++n) _Pragma("unroll") for (int k = 0; k < 2; ++k) \
        acc[ai][bj][m][n] = __builtin_amdgcn_mfma_f32_16x16x32_bf16(Bt[n][k], At[m][k], acc[ai][bj][m][n], 0, 0, 0); __builtin_amdgcn_s_setprio(0); } while (0)
#define PG8_WAIT_V(n) asm volatile("s_waitcnt vmcnt(" #n ")" ::: "memory")
#define PG8_WAIT_L(n) asm volatile("s_waitcnt lgkmcnt(" #n ")" ::: "memory")
#define PG8_BAR __builtin_amdgcn_s_barrier()
#define PG8_SCHED __builtin_amdgcn_sched_barrier(0)
    Unit cur, nxt; int ui = 0;
    if (!S.next(0, cur)) return;
    f32x4 acc[2][2][4][2];
#pragma unroll
    for (int a = 0; a < 2; ++a)
#pragma unroll
        for (int b = 0; b < 2; ++b)
#pragma unroll
            for (int m = 0; m < 4; ++m)
#pragma unroll
                for (int n = 0; n < 2; ++n) acc[a][b][m][n] = (f32x4){0.f, 0.f, 0.f, 0.f};
    bf16x8 At[4][2], B0[2][2], B1[2][2];
    const char* cA = (const char*)g.A + (size_t)cur.pm * tstep; const char* cB = (const char*)g.Bt + (size_t)cur.pn * tstep;
    S.a_ready(cur);
    if constexpr (SP2) {
        PG8_STAGE(PG8_SB(0, 0), cB, voffB); PG8_STAGE(PG8_SB(0, 1), cB + hstep, voffB); PG8_STAGE(PG8_SA(0, 0), cA, voffA); PG8_STAGE(PG8_SA(0, 1), cA + hstep, voffA);
        if (wr == 1) PG8_BAR;
        PG8_WAIT_V(2); PG8_BAR;
        PG8_STAGE(PG8_SB(1, 0), cB + kstep, voffB); PG8_STAGE(PG8_SA(1, 0), cA + kstep, voffA); PG8_STAGE(PG8_SB(1, 1), cB + hstep + kstep, voffB);
        PG8_WAIT_V(6); PG8_BAR;
    } else {
        PG8_STAGE(PG8_SB(0, 0), cB, voffB); PG8_STAGE(PG8_SA(0, 0), cA, voffA); PG8_STAGE(PG8_SB(0, 1), cB + hstep, voffB); PG8_STAGE(PG8_SA(0, 1), cA + hstep, voffA);
        if (wr == 1) PG8_BAR;
        PG8_WAIT_V(4); PG8_BAR;
        PG8_STAGE(PG8_SB(1, 0), cB + kstep, voffB); PG8_STAGE(PG8_SA(1, 0), cA + kstep, voffA); PG8_STAGE(PG8_SB(1, 1), cB + hstep + kstep, voffB);
        PG8_WAIT_V(6); PG8_BAR;
    }
    for (;;) {
        const bool has_next = S.next(ui + 1, nxt);
        const char* nA = has_next ? (const char*)g.A + (size_t)nxt.pm * tstep : cA; const char* nB = has_next ? (const char*)g.Bt + (size_t)nxt.pn * tstep : cB;
        for (int t = 0; t < nt; t += 2) {
            const bool last = (t == nt - 2);
            const char* a1 = cA + (size_t)(t + 1) * kstep;
            const char* a2 = last ? nA : cA + (size_t)(t + 2) * kstep; const char* b2 = last ? nB : cB + (size_t)(t + 2) * kstep;
            const char* a3 = a2 + kstep; const char* b3 = b2 + kstep;
            if (last && has_next) S.a_ready(nxt);
            if constexpr (SP2) {
            PG8_LDB(B0, 0, 0); PG8_LDB(B1, 0, 1); PG8_SCHED; PG8_LDA(At, 0, 0); PG8_STAGE(PG8_SA(1, 1), a1 + hstep, voffA);
            PG8_WAIT_V(8); PG8_WAIT_L(0); PG8_BAR; PG8_MMA(0, 0, At, B0); PG8_MMA(0, 1, At, B1); PG8_BAR; PG8_SCHED;
            PG8_LDA(At, 0, 1); PG8_STAGE(PG8_SB(0, 0), b2, voffB); PG8_STAGE(PG8_SB(0, 1), b2 + hstep, voffB); PG8_STAGE(PG8_SA(0, 0), a2, voffA);
            PG8_WAIT_V(8); PG8_WAIT_L(0); PG8_BAR; PG8_MMA(1, 0, At, B0); PG8_MMA(1, 1, At, B1); PG8_BAR; PG8_SCHED;
            PG8_LDB(B0, 1, 0); PG8_LDB(B1, 1, 1); PG8_SCHED; PG8_LDA(At, 1, 0); PG8_STAGE(PG8_SA(0, 1), a2 + hstep, voffA);
            PG8_WAIT_V(8); PG8_WAIT_L(0); PG8_BAR; PG8_MMA(0, 0, At, B0); PG8_MMA(0, 1, At, B1); PG8_BAR; PG8_SCHED;
            PG8_LDA(At, 1, 1); PG8_STAGE(PG8_SB(1, 0), b3, voffB); PG8_STAGE(PG8_SB(1, 1), b3 + hstep, voffB); PG8_STAGE(PG8_SA(1, 0), a3, voffA);
            PG8_WAIT_V(8); PG8_WAIT_L(0); PG8_BAR; PG8_MMA(1, 0, At, B0); PG8_MMA(1, 1, At, B1); PG8_BAR; PG8_SCHED;
            } else {
            PG8_LDB(B0, 0, 0); PG8_SCHED; PG8_LDA(At, 0, 0); PG8_STAGE(PG8_SA(1, 1), a1 + hstep, voffA);
            PG8_WAIT_L(8); PG8_BAR; PG8_WAIT_L(0); PG8_MMA(0, 0, At, B0); PG8_BAR; PG8_SCHED;
            PG8_LDB(B1, 0, 1); PG8_STAGE(PG8_SB(0, 0), b2, voffB);
            PG8_BAR; PG8_WAIT_L(0); PG8_MMA(0, 1, At, B1); PG8_BAR;
            PG8_LDA(At, 0, 1); PG8_STAGE(PG8_SA(0, 0), a2, voffA);
            PG8_BAR; PG8_WAIT_L(0); PG8_MMA(1, 0, At, B0); PG8_BAR; PG8_SCHED;
            PG8_STAGE(PG8_SB(0, 1), b2 + hstep, voffB);
            PG8_WAIT_V(6); PG8_BAR; PG8_MMA(1, 1, At, B1); PG8_BAR;
            PG8_LDB(B0, 1, 0); PG8_SCHED; PG8_LDA(At, 1, 0); PG8_STAGE(PG8_SA(0, 1), a2 + hstep, voffA);
            PG8_WAIT_L(8); PG8_BAR; PG8_WAIT_L(0); PG8_MMA(0, 0, At, B0); PG8_BAR; PG8_SCHED;
            PG8_LDB(B1, 1, 1); PG8_STAGE(PG8_SB(1, 0), b3, voffB);
            PG8_BAR; PG8_WAIT_L(0); PG8_MMA(0, 1, At, B1); PG8_BAR;
            PG8_LDA(At, 1, 1); PG8_STAGE(PG8_SA(1, 0), a3, voffA);
            PG8_BAR; PG8_WAIT_L(0); PG8_MMA(1, 0, At, B0); PG8_BAR; PG8_SCHED;
            PG8_STAGE(PG8_SB(1, 1), b3 + hstep, voffB);
            PG8_WAIT_V(6); PG8_BAR; PG8_MMA(1, 1, At, B1); PG8_BAR;
            }
        }
        if constexpr (ALIGN_EPI) { if (wr == 0) PG8_BAR; }
        if constexpr (!Epi::AFTER_DRAIN) { E(acc, cur, wr, wc, fr, fq); S.done(cur); }
        if (!has_next) break;
#pragma unroll
        for (int a = 0; a < 2; ++a)
#pragma unroll
            for (int b = 0; b < 2; ++b)
#pragma unroll
                for (int m = 0; m < 4; ++m)
#pragma unroll
                    for (int n = 0; n < 2; ++n) acc[a][b][m][n] = (f32x4){0.f, 0.f, 0.f, 0.f};
        cur = nxt; cA = nA; cB = nB; ++ui;
        if constexpr (ALIGN_EPI) { if (wr == 1) PG8_BAR; }
    }
    PG8_WAIT_V(0);
    if constexpr (!ALIGN_EPI) { if (wr == 0) PG8_BAR; }
    PG8_BAR;
    if constexpr (Epi::AFTER_DRAIN) { E.fused(acc, cur, wr, wc, fr, fq, lds, wid, lane); S.done(cur); }
#undef PG8_SA
#undef PG8_SB
#undef PG8_STAGE
#undef PG8_LDA
#undef PG8_LDB
#undef PG8_MMA
#undef PG8_WAIT_V
#undef PG8_WAIT_L
#undef PG8_BAR
#undef PG8_SCHED
}
}

#ifndef PG8_SP2
#define PG8_SP2 true
#endif
#ifndef PG8_ALIGN
#define PG8_ALIGN true
#endif
#define GAS __attribute__((address_space(1)))
#define LAS __attribute__((address_space(3)))
typedef unsigned short bf16;
typedef unsigned v4u __attribute__((ext_vector_type(4)));
typedef float f32x4 __attribute__((ext_vector_type(4)));
typedef short bf16x8 __attribute__((ext_vector_type(8)));
typedef GAS unsigned gu32;
typedef GAS unsigned long long gu64;
#define RLX_AGENT __ATOMIC_RELAXED, __HIP_MEMORY_SCOPE_AGENT
#define LDS_WAIT() asm volatile("s_waitcnt lgkmcnt(0)" ::: "memory")
#define VM_WAIT() asm volatile("s_waitcnt vmcnt(0)" ::: "memory")
__device__ __forceinline__ unsigned long long rt() { return __builtin_amdgcn_s_memrealtime(); }
__device__ __forceinline__ unsigned f2bf(float f) { unsigned u = __builtin_bit_cast(unsigned, f); return (u + 0x7fffu + ((u >> 16) & 1u)) >> 16; }
__device__ __forceinline__ unsigned pk2(float lo, float hi) { return f2bf(lo) | (f2bf(hi) << 16); }

#define XB_TMO      128
#define XB_XCNT(j)  (256  + 64 * (j))
#define XB_XSUB(j)  (1280 + 64 * (j))
#define XB_XGEN(j)  (2304 + 64 * (j))
#define XB_TOP      3328
#define XB_TOPGEN   3392
#define XCD_BAR_WORDS 3456
#define XB_SPIN_CAP (1u << 18)

__device__ __forceinline__ unsigned xb_ld(unsigned* p)              { return __hip_atomic_load(p, __ATOMIC_RELAXED, __HIP_MEMORY_SCOPE_AGENT); }
__device__ __forceinline__ unsigned xb_add(unsigned* p, unsigned v) { return __hip_atomic_fetch_add(p, v, __ATOMIC_RELAXED, __HIP_MEMORY_SCOPE_AGENT); }
__device__ __forceinline__ unsigned xb_xcc_id() { return (unsigned)__builtin_amdgcn_s_getreg((3 << 11) | 20) & 0xFu; }
#define XB_SPIN(cond, bar) do { unsigned _sp = 0; while (cond) { __builtin_amdgcn_s_sleep(1); \
    if ((++_sp & 255u) == 0u) { if (xb_ld(&(bar)[XB_TMO])) break; if (_sp > XB_SPIN_CAP) { atomicAdd(&(bar)[XB_TMO], 1u); break; } } } } while (0)

struct XcdBarrier {
    unsigned* bar; unsigned x;
    volatile LAS unsigned* st;
};

__device__ __forceinline__ XcdBarrier xcd_barrier_post(unsigned* bar, volatile LAS unsigned* st) {
    XcdBarrier b; b.bar = bar; b.x = xb_xcc_id(); b.st = st;
    if (threadIdx.x == 0) (void)xb_add(&bar[XB_XCNT(b.x)], 1u);
    return b;
}
__device__ __forceinline__ void xcd_barrier_complete(unsigned* bar, unsigned x, unsigned& nloc, unsigned& nx) {
    const unsigned G = gridDim.x * gridDim.y * gridDim.z;
    unsigned sum, cnt, mine, sp = 0u;
    for (;;) {
        sum = 0u; cnt = 0u; mine = 0u;
#pragma unroll
        for (unsigned j = 0; j < 16; ++j) { const unsigned c = xb_ld(&bar[XB_XCNT(j)]); sum += c; cnt += (c > 0u) ? 1u : 0u; mine = (j == x) ? c : mine; }
        if (sum == G) break;
        __builtin_amdgcn_s_sleep(1);
        if ((++sp & 255u) == 0u) { if (xb_ld(&bar[XB_TMO])) break; if (sp > XB_SPIN_CAP) { atomicAdd(&bar[XB_TMO], 1u); break; } }
    }
    nloc = mine > 0u ? mine : 1u; nx = cnt > 0u ? cnt : 1u;
}

__device__ __forceinline__ void xcd_barrier(const XcdBarrier& b) {
    asm volatile("s_waitcnt vmcnt(0)" ::: "memory");
    __syncthreads();
    if (threadIdx.x == 0) {
        unsigned* bar = b.bar;
        __builtin_amdgcn_s_waitcnt(0);
        unsigned nloc = b.st[0], nx = b.st[1];
        if (nloc == 0u) { xcd_barrier_complete(bar, b.x, nloc, nx); b.st[0] = nloc; b.st[1] = nx; }
        const unsigned old = xb_add(&bar[XB_XSUB(b.x)], 1u);
        const unsigned gen = old / nloc;
        if (old + 1u == (gen + 1u) * nloc) {
            __builtin_amdgcn_fence(__ATOMIC_RELEASE, "agent");
            asm volatile("s_waitcnt vmcnt(0)" ::: "memory");
            const unsigned og = xb_add(&bar[XB_TOP], 1u);
            const unsigned tg = og / nx;
            if (og + 1u == (tg + 1u) * nx) xb_add(&bar[XB_TOPGEN], 1u);
            else XB_SPIN(xb_ld(&bar[XB_TOPGEN]) == tg, bar);
            __builtin_amdgcn_fence(__ATOMIC_ACQUIRE, "agent");
            xb_add(&bar[XB_XGEN(b.x)], 1u);
            asm volatile("s_waitcnt vmcnt(0)" ::: "memory");
        } else {
            XB_SPIN(xb_ld(&bar[XB_XGEN(b.x)]) == gen, bar);
            __builtin_amdgcn_fence(__ATOMIC_ACQUIRE, "agent");
            asm volatile("s_waitcnt vmcnt(0)" ::: "memory");
        }
    }
    __syncthreads();
}

constexpr int NWAVES = 8;
constexpr int T = 16384, D = 2048, NIN = 11264;
constexpr float LN_EPS = 1e-5f, GN_EPS = 64e-5f, ALPHA = 1.189207115002721f;
constexpr size_t MiB = 1u << 20;
constexpr size_t WS_CTL = 0, CTL_ZERO_BYTES = 1 * MiB;
constexpr size_t WS_WIN = 1 * MiB, WS_WUA = 45 * MiB, WS_WUB = 49 * MiB, WS_WO = 53 * MiB, WS_WQ = 61 * MiB, WS_WPG = 69 * MiB, WS_WPE = 77 * MiB;
constexpr size_t WS_L1 = 78 * MiB;
constexpr size_t WS_L2 = 79 * MiB + MiB / 2;
constexpr size_t WS_PB = 81 * MiB;
constexpr size_t WS_XB = 90 * MiB;
constexpr size_t WS_PROJ = 154 * MiB;
constexpr size_t WS_Q = WS_PROJ, WS_K = WS_PROJ + 32 * MiB, WS_V = WS_PROJ + 64 * MiB, WS_RR = WS_PROJ + 96 * MiB, WS_RK = WS_PROJ + 128 * MiB, WS_RV = WS_PROJ + 160 * MiB, WS_RC = WS_PROJ + 192 * MiB;
constexpr size_t WS_YB = WS_Q;
constexpr size_t WS_YRAW = WS_K;
constexpr size_t WS_GG = 474 * MiB;
constexpr size_t WS_DREG = 378 * MiB;
constexpr size_t WS_HID = WS_DREG;
constexpr size_t WS_XW = WS_DREG + 24 * MiB;
constexpr size_t WS_LW = WS_DREG;
constexpr size_t WS_AA = WS_DREG + 64 * MiB;
constexpr size_t WS_GATE = WS_DREG;
constexpr size_t WS_MIX = WS_XB, WS_PQ = WS_XB;
constexpr size_t WS_H1 = 186 * MiB;
constexpr size_t WS_X1 = 314 * MiB;
constexpr size_t WS_X1B = 442 * MiB;
constexpr size_t WS_PE = 154 * MiB;
constexpr size_t WS_YA = 506 * MiB;
constexpr size_t WS_IDX = 506 * MiB, WS_PG = 514 * MiB;
constexpr size_t WS_RKC = 538 * MiB;
constexpr size_t WS_END = 539 * MiB;
constexpr int CW_BAR = 4096;
constexpr int RING_OFF = 0, RING_BYTES = 131072, LDSCTL_OFF = RING_BYTES, MISC_OFF = LDSCTL_OFF + 320, LDS_BYTES = 147456;
constexpr int NPHASE = 13;
#ifndef MK_ONE_LAUNCH
#define MK_ONE_LAUNCH 0
#endif

struct Frame {
    LAS unsigned char* lds; volatile LAS unsigned* MISC; gu32* ctl;
    int tid, lane, wave, vcu, G;
};
__device__ __forceinline__ float wave_sum(float v) {
#pragma unroll
    for (int o = 1; o < 64; o <<= 1) v += __shfl_xor(v, o);
    return v;
}
__device__ __forceinline__ float wave_max(float v) {
#pragma unroll
    for (int o = 1; o < 64; o <<= 1) v = fmaxf(v, __shfl_xor(v, o));
    return v;
}
__device__ __forceinline__ float bflo(unsigned w) { return __uint_as_float(w << 16); }
__device__ __forceinline__ float bfhi(unsigned w) { return __uint_as_float(w & 0xffff0000u); }
__device__ __forceinline__ float bf1(bf16 b) { return __uint_as_float(((unsigned)b) << 16); }
typedef __attribute__((ext_vector_type(2))) __bf16 bf16x2_t;
typedef float f32x16 __attribute__((ext_vector_type(16)));
__device__ __forceinline__ float dot2(unsigned a, unsigned b, float c) { return __builtin_amdgcn_fdot2_f32_bf16(__builtin_bit_cast(bf16x2_t, a), __builtin_bit_cast(bf16x2_t, b), c, false); }
__device__ __forceinline__ float rdlane(float v, int l) { return __builtin_bit_cast(float, __builtin_amdgcn_readlane(__builtin_bit_cast(int, v), l)); }
__device__ __forceinline__ int rdlanei(int v, int l) { return __builtin_amdgcn_readlane(v, l); }

__device__ __forceinline__ void p0_transpose_item(const float* W, int K, int N, bf16* WT, LAS float* scr, int item, int lane) {
    const int nblk = N / 32, kb = item / nblk, nb = item % nblk, k0 = 64 * kb, n0 = 32 * nb;
#pragma unroll 8
    for (int i = 0; i < 32; ++i) { const int kk = 2 * i + (lane >> 5); scr[kk * 33 + (lane & 31)] = W[(size_t)(k0 + kk) * N + n0 + (lane & 31)]; }
    LDS_WAIT(); asm volatile("" ::: "memory");
    const int c = lane & 7;
#pragma unroll
    for (int j = 0; j < 4; ++j) { const int n = (lane >> 3) + 8 * j; const LAS float* s = scr + (8 * c) * 33 + n;
        v4u o; o.x = pk2(s[0 * 33], s[1 * 33]); o.y = pk2(s[2 * 33], s[3 * 33]); o.z = pk2(s[4 * 33], s[5 * 33]); o.w = pk2(s[6 * 33], s[7 * 33]);
        *(GAS v4u*)(WT + (size_t)(n0 + n) * K + k0 + 8 * c) = o; }
    LDS_WAIT(); asm volatile("" ::: "memory");
}
__device__ __forceinline__ void cvt_rows_bf16(const float* src, bf16* dst, size_t n8, size_t i0, size_t stride) {
    for (size_t i = i0; i < n8; i += stride) { const f32x4 a = ((const GAS f32x4*)src)[2 * i], b = ((const GAS f32x4*)src)[2 * i + 1];
        v4u o; o.x = pk2(a.x, a.y); o.y = pk2(a.z, a.w); o.z = pk2(b.x, b.y); o.w = pk2(b.z, b.w); ((GAS v4u*)dst)[i] = o; }
}


#ifndef P4_VARIANT
#define P4_VARIANT 0
#endif
#ifndef P4_ALIGN
#define P4_ALIGN PG8_ALIGN
#endif
#ifndef P4_SP2
#define P4_SP2 PG8_SP2
#endif
#ifndef DIAG_TOL
#define DIAG_TOL 0.03f
#endif
#ifndef DIAG_UNIT_MS
#define DIAG_UNIT_MS 10
#endif
#ifndef DIAG_LAST
#define DIAG_LAST -1
#endif
template <class TT_> __device__ __forceinline__ float dg_val(const TT_* p, size_t i);
template <> __device__ __forceinline__ float dg_val<float>(const float* p, size_t i) { return p[i]; }
template <> __device__ __forceinline__ float dg_val<bf16>(const bf16* p, size_t i) { return bf1(p[i]); }
template <> __device__ __forceinline__ float dg_val<int>(const int* p, size_t i) { return (float)p[i] * (1.0f / 1024.0f); }
template <class TT_> __device__ __forceinline__ void digest(float* out, int slot, const TT_* buf, size_t n, size_t gt, size_t NGT) {
    constexpr size_t M = (size_t)1024 * 2048;
    for (size_t e = gt; e < M; e += NGT) { float s = 0.f; for (size_t j = e; j < n; j += M) s += dg_val<TT_>(buf, j); out[(size_t)slot * M + e] = s; }
}

struct Args { const float* in[30]; float* out; unsigned char* ws; int ph_lo, ph_hi, li, pad; };

__global__ void __launch_bounds__(NWAVES * 64, 2) mk_fwd(Args args) {
    extern __shared__ __attribute__((aligned(16))) unsigned char lds[];
    for (int u = threadIdx.x; u < (LDS_BYTES - LDSCTL_OFF) / 4; u += NWAVES * 64) ((LAS unsigned*)((LAS unsigned char*)lds + LDSCTL_OFF))[u] = 0u;
    __syncthreads();
    XcdBarrier bar; bar.bar = (unsigned*)(args.ws + WS_CTL) + CW_BAR; bar.x = 0; bar.st = nullptr;
    if (MK_ONE_LAUNCH) bar = xcd_barrier_post((unsigned*)(args.ws + WS_CTL) + CW_BAR, (volatile LAS unsigned*)((LAS unsigned char*)lds + MISC_OFF) + 8);
    const int lo = args.ph_lo, hi = args.ph_hi;
#ifdef DIAG_TIME
    if (blockIdx.x == 0 && threadIdx.x == 0) { const unsigned long long t0_ = __builtin_amdgcn_s_memrealtime(); ((unsigned long long*)(args.ws + WS_CTL))[8] = t0_; }
#endif
#ifndef PHMASK
#define PHMASK 0xffffffffu
#endif
#define IN(k) (((PHMASK >> (k)) & 1u) && lo <= (k) && (k) < hi)
#define SEAM(k) do { if (IN(k) && IN((k) + 1)) xcd_barrier(bar); } while (0)
#define LOCALS const int tid = threadIdx.x, lane = tid & 63, wave = __builtin_amdgcn_readfirstlane(tid >> 6); const int G_ = gridDim.x, bx_ = blockIdx.x, vcu = (G_ % 8 == 0) ? (bx_ % 8) * (G_ / 8) + bx_ / 8 : bx_; \
    const int gw = vcu * NWAVES + wave, NGW = G_ * NWAVES; const size_t gt = (size_t)vcu * 512 + tid, NGT = (size_t)G_ * 512; (void)lane; (void)gw; (void)NGW; (void)gt; (void)NGT;
#define LDSP ((LAS unsigned char*)lds)
#define x_in (args.in[0])
#define p_in (args.in[1])
#define w_in (args.in[2])
#define mu (args.in[3])
#define w0 (args.in[4])
#define wl1 (args.in[5])
#define wl2 (args.in[6])
#define a0 (args.in[7])
#define al1 (args.in[8])
#define al2 (args.in[9])
#define gl1 (args.in[10])
#define gl2 (args.in[11])
#define k_k (args.in[12])
#define k_a (args.in[13])
#define r_k (args.in[14])
#define lnx_w (args.in[15])
#define lnx_b (args.in[16])
#define w_up_a (args.in[17])
#define w_up_b (args.in[18])
#define w_o (args.in[19])
#define ln1_w (args.in[20])
#define ln1_b (args.in[21])
#define peer_wq (args.in[22])
#define sub_keys (args.in[23])
#define peer_u (args.in[24])
#define peer_v (args.in[25])
#define ple_wg (args.in[26])
#define ple_wp (args.in[27])
#define ln2_w (args.in[28])
#define ln2_b (args.in[29])
#define WIN_T ((bf16*)(args.ws + WS_WIN))
#define WUA_T ((bf16*)(args.ws + WS_WUA))
#define WUB_T ((bf16*)(args.ws + WS_WUB))
#define WO_T ((bf16*)(args.ws + WS_WO))
#define WQ_T ((bf16*)(args.ws + WS_WQ))
#define WPG_T ((bf16*)(args.ws + WS_WPG))
#define WPE_T ((bf16*)(args.ws + WS_WPE))
#define L1_T ((bf16*)(args.ws + WS_L1))
#define L2_T ((bf16*)(args.ws + WS_L2))
#define PB ((bf16*)(args.ws + WS_PB))
#define XB ((bf16*)(args.ws + WS_XB))
#define QB ((bf16*)(args.ws + WS_Q))
#define KB ((bf16*)(args.ws + WS_K))
#define VB ((bf16*)(args.ws + WS_V))
#define RR ((bf16*)(args.ws + WS_RR))
#define RK ((bf16*)(args.ws + WS_RK))
#define RV ((bf16*)(args.ws + WS_RV))
#define RC ((bf16*)(args.ws + WS_RC))
#define YA ((bf16*)(args.ws + WS_YA))
#define YB ((bf16*)(args.ws + WS_YB))
#define YRAW ((float*)(args.ws + WS_YRAW))
#define GG ((bf16*)(args.ws + WS_GG))
#define HID ((bf16*)(args.ws + WS_HID))
#define XW ((bf16*)(args.ws + WS_XW))
#define LW ((float*)(args.ws + WS_LW))
#define AA ((bf16*)(args.ws + WS_AA))
#define GATE ((bf16*)(args.ws + WS_GATE))
#define MIX ((bf16*)(args.ws + WS_MIX))
#define PQ ((bf16*)(args.ws + WS_PQ))
#define H1 ((float*)(args.ws + WS_H1))
#define X1 ((float*)(args.ws + WS_X1))
#define X1B ((bf16*)(args.ws + WS_X1B))
#define PE ((bf16*)(args.ws + WS_PE))
#define IDX ((int*)(args.ws + WS_IDX))
#define PG ((float*)(args.ws + WS_PG))
#define RKC ((float*)(args.ws + WS_RKC))
    if (IN(0)) {
        LOCALS
        LAS float* scr = (LAS float*)(LDSP + RING_OFF + wave * 16384);
        constexpr int I_IN = (D / 64) * (NIN / 32), I_UA = (1024 / 64) * (D / 32), I_SQ = (D / 64) * (D / 32), I_PE = (256 / 64) * (D / 32);
        constexpr int NITEMS = I_IN + 2 * I_UA + 3 * I_SQ + I_PE;
        for (int it = gw; it < NITEMS; it += NGW) {
            int r = it;
            if (r < I_IN) { p0_transpose_item(w_in, D, NIN, WIN_T, scr, r, lane); continue; } r -= I_IN;
            if (r < I_UA) { p0_transpose_item(w_up_a, 1024, D, WUA_T, scr, r, lane); continue; } r -= I_UA;
            if (r < I_UA) { p0_transpose_item(w_up_b, 1024, D, WUB_T, scr, r, lane); continue; } r -= I_UA;
            if (r < I_SQ) { p0_transpose_item(w_o, D, D, WO_T, scr, r, lane); continue; } r -= I_SQ;
            if (r < I_SQ) { p0_transpose_item(peer_wq, D, D, WQ_T, scr, r, lane); continue; } r -= I_SQ;
            if (r < I_SQ) { p0_transpose_item(ple_wg, D, D, WPG_T, scr, r, lane); continue; } r -= I_SQ;
            p0_transpose_item(ple_wp, 256, D, WPE_T, scr, r, lane);
        }
        for (size_t i = gt; i < (size_t)2 * 294912; i += NGT) {
            if (i < 294912) { const int j = (int)(i >> 10), k = (int)(i & 1023);
                const float v = j < 64 ? wl1[(size_t)k * 64 + j] : (j < 128 ? al1[(size_t)k * 64 + (j - 64)] : gl1[(size_t)k * 160 + (j - 128)]);
                L1_T[i] = (bf16)f2bf(v); }
            else { const int e = (int)(i - 294912); float v;
                if (e < 65536) { const int c = e >> 6, j = e & 63; v = wl2[(size_t)j * 1024 + c]; }
                else if (e < 131072) { const int e2 = e - 65536, c = e2 >> 6, j = e2 & 63; v = al2[(size_t)j * 1024 + c]; }
                else { const int e2 = e - 131072, c = e2 / 160, j = e2 % 160; v = gl2[(size_t)j * 1024 + c]; }
                L2_T[e] = (bf16)f2bf(v); }
        }
        cvt_rows_bf16(x_in, XB, (size_t)T * D / 8, gt, NGT);
        cvt_rows_bf16(p_in, PB, (size_t)T * 256 / 8, gt, NGT);
    }
    SEAM(0);
    if (IN(1)) {
        LOCALS
        pg8::Gemm g{XB, WIN_T, T, 7168, D}; pg8::StaticOrder S; S.init(T, 7168, (int)gridDim.x, (int)blockIdx.x);
        pg8::EpiB16<pg8::FnProj> E{{QB}};
        pg8::gemm_phase<pg8::EpiB16<pg8::FnProj>, pg8::StaticOrder, PG8_ALIGN, PG8_SP2>(LDSP + RING_OFF, g, S, E);
    }
    SEAM(1);
    if (IN(2)) {
        LOCALS
        for (int item = gw; item < 16 * T; item += NGW) {
            const int head = item & 15, t = item >> 4;
            const GAS v4u* qr = (const GAS v4u*)(QB + (size_t)t * 1024 + head * 64);
            v4u qv[8];
#pragma unroll
            for (int i = 0; i < 8; ++i) qv[i] = qr[i];
            float o = 0.f, carry = 0.f;
            for (int sb = t - 1; sb >= 0; sb -= 64) {
                const int s = sb - lane; const bool valid = s >= 0; const int sc = valid ? s : 0;
                const GAS v4u* kr = (const GAS v4u*)(KB + (size_t)sc * 1024 + head * 64);
                float z = 0.f;
#pragma unroll
                for (int i = 0; i < 8; ++i) { const v4u kv = kr[i]; z = dot2(kv.x, qv[i].x, z); z = dot2(kv.y, qv[i].y, z); z = dot2(kv.z, qv[i].z, z); z = dot2(kv.w, qv[i].w, z); }
                const float lk = valid ? -(fmaxf(z, 0.f) + __logf(1.0f + __expf(-fabsf(z)))) : 0.f;
                float cs = lk;
#pragma unroll
                for (int off = 1; off < 64; off <<= 1) { const float n = __shfl_up(cs, off); if (lane >= off) cs += n; }
                const float w = valid ? __expf(z + cs + carry) : 0.f;
                carry += rdlane(cs, 63);
                const int nk = (sb + 1 < 64) ? sb + 1 : 64;
                const GAS bf16* vp = (const GAS bf16*)(VB + (size_t)sb * 1024 + head * 64 + lane);
                for (int j = 0; j < nk; ++j) { const float wj = rdlane(w, j); o += wj * bf1(vp[-(ptrdiff_t)j * 1024]); }
                if (carry < -104.0f) break;
            }
            YA[(size_t)t * 1024 + head * 64 + lane] = (bf16)f2bf(o);
        }
        for (int tile = gw; tile < T / 32; tile += NGW) {
            const int n = lane & 31, h = lane >> 5, t = tile * 32 + n;
            f32x16 C1[9];
#pragma unroll
            for (int m = 0; m < 9; ++m)
#pragma unroll
                for (int i = 0; i < 16; ++i) C1[m][i] = 0.f;
#pragma unroll 2
            for (int ks = 0; ks < 64; ++ks) {
                const int k0 = ks * 16 + 8 * h;
                const v4u cv = *(const GAS v4u*)(RC + (size_t)t * 1024 + k0); v4u pv = (v4u){0u, 0u, 0u, 0u}; if (t > 0) pv = *(const GAS v4u*)(RC + (size_t)(t - 1) * 1024 + k0);
                const float c[8] = {bflo(cv.x), bfhi(cv.x), bflo(cv.y), bfhi(cv.y), bflo(cv.z), bfhi(cv.z), bflo(cv.w), bfhi(cv.w)};
                const float p[8] = {bflo(pv.x), bfhi(pv.x), bflo(pv.y), bfhi(pv.y), bflo(pv.z), bfhi(pv.z), bflo(pv.w), bfhi(pv.w)};
                bf16x8 xf[3];
#pragma unroll
                for (int m = 0; m < 3; ++m) { const GAS f32x4* mm = (const GAS f32x4*)(mu + (3 + m) * 1024 + k0); const f32x4 m0 = mm[0], m1 = mm[1];
                    const float mv[8] = {m0.x, m0.y, m0.z, m0.w, m1.x, m1.y, m1.z, m1.w}; float o[8];
#pragma unroll
                    for (int j = 0; j < 8; ++j) o[j] = c[j] + (p[j] - c[j]) * mv[j];
                    v4u w; w.x = pk2(o[0], o[1]); w.y = pk2(o[2], o[3]); w.z = pk2(o[4], o[5]); w.w = pk2(o[6], o[7]); xf[m] = __builtin_bit_cast(bf16x8, w); }
#pragma unroll
                for (int m = 0; m < 9; ++m) { const bf16x8 af = *(const GAS bf16x8*)(L1_T + (size_t)(m * 32 + n) * 1024 + k0);
                    C1[m] = __builtin_amdgcn_mfma_f32_32x32x16_bf16(af, xf[m < 2 ? 0 : (m < 4 ? 1 : 2)], C1[m], 0, 0, 0); }
            }
            bf16x8 hf[18];
#pragma unroll
            for (int m = 0; m < 9; ++m)
#pragma unroll
                for (int s2 = 0; s2 < 2; ++s2) { float v[8];
#pragma unroll
                    for (int j = 0; j < 8; ++j) { const float x = C1[m][8 * s2 + j]; v[j] = m < 2 ? pg8::ftanh(x) : (m < 4 ? x : pg8::fsigmoid(x)); }
                    v4u w; w.x = pk2(v[0], v[1]); w.y = pk2(v[2], v[3]); w.z = pk2(v[4], v[5]); w.w = pk2(v[6], v[7]); hf[2 * m + s2] = __builtin_bit_cast(bf16x8, w); }
            typedef unsigned long long u64;
            for (int ct = 0; ct < 32; ++ct) {
                const int cch = ct * 32 + n;
                f32x16 Yw, Ya, Yg;
#pragma unroll
                for (int i = 0; i < 16; ++i) { Yw[i] = 0.f; Ya[i] = 0.f; Yg[i] = 0.f; }
#pragma unroll
                for (int s2 = 0; s2 < 4; ++s2) { const int j0 = 16 * s2 + 4 * h;
                    const GAS u64* rw = (const GAS u64*)(L2_T + (size_t)cch * 64 + j0); const GAS u64* ra = (const GAS u64*)(L2_T + 65536 + (size_t)cch * 64 + j0);
                    const u64 w0v = rw[0], w1v = rw[2], a0v = ra[0], a1v = ra[2];
                    const v4u wa = (v4u){(unsigned)w0v, (unsigned)(w0v >> 32), (unsigned)w1v, (unsigned)(w1v >> 32)}, aa4 = (v4u){(unsigned)a0v, (unsigned)(a0v >> 32), (unsigned)a1v, (unsigned)(a1v >> 32)};
                    Yw = __builtin_amdgcn_mfma_f32_32x32x16_bf16(__builtin_bit_cast(bf16x8, wa), hf[s2], Yw, 0, 0, 0);
                    Ya = __builtin_amdgcn_mfma_f32_32x32x16_bf16(__builtin_bit_cast(bf16x8, aa4), hf[4 + s2], Ya, 0, 0, 0); }
#pragma unroll
                for (int s2 = 0; s2 < 10; ++s2) { const int j0 = 16 * s2 + 4 * h;
                    const GAS u64* rg = (const GAS u64*)(L2_T + 131072 + (size_t)cch * 160 + j0); const u64 g0v = rg[0], g1v = rg[2];
                    const v4u ga = (v4u){(unsigned)g0v, (unsigned)(g0v >> 32), (unsigned)g1v, (unsigned)(g1v >> 32)};
                    Yg = __builtin_amdgcn_mfma_f32_32x32x16_bf16(__builtin_bit_cast(bf16x8, ga), hf[8 + s2], Yg, 0, 0, 0); }
#pragma unroll
                for (int q = 0; q < 4; ++q) { const int c0 = ct * 32 + 8 * q + 4 * h;
                    const f32x4 wb = *(const GAS f32x4*)(w0 + c0), ab = *(const GAS f32x4*)(a0 + c0); f32x4 lwv; float av[4], gv[4];
#pragma unroll
                    for (int j = 0; j < 4; ++j) { lwv[j] = -__expf(-pg8::fsoftplus(-(wb[j] + Yw[4 * q + j])) - 0.5f); av[j] = pg8::fsigmoid(ab[j] + Ya[4 * q + j]); gv[j] = Yg[4 * q + j]; }
                    *(GAS f32x4*)(LW + (size_t)t * 1024 + c0) = lwv;
                    *(GAS u64*)(AA + (size_t)t * 1024 + c0) = (u64)pk2(av[0], av[1]) | ((u64)pk2(av[2], av[3]) << 32);
                    *(GAS u64*)(GG + (size_t)t * 1024 + c0) = (u64)pk2(gv[0], gv[1]) | ((u64)pk2(gv[2], gv[3]) << 32); }
            }
        }
    }
    SEAM(2);
    if (IN(3)) {
        LOCALS
        if (blockIdx.x < 16) {
            const int head = (int)blockIdx.x, v = 8 * wave + (lane >> 3), kq = lane & 7, ch0 = head * 64 + 8 * kq, chv = head * 64 + v;
            float mur[8], muk[8], ckk[8], cka[8], crk[8];
#pragma unroll
            for (int i = 0; i < 8; ++i) { mur[i] = mu[ch0 + i]; muk[i] = mu[1024 + ch0 + i]; ckk[i] = k_k[ch0 + i]; cka[i] = k_a[ch0 + i]; crk[i] = r_k[ch0 + i]; }
            const float muv = mu[2048 + chv];
            float S[8], rp[8], kp[8]; float vp = 0.f;
#pragma unroll
            for (int i = 0; i < 8; ++i) { S[i] = 0.f; rp[i] = 0.f; kp[i] = 0.f; }
            v4u nr = *(const GAS v4u*)(RR + ch0), nk = *(const GAS v4u*)(RK + ch0), na = *(const GAS v4u*)(AA + ch0);
            f32x4 nl0 = *(const GAS f32x4*)(LW + ch0), nl1 = *(const GAS f32x4*)(LW + ch0 + 4); bf16 nv = RV[chv];
            for (int t = 0; t < T; ++t) {
                const v4u cr = nr, ck = nk, ca = na; const f32x4 l0 = nl0, l1 = nl1; const bf16 cvv = nv;
                { const int tn = (t + 1 < T) ? t + 1 : t; const size_t o = (size_t)tn * 1024;
                  nr = *(const GAS v4u*)(RR + o + ch0); nk = *(const GAS v4u*)(RK + o + ch0); na = *(const GAS v4u*)(AA + o + ch0);
                  nl0 = *(const GAS f32x4*)(LW + o + ch0); nl1 = *(const GAS f32x4*)(LW + o + ch0 + 4); nv = RV[o + chv]; }
                const float r[8] = {bflo(cr.x), bfhi(cr.x), bflo(cr.y), bfhi(cr.y), bflo(cr.z), bfhi(cr.z), bflo(cr.w), bfhi(cr.w)};
                const float k[8] = {bflo(ck.x), bfhi(ck.x), bflo(ck.y), bfhi(ck.y), bflo(ck.z), bfhi(ck.z), bflo(ck.w), bfhi(ck.w)};
                float a[8] = {bflo(ca.x), bfhi(ca.x), bflo(ca.y), bfhi(ca.y), bflo(ca.z), bfhi(ca.z), bflo(ca.w), bfhi(ca.w)};
                float lw[8] = {l0.x, l0.y, l0.z, l0.w, l1.x, l1.y, l1.z, l1.w};
                const float vc = bf1(cvv); const float vs = vc + (vp - vc) * muv;
                float rs[8], ks[8], kk[8]; float nrm = 0.f;
#pragma unroll
                for (int i = 0; i < 8; ++i) { rs[i] = r[i] + (rp[i] - r[i]) * mur[i]; ks[i] = k[i] + (kp[i] - k[i]) * muk[i]; kk[i] = ks[i] * ckk[i]; nrm += kk[i] * kk[i]; }
                nrm += __shfl_xor(nrm, 1); nrm += __shfl_xor(nrm, 2); nrm += __shfl_xor(nrm, 4);
                const float inv = 1.0f / fmaxf(sqrtf(nrm), 1e-12f);
                float sa = 0.f, km[8];
#pragma unroll
                for (int i = 0; i < 8; ++i) { kk[i] *= inv; km[i] = ks[i] * (1.0f + (a[i] - 1.0f) * cka[i]); sa -= S[i] * kk[i]; }
                sa += __shfl_xor(sa, 1); sa += __shfl_xor(sa, 2); sa += __shfl_xor(sa, 4);
                float y = 0.f, rkc = 0.f;
#pragma unroll
                for (int i = 0; i < 8; ++i) { S[i] = S[i] * __expf(lw[i]) + sa * (kk[i] * a[i]) + vs * km[i]; y += S[i] * rs[i]; rkc += rs[i] * km[i] * crk[i]; }
                y += __shfl_xor(y, 1); y += __shfl_xor(y, 2); y += __shfl_xor(y, 4);
                rkc += __shfl_xor(rkc, 1); rkc += __shfl_xor(rkc, 2); rkc += __shfl_xor(rkc, 4);
                if (kq == 0) YRAW[(size_t)t * 1024 + chv] = y;
                if (tid == 0) RKC[t * 16 + head] = rkc;
#pragma unroll
                for (int i = 0; i < 8; ++i) { rp[i] = r[i]; kp[i] = k[i]; }
                vp = vc;
            }
        }
    }
    SEAM(3);
    if (IN(4)) {
        LOCALS
        for (int item = gw; item < 16 * T; item += NGW) {
            const int head = item & 15, t = item >> 4, ch = head * 64 + lane; const size_t o = (size_t)t * 1024 + ch;
            const float y = YRAW[o]; const float mean = wave_sum(y) * (1.0f / 64.0f); const float d = y - mean; const float var = wave_sum(d * d) * (1.0f / 64.0f);
            const float yn = d * (1.0f / sqrtf(var + GN_EPS)) * lnx_w[ch] + lnx_b[ch];
            const float vc = bf1(RV[o]); const float vpv = t > 0 ? bf1(RV[o - 1024]) : 0.f; const float vs = vc + (vpv - vc) * mu[2048 + ch];
            YB[o] = (bf16)f2bf((yn + RKC[t * 16 + head] * vs) * bf1(GG[o]));
        }
    }
    SEAM(4);
    if (IN(5)) {
        LOCALS
        pg8::Gemm g{XB, WIN_T + (size_t)7168 * D, T, 4096, D}; pg8::StaticOrder S; S.init(T, 4096, (int)gridDim.x, (int)blockIdx.x);
        pg8::EpiB16<pg8::FnGate> E{{GATE}};
        pg8::gemm_phase<pg8::EpiB16<pg8::FnGate>, pg8::StaticOrder, PG8_ALIGN, PG8_SP2>(LDSP + RING_OFF, g, S, E);
    }
    SEAM(5);
    if (IN(7)) {
        LOCALS
        { pg8::Gemm g{YA, WUA_T, T, D, 1024}; pg8::StaticOrder S; S.init(T, D, (int)gridDim.x, (int)blockIdx.x);
          pg8::EpiB16<pg8::FnMix<0>> E{{GATE, MIX}};
          pg8::gemm_phase<pg8::EpiB16<pg8::FnMix<0>>, pg8::StaticOrder, PG8_ALIGN, PG8_SP2>(LDSP + RING_OFF, g, S, E); }
        __syncthreads();
        { pg8::Gemm g{YB, WUB_T, T, D, 1024}; pg8::StaticOrder S; S.init(T, D, (int)gridDim.x, (int)blockIdx.x);
          pg8::EpiB16<pg8::FnMix<1>> E{{GATE + (size_t)T * 2048, MIX}};
          pg8::gemm_phase<pg8::EpiB16<pg8::FnMix<1>>, pg8::StaticOrder, PG8_ALIGN, PG8_SP2>(LDSP + RING_OFF, g, S, E); }
    }
    SEAM(7);
    if (IN(8)) {
        LOCALS
        pg8::Gemm g{MIX, WO_T, T, D, D}; pg8::StaticOrder S; S.init(T, D, (int)gridDim.x, (int)blockIdx.x);
        pg8::EpiF32x<pg8::FnWo> E{{x_in, H1, ALPHA}};
        pg8::gemm_phase<pg8::EpiF32x<pg8::FnWo>, pg8::StaticOrder, PG8_ALIGN, PG8_SP2>(LDSP + RING_OFF, g, S, E);
    }
    SEAM(8);
    if (IN(9)) {
        LOCALS
        for (int t = gw; t < T; t += NGW) {
            const GAS f32x4* hr = (const GAS f32x4*)(H1 + (size_t)t * D) + lane; f32x4 v[8]; float s = 0.f;
#pragma unroll
            for (int j = 0; j < 8; ++j) { v[j] = hr[64 * j]; s += (v[j].x + v[j].y) + (v[j].z + v[j].w); }
            const float mean = wave_sum(s) * (1.0f / D); float q = 0.f;
#pragma unroll
            for (int j = 0; j < 8; ++j) { v[j] = v[j] - mean; q += (v[j].x * v[j].x + v[j].y * v[j].y) + (v[j].z * v[j].z + v[j].w * v[j].w); }
            const float rstd = 1.0f / sqrtf(wave_sum(q) * (1.0f / D) + LN_EPS);
#pragma unroll
            for (int j = 0; j < 8; ++j) { const f32x4 gg = ((const GAS f32x4*)ln1_w)[64 * j + lane], bb = ((const GAS f32x4*)ln1_b)[64 * j + lane]; const f32x4 o = v[j] * rstd * gg + bb;
                ((GAS f32x4*)(X1 + (size_t)t * D))[64 * j + lane] = o;
                ((GAS unsigned long long*)(X1B + (size_t)t * D))[64 * j + lane] = (unsigned long long)pk2(o.x, o.y) | ((unsigned long long)pk2(o.z, o.w) << 32); }
        }
    }
    SEAM(9);
    if (IN(10)) {
        LOCALS
        { pg8::Gemm g{X1B, WQ_T, T, D, D}; pg8::StaticOrder S; S.init(T, D, (int)gridDim.x, (int)blockIdx.x);
          pg8::EpiB16<pg8::FnPlain16> E{{PQ, D}};
          pg8::gemm_phase<pg8::EpiB16<pg8::FnPlain16>, pg8::StaticOrder, PG8_ALIGN, PG8_SP2>(LDSP + RING_OFF, g, S, E); }
        for (int task = gw; task < (T / 32) * 4; task += NGW) {
            const int tile = task >> 2, cg = task & 3, n = lane & 31, h = lane >> 5, t = tile * 32 + n;
            bf16x8 bfr[16];
#pragma unroll
            for (int ks = 0; ks < 16; ++ks) bfr[ks] = *(const GAS bf16x8*)(PB + (size_t)t * 256 + ks * 16 + 8 * h);
            for (int ci = 0; ci < 16; ++ci) {
                const int ct = cg * 16 + ci; f32x16 Y;
#pragma unroll
                for (int i = 0; i < 16; ++i) Y[i] = 0.f;
#pragma unroll
                for (int ks = 0; ks < 16; ++ks) { const bf16x8 af = *(const GAS bf16x8*)(WPE_T + (size_t)(ct * 32 + n) * 256 + ks * 16 + 8 * h); Y = __builtin_amdgcn_mfma_f32_32x32x16_bf16(af, bfr[ks], Y, 0, 0, 0); }
#pragma unroll
                for (int q = 0; q < 4; ++q) *(GAS unsigned long long*)(PE + (size_t)t * D + ct * 32 + 8 * q + 4 * h) = (unsigned long long)pk2(Y[4 * q], Y[4 * q + 1]) | ((unsigned long long)pk2(Y[4 * q + 2], Y[4 * q + 3]) << 32);
            }
        }
    }
    SEAM(10);
    if (IN(11)) {
        LOCALS
        { pg8::Gemm g{X1B, WPG_T, T, D, D}; pg8::StaticOrder S; S.init(T, D, (int)gridDim.x, (int)blockIdx.x);
          pg8::EpiB16<pg8::FnPle> E{{PE}};
          pg8::gemm_phase<pg8::EpiB16<pg8::FnPle>, pg8::StaticOrder, PG8_ALIGN, PG8_SP2>(LDSP + RING_OFF, g, S, E); }
        __syncthreads();
        LAS bf16* SK = (LAS bf16*)(LDSP + RING_OFF);
        for (int i = tid; i < 32768; i += 512) { const int row = i >> 7, d = i & 127; SK[row * 132 + d] = (bf16)f2bf(sub_keys[i]); }
        __syncthreads();
        for (int item = gw; item < 8 * T; item += NGW) {
            const int h = item & 7, t = item >> 3;
            const GAS unsigned* qp = (const GAS unsigned*)(PQ + (size_t)t * D + h * 256);
            const unsigned q0 = qp[lane], q1 = qp[64 + lane];
            float s00 = 0.f, s01 = 0.f, s10 = 0.f, s11 = 0.f;
            const LAS unsigned long long* r00 = (const LAS unsigned long long*)(SK + (size_t)(lane) * 132);
            const LAS unsigned long long* r01 = (const LAS unsigned long long*)(SK + (size_t)(lane + 64) * 132);
            const LAS unsigned long long* r10 = (const LAS unsigned long long*)(SK + (size_t)(128 + lane) * 132);
            const LAS unsigned long long* r11 = (const LAS unsigned long long*)(SK + (size_t)(192 + lane) * 132);
#pragma unroll 8
            for (int i = 0; i < 32; ++i) {
                const unsigned qa0 = (unsigned)rdlanei((int)q0, 2 * i), qb0 = (unsigned)rdlanei((int)q0, 2 * i + 1), qa1 = (unsigned)rdlanei((int)q1, 2 * i), qb1 = (unsigned)rdlanei((int)q1, 2 * i + 1);
                const unsigned long long a = r00[i], b = r01[i], c = r10[i], d = r11[i];
                s00 = dot2((unsigned)a, qa0, s00); s00 = dot2((unsigned)(a >> 32), qb0, s00);
                s01 = dot2((unsigned)b, qa0, s01); s01 = dot2((unsigned)(b >> 32), qb0, s01);
                s10 = dot2((unsigned)c, qa1, s10); s10 = dot2((unsigned)(c >> 32), qb1, s10);
                s11 = dot2((unsigned)d, qa1, s11); s11 = dot2((unsigned)(d >> 32), qb1, s11);
            }
            const float NEG = -3.0e38f;
            float ts0 = NEG, ts1 = NEG; int ti0 = 0, ti1 = 0;
#pragma unroll 1
            for (int c = 0; c < 2; ++c) {
                float v0 = c ? s10 : s00, v1 = c ? s11 : s01; float ts = NEG; int ti = 0;
                for (int it = 0; it < 16; ++it) {
                    const float m = wave_max(fmaxf(v0, v1));
                    const unsigned long long b0 = __ballot(v0 == m), b1 = __ballot(v1 == m);
                    int key;
                    if (b0) { const int l = __ffsll((long long)b0) - 1; key = l; if (lane == l) v0 = NEG; }
                    else { const int l = __ffsll((long long)b1) - 1; key = l + 64; if (lane == l) v1 = NEG; }
                    if (lane == it) { ts = m; ti = key; }
                }
                if (c) { ts1 = ts; ti1 = ti; } else { ts0 = ts; ti0 = ti; }
            }
            const int ci = lane & 15, jb = (lane >> 4) * 4;
            const float a_s = __shfl(ts0, ci); const int a_i = __shfl(ti0, ci);
            float cs[4]; int ce[4];
#pragma unroll
            for (int jj = 0; jj < 4; ++jj) { cs[jj] = a_s + __shfl(ts1, jb + jj); ce[jj] = a_i * 128 + __shfl(ti1, jb + jj); }
            float bs = NEG; int be = 0;
            for (int it = 0; it < 16; ++it) {
                const float m = wave_max(fmaxf(fmaxf(cs[0], cs[1]), fmaxf(cs[2], cs[3])));
                const unsigned long long b0 = __ballot(cs[0] == m), b1 = __ballot(cs[1] == m), b2 = __ballot(cs[2] == m), b3 = __ballot(cs[3] == m);
                int e;
                if (b0) { const int l = __ffsll((long long)b0) - 1; e = rdlanei(ce[0], l); if (lane == l) cs[0] = NEG; }
                else if (b1) { const int l = __ffsll((long long)b1) - 1; e = rdlanei(ce[1], l); if (lane == l) cs[1] = NEG; }
                else if (b2) { const int l = __ffsll((long long)b2) - 1; e = rdlanei(ce[2], l); if (lane == l) cs[2] = NEG; }
                else { const int l = __ffsll((long long)b3) - 1; e = rdlanei(ce[3], l); if (lane == l) cs[3] = NEG; }
                if (lane == it) { bs = m; be = e; }
            }
            const float mx = rdlane(bs, 0); const float ex = lane < 16 ? __expf(bs - mx) : 0.f; const float sum = wave_sum(ex);
            if (lane < 16) { IDX[(size_t)t * 128 + h * 16 + lane] = be; PG[(size_t)t * 128 + h * 16 + lane] = ex / sum; }
        }
    }
    SEAM(11);
    if (IN(12)) {
        LOCALS
        for (int t = gw; t < T; t += NGW) {
            f32x4 xv[8], fv[8];
#pragma unroll
            for (int j = 0; j < 8; ++j) { xv[j] = ((const GAS f32x4*)(X1 + (size_t)t * D))[64 * j + lane]; fv[j] = (f32x4){0.f, 0.f, 0.f, 0.f}; }
            const int e0 = IDX[(size_t)t * 128 + lane], e1 = IDX[(size_t)t * 128 + 64 + lane]; const float g0 = PG[(size_t)t * 128 + lane], g1 = PG[(size_t)t * 128 + 64 + lane];
#pragma unroll 2
            for (int j = 0; j < 128; ++j) {
                const int e = j < 64 ? rdlanei(e0, j) : rdlanei(e1, j - 64); const float gte = j < 64 ? rdlane(g0, j) : rdlane(g1, j - 64);
                const GAS f32x4* ur = (const GAS f32x4*)(peer_u + (size_t)e * D) + lane; float hsum = 0.f;
#pragma unroll
                for (int jj = 0; jj < 8; ++jj) { const f32x4 uu = ur[64 * jj]; hsum += (uu.x * xv[jj].x + uu.y * xv[jj].y) + (uu.z * xv[jj].z + uu.w * xv[jj].w); }
                hsum = wave_sum(hsum);
                const float act = 0.5f * hsum * (1.0f + erff(hsum * 0.70710678118f)) * gte;
                const GAS f32x4* vr = (const GAS f32x4*)(peer_v + (size_t)e * D) + lane;
#pragma unroll
                for (int jj = 0; jj < 8; ++jj) fv[jj] = fv[jj] + vr[64 * jj] * act;
            }
            float s = 0.f;
#pragma unroll
            for (int j = 0; j < 8; ++j) { const unsigned long long pw = ((const GAS unsigned long long*)(PE + (size_t)t * D))[64 * j + lane]; const unsigned plo = (unsigned)pw, phi = (unsigned)(pw >> 32);
                fv[j] = xv[j] * ALPHA + fv[j] + (f32x4){bflo(plo), bfhi(plo), bflo(phi), bfhi(phi)}; s += (fv[j].x + fv[j].y) + (fv[j].z + fv[j].w); }
            const float mean = wave_sum(s) * (1.0f / D); float q = 0.f;
#pragma unroll
            for (int j = 0; j < 8; ++j) { fv[j] = fv[j] - mean; q += (fv[j].x * fv[j].x + fv[j].y * fv[j].y) + (fv[j].z * fv[j].z + fv[j].w * fv[j].w); }
            const float rstd = 1.0f / sqrtf(wave_sum(q) * (1.0f / D) + LN_EPS);
#pragma unroll
            for (int j = 0; j < 8; ++j) { const f32x4 gg = ((const GAS f32x4*)ln2_w)[64 * j + lane], bb = ((const GAS f32x4*)ln2_b)[64 * j + lane];
                ((GAS f32x4*)(args.out + (size_t)t * D))[64 * j + lane] = fv[j] * rstd * gg + bb; }
        }
    }


#ifdef DIAG_TIME
    xcd_barrier(bar);
    { LOCALS
      const unsigned long long t0_ = __hip_atomic_load((unsigned long long*)(args.ws + WS_CTL) + 8, __ATOMIC_RELAXED, __HIP_MEMORY_SCOPE_AGENT);
      const float ms_ = (float)(__builtin_amdgcn_s_memrealtime() - t0_) * (1.0f / 100000.0f);
      const float u_ = (float)DIAG_UNIT_MS; const float c_ = 1.0f + (ms_ > u_ ? 1.f : 0.f) + (ms_ > 2 * u_ ? 1.f : 0.f) + (ms_ > 4 * u_ ? 1.f : 0.f) + (ms_ > 8 * u_ ? 1.f : 0.f) + (ms_ > 16 * u_ ? 1.f : 0.f) + (ms_ > 32 * u_ ? 1.f : 0.f);
      for (size_t e = gt; e < (size_t)T * D; e += NGT) args.out[e] = c_; }
#endif
#if DIAG_LAST >= 0
    xcd_barrier(bar);
    { LOCALS
      constexpr size_t N1 = (size_t)T * 1024;
      int used = 0;
#if DIAG_LAST == 1
      digest<bf16>(args.out, 0, QB, N1, gt, NGT); digest<bf16>(args.out, 1, KB, N1, gt, NGT); digest<bf16>(args.out, 2, VB, N1, gt, NGT);
      digest<bf16>(args.out, 3, RR, N1, gt, NGT); digest<bf16>(args.out, 4, RK, N1, gt, NGT); digest<bf16>(args.out, 5, RV, N1, gt, NGT); digest<bf16>(args.out, 6, RC, N1, gt, NGT); used = 7;
#elif DIAG_LAST == 2
      digest<bf16>(args.out, 0, YA, N1, gt, NGT); digest<float>(args.out, 1, LW, N1, gt, NGT); digest<bf16>(args.out, 2, AA, N1, gt, NGT); digest<bf16>(args.out, 3, GG, N1, gt, NGT); used = 4;
#elif DIAG_LAST == 3
      digest<float>(args.out, 0, YRAW, N1, gt, NGT); digest<float>(args.out, 1, RKC, (size_t)T * 16, gt, NGT); used = 2;
#elif DIAG_LAST == 4
      digest<bf16>(args.out, 0, YB, N1, gt, NGT); used = 1;
#elif DIAG_LAST == 5
      digest<bf16>(args.out, 0, GATE, 4 * N1, gt, NGT); used = 1;
#elif DIAG_LAST == 7
      digest<bf16>(args.out, 0, MIX, 2 * N1, gt, NGT); used = 1;
#elif DIAG_LAST == 8
      digest<float>(args.out, 0, H1, 2 * N1, gt, NGT); used = 1;
#elif DIAG_LAST == 9
      digest<float>(args.out, 0, X1, 2 * N1, gt, NGT); used = 1;
#elif DIAG_LAST == 10
      digest<bf16>(args.out, 0, PQ, 2 * N1, gt, NGT); digest<bf16>(args.out, 1, PE, 2 * N1, gt, NGT); used = 2;
#elif DIAG_LAST == 11
      digest<int>(args.out, 0, IDX, (size_t)T * 128, gt, NGT); digest<float>(args.out, 1, PG, (size_t)T * 128, gt, NGT); digest<bf16>(args.out, 2, PE, 2 * N1, gt, NGT); used = 3;
#endif
      for (size_t e = gt + (size_t)used * 2097152; e < (size_t)T * D; e += NGT) args.out[e] = 1.0f;
    }
#endif
#undef IN
#undef SEAM
}


#ifdef DIAG_CHECK
__device__ __forceinline__ unsigned hsh(unsigned x) { x ^= x >> 16; x *= 0x7feb352dU; x ^= x >> 15; x *= 0x846ca68bU; x ^= x >> 16; return x; }
__device__ __forceinline__ void chk_acc(unsigned char* ws, int id, float ref, float got) { float* a = (float*)(ws + WS_CTL) + 1024 + 2 * id; const float d = ref - got; atomicAdd(a, d * d); atomicAdd(a + 1, ref * ref); }
__global__ void __launch_bounds__(512) mk_check(Args args) {
    extern __shared__ __attribute__((aligned(16))) unsigned char lds[];
    LOCALS
    const int id = args.pad - 1;
    if (id == 0) {
        for (size_t i = gt; i < 8192; i += NGT) { const unsigned hh = hsh((unsigned)i * 2u + 1u); const int t = (int)(hh % T), col = (int)(hsh(hh) % 7168u);
            float ref = 0.f; for (int k = 0; k < D; ++k) ref += x_in[(size_t)t * D + k] * w_in[(size_t)k * NIN + col];
            const int reg = col >> 10, c = col & 1023; const float got = bf1(QB[(size_t)reg * ((size_t)T * 1024) + (size_t)t * 1024 + c]) * (reg == 0 ? 8.f : 1.f);
            chk_acc(args.ws, 0, ref, got); }
    } else if (id == 1) {
        for (int smp = gw; smp < 256; smp += NGW) { const unsigned hh = hsh(7777u + smp); const int t = (int)(hh % T), head = (int)(hsh(hh) % 16u);
            const float q = bf1(QB[(size_t)t * 1024 + head * 64 + lane]); float o = 0.f;
            for (int sk = 0; sk < t; ++sk) { const float z = wave_sum(q * bf1(KB[(size_t)sk * 1024 + head * 64 + lane])); const float beta = 1.0f / (1.0f + expf(-z));
                o = o * (1.0f - beta) + beta * bf1(VB[(size_t)sk * 1024 + head * 64 + lane]); }
            chk_acc(args.ws, 1, o, bf1(YA[(size_t)t * 1024 + head * 64 + lane])); }
    } else if (id == 2) {
        LAS float* xs = (LAS float*)lds + wave * 3072;
        for (int smp = gw; smp < 512; smp += NGW) { const unsigned hh = hsh(991u + smp); const int t = (int)(hh % T), c = (int)(hsh(hh) % 1024u);
            for (int k = lane; k < 1024; k += 64) { const float cv = bf1(RC[(size_t)t * 1024 + k]), pv = t > 0 ? bf1(RC[(size_t)(t - 1) * 1024 + k]) : 0.f;
                xs[k] = cv + (pv - cv) * mu[3 * 1024 + k]; xs[1024 + k] = cv + (pv - cv) * mu[4 * 1024 + k]; xs[2048 + k] = cv + (pv - cv) * mu[5 * 1024 + k]; }
            asm volatile("s_waitcnt lgkmcnt(0)" ::: "memory");
            float hw = 0.f, ha = 0.f, hg0 = 0.f, hg1 = 0.f, hg2 = 0.f;
            for (int k = 0; k < 1024; ++k) { hw += xs[k] * wl1[(size_t)k * 64 + lane]; ha += xs[1024 + k] * al1[(size_t)k * 64 + lane];
                hg0 += xs[2048 + k] * gl1[(size_t)k * 160 + lane]; hg1 += xs[2048 + k] * gl1[(size_t)k * 160 + 64 + lane]; if (lane < 32) hg2 += xs[2048 + k] * gl1[(size_t)k * 160 + 128 + lane]; }
            hw = tanhf(hw); hg0 = 1.f / (1.f + expf(-hg0)); hg1 = 1.f / (1.f + expf(-hg1)); hg2 = 1.f / (1.f + expf(-hg2));
            const float wpre = w0[c] + wave_sum(hw * wl2[(size_t)lane * 1024 + c]);
            const float apre = a0[c] + wave_sum(ha * al2[(size_t)lane * 1024 + c]);
            const float gref = wave_sum(hg0 * gl2[(size_t)lane * 1024 + c] + hg1 * gl2[(size_t)(64 + lane) * 1024 + c] + (lane < 32 ? hg2 * gl2[(size_t)(128 + lane) * 1024 + c] : 0.f));
            const float sp = -wpre > 20.f ? -wpre : log1pf(expf(-wpre)); const float lwref = -expf(-sp - 0.5f); const float aref = 1.f / (1.f + expf(-apre));
            if (lane == 0) { chk_acc(args.ws, 2, lwref, LW[(size_t)t * 1024 + c]); chk_acc(args.ws, 3, aref, bf1(AA[(size_t)t * 1024 + c])); chk_acc(args.ws, 4, gref, bf1(GG[(size_t)t * 1024 + c])); }
            asm volatile("s_waitcnt lgkmcnt(0)" ::: "memory"); }
    } else if (id == 5) {
        LAS float* vs_ = (LAS float*)lds + wave * 512;
        for (int smp = gw; smp < 128; smp += NGW) { const unsigned hh = hsh(4242u + smp); const int t1 = 800 + (int)(hh % (T - 800)), head = (int)(hsh(hh) % 16u), ch = head * 64 + lane;
            float S[64];
#pragma unroll
            for (int k = 0; k < 64; ++k) S[k] = 0.f;
            float y = 0.f;
            for (int t = t1 - 768; t <= t1; ++t) { const size_t o = (size_t)t * 1024 + ch;
                const float rc = bf1(RR[o]), rp = bf1(RR[o - 1024]), kc = bf1(RK[o]), kp = bf1(RK[o - 1024]), vc = bf1(RV[o]), vp = bf1(RV[o - 1024]);
                const float rs = rc + (rp - rc) * mu[ch], ks = kc + (kp - kc) * mu[1024 + ch], vsv = vc + (vp - vc) * mu[2048 + ch];
                const float a = bf1(AA[o]); float kk = ks * k_k[ch]; const float nrm = sqrtf(wave_sum(kk * kk)); kk = kk / fmaxf(nrm, 1e-12f);
                const float km = ks * (1.0f + (a - 1.0f) * k_a[ch]);
                vs_[lane] = expf(LW[o]); vs_[64 + lane] = -kk; vs_[128 + lane] = kk * a; vs_[192 + lane] = km; vs_[256 + lane] = rs;
                asm volatile("s_waitcnt lgkmcnt(0)" ::: "memory");
                float sa = 0.f;
#pragma unroll
                for (int k = 0; k < 64; ++k) sa += S[k] * vs_[64 + k];
                y = 0.f;
#pragma unroll
                for (int k = 0; k < 64; ++k) { S[k] = S[k] * vs_[k] + sa * vs_[128 + k] + vsv * vs_[192 + k]; y += S[k] * vs_[256 + k]; }
                asm volatile("s_waitcnt lgkmcnt(0)" ::: "memory"); }
            chk_acc(args.ws, 5, y, YRAW[(size_t)t1 * 1024 + ch]); }
    } else if (id == 6) {
        for (int smp = gw; smp < 512; smp += NGW) { const unsigned hh = hsh(31337u + smp); const int t = 1 + (int)(hh % (T - 1)), head = (int)(hsh(hh) % 16u), ch = head * 64 + lane; const size_t o = (size_t)t * 1024 + ch;
            const float rc = bf1(RR[o]), rp = bf1(RR[o - 1024]), kc = bf1(RK[o]), kp = bf1(RK[o - 1024]), vc = bf1(RV[o]), vp = bf1(RV[o - 1024]);
            const float rs = rc + (rp - rc) * mu[ch], ks = kc + (kp - kc) * mu[1024 + ch], vsv = vc + (vp - vc) * mu[2048 + ch];
            const float km = ks * (1.0f + (bf1(AA[o]) - 1.0f) * k_a[ch]); const float rk = wave_sum(rs * km * r_k[ch]);
            const float y = YRAW[o]; const float mean = wave_sum(y) / 64.f; const float var = wave_sum((y - mean) * (y - mean)) / 64.f;
            const float ref = ((y - mean) / sqrtf(var + GN_EPS) * lnx_w[ch] + lnx_b[ch] + rk * vsv) * bf1(GG[o]);
            chk_acc(args.ws, 6, ref, bf1(YB[o])); }
    } else if (id == 7) {
        for (size_t i = gt; i < 4096; i += NGT) { const unsigned hh = hsh((unsigned)i * 2u + 5u); const int t = (int)(hh % T), col = (int)(hsh(hh) % 4096u);
            float ref = 0.f; for (int k = 0; k < D; ++k) ref += x_in[(size_t)t * D + k] * w_in[(size_t)k * NIN + 7168 + col];
#ifndef DIAG_RAWGATE
            ref = 1.f / (1.f + expf(-ref));
#endif
            chk_acc(args.ws, 7, ref, bf1(GATE[(size_t)(col >> 11) * ((size_t)T * 2048) + (size_t)t * 2048 + (col & 2047)])); }
    } else if (id == 15) {
        for (size_t i = gt; i < 262144; i += NGT) { const unsigned hh = hsh((unsigned)i * 2u + 77u); const int k = (int)(hh % D), col = (int)(hsh(hh) % NIN);
            chk_acc(args.ws, col < 7168 ? 15 : 16, w_in[(size_t)k * NIN + col], bf1(WIN_T[(size_t)col * D + k])); }
    } else if (id == 17) {
        for (size_t i = gt; i < 262144; i += NGT) { const unsigned hh = hsh((unsigned)i * 2u + 177u); const size_t e = ((size_t)hh * 8191u + hsh(hh)) % ((size_t)T * D); chk_acc(args.ws, 17, x_in[e], bf1(XB[e])); }
    } else if (id == 8) {
        for (size_t i = gt; i < 4096; i += NGT) { const unsigned hh = hsh((unsigned)i * 2u + 9u); const int t = (int)(hh % T), col = (int)(hsh(hh) % 2048u);
            float ya = 0.f, yb = 0.f; for (int k = 0; k < 1024; ++k) { ya += bf1(YA[(size_t)t * 1024 + k]) * w_up_a[(size_t)k * D + col]; yb += bf1(YB[(size_t)t * 1024 + k]) * w_up_b[(size_t)k * D + col]; }
            const float ref = bf1(GATE[(size_t)t * 2048 + col]) * ya + bf1(GATE[(size_t)T * 2048 + (size_t)t * 2048 + col]) * yb; chk_acc(args.ws, 8, ref, bf1(MIX[(size_t)t * 2048 + col])); }
    } else if (id == 9) {
        for (size_t i = gt; i < 4096; i += NGT) { const unsigned hh = hsh((unsigned)i * 2u + 13u); const int t = (int)(hh % T), col = (int)(hsh(hh) % 2048u);
            float ref = 0.f; for (int k = 0; k < D; ++k) ref += bf1(MIX[(size_t)t * D + k]) * w_o[(size_t)k * D + col];
            ref += ALPHA * x_in[(size_t)t * D + col]; chk_acc(args.ws, 9, ref, H1[(size_t)t * D + col]); }
    } else if (id == 10) {
        for (size_t i = gt; i < 4096; i += NGT) { const unsigned hh = hsh((unsigned)i * 2u + 21u); const int t = (int)(hh % T), col = (int)(hsh(hh) % 2048u);
            float ref = 0.f; for (int k = 0; k < D; ++k) ref += X1[(size_t)t * D + k] * peer_wq[(size_t)k * D + col];
            chk_acc(args.ws, 10, ref, bf1(PQ[(size_t)t * D + col]));
            float r2 = 0.f; for (int k = 0; k < 256; ++k) r2 += p_in[(size_t)t * 256 + k] * ple_wp[(size_t)k * D + col];
            chk_acc(args.ws, 11, r2, bf1(PE[(size_t)t * D + col])); }
    } else if (id == 12) {
        for (size_t i = gt; i < 4096; i += NGT) { const unsigned hh = hsh((unsigned)i * 2u + 29u); const int t = (int)(hh % T), col = (int)(hsh(hh) % 2048u);
            float ref = 0.f; for (int k = 0; k < D; ++k) ref += X1[(size_t)t * D + k] * ple_wg[(size_t)k * D + col];
            float r2 = 0.f; for (int k = 0; k < 256; ++k) r2 += p_in[(size_t)t * 256 + k] * ple_wp[(size_t)k * D + col];
            chk_acc(args.ws, 12, r2 / (1.f + expf(-ref)), bf1(PE[(size_t)t * D + col])); }
        LAS float* sc = (LAS float*)lds + wave * 256;
        for (int smp = gw; smp < 512; smp += NGW) { const unsigned hh = hsh(555u + smp); const int t = (int)(hh % T), h = (int)(hsh(hh) % 8u);
            for (int r = lane; r < 256; r += 64) { const int c = r >> 7, nn = r & 127; float s = 0.f; for (int d = 0; d < 128; ++d) s += bf1(PQ[(size_t)t * D + h * 256 + c * 128 + d]) * sub_keys[(size_t)(c * 128 + nn) * 128 + d]; sc[r] = s; }
            asm volatile("s_waitcnt lgkmcnt(0)" ::: "memory");
            const int e = IDX[(size_t)t * 128 + h * 16 + (lane & 15)]; const float mys = sc[e >> 7] + sc[128 + (e & 127)];
            float mn = mys, mxv = mys;
#pragma unroll
            for (int o2 = 1; o2 < 16; o2 <<= 1) { mn = fminf(mn, __shfl_xor(mn, o2)); mxv = fmaxf(mxv, __shfl_xor(mxv, o2)); }
            float ex = expf(mys - mxv), sm = ex;
#pragma unroll
            for (int o2 = 1; o2 < 16; o2 <<= 1) sm += __shfl_xor(sm, o2);
            if (lane < 16) chk_acc(args.ws, 13, ex / sm, PG[(size_t)t * 128 + h * 16 + lane]);
            int cnt = 0; for (int pr = lane; pr < 16384; pr += 64) cnt += (sc[pr >> 7] + sc[128 + (pr & 127)] > mn + 1e-6f) ? 1 : 0;
#pragma unroll
            for (int o2 = 1; o2 < 64; o2 <<= 1) cnt += __shfl_xor(cnt, o2);
            if (lane == 0) chk_acc(args.ws, 14, 15.f, (float)cnt);
            asm volatile("s_waitcnt lgkmcnt(0)" ::: "memory"); }
    } else if (id == 98) {
        const float* a = (const float*)(args.ws + WS_CTL) + 1024; float c = 1.f; unsigned long long sel = DIAG_CHECK;
        for (int b = 4; b >= 0; --b) { const int k = (int)(sel % 100ull); sel /= 100ull; const float rel = sqrtf(a[2 * k] / fmaxf(a[2 * k + 1], 1e-30f)); if (!(rel < DIAG_TOL)) c += (float)(1 << b); }
#ifdef DIAG_LADDER
        { c = 1.f; const float rel = sqrtf(a[2 * DIAG_LADDER] / fmaxf(a[2 * DIAG_LADDER + 1], 1e-30f)); const float th[5] = {0.01f, 0.03f, 0.1f, 0.3f, 1.0f}; for (int b = 0; b < 5; ++b) if (!(rel < th[b])) c += 1.f; }
#endif
        for (size_t e = gt; e < (size_t)T * D; e += NGT) args.out[e] = c;
    }
}
#endif

extern "C" void kernel_launch(void* const* d_in, const int* in_sizes, int n_in, void* d_out, int out_size, void* d_ws, size_t ws_size, hipStream_t stream) {
    static int grid = 0;
    if (grid == 0) {
        if (n_in != 30 || in_sizes[0] != T * D || out_size != T * D || ws_size < WS_END) { fprintf(stderr, "kernel_launch: unexpected shapes / workspace (n_in %d, ws %zu); nothing launched\n", n_in, ws_size); grid = -1; return; }
        int dev = 0, cus = 0, per_cu = 0;
        if (hipGetDevice(&dev) != hipSuccess || hipDeviceGetAttribute(&cus, hipDeviceAttributeMultiprocessorCount, dev) != hipSuccess) { grid = -1; return; }
        if (hipFuncSetAttribute((const void*)mk_fwd, hipFuncAttributeMaxDynamicSharedMemorySize, LDS_BYTES) != hipSuccess) { fprintf(stderr, "kernel_launch: hipFuncSetAttribute failed\n"); grid = -1; return; }
        if (hipOccupancyMaxActiveBlocksPerMultiprocessor(&per_cu, (const void*)mk_fwd, NWAVES * 64, LDS_BYTES) != hipSuccess || per_cu < 1) fprintf(stderr, "kernel_launch: occupancy query says %d\n", per_cu);
        (void)hipGetLastError();
#ifdef DIAG_CHECK
        (void)hipFuncSetAttribute((const void*)mk_check, hipFuncAttributeMaxDynamicSharedMemorySize, 131072);
#endif
        grid = cus;
    }
    if (grid < 0) return;
    if (hipMemsetAsync((char*)d_ws + WS_CTL, 0, CTL_ZERO_BYTES, stream) != hipSuccess) return;
    Args a{};
    for (int i = 0; i < 30; ++i) a.in[i] = (const float*)d_in[i];
    a.out = (float*)d_out; a.ws = (unsigned char*)d_ws;
#if MK_ONE_LAUNCH
    a.ph_lo = 0; a.ph_hi = (DIAG_LAST >= 0) ? DIAG_LAST + 1 : NPHASE;
#ifdef DIAG_TIME
    a.ph_hi = DIAG_TIME + 1;
#endif a.li = 0;
    hipLaunchKernelGGL(mk_fwd, dim3(grid), dim3(NWAVES * 64), LDS_BYTES, stream, a);
#else
    for (int li = 0; li < NPHASE; ++li) { a.ph_lo = li; a.ph_hi = li + 1; a.li = li; a.pad = 0; hipLaunchKernelGGL(mk_fwd, dim3(grid), dim3(NWAVES * 64), LDS_BYTES, stream, a);
#ifdef DIAG_CHECK
        static const int chk_after[][2] = {{0, 15}, {4, 17}, {1, 0}, {2, 1}, {2, 2}, {3, 5}, {4, 6}, {5, 7}, {7, 8}, {8, 9}, {10, 10}, {11, 12}};
        for (auto& ca : chk_after) if (ca[0] == li) { a.pad = ca[1] + 1; hipLaunchKernelGGL(mk_check, dim3(grid), dim3(512), 131072, stream, a); }
        if (li == NPHASE - 1) { a.pad = 99; hipLaunchKernelGGL(mk_check, dim3(grid), dim3(512), 131072, stream, a); }
#endif
    }
#endif
}
```

```cpp
#define MK_ONE_LAUNCH 1
#include <hip/hip_runtime.h>
#include <cstdio>
#include <cstdint>
namespace pg8 {
#define PG8_LAS __attribute__((address_space(3)))
typedef unsigned short bf16_t;
typedef short bf16x8 __attribute__((ext_vector_type(8)));
typedef float f32x4 __attribute__((ext_vector_type(4)));
typedef unsigned u32x4 __attribute__((ext_vector_type(4)));
constexpr int BM = 256, BK = 64, HALF = 128, HTB = HALF * BK * 2  , STAGE_BYTES = 8 * HTB, NXCD = 8, WGM = 8;

__host__ __device__ __forceinline__ int lds_byte(int r, int c) { const int st = (r >> 4) * 2 + (c >> 5), rr = r & 15, cc = c & 31, ob = rr * 64 + cc * 2; return st * 1024 + (ob ^ (((ob >> 9) & 1) << 5)); }
__host__ __device__ __forceinline__ void stage_rc(int b, int& R, int& C) { const int st = b / 1024, sb = b % 1024, swz = sb ^ (((sb >> 9) & 1) << 5); R = (st >> 1) * 16 + swz / 64; C = (st & 1) * 32 + (swz % 64) / 2; }
__host__ __device__ __forceinline__ int perm32(int rho) { const int n = rho >> 4, i = rho & 15; return 8 * (i >> 2) + 4 * n + (i & 3); }

struct Unit { int pm, pn; };
struct Gemm { const bf16_t* A; const bf16_t* Bt; int M, N, K; };

struct StaticOrder {
    int nM, nN, nwg, G, c;
    __host__ __device__ void init(int M, int N, int G_, int c_) { nM = M / BM; nN = N / BM; nwg = nM * nN; G = G_; c = c_; }
    __host__ __device__ bool next(int i, Unit& u) const {
        const long L = (long)i * G + c; if (L >= nwg) return false;
        int wgid = (int)L; { const int q = nwg / NXCD, r = nwg % NXCD, xcd = wgid % NXCD, off = wgid / NXCD; wgid = (xcd < r ? xcd * (q + 1) : r * (q + 1) + (xcd - r) * q) + off; }
        const int nig = WGM * nN, gid = wgid / nig, fm = gid * WGM, gsz = (nM - fm) < WGM ? (nM - fm) : WGM;
        u.pm = fm + ((wgid % nig) % gsz); u.pn = (wgid % nig) / gsz; return true;
    }
    __device__ __forceinline__ void a_ready(const Unit&) const {}
    __device__ __forceinline__ void done(const Unit&) const {}
};

typedef float cvt_f32x2 __attribute__((ext_vector_type(2))); typedef __bf16 cvt_bf16x2 __attribute__((ext_vector_type(2)));
__device__ __forceinline__ unsigned cvt_pk_bf16(float lo, float hi) { const cvt_f32x2 v = {lo, hi}; return __builtin_bit_cast(unsigned, __builtin_convertvector(v, cvt_bf16x2)); }
typedef float f32x2 __attribute__((ext_vector_type(2)));
__device__ __forceinline__ f32x2 gelu_pk(f32x2 v) {
    const f32x2 av = __builtin_elementwise_abs(v), d = av * 0.2316418882f + 1.0f;
    f32x2 t; t.x = __builtin_amdgcn_rcpf(d.x); t.y = __builtin_amdgcn_rcpf(d.y);
    f32x2 q = t * 0.5307027145f + (-0.7265760135f); q = q * t + 0.7107068705f; q = q * t + (-0.142248368f); q = q * t + 0.127414796f; q = q * t;
    const f32x2 s = (v * v) * (-0.72134752044f);
    f32x2 e; e.x = __builtin_amdgcn_exp2f(s.x); e.y = __builtin_amdgcn_exp2f(s.y);
    const f32x2 m = v * (q * e), r = v - m;
    f32x2 o; o.x = v.x < 0.f ? m.x : r.x; o.y = v.y < 0.f ? m.y : r.y; return o;
}


__device__ __forceinline__ float bf_lo(unsigned w) { return __uint_as_float(w << 16); }
__device__ __forceinline__ float bf_hi(unsigned w) { return __uint_as_float(w & 0xffff0000u); }
__device__ __forceinline__ float fsigmoid(float x) { return __builtin_amdgcn_rcpf(1.0f + __expf(-x)); }
__device__ __forceinline__ float ftanh(float x) { return 1.0f - 2.0f * __builtin_amdgcn_rcpf(__expf(2.0f * x) + 1.0f); }
__device__ __forceinline__ float fsoftplus(float x) { return fmaxf(x, 0.f) + __logf(1.0f + __expf(-fabsf(x))); }
__device__ __forceinline__ u32x4 pack8(const f32x4& a, const f32x4& b) { u32x4 w; w.x = cvt_pk_bf16(a[0], a[1]); w.y = cvt_pk_bf16(a[2], a[3]); w.z = cvt_pk_bf16(b[0], b[1]); w.w = cvt_pk_bf16(b[2], b[3]); return w; }
__device__ __forceinline__ void unpack8(const u32x4& w, f32x4& a, f32x4& b) { a = (f32x4){bf_lo(w.x), bf_hi(w.x), bf_lo(w.y), bf_hi(w.y)}; b = (f32x4){bf_lo(w.z), bf_hi(w.z), bf_lo(w.w), bf_hi(w.w)}; }

template <class Fn> struct EpiB16 {
    static constexpr bool PERM = true, AFTER_DRAIN = false;
    Fn f;
    __device__ __forceinline__ void operator()(const f32x4 (&acc)[2][2][4][2], const Unit& u, int wr, int wc, int fr, int fq) const {
        const int row0 = u.pm * BM + wr * 64 + fr, col0 = u.pn * BM + wc * 32 + 8 * fq;
#pragma unroll
        for (int ai = 0; ai < 2; ++ai)
#pragma unroll
            for (int m = 0; m < 4; ++m)
#pragma unroll
                for (int bj = 0; bj < 2; ++bj) f(row0 + ai * HALF + m * 16, col0 + bj * HALF, acc[ai][bj][m][0], acc[ai][bj][m][1]);
    }
};
template <class Fn> struct EpiF32x {
    static constexpr bool PERM = false, AFTER_DRAIN = false;
    Fn f;
    __device__ __forceinline__ void operator()(const f32x4 (&acc)[2][2][4][2], const Unit& u, int wr, int wc, int fr, int fq) const {
        const int row0 = u.pm * BM + wr * 64 + fr, col0 = u.pn * BM + wc * 32 + 4 * fq;
#pragma unroll
        for (int ai = 0; ai < 2; ++ai)
#pragma unroll
            for (int m = 0; m < 4; ++m)
#pragma unroll
                for (int bj = 0; bj < 2; ++bj)
#pragma unroll
                    for (int n = 0; n < 2; ++n) f(row0 + ai * HALF + m * 16, col0 + bj * HALF + n * 16, acc[ai][bj][m][n]);
    }
};
constexpr int TT = 16384;
__device__ __forceinline__ unsigned long long pack8f8(const f32x4& a, const f32x4& b) { int w0_ = 0, w1_ = 0; w0_ = __builtin_amdgcn_cvt_pk_fp8_f32(a[0], a[1], w0_, false); w0_ = __builtin_amdgcn_cvt_pk_fp8_f32(a[2], a[3], w0_, true);
    w1_ = __builtin_amdgcn_cvt_pk_fp8_f32(b[0], b[1], w1_, false); w1_ = __builtin_amdgcn_cvt_pk_fp8_f32(b[2], b[3], w1_, true); return (unsigned long long)(unsigned)w0_ | ((unsigned long long)(unsigned)w1_ << 32); }
typedef float epi_f32x2 __attribute__((ext_vector_type(2)));
__device__ __forceinline__ void unpack8f8(unsigned long long w, float sc, f32x4& a, f32x4& b) { const int lo = (int)(unsigned)w, hi = (int)(unsigned)(w >> 32);
    const epi_f32x2 a0 = __builtin_amdgcn_cvt_pk_f32_fp8(lo, false), a1 = __builtin_amdgcn_cvt_pk_f32_fp8(lo, true), b0 = __builtin_amdgcn_cvt_pk_f32_fp8(hi, false), b1 = __builtin_amdgcn_cvt_pk_f32_fp8(hi, true);
    a = (f32x4){a0.x, a0.y, a1.x, a1.y} * sc; b = (f32x4){b0.x, b0.y, b1.x, b1.y} * sc; }
struct FnProj { bf16_t* base;
    __device__ __forceinline__ void operator()(int row, int col, f32x4 a, f32x4 b) const {
        const int reg = col >> 10, c = col & 1023; const float sc = reg == 0 ? 0.125f * 1.44269504088896f   : 1.0f; a = a * sc; b = b * sc;
        *(u32x4*)(base + (size_t)reg * ((size_t)TT * 1024) + (size_t)row * 1024 + c) = pack8(a, b); } };
struct FnGate { bf16_t* base;
    __device__ __forceinline__ void operator()(int row, int col, f32x4 a, f32x4 b) const {
        const int reg = col >> 11, c = col & 2047;
#pragma unroll
        for (int j = 0; j < 4; ++j) {
#ifndef DIAG_RAWGATE
            a[j] = fsigmoid(a[j]); b[j] = fsigmoid(b[j]);
#endif
        }
        a = a * 256.0f; b = b * 256.0f;
        *(unsigned long long*)((unsigned char*)base + (size_t)reg * ((size_t)TT * 2048) + (size_t)row * 2048 + c) = pack8f8(a, b); } };
struct FnLora1 { bf16_t* out; int act;
    __device__ __forceinline__ void operator()(int row, int col, f32x4 a, f32x4 b) const {
#pragma unroll
        for (int j = 0; j < 4; ++j) { if (act == 0) { a[j] = ftanh(a[j]); b[j] = ftanh(b[j]); } else if (act == 2) { a[j] = fsigmoid(a[j]); b[j] = fsigmoid(b[j]); } }
        *(u32x4*)(out + (size_t)row * 256 + col) = pack8(a, b); } };
struct FnLora2 { float* lw; bf16_t* aa; bf16_t* gg; const float* w0; const float* a0;
    __device__ __forceinline__ void operator()(int row, int col, f32x4 a, f32x4 b) const {
        const int which = col >> 10, c = col & 1023, t = row - which * TT;
        if (which == 0) { a = a + *(const f32x4*)(w0 + c); b = b + *(const f32x4*)(w0 + c + 4);
            *(f32x4*)(lw + (size_t)t * 1024 + c) = a; *(f32x4*)(lw + (size_t)t * 1024 + c + 4) = b; }
        else if (which == 1) { a = a + *(const f32x4*)(a0 + c); b = b + *(const f32x4*)(a0 + c + 4);
            *(u32x4*)(aa + (size_t)t * 1024 + c) = pack8(a, b); }
        else { *(u32x4*)(gg + (size_t)t * 1024 + c) = pack8(a, b); } } };

template <int W> struct FnLora2S { float* lw; bf16_t* aa; bf16_t* gg; const float* w0; const float* a0;
    __device__ __forceinline__ void operator()(int row, int col, f32x4 a, f32x4 b) const { const FnLora2 f{lw, aa, gg, w0, a0}; f(row + W * TT, col + W * 1024, a, b); } };
template <int ADD> struct FnMix { const bf16_t* gate; bf16_t* mix;
    __device__ __forceinline__ void operator()(int row, int col, f32x4 a, f32x4 b) const {
        const size_t o = (size_t)row * 2048 + col; f32x4 g0, g1; unpack8f8(*(const unsigned long long*)((const unsigned char*)gate + o), 1.0f / 256.0f, g0, g1); a = a * g0; b = b * g1;
        if (ADD) { f32x4 m0, m1; unpack8(*(const u32x4*)(mix + o), m0, m1); a = a + m0; b = b + m1; }
        *(u32x4*)(mix + o) = pack8(a, b); } };
struct FnMixF8 { const bf16_t* gate; const bf16_t* mixp; unsigned char* mix8;
    __device__ __forceinline__ void operator()(int row, int col, f32x4 a, f32x4 b) const {
        const size_t o = (size_t)row * 2048 + col; f32x4 g0, g1, m0, m1; unpack8f8(*(const unsigned long long*)((const unsigned char*)gate + o), 1.0f / 256.0f, g0, g1); unpack8(*(const u32x4*)(mixp + o), m0, m1); a = a * g0 + m0; b = b * g1 + m1;
        int w0_ = 0, w1_ = 0; w0_ = __builtin_amdgcn_cvt_pk_fp8_f32(a[0], a[1], w0_, false); w0_ = __builtin_amdgcn_cvt_pk_fp8_f32(a[2], a[3], w0_, true);
        w1_ = __builtin_amdgcn_cvt_pk_fp8_f32(b[0], b[1], w1_, false); w1_ = __builtin_amdgcn_cvt_pk_fp8_f32(b[2], b[3], w1_, true);
        *(unsigned long long*)(mix8 + o) = (unsigned long long)(unsigned)w0_ | ((unsigned long long)(unsigned)w1_ << 32); } };
struct FnWo { const float* x; float* h1; float alpha;
    __device__ __forceinline__ void operator()(int row, int col, f32x4 a) const {
        const size_t o = (size_t)row * 2048 + col; *(f32x4*)(h1 + o) = *(const f32x4*)(x + o) * alpha + a; } };
struct FnWoB16 { const float* x; bf16_t* h1; float alpha;
    __device__ __forceinline__ void operator()(int row, int col, f32x4 a, f32x4 b) const {
        const size_t o = (size_t)row * 2048 + col; a = a + *(const f32x4*)(x + o) * alpha; b = b + *(const f32x4*)(x + o + 4) * alpha; *(u32x4*)(h1 + o) = pack8(a, b); } };
struct FnPlain16 { bf16_t* out; int ld;
    __device__ __forceinline__ void operator()(int row, int col, f32x4 a, f32x4 b) const { *(u32x4*)(out + (size_t)row * ld + col) = pack8(a, b); } };
struct FnPle { bf16_t* pe;
    __device__ __forceinline__ void operator()(int row, int col, f32x4 a, f32x4 b) const {
        const size_t o = (size_t)row * 2048 + col; f32x4 p0, p1; unpack8(*(const u32x4*)(pe + o), p0, p1);
#pragma unroll
        for (int j = 0; j < 4; ++j) { a[j] = fsigmoid(a[j]) * p0[j]; b[j] = fsigmoid(b[j]) * p1[j]; }
        *(u32x4*)(pe + o) = pack8(a, b); } };
struct DiagOrder { int G, c;
    __device__ __forceinline__ bool next(int i, Unit& u) const { const int L = i * G + c; if (L >= 768) return false; const int which = L >> 8, r = L & 255; u.pm = which * 64 + (r & 63); u.pn = which * 4 + (r >> 6); return true; }
    __device__ __forceinline__ void a_ready(const Unit&) const {}
    __device__ __forceinline__ void done(const Unit&) const {}
};
typedef int pg8_v4i __attribute__((ext_vector_type(4))); typedef int pg8_v8i __attribute__((ext_vector_type(8)));
template <class Epi, class Sched, bool ALIGN_EPI = false, bool SP2 = false, int F8SCALE = 0>
__device__ __forceinline__ void gemm_phase(PG8_LAS unsigned char* lds, const Gemm g, const Sched& S, const Epi& E) {
    const int tid = threadIdx.x, wid = __builtin_amdgcn_readfirstlane(tid >> 6), lane = tid & 63, wr = wid >> 2, wc = wid & 3, fr = lane & 15, fq = lane >> 4;
    const int K = g.K, nt = K / BK;
    unsigned voffA[2], voffB[2];
#pragma unroll
    for (int i = 0; i < 2; ++i) { int R, C; stage_rc(tid * 16 + i * 8192, R, C); const int Rb = Epi::PERM ? ((R & ~31) + perm32(R & 31)) : R;
        voffA[i] = (unsigned)(R * K + C) * 2u; voffB[i] = (unsigned)(Rb * K + C) * 2u; }
    const size_t kstep = (size_t)(BK * 2);
    const size_t hstep = (size_t)HALF * K * 2;
    const size_t tstep = 2 * hstep;
    const unsigned ldsw = (unsigned)wid * 1024u;
    const int aoff = lds_byte(wr * 64 + fr, fq * 8), boff = lds_byte(wc * 32 + fr, fq * 8);
#define PG8_SA(b, h) (((b) * 2 + (h)) * HTB)
#define PG8_SB(b, h) ((4 + (b) * 2 + (h)) * HTB)
#define PG8_STAGE(bufoff, gbase, voff) do { _Pragma("unroll") for (int _i = 0; _i < 2; ++_i) \
        __builtin_amdgcn_global_load_lds((const unsigned*)((const char*)(gbase) + (voff)[_i]), (PG8_LAS unsigned*)(lds + (bufoff) + ldsw + _i * 8192), 16, 0, 0); } while (0)
#define PG8_LDA(dst, b, h) do { _Pragma("unroll") for (int m = 0; m < 4; ++m) dst[m] = __builtin_shufflevector(*(const PG8_LAS pg8_v4i*)(lds + PG8_SA(b, h) + aoff + m * 2048), *(const PG8_LAS pg8_v4i*)(lds + PG8_SA(b, h) + aoff + m * 2048 + 1024), 0, 1, 2, 3, 4, 5, 6, 7); } while (0)
#define PG8_LDB(dst, b, h) do { _Pragma("unroll") for (int n = 0; n < 2; ++n) dst[n] = __builtin_shufflevector(*(const PG8_LAS pg8_v4i*)(lds + PG8_SB(b, h) + boff + n * 2048), *(const PG8_LAS pg8_v4i*)(lds + PG8_SB(b, h) + boff + n * 2048 + 1024), 0, 1, 2, 3, 4, 5, 6, 7); } while (0)
#define PG8_LO(v) __builtin_bit_cast(bf16x8, __builtin_shufflevector(v, v, 0, 1, 2, 3))
#define PG8_HI(v) __builtin_bit_cast(bf16x8, __builtin_shufflevector(v, v, 4, 5, 6, 7))
#define PG8_MMA(ai, bj, At, Bt) do { __builtin_amdgcn_s_setprio(1); _Pragma("unroll") for (int m = 0; m < 4; ++m) _Pragma("unroll") for (int n = 0; n < 2; ++n) { \
        if constexpr (F8SCALE == 0) { acc[ai][bj][m][n] = __builtin_amdgcn_mfma_f32_16x16x32_bf16(PG8_LO(Bt[n]), PG8_LO(At[m]), acc[ai][bj][m][n], 0, 0, 0); \
                                      acc[ai][bj][m][n] = __builtin_amdgcn_mfma_f32_16x16x32_bf16(PG8_HI(Bt[n]), PG8_HI(At[m]), acc[ai][bj][m][n], 0, 0, 0); } \
        else asm volatile("v_mfma_scale_f32_16x16x128_f8f6f4 %0, %1, %2, %0, %3, %4 op_sel_hi:[0,0,0]" : "+v"(acc[ai][bj][m][n]) : "v"(Bt[n]), "v"(At[m]), "v"(f8_sw_), "v"(f8_sa_)); } \
        __builtin_amdgcn_s_setprio(0); } while (0)
#define PG8_WAIT_V(n) asm volatile("s_waitcnt vmcnt(" #n ")" ::: "memory")
#define PG8_WAIT_L(n) asm volatile("s_waitcnt lgkmcnt(" #n ")" ::: "memory")
#define PG8_BAR __builtin_amdgcn_s_barrier()
#define PG8_SCHED __builtin_amdgcn_sched_barrier(0)
    Unit cur, nxt; int ui = 0;
    if (!S.next(0, cur)) return;
    f32x4 acc[2][2][4][2];
#pragma unroll
    for (int a = 0; a < 2; ++a)
#pragma unroll
        for (int b = 0; b < 2; ++b)
#pragma unroll
            for (int m = 0; m < 4; ++m)
#pragma unroll
                for (int n = 0; n < 2; ++n) acc[a][b][m][n] = (f32x4){0.f, 0.f, 0.f, 0.f};
    pg8_v8i At[4], B0[2], B1[2]; const int f8_sw_ = F8SCALE * 0x01010101, f8_sa_ = 0x7f7f7f7f; (void)f8_sw_; (void)f8_sa_;
    const char* cA = (const char*)g.A + (size_t)cur.pm * tstep; const char* cB = (const char*)g.Bt + (size_t)cur.pn * tstep;
    S.a_ready(cur);
    if constexpr (SP2) {
        PG8_STAGE(PG8_SB(0, 0), cB, voffB); PG8_STAGE(PG8_SB(0, 1), cB + hstep, voffB); PG8_STAGE(PG8_SA(0, 0), cA, voffA); PG8_STAGE(PG8_SA(0, 1), cA + hstep, voffA);
        if (wr == 1) PG8_BAR;
        PG8_WAIT_V(2); PG8_BAR;
        PG8_STAGE(PG8_SB(1, 0), cB + kstep, voffB); PG8_STAGE(PG8_SA(1, 0), cA + kstep, voffA); PG8_STAGE(PG8_SB(1, 1), cB + hstep + kstep, voffB);
        PG8_WAIT_V(6); PG8_BAR;
    } else {
        PG8_STAGE(PG8_SB(0, 0), cB, voffB); PG8_STAGE(PG8_SA(0, 0), cA, voffA); PG8_STAGE(PG8_SB(0, 1), cB + hstep, voffB); PG8_STAGE(PG8_SA(0, 1), cA + hstep, voffA);
        if (wr == 1) PG8_BAR;
        PG8_WAIT_V(4); PG8_BAR;
        PG8_STAGE(PG8_SB(1, 0), cB + kstep, voffB); PG8_STAGE(PG8_SA(1, 0), cA + kstep, voffA); PG8_STAGE(PG8_SB(1, 1), cB + hstep + kstep, voffB);
        PG8_WAIT_V(6); PG8_BAR;
    }
    for (;;) {
        const bool has_next = S.next(ui + 1, nxt);
        const char* nA = has_next ? (const char*)g.A + (size_t)nxt.pm * tstep : cA; const char* nB = has_next ? (const char*)g.Bt + (size_t)nxt.pn * tstep : cB;
        for (int t = 0; t < nt; t += 2) {
            const bool last = (t == nt - 2);
            const char* a1 = cA + (size_t)(t + 1) * kstep;
            const char* a2 = last ? nA : cA + (size_t)(t + 2) * kstep; const char* b2 = last ? nB : cB + (size_t)(t + 2) * kstep;
            const char* a3 = a2 + kstep; const char* b3 = b2 + kstep;
            if (last && has_next) S.a_ready(nxt);
            if constexpr (SP2) {
            PG8_LDB(B0, 0, 0); PG8_LDB(B1, 0, 1); PG8_SCHED; PG8_LDA(At, 0, 0); PG8_STAGE(PG8_SA(1, 1), a1 + hstep, voffA);
            PG8_WAIT_V(8); PG8_WAIT_L(0); PG8_BAR; PG8_MMA(0, 0, At, B0); PG8_MMA(0, 1, At, B1); PG8_BAR; PG8_SCHED;
            PG8_LDA(At, 0, 1); PG8_STAGE(PG8_SB(0, 0), b2, voffB); PG8_STAGE(PG8_SB(0, 1), b2 + hstep, voffB); PG8_STAGE(PG8_SA(0, 0), a2, voffA);
            PG8_WAIT_V(8); PG8_WAIT_L(0); PG8_BAR; PG8_MMA(1, 0, At, B0); PG8_MMA(1, 1, At, B1); PG8_BAR; PG8_SCHED;
            PG8_LDB(B0, 1, 0); PG8_LDB(B1, 1, 1); PG8_SCHED; PG8_LDA(At, 1, 0); PG8_STAGE(PG8_SA(0, 1), a2 + hstep, voffA);
            PG8_WAIT_V(8); PG8_WAIT_L(0); PG8_BAR; PG8_MMA(0, 0, At, B0); PG8_MMA(0, 1, At, B1); PG8_BAR; PG8_SCHED;
            PG8_LDA(At, 1, 1); PG8_STAGE(PG8_SB(1, 0), b3, voffB); PG8_STAGE(PG8_SB(1, 1), b3 + hstep, voffB); PG8_STAGE(PG8_SA(1, 0), a3, voffA);
            PG8_WAIT_V(8); PG8_WAIT_L(0); PG8_BAR; PG8_MMA(1, 0, At, B0); PG8_MMA(1, 1, At, B1); PG8_BAR; PG8_SCHED;
            } else {
            PG8_LDB(B0, 0, 0); PG8_SCHED; PG8_LDA(At, 0, 0); PG8_STAGE(PG8_SA(1, 1), a1 + hstep, voffA);
            PG8_WAIT_L(8); PG8_BAR; PG8_WAIT_L(0); PG8_MMA(0, 0, At, B0); PG8_BAR; PG8_SCHED;
            PG8_LDB(B1, 0, 1); PG8_STAGE(PG8_SB(0, 0), b2, voffB);
            PG8_BAR; PG8_WAIT_L(0); PG8_MMA(0, 1, At, B1); PG8_BAR;
            PG8_LDA(At, 0, 1); PG8_STAGE(PG8_SA(0, 0), a2, voffA);
            PG8_BAR; PG8_WAIT_L(0); PG8_MMA(1, 0, At, B0); PG8_BAR; PG8_SCHED;
            PG8_STAGE(PG8_SB(0, 1), b2 + hstep, voffB);
            PG8_WAIT_V(6); PG8_BAR; PG8_MMA(1, 1, At, B1); PG8_BAR;
            PG8_LDB(B0, 1, 0); PG8_SCHED; PG8_LDA(At, 1, 0); PG8_STAGE(PG8_SA(0, 1), a2 + hstep, voffA);
            PG8_WAIT_L(8); PG8_BAR; PG8_WAIT_L(0); PG8_MMA(0, 0, At, B0); PG8_BAR; PG8_SCHED;
            PG8_LDB(B1, 1, 1); PG8_STAGE(PG8_SB(1, 0), b3, voffB);
            PG8_BAR; PG8_WAIT_L(0); PG8_MMA(0, 1, At, B1); PG8_BAR;
            PG8_LDA(At, 1, 1); PG8_STAGE(PG8_SA(1, 0), a3, voffA);
            PG8_BAR; PG8_WAIT_L(0); PG8_MMA(1, 0, At, B0); PG8_BAR; PG8_SCHED;
            PG8_STAGE(PG8_SB(1, 1), b3 + hstep, voffB);
            PG8_WAIT_V(6); PG8_BAR; PG8_MMA(1, 1, At, B1); PG8_BAR;
            }
        }
        if constexpr (ALIGN_EPI) { if (wr == 0) PG8_BAR; }
        if constexpr (!Epi::AFTER_DRAIN) { E(acc, cur, wr, wc, fr, fq); S.done(cur); }
        if (!has_next) break;
#pragma unroll
        for (int a = 0; a < 2; ++a)
#pragma unroll
            for (int b = 0; b < 2; ++b)
#pragma unroll
                for (int m = 0; m < 4; ++m)
#pragma unroll
                    for (int n = 0; n < 2; ++n) acc[a][b][m][n] = (f32x4){0.f, 0.f, 0.f, 0.f};
        cur = nxt; cA = nA; cB = nB; ++ui;
        if constexpr (ALIGN_EPI) { if (wr == 1) PG8_BAR; }
    }
    PG8_WAIT_V(0);
    if constexpr (!ALIGN_EPI) { if (wr == 0) PG8_BAR; }
    PG8_BAR;
    if constexpr (Epi::AFTER_DRAIN) { E.fused(acc, cur, wr, wc, fr, fq, lds, wid, lane); S.done(cur); }
#undef PG8_SA
#undef PG8_SB
#undef PG8_STAGE
#undef PG8_LDA
#undef PG8_LDB
#undef PG8_MMA
#undef PG8_WAIT_V
#undef PG8_WAIT_L
#undef PG8_BAR
#undef PG8_SCHED
}
}

#ifndef PG8_SP2
#define PG8_SP2 true
#endif
#ifndef PG8_ALIGN
#define PG8_ALIGN true
#endif
#define GAS __attribute__((address_space(1)))
#define LAS __attribute__((address_space(3)))
typedef unsigned short bf16;
typedef unsigned v4u __attribute__((ext_vector_type(4)));
typedef float f32x4 __attribute__((ext_vector_type(4)));
typedef short bf16x8 __attribute__((ext_vector_type(8)));
typedef GAS unsigned gu32;
typedef GAS unsigned long long gu64;
#define RLX_AGENT __ATOMIC_RELAXED, __HIP_MEMORY_SCOPE_AGENT
#define LDS_WAIT() asm volatile("s_waitcnt lgkmcnt(0)" ::: "memory")
#define VM_WAIT() asm volatile("s_waitcnt vmcnt(0)" ::: "memory")
__device__ __forceinline__ unsigned long long rt() { return __builtin_amdgcn_s_memrealtime(); }
__device__ __forceinline__ unsigned f2bf(float f) { return pg8::cvt_pk_bf16(f, f) & 0xffffu; }
__device__ __forceinline__ unsigned pk2(float lo, float hi) { return pg8::cvt_pk_bf16(lo, hi); }

#define XB_TMO      128
#define XB_XCNT(j)  (256  + 64 * (j))
#define XB_XSUB(j)  (1280 + 64 * (j))
#define XB_XGEN(j)  (2304 + 64 * (j))
#define XB_TOP      3328
#define XB_TOPGEN   3392
#define XCD_BAR_WORDS 3456
#define XB_SPIN_CAP (1u << 18)

__device__ __forceinline__ unsigned xb_ld(unsigned* p)              { return __hip_atomic_load(p, __ATOMIC_RELAXED, __HIP_MEMORY_SCOPE_AGENT); }
__device__ __forceinline__ unsigned xb_add(unsigned* p, unsigned v) { return __hip_atomic_fetch_add(p, v, __ATOMIC_RELAXED, __HIP_MEMORY_SCOPE_AGENT); }
__device__ __forceinline__ unsigned xb_xcc_id() { return (unsigned)__builtin_amdgcn_s_getreg((3 << 11) | 20) & 0xFu; }
#define XB_SPIN(cond, bar) do { unsigned _sp = 0; while (cond) { __builtin_amdgcn_s_sleep(1); \
    if ((++_sp & 255u) == 0u) { if (xb_ld(&(bar)[XB_TMO])) break; if (_sp > XB_SPIN_CAP) { atomicAdd(&(bar)[XB_TMO], 1u); break; } } } } while (0)

struct XcdBarrier {
    unsigned* bar; unsigned x;
    volatile LAS unsigned* st;
};

__device__ __forceinline__ XcdBarrier xcd_barrier_post(unsigned* bar, volatile LAS unsigned* st) {
    XcdBarrier b; b.bar = bar; b.x = xb_xcc_id(); b.st = st;
    if (threadIdx.x == 0) (void)xb_add(&bar[XB_XCNT(b.x)], 1u);
    return b;
}
__device__ __forceinline__ void xcd_barrier_complete(unsigned* bar, unsigned x, unsigned& nloc, unsigned& nx) {
    const unsigned G = gridDim.x * gridDim.y * gridDim.z;
    unsigned sum, cnt, mine, sp = 0u;
    for (;;) {
        sum = 0u; cnt = 0u; mine = 0u;
#pragma unroll
        for (unsigned j = 0; j < 16; ++j) { const unsigned c = xb_ld(&bar[XB_XCNT(j)]); sum += c; cnt += (c > 0u) ? 1u : 0u; mine = (j == x) ? c : mine; }
        if (sum == G) break;
        __builtin_amdgcn_s_sleep(1);
        if ((++sp & 255u) == 0u) { if (xb_ld(&bar[XB_TMO])) break; if (sp > XB_SPIN_CAP) { atomicAdd(&bar[XB_TMO], 1u); break; } }
    }
    nloc = mine > 0u ? mine : 1u; nx = cnt > 0u ? cnt : 1u;
}

__device__ __forceinline__ void xcd_barrier(const XcdBarrier& b) {
    asm volatile("s_waitcnt vmcnt(0)" ::: "memory");
    __syncthreads();
    if (threadIdx.x == 0) {
        unsigned* bar = b.bar;
        __builtin_amdgcn_s_waitcnt(0);
        unsigned nloc = b.st[0], nx = b.st[1];
        if (nloc == 0u) { xcd_barrier_complete(bar, b.x, nloc, nx); b.st[0] = nloc; b.st[1] = nx; }
        const unsigned old = xb_add(&bar[XB_XSUB(b.x)], 1u);
        const unsigned gen = old / nloc;
        if (old + 1u == (gen + 1u) * nloc) {
            __builtin_amdgcn_fence(__ATOMIC_RELEASE, "agent");
            asm volatile("s_waitcnt vmcnt(0)" ::: "memory");
            const unsigned og = xb_add(&bar[XB_TOP], 1u);
            const unsigned tg = og / nx;
            if (og + 1u == (tg + 1u) * nx) xb_add(&bar[XB_TOPGEN], 1u);
            else XB_SPIN(xb_ld(&bar[XB_TOPGEN]) == tg, bar);
            __builtin_amdgcn_fence(__ATOMIC_ACQUIRE, "agent");
            xb_add(&bar[XB_XGEN(b.x)], 1u);
            asm volatile("s_waitcnt vmcnt(0)" ::: "memory");
        } else {
            XB_SPIN(xb_ld(&bar[XB_XGEN(b.x)]) == gen, bar);
            __builtin_amdgcn_fence(__ATOMIC_ACQUIRE, "agent");
            asm volatile("s_waitcnt vmcnt(0)" ::: "memory");
        }
    }
    __syncthreads();
}

constexpr int NWAVES = 8;
constexpr int T = 16384, D = 2048, NIN = 11264;
constexpr float LN_EPS = 1e-5f, GN_EPS = 64e-5f, ALPHA = 1.189207115002721f;
constexpr size_t MiB = 1u << 20;
constexpr size_t WS_CTL = 0, CTL_ZERO_BYTES = 1 * MiB;
constexpr size_t WS_WIN = 1 * MiB, WS_WUA = 45 * MiB, WS_WUB = 49 * MiB, WS_WO = 53 * MiB, WS_WQ = 61 * MiB, WS_WPG = 69 * MiB, WS_WPE = 77 * MiB;
constexpr size_t WS_L1 = 78 * MiB;
constexpr size_t WS_L2 = 79 * MiB + MiB / 2;
constexpr size_t WS_PB = 81 * MiB;
constexpr size_t WS_XB = 90 * MiB;
constexpr size_t WS_PROJ = 154 * MiB;
constexpr size_t WS_Q = WS_PROJ, WS_K = WS_PROJ + 32 * MiB, WS_V = WS_PROJ + 64 * MiB, WS_RR = WS_PROJ + 96 * MiB, WS_RK = WS_PROJ + 128 * MiB, WS_RV = WS_PROJ + 160 * MiB, WS_RC = WS_PROJ + 192 * MiB;
constexpr size_t WS_YB = WS_RK;
constexpr size_t WS_QC = WS_Q, WS_GTC = WS_K, WS_YLC = WS_V, WS_TTC = WS_RC, WS_SB = WS_XB + 32 * MiB;
constexpr size_t WS_YRAW = WS_K;
constexpr size_t WS_GG = 522 * MiB;
constexpr size_t WS_DREG = 378 * MiB;
constexpr size_t WS_HID = WS_DREG;
constexpr size_t WS_XW = WS_DREG + 24 * MiB;
constexpr size_t WS_LW = WS_DREG;
constexpr size_t WS_AA = WS_DREG + 64 * MiB;
constexpr size_t WS_GATE = WS_DREG;
constexpr size_t WS_MIX = WS_XB, WS_PQ = WS_XB;
constexpr size_t WS_MIX8 = WS_Q;
constexpr size_t WS_X1B8 = 378 * MiB;
constexpr size_t WS_H1 = 186 * MiB;
constexpr size_t WS_X1 = 314 * MiB;
constexpr size_t WS_X1B = 442 * MiB;
constexpr size_t WS_PE = 154 * MiB;
constexpr size_t WS_YA = 506 * MiB;
constexpr size_t WS_IDX = 506 * MiB, WS_PG = 514 * MiB;
constexpr size_t WS_UB = 314 * MiB, WS_VB = 346 * MiB;
constexpr float U_SCALE = 64.0f, V_SCALE = 2.0f;
constexpr int ROW6 = 1536;
constexpr size_t WS_RKC = 538 * MiB;
constexpr size_t WS_END = 539 * MiB;
constexpr int CW_BAR = 4096, CW_RCNT = 16384;
constexpr int RING_OFF = 0, RING_BYTES = 131072, LDSCTL_OFF = RING_BYTES, MISC_OFF = LDSCTL_OFF + 320, LDS_BYTES = 147456;
constexpr int NPHASE = 13;
#ifndef MK_ONE_LAUNCH
#define MK_ONE_LAUNCH 0
#endif

struct Frame {
    LAS unsigned char* lds; volatile LAS unsigned* MISC; gu32* ctl;
    int tid, lane, wave, vcu, G;
};
template <int CTRL> __device__ __forceinline__ float dpp_addc(float x) { return x + __builtin_bit_cast(float, __builtin_amdgcn_mov_dpp(__builtin_bit_cast(int, x), CTRL, 0xf, 0xf, true)); }
__device__ __forceinline__ float row16_sum(float x) { x = dpp_addc<0xB1>(x); x = dpp_addc<0x4E>(x); x = dpp_addc<0x141>(x); x = dpp_addc<0x140>(x); return x; }
__device__ __forceinline__ float wave_sum(float v) {
    v = row16_sum(v);
    const float a = __builtin_bit_cast(float, __builtin_amdgcn_readlane(__builtin_bit_cast(int, v), 0)), b = __builtin_bit_cast(float, __builtin_amdgcn_readlane(__builtin_bit_cast(int, v), 16));
    const float c = __builtin_bit_cast(float, __builtin_amdgcn_readlane(__builtin_bit_cast(int, v), 32)), d = __builtin_bit_cast(float, __builtin_amdgcn_readlane(__builtin_bit_cast(int, v), 48));
    return (a + b) + (c + d);
}
__device__ __forceinline__ float wave_max(float v) {
#pragma unroll
    for (int o = 1; o < 64; o <<= 1) v = fmaxf(v, __shfl_xor(v, o));
    return v;
}
__device__ __forceinline__ float bflo(unsigned w) { return __uint_as_float(w << 16); }
__device__ __forceinline__ float bfhi(unsigned w) { return __uint_as_float(w & 0xffff0000u); }
__device__ __forceinline__ float bf1(bf16 b) { return __uint_as_float(((unsigned)b) << 16); }
typedef __attribute__((ext_vector_type(2))) __bf16 bf16x2_t;
typedef float f32x16 __attribute__((ext_vector_type(16)));
__device__ __forceinline__ float dot2(unsigned a, unsigned b, float c) { return __builtin_amdgcn_fdot2_f32_bf16(__builtin_bit_cast(bf16x2_t, a), __builtin_bit_cast(bf16x2_t, b), c, false); }
__device__ __forceinline__ float rdlane(float v, int l) { return __builtin_bit_cast(float, __builtin_amdgcn_readlane(__builtin_bit_cast(int, v), l)); }
__device__ __forceinline__ int rdlanei(int v, int l) { return __builtin_amdgcn_readlane(v, l); }

__device__ __forceinline__ void p0_transpose_item(const float* W, int K, int N, bf16* WT, LAS float* scr, int item, int lane) {
    const int nblk = N / 32, kb = item / nblk, nb = item % nblk, k0 = 64 * kb, n0 = 32 * nb;
#pragma unroll 8
    for (int i = 0; i < 32; ++i) { const int kk = 2 * i + (lane >> 5); scr[kk * 33 + (lane & 31)] = W[(size_t)(k0 + kk) * N + n0 + (lane & 31)]; }
    LDS_WAIT(); asm volatile("" ::: "memory");
    const int c = lane & 7;
#pragma unroll
    for (int j = 0; j < 4; ++j) { const int n = (lane >> 3) + 8 * j; const LAS float* s = scr + (8 * c) * 33 + n;
        v4u o; o.x = pk2(s[0 * 33], s[1 * 33]); o.y = pk2(s[2 * 33], s[3 * 33]); o.z = pk2(s[4 * 33], s[5 * 33]); o.w = pk2(s[6 * 33], s[7 * 33]);
        *(GAS v4u*)(WT + (size_t)(n0 + n) * K + k0 + 8 * c) = o; }
    LDS_WAIT(); asm volatile("" ::: "memory");
}
__device__ __forceinline__ void p0_transpose_item8(const float* W, int K, int N, unsigned char* WT, float scale, LAS float* scr, int item, int lane) {
    const int nblk = N / 32, kb = item / nblk, nb = item % nblk, k0 = 64 * kb, n0 = 32 * nb;
#pragma unroll 8
    for (int i = 0; i < 32; ++i) { const int kk = 2 * i + (lane >> 5); scr[kk * 33 + (lane & 31)] = W[(size_t)(k0 + kk) * N + n0 + (lane & 31)] * scale; }
    LDS_WAIT(); asm volatile("" ::: "memory");
    const int c = lane & 7;
#pragma unroll
    for (int j = 0; j < 4; ++j) { const int n = (lane >> 3) + 8 * j; const LAS float* s = scr + (8 * c) * 33 + n;
        int w0_ = 0, w1_ = 0; w0_ = __builtin_amdgcn_cvt_pk_fp8_f32(s[0 * 33], s[1 * 33], w0_, false); w0_ = __builtin_amdgcn_cvt_pk_fp8_f32(s[2 * 33], s[3 * 33], w0_, true);
        w1_ = __builtin_amdgcn_cvt_pk_fp8_f32(s[4 * 33], s[5 * 33], w1_, false); w1_ = __builtin_amdgcn_cvt_pk_fp8_f32(s[6 * 33], s[7 * 33], w1_, true);
        *(GAS unsigned long long*)(WT + (size_t)(n0 + n) * K + k0 + 8 * c) = (unsigned long long)(unsigned)w0_ | ((unsigned long long)(unsigned)w1_ << 32); }
    LDS_WAIT(); asm volatile("" ::: "memory");
}
__device__ __forceinline__ void cvt_rows_bf16(const float* src, bf16* dst, size_t n8, size_t i0, size_t stride) {
    for (size_t i = i0; i < n8; i += stride) { const f32x4 a = ((const GAS f32x4*)src)[2 * i], b = ((const GAS f32x4*)src)[2 * i + 1];
        v4u o; o.x = pk2(a.x, a.y); o.y = pk2(a.z, a.w); o.z = pk2(b.x, b.y); o.w = pk2(b.z, b.w); ((GAS v4u*)dst)[i] = o; }
}


typedef short v4i16_t __attribute__((ext_vector_type(4)));
constexpr int RW_PIT = 144, RW_SLOT = 64 * RW_PIT;
__device__ __forceinline__ bf16x8 rw_fd(const LAS unsigned char* img, int r0, int ks, int idx, int g) { return *(const LAS bf16x8*)(img + (r0 + idx) * RW_PIT + (32 * ks + 8 * g) * 2); }
__device__ __forceinline__ bf16x8 rw_ft(const LAS unsigned char* img, int c0, int ks, int idx, int g) {
    const LAS unsigned char* a = img + (32 * ks + 8 * g + (idx >> 2)) * RW_PIT + (c0 + 4 * (idx & 3)) * 2;
    const v4i16_t lo = __builtin_amdgcn_ds_read_tr16_b64_v4i16((LAS v4i16_t*)a), hi = __builtin_amdgcn_ds_read_tr16_b64_v4i16((LAS v4i16_t*)(a + 4 * RW_PIT));
    return __builtin_shufflevector(lo, hi, 0, 1, 2, 3, 4, 5, 6, 7); }
template <int MX, int MY> __device__ __forceinline__ void rw_mm2(const LAS unsigned char* X, const LAS unsigned char* Y, int mt, int ntb, f32x4& c0, f32x4& c1, int idx, int g) {
#pragma unroll
    for (int ks = 0; ks < 2; ++ks) {
        const bf16x8 a = MX ? rw_ft(X, 16 * mt, ks, idx, g) : rw_fd(X, 16 * mt, ks, idx, g);
        const bf16x8 b0 = MY ? rw_ft(Y, 16 * ntb, ks, idx, g) : rw_fd(Y, 16 * ntb, ks, idx, g);
        const bf16x8 b1 = MY ? rw_ft(Y, 16 * ntb + 16, ks, idx, g) : rw_fd(Y, 16 * ntb + 16, ks, idx, g);
        c0 = __builtin_amdgcn_mfma_f32_16x16x32_bf16(a, b0, c0, 0, 0, 0); c1 = __builtin_amdgcn_mfma_f32_16x16x32_bf16(a, b1, c1, 0, 0, 0); }
}
template <int MX, int MY, int MZ> __device__ __forceinline__ void rw_mm2_shareA(const LAS unsigned char* X, const LAS unsigned char* Y, const LAS unsigned char* Z, int mt, int ntb, f32x4& c0, f32x4& c1, f32x4& d0, f32x4& d1, int idx, int g) {
#pragma unroll
    for (int ks = 0; ks < 2; ++ks) {
        const bf16x8 a = MX ? rw_ft(X, 16 * mt, ks, idx, g) : rw_fd(X, 16 * mt, ks, idx, g);
        const bf16x8 y0 = MY ? rw_ft(Y, 16 * ntb, ks, idx, g) : rw_fd(Y, 16 * ntb, ks, idx, g), y1 = MY ? rw_ft(Y, 16 * ntb + 16, ks, idx, g) : rw_fd(Y, 16 * ntb + 16, ks, idx, g);
        const bf16x8 z0 = MZ ? rw_ft(Z, 16 * ntb, ks, idx, g) : rw_fd(Z, 16 * ntb, ks, idx, g), z1 = MZ ? rw_ft(Z, 16 * ntb + 16, ks, idx, g) : rw_fd(Z, 16 * ntb + 16, ks, idx, g);
        c0 = __builtin_amdgcn_mfma_f32_16x16x32_bf16(a, y0, c0, 0, 0, 0); c1 = __builtin_amdgcn_mfma_f32_16x16x32_bf16(a, y1, c1, 0, 0, 0);
        d0 = __builtin_amdgcn_mfma_f32_16x16x32_bf16(a, z0, d0, 0, 0, 0); d1 = __builtin_amdgcn_mfma_f32_16x16x32_bf16(a, z1, d1, 0, 0, 0); }
}
template <int MX, int MW, int MY> __device__ __forceinline__ void rw_mm2_shareB(const LAS unsigned char* X, const LAS unsigned char* W, const LAS unsigned char* Y, int mt, int ntb, f32x4& c0, f32x4& c1, f32x4& d0, f32x4& d1, int idx, int g) {
#pragma unroll
    for (int ks = 0; ks < 2; ++ks) {
        const bf16x8 a = MX ? rw_ft(X, 16 * mt, ks, idx, g) : rw_fd(X, 16 * mt, ks, idx, g), w = MW ? rw_ft(W, 16 * mt, ks, idx, g) : rw_fd(W, 16 * mt, ks, idx, g);
        const bf16x8 y0 = MY ? rw_ft(Y, 16 * ntb, ks, idx, g) : rw_fd(Y, 16 * ntb, ks, idx, g), y1 = MY ? rw_ft(Y, 16 * ntb + 16, ks, idx, g) : rw_fd(Y, 16 * ntb + 16, ks, idx, g);
        c0 = __builtin_amdgcn_mfma_f32_16x16x32_bf16(a, y0, c0, 0, 0, 0); c1 = __builtin_amdgcn_mfma_f32_16x16x32_bf16(a, y1, c1, 0, 0, 0);
        d0 = __builtin_amdgcn_mfma_f32_16x16x32_bf16(w, y0, d0, 0, 0, 0); d1 = __builtin_amdgcn_mfma_f32_16x16x32_bf16(w, y1, d1, 0, 0, 0); }
}
#define RW_FR(M, img, r0, ks) ((M) ? rw_ft(img, r0, ks, idx, g) : rw_fd(img, r0, ks, idx, g))
#define RW_MF(a, b, c) c = __builtin_amdgcn_mfma_f32_16x16x32_bf16(a, b, c, 0, 0, 0)
template <int MX, int MY> __device__ __forceinline__ void rw_mm22(const LAS unsigned char* X, const LAS unsigned char* Y, int mt0, int nt0, f32x4 (&c)[2][2], int idx, int g, bool k0 = true, bool k1 = true) {
#pragma unroll
    for (int ks = 0; ks < 2; ++ks) if (ks == 0 ? k0 : k1) { const bf16x8 a0 = RW_FR(MX, X, 16 * mt0, ks), a1 = RW_FR(MX, X, 16 * mt0 + 16, ks), b0 = RW_FR(MY, Y, 16 * nt0, ks), b1 = RW_FR(MY, Y, 16 * nt0 + 16, ks);
        RW_MF(a0, b0, c[0][0]); RW_MF(a0, b1, c[0][1]); RW_MF(a1, b0, c[1][0]); RW_MF(a1, b1, c[1][1]); }
}
template <int MX, int MY, int MZ> __device__ __forceinline__ void rw_mm22_shareA(const LAS unsigned char* X, const LAS unsigned char* Y, const LAS unsigned char* Z, int mt0, int nt0, f32x4 (&c)[2][2], f32x4 (&d)[2][2], int idx, int g, bool cy1 = true) {
#pragma unroll
    for (int ks = 0; ks < 2; ++ks) { const bf16x8 a0 = RW_FR(MX, X, 16 * mt0, ks), a1 = RW_FR(MX, X, 16 * mt0 + 16, ks), z0 = RW_FR(MZ, Z, 16 * nt0, ks), z1 = RW_FR(MZ, Z, 16 * nt0 + 16, ks);
        if (ks == 0 || cy1) { const bf16x8 y0 = RW_FR(MY, Y, 16 * nt0, ks), y1 = RW_FR(MY, Y, 16 * nt0 + 16, ks); RW_MF(a0, y0, c[0][0]); RW_MF(a0, y1, c[0][1]); RW_MF(a1, y0, c[1][0]); RW_MF(a1, y1, c[1][1]); }
        RW_MF(a0, z0, d[0][0]); RW_MF(a0, z1, d[0][1]); RW_MF(a1, z0, d[1][0]); RW_MF(a1, z1, d[1][1]); }
}
template <int MX, int MW, int MY> __device__ __forceinline__ void rw_mm22_shareB(const LAS unsigned char* X, const LAS unsigned char* W, const LAS unsigned char* Y, int mt0, int nt0, f32x4 (&c)[2][2], f32x4 (&d)[2][2], int idx, int g, bool cx0 = true, bool cx1 = true, bool dw0 = true) {
#pragma unroll
    for (int ks = 0; ks < 2; ++ks) { const bool cx = ks == 0 ? cx0 : cx1, dw = ks == 0 ? dw0 : true;
        if (cx || dw) { const bf16x8 y0 = RW_FR(MY, Y, 16 * nt0, ks), y1 = RW_FR(MY, Y, 16 * nt0 + 16, ks);
            if (cx) { const bf16x8 a0 = RW_FR(MX, X, 16 * mt0, ks), a1 = RW_FR(MX, X, 16 * mt0 + 16, ks); RW_MF(a0, y0, c[0][0]); RW_MF(a0, y1, c[0][1]); RW_MF(a1, y0, c[1][0]); RW_MF(a1, y1, c[1][1]); }
            if (dw) { const bf16x8 w0 = RW_FR(MW, W, 16 * mt0, ks), w1 = RW_FR(MW, W, 16 * mt0 + 16, ks); RW_MF(w0, y0, d[0][0]); RW_MF(w0, y1, d[0][1]); RW_MF(w1, y0, d[1][0]); RW_MF(w1, y1, d[1][1]); } } }
}
__device__ __forceinline__ void rw_st(LAS unsigned char* E, int mt, int nt, const f32x4& c, int idx, int g) {
    *(LAS unsigned long long*)(E + (16 * nt + idx) * RW_PIT + (16 * mt + 4 * g) * 2) = (unsigned long long)pk2(c[0], c[1]) | ((unsigned long long)pk2(c[2], c[3]) << 32); }
__device__ __forceinline__ f32x4 rw_ld(const LAS unsigned char* E, int mt, int nt, int idx, int g) {
    const unsigned long long w = *(const LAS unsigned long long*)(E + (16 * nt + idx) * RW_PIT + (16 * mt + 4 * g) * 2); const unsigned lo = (unsigned)w, hi = (unsigned)(w >> 32);
    return (f32x4){bflo(lo), bfhi(lo), bflo(hi), bfhi(hi)}; }
__device__ __forceinline__ void rw_stg_wt(bf16* E, int mt, int nt, const f32x4& c, int idx, int g) {
    __hip_atomic_store((gu64*)(E + (16 * nt + idx) * 64 + 16 * mt + 4 * g), (unsigned long long)pk2(c[0], c[1]) | ((unsigned long long)pk2(c[2], c[3]) << 32), RLX_AGENT); }
__device__ __forceinline__ void rw_stg(bf16* E, int mt, int nt, const f32x4& c, int idx, int g) {
    *(GAS unsigned long long*)(E + (16 * nt + idx) * 64 + 16 * mt + 4 * g) = (unsigned long long)pk2(c[0], c[1]) | ((unsigned long long)pk2(c[2], c[3]) << 32); }

__device__ __forceinline__ void bitonic_merge16_desc(float (&v)[16]) {
#pragma unroll
    for (int j = 8; j > 0; j >>= 1)
#pragma unroll
        for (int i = 0; i < 16; ++i) { const int l = i ^ j; if (l > i) { const float hi = fmaxf(v[i], v[l]), lo = fminf(v[i], v[l]); v[i] = hi; v[l] = lo; } }
}
__device__ __forceinline__ void bitonic_sort16_desc(float (&v)[16]) {
#pragma unroll
    for (int k = 2; k <= 16; k <<= 1)
#pragma unroll
        for (int j = k >> 1; j > 0; j >>= 1)
#pragma unroll
            for (int i = 0; i < 16; ++i) { const int l = i ^ j; if (l > i) { const float hi = fmaxf(v[i], v[l]), lo = fminf(v[i], v[l]); const bool desc = (i & k) == 0; v[i] = desc ? hi : lo; v[l] = desc ? lo : hi; } }
}
__device__ __forceinline__ void top16_merge_desc(float (&a)[16], const float (&b)[16]) {
#pragma unroll
    for (int i = 0; i < 16; ++i) a[i] = fmaxf(a[i], b[15 - i]);
    bitonic_merge16_desc(a);
}

#ifndef P4_VARIANT
#define P4_VARIANT 0
#endif
#ifndef P4_ALIGN
#define P4_ALIGN PG8_ALIGN
#endif
#ifndef P4_SP2
#define P4_SP2 PG8_SP2
#endif
#ifndef DIAG_TOL
#define DIAG_TOL 0.03f
#endif
#ifndef REPEAT_SUB
#define REPEAT_SUB 0
#endif
#ifndef REPEAT_PHASE
#define REPEAT_PHASE -1
#endif
#define REP_BEGIN(k) for (int rep_ = 0; rep_ < ((REPEAT_PHASE) == (k) ? 2 : 1); ++rep_) {
#define REP_END(k) if ((REPEAT_PHASE) == (k) && rep_ == 0) xcd_barrier(bar); }
#ifndef DIAG_RATIO
#define DIAG_RATIO 2.0
#endif
#ifndef DIAG_UNIT_MS
#define DIAG_UNIT_MS 10
#endif
#ifndef DIAG_LAST
#define DIAG_LAST -1
#endif
template <class TT_> __device__ __forceinline__ float dg_val(const TT_* p, size_t i);
template <> __device__ __forceinline__ float dg_val<float>(const float* p, size_t i) { return p[i]; }
template <> __device__ __forceinline__ float dg_val<bf16>(const bf16* p, size_t i) { return bf1(p[i]); }
template <> __device__ __forceinline__ float dg_val<int>(const int* p, size_t i) { return (float)p[i] * (1.0f / 1024.0f); }
template <class TT_> __device__ __forceinline__ void digest(float* out, int slot, const TT_* buf, size_t n, size_t gt, size_t NGT) {
    constexpr size_t M = (size_t)1024 * 2048;
    for (size_t e = gt; e < M; e += NGT) { float s = 0.f; for (size_t j = e; j < n; j += M) s += dg_val<TT_>(buf, j); out[(size_t)slot * M + e] = s; }
}

__device__ __forceinline__ void cvt_rows_fp8(const float* src, unsigned char* dst, size_t n16, float scale, size_t i0, size_t stride) {
    for (size_t i = i0; i < n16; i += stride) { v4u o;
#pragma unroll
        for (int q = 0; q < 4; ++q) { const f32x4 a = ((const GAS f32x4*)src)[4 * i + q] * scale; int w = 0; w = __builtin_amdgcn_cvt_pk_fp8_f32(a.x, a.y, w, false); w = __builtin_amdgcn_cvt_pk_fp8_f32(a.z, a.w, w, true); o[q] = (unsigned)w; }
        ((GAS v4u*)dst)[i] = o; }
}

typedef unsigned v16u_t __attribute__((ext_vector_type(16))); typedef float v32f_t __attribute__((ext_vector_type(32))); typedef float v16f_t __attribute__((ext_vector_type(16))); typedef unsigned v6u_t __attribute__((ext_vector_type(6)));
__device__ __forceinline__ void cvt_rows_fp6(const float* src, unsigned char* dst, int nrows, float scale, int gw, int ngw, int lane) {
    for (int row = gw; row < nrows; row += ngw) { v16f_t a, b;
#pragma unroll
        for (int q = 0; q < 8; ++q) { const f32x4 v = *(const GAS f32x4*)(src + (size_t)row * 2048 + 256 * q + 4 * lane) * scale; a[2 * q] = v.x; b[2 * q] = v.y; a[2 * q + 1] = v.z; b[2 * q + 1] = v.w; }
        const v6u_t p = __builtin_amdgcn_cvt_scalef32_2xpk16_fp6_f32(a, b, 1.0f); GAS unsigned long long* d = (GAS unsigned long long*)(dst + (size_t)row * 1536 + 24 * lane);
        d[0] = (unsigned long long)p[0] | ((unsigned long long)p[1] << 32); d[1] = (unsigned long long)p[2] | ((unsigned long long)p[3] << 32); d[2] = (unsigned long long)p[4] | ((unsigned long long)p[5] << 32); }
}
__device__ __forceinline__ v32f_t ld_fp6x32(const unsigned char* p) { const GAS unsigned long long* q = (const GAS unsigned long long*)p; const unsigned long long w0 = q[0], w1 = q[1], w2 = q[2];
    const v6u_t v = {(unsigned)w0, (unsigned)(w0 >> 32), (unsigned)w1, (unsigned)(w1 >> 32), (unsigned)w2, (unsigned)(w2 >> 32)}; return __builtin_amdgcn_cvt_scalef32_pk32_f32_fp6(v, 1.0f); }

struct Args { const float* in[30]; float* out; unsigned char* ws; int ph_lo, ph_hi, li, pad; };

__global__ void __launch_bounds__(NWAVES * 64, 2) mk_fwd(Args args) {
    extern __shared__ __attribute__((aligned(16))) unsigned char lds[];
    for (int u = threadIdx.x; u < (LDS_BYTES - LDSCTL_OFF) / 4; u += NWAVES * 64) ((LAS unsigned*)((LAS unsigned char*)lds + LDSCTL_OFF))[u] = 0u;
    __syncthreads();
    XcdBarrier bar; bar.bar = (unsigned*)(args.ws + WS_CTL) + CW_BAR; bar.x = 0; bar.st = nullptr;
    if (MK_ONE_LAUNCH) bar = xcd_barrier_post((unsigned*)(args.ws + WS_CTL) + CW_BAR, (volatile LAS unsigned*)((LAS unsigned char*)lds + MISC_OFF) + 8);
    const int lo = args.ph_lo, hi = args.ph_hi;
#ifdef DIAG_TIME
    if (blockIdx.x == 0 && threadIdx.x == 0) { const unsigned long long t0_ = __builtin_amdgcn_s_memrealtime(); ((unsigned long long*)(args.ws + WS_CTL))[8] = t0_; }
#endif
#ifndef PHMASK
#define PHMASK 0xffffffffu
#endif
#define IN(k) (((PHMASK >> (k)) & 1u) && lo <= (k) && (k) < hi)
#define SEAM(k) do { if (IN(k) && IN((k) + 1)) xcd_barrier(bar); } while (0)
#define LOCALS const int tid = threadIdx.x, lane = tid & 63, wave = __builtin_amdgcn_readfirstlane(tid >> 6); const int G_ = gridDim.x, bx_ = blockIdx.x, vcu = (G_ % 8 == 0) ? (bx_ % 8) * (G_ / 8) + bx_ / 8 : bx_; \
    const int gw = vcu * NWAVES + wave, NGW = G_ * NWAVES; const size_t gt = (size_t)vcu * 512 + tid, NGT = (size_t)G_ * 512; (void)lane; (void)gw; (void)NGW; (void)gt; (void)NGT;
#define LDSP ((LAS unsigned char*)lds)
#define x_in (args.in[0])
#define p_in (args.in[1])
#define w_in (args.in[2])
#define mu (args.in[3])
#define w0 (args.in[4])
#define wl1 (args.in[5])
#define wl2 (args.in[6])
#define a0 (args.in[7])
#define al1 (args.in[8])
#define al2 (args.in[9])
#define gl1 (args.in[10])
#define gl2 (args.in[11])
#define k_k (args.in[12])
#define k_a (args.in[13])
#define r_k (args.in[14])
#define lnx_w (args.in[15])
#define lnx_b (args.in[16])
#define w_up_a (args.in[17])
#define w_up_b (args.in[18])
#define w_o (args.in[19])
#define ln1_w (args.in[20])
#define ln1_b (args.in[21])
#define peer_wq (args.in[22])
#define sub_keys (args.in[23])
#define peer_u (args.in[24])
#define peer_v (args.in[25])
#define ple_wg (args.in[26])
#define ple_wp (args.in[27])
#define ln2_w (args.in[28])
#define ln2_b (args.in[29])
#define WIN_T ((bf16*)(args.ws + WS_WIN))
#define WUA_T ((bf16*)(args.ws + WS_WUA))
#define WUB_T ((bf16*)(args.ws + WS_WUB))
#define WO_T ((bf16*)(args.ws + WS_WO))
#define WQ_T ((bf16*)(args.ws + WS_WQ))
#define WPG_T ((bf16*)(args.ws + WS_WPG))
#define WPE_T ((bf16*)(args.ws + WS_WPE))
#define L1_T ((bf16*)(args.ws + WS_L1))
#define L2_T ((bf16*)(args.ws + WS_L2))
#define PB ((bf16*)(args.ws + WS_PB))
#define XB ((bf16*)(args.ws + WS_XB))
#define QB ((bf16*)(args.ws + WS_Q))
#define KB ((bf16*)(args.ws + WS_K))
#define VB ((bf16*)(args.ws + WS_V))
#define RR ((bf16*)(args.ws + WS_RR))
#define RK ((bf16*)(args.ws + WS_RK))
#define RV ((bf16*)(args.ws + WS_RV))
#define RC ((bf16*)(args.ws + WS_RC))
#define YA ((bf16*)(args.ws + WS_YA))
#define YB ((bf16*)(args.ws + WS_YB))
#define YRAW ((float*)(args.ws + WS_YRAW))
#define QC ((bf16*)(args.ws + WS_QC))
#define GTC ((bf16*)(args.ws + WS_GTC))
#define YLC ((bf16*)(args.ws + WS_YLC))
#define TTC ((bf16*)(args.ws + WS_TTC))
#define SBF ((bf16*)(args.ws + WS_SB))
#define MIX8 ((unsigned char*)(args.ws + WS_MIX8))
#define X1B8 ((unsigned char*)(args.ws + WS_X1B8))
#define UB ((unsigned char*)(args.ws + WS_UB))
#define VB2 ((unsigned char*)(args.ws + WS_VB))
#define GG ((bf16*)(args.ws + WS_GG))
#define HID ((bf16*)(args.ws + WS_HID))
#define XW ((bf16*)(args.ws + WS_XW))
#define LW ((float*)(args.ws + WS_LW))
#define AA ((bf16*)(args.ws + WS_AA))
#define GATE ((bf16*)(args.ws + WS_GATE))
#define MIX ((bf16*)(args.ws + WS_MIX))
#define PQ ((bf16*)(args.ws + WS_PQ))
#define H1 ((float*)(args.ws + WS_H1))
#define X1 ((float*)(args.ws + WS_X1))
#define X1B ((bf16*)(args.ws + WS_X1B))
#define PE ((bf16*)(args.ws + WS_PE))
#define IDX ((int*)(args.ws + WS_IDX))
#define PG ((float*)(args.ws + WS_PG))
#define RKC ((float*)(args.ws + WS_RKC))
    if (IN(0)) {
        LOCALS
        LAS float* scr = (LAS float*)(LDSP + RING_OFF + wave * 16384);
        constexpr int I_IN = (D / 64) * (NIN / 32), I_UA = (1024 / 64) * (D / 32), I_SQ = (D / 64) * (D / 32), I_PE = (256 / 64) * (D / 32);
        for (int it = gw; it < I_IN; it += NGW) p0_transpose_item8(w_in, D, NIN, (unsigned char*)WIN_T, 32.0f, scr, it, lane);
        for (size_t i = gt; i < (size_t)2 * 294912; i += NGT) {
            if (i < 294912) { const int j = (int)(i & 7), ln = (int)(i >> 3) & 63, ks = (int)(i >> 9) & 63, m = (int)(i >> 15); const int row = m * 32 + (ln & 31), col = ks * 16 + 8 * (ln >> 5) + j;
                const float v = row < 64 ? wl1[(size_t)col * 64 + row] : (row < 128 ? al1[(size_t)col * 64 + (row - 64)] : gl1[(size_t)col * 160 + (row - 128)]);
                L1_T[i] = (bf16)f2bf(v); }
            else { const int e = (int)(i - 294912); float v;
                if (e < 131072) { const int e2 = e & 65535, jj = e2 & 7, ln = (e2 >> 3) & 63, sx = (e2 >> 9) & 3, ct = e2 >> 11; const int c = ct * 32 + (ln & 31), jh = 16 * sx + 8 * (jj >> 2) + 4 * (ln >> 5) + (jj & 3);
                    v = (e < 65536 ? wl2 : al2)[(size_t)jh * 1024 + c]; }
                else { const int e2 = e - 131072, jj = e2 & 7, ln = (e2 >> 3) & 63, rest = e2 >> 9, sx = rest % 10, ct = rest / 10; const int c = ct * 32 + (ln & 31), jh = 16 * sx + 8 * (jj >> 2) + 4 * (ln >> 5) + (jj & 3);
                    v = gl2[(size_t)jh * 1024 + c]; }
                L2_T[e] = (bf16)f2bf(v); }
        }
        cvt_rows_fp8(x_in, (unsigned char*)XB, (size_t)T * D / 16, 1.0f, gt, NGT);
    }
    SEAM(0);
    if (IN(1)) {
        LOCALS
        REP_BEGIN(1)
        pg8::Gemm g{XB, WIN_T, T, 7168, D / 2}; pg8::StaticOrder S; S.init(T, 7168, (int)gridDim.x, (int)blockIdx.x);
        pg8::EpiB16<pg8::FnProj> E{{QB}};
        pg8::gemm_phase<pg8::EpiB16<pg8::FnProj>, pg8::StaticOrder, PG8_ALIGN, PG8_SP2, 122>(LDSP + RING_OFF, g, S, E);
        REP_END(1)
    }
    SEAM(1);
    if (IN(2)) {
        LOCALS
        REP_BEGIN(2)
#ifndef SKIP_LORA
        for (int rl_ = 0; rl_ < (REPEAT_SUB == 1 ? 2 : 1); ++rl_) {
        {
            typedef unsigned long long u64;
            LAS unsigned char* hl = LDSP + RING_OFF + 73728;
            LAS unsigned char* cst = LDSP + RING_OFF;
            const int w4 = wave & 3, half = wave >> 2, n = lane & 31, h = lane >> 5;
            const int m0 = w4 == 0 ? 0 : (w4 == 1 ? 2 : (w4 == 2 ? 4 : 7)), cnt = w4 == 2 ? 3 : 2, xsel = w4 < 2 ? w4 : 2;
            for (int pair = (int)blockIdx.x; pair < T / 64; pair += (int)gridDim.x) {
                const int tb = 64 * pair;
                f32x16 Ca[3], Cb[3];
#pragma unroll
                for (int m = 0; m < 3; ++m)
#pragma unroll
                    for (int i = 0; i < 16; ++i) { Ca[m][i] = 0.f; Cb[m][i] = 0.f; }
#pragma unroll 1
                for (int kh = 0; kh < 2; ++kh) {
                    for (int i = tid; i < 65 * 64; i += 512) { const int row = i >> 6, c16 = i & 63; const int tr = tb - 1 + row;
                        const v4u v = tr >= 0 ? *(const GAS v4u*)(RC + (size_t)tr * 1024 + kh * 512 + c16 * 8) : (v4u){0u, 0u, 0u, 0u};
                        *(LAS v4u*)(cst + row * 1040 + c16 * 16) = v; }
                    __syncthreads();
#pragma unroll 2
                    for (int k2 = 16 * half; k2 < 16 * half + 16; ++k2) {
                        const int ks = kh * 32 + k2, k0 = ks * 16 + 8 * h, kl = k2 * 16 + 8 * h;
                        const GAS f32x4* mm = (const GAS f32x4*)(mu + (3 + xsel) * 1024 + k0); const f32x4 ma = mm[0], mb = mm[1];
                        const float mv[8] = {ma.x, ma.y, ma.z, ma.w, mb.x, mb.y, mb.z, mb.w};
                        const GAS bf16x8* af = (const GAS bf16x8*)(L1_T + ((size_t)m0 * 64 + ks) * 512) + lane;
                        const bf16x8 f0 = af[0], f1 = af[64 * 64], f2 = cnt == 3 ? af[2 * 64 * 64] : f0;
#pragma unroll
                        for (int tl = 0; tl < 2; ++tl) {
                            const v4u cv = *(const LAS v4u*)(cst + (32 * tl + n + 1) * 1040 + kl * 2), pv = *(const LAS v4u*)(cst + (32 * tl + n) * 1040 + kl * 2);
                            const float c[8] = {bflo(cv.x), bfhi(cv.x), bflo(cv.y), bfhi(cv.y), bflo(cv.z), bfhi(cv.z), bflo(cv.w), bfhi(cv.w)};
                            const float p[8] = {bflo(pv.x), bfhi(pv.x), bflo(pv.y), bfhi(pv.y), bflo(pv.z), bfhi(pv.z), bflo(pv.w), bfhi(pv.w)};
                            float o[8];
#pragma unroll
                            for (int j = 0; j < 8; ++j) o[j] = c[j] + (p[j] - c[j]) * mv[j];
                            v4u xw_; xw_.x = pk2(o[0], o[1]); xw_.y = pk2(o[2], o[3]); xw_.z = pk2(o[4], o[5]); xw_.w = pk2(o[6], o[7]); const bf16x8 xf = __builtin_bit_cast(bf16x8, xw_);
                            if (tl == 0) { Ca[0] = __builtin_amdgcn_mfma_f32_32x32x16_bf16(f0, xf, Ca[0], 0, 0, 0); Ca[1] = __builtin_amdgcn_mfma_f32_32x32x16_bf16(f1, xf, Ca[1], 0, 0, 0); if (cnt == 3) Ca[2] = __builtin_amdgcn_mfma_f32_32x32x16_bf16(f2, xf, Ca[2], 0, 0, 0); }
                            else { Cb[0] = __builtin_amdgcn_mfma_f32_32x32x16_bf16(f0, xf, Cb[0], 0, 0, 0); Cb[1] = __builtin_amdgcn_mfma_f32_32x32x16_bf16(f1, xf, Cb[1], 0, 0, 0); if (cnt == 3) Cb[2] = __builtin_amdgcn_mfma_f32_32x32x16_bf16(f2, xf, Cb[2], 0, 0, 0); }
                        }
                    }
                    __syncthreads();
                }
                { LAS unsigned char* px = LDSP + RING_OFF;
#define LX_EXPORT(C) { _Pragma("unroll") for (int m = 0; m < 3; ++m) if (m < cnt) { _Pragma("unroll") for (int q = 0; q < 4; ++q) *(LAS f32x4*)(px + ((((half * 9 + m0 + m) * 4 + q) * 64 + lane) * 16)) = (f32x4){C[m][4 * q], C[m][4 * q + 1], C[m][4 * q + 2], C[m][4 * q + 3]}; } }
#define LX_FINISH(C) { _Pragma("unroll") for (int m = 0; m < 3; ++m) if (m < cnt) { _Pragma("unroll") for (int q = 0; q < 4; ++q) { const f32x4 v_ = *(const LAS f32x4*)(px + (((((1 - half) * 9 + m0 + m) * 4 + q) * 64 + lane) * 16)); C[m][4 * q] += v_[0]; C[m][4 * q + 1] += v_[1]; C[m][4 * q + 2] += v_[2]; C[m][4 * q + 3] += v_[3]; } \
                    _Pragma("unroll") for (int s2 = 0; s2 < 2; ++s2) { float v[8]; \
                        _Pragma("unroll") for (int j = 0; j < 8; ++j) { const float x = C[m][8 * s2 + j]; v[j] = w4 == 0 ? pg8::ftanh(x) : (w4 == 1 ? x : pg8::fsigmoid(x)); } \
                        v4u w; w.x = pk2(v[0], v[1]); w.y = pk2(v[2], v[3]); w.z = pk2(v[4], v[5]); w.w = pk2(v[6], v[7]); \
                        *(LAS v4u*)(hl + ((half * 18 + 2 * (m0 + m) + s2) * 64 + lane) * 16) = w; } } }
                  if (half == 0) LX_EXPORT(Cb) else LX_EXPORT(Ca)
                  __syncthreads();
                  if (half == 0) LX_FINISH(Ca) else LX_FINISH(Cb)
#undef LX_EXPORT
#undef LX_FINISH
                }
                __syncthreads();
#pragma unroll 1
                for (int c4 = 0; c4 < 4; ++c4) {
                    const int ct = w4 * 8 + 4 * half + c4;
                    const GAS bf16x8* fw = (const GAS bf16x8*)(L2_T + (size_t)ct * 4 * 512) + lane; const GAS bf16x8* fa = (const GAS bf16x8*)(L2_T + 65536 + (size_t)ct * 4 * 512) + lane;
                    const GAS bf16x8* fg = (const GAS bf16x8*)(L2_T + 131072 + (size_t)ct * 10 * 512) + lane;
                    bf16x8 wfr[18];
#pragma unroll
                    for (int s2 = 0; s2 < 4; ++s2) { wfr[s2] = fw[64 * s2]; wfr[4 + s2] = fa[64 * s2]; }
#pragma unroll
                    for (int s2 = 0; s2 < 10; ++s2) wfr[8 + s2] = fg[64 * s2];
#pragma unroll 1
                    for (int tl = 0; tl < 2; ++tl) {
                        const int tt_ = (2 * pair + tl) * 32 + n;
                        f32x16 Yw, Ya, Yg;
#pragma unroll
                        for (int i = 0; i < 16; ++i) { Yw[i] = 0.f; Ya[i] = 0.f; Yg[i] = 0.f; }
#pragma unroll
                        for (int s2 = 0; s2 < 4; ++s2) { Yw = __builtin_amdgcn_mfma_f32_32x32x16_bf16(wfr[s2], *(const LAS bf16x8*)(hl + ((tl * 18 + s2) * 64 + lane) * 16), Yw, 0, 0, 0);
                            Ya = __builtin_amdgcn_mfma_f32_32x32x16_bf16(wfr[4 + s2], *(const LAS bf16x8*)(hl + ((tl * 18 + 4 + s2) * 64 + lane) * 16), Ya, 0, 0, 0); }
#pragma unroll
                        for (int s2 = 0; s2 < 10; ++s2) Yg = __builtin_amdgcn_mfma_f32_32x32x16_bf16(wfr[8 + s2], *(const LAS bf16x8*)(hl + ((tl * 18 + 8 + s2) * 64 + lane) * 16), Yg, 0, 0, 0);
#pragma unroll
                        for (int q = 0; q < 4; ++q) { const int c0 = ct * 32 + 8 * q + 4 * h;
                            const f32x4 wb = *(const GAS f32x4*)(w0 + c0), ab = *(const GAS f32x4*)(a0 + c0); f32x4 lwv; float av[4], gv[4];
#pragma unroll
                            for (int j = 0; j < 4; ++j) { lwv[j] = -__expf(-pg8::fsoftplus(-(wb[j] + Yw[4 * q + j])) - 0.5f); av[j] = pg8::fsigmoid(ab[j] + Ya[4 * q + j]); gv[j] = Yg[4 * q + j]; }
                            *(GAS f32x4*)(LW + (size_t)tt_ * 1024 + c0) = lwv;
                            *(GAS u64*)(AA + (size_t)tt_ * 1024 + c0) = (u64)pk2(av[0], av[1]) | ((u64)pk2(av[2], av[3]) << 32);
                            { int w8_ = 0; w8_ = __builtin_amdgcn_cvt_pk_fp8_f32(gv[0], gv[1], w8_, false); w8_ = __builtin_amdgcn_cvt_pk_fp8_f32(gv[2], gv[3], w8_, true); *(GAS unsigned*)((unsigned char*)GG + (size_t)tt_ * 1024 + c0) = (unsigned)w8_; } }
                    }
                }
                __syncthreads();
            }
        }
        if (REPEAT_SUB == 1) __syncthreads(); }
#endif
#ifndef SKIP_ATTN
        for (int ra_ = 0; ra_ < (REPEAT_SUB == 2 ? 2 : 1); ++ra_) {
        {
            LAS unsigned char* vl = LDSP + RING_OFF + wave * 4608;
            const int n = lane & 31, h = lane >> 5, i16 = lane & 15, dcol = 16 * ((lane >> 4) & 1);
            for (int task = gw; task < 16 * (T / 32); task += NGW) {
                const int head = task & 15, q0 = (task >> 4) * 32;
                bf16x8 qf[4];
#pragma unroll
                for (int ks = 0; ks < 4; ++ks) qf[ks] = *(const GAS bf16x8*)(QB + (size_t)(q0 + n) * 1024 + head * 64 + 16 * ks + 8 * h);
                f32x16 O0, O1;
#pragma unroll
                for (int i = 0; i < 16; ++i) { O0[i] = 0.f; O1[i] = 0.f; }
                float carry = 1.f;
                bf16x8 kf[4]; v4u vv[4];
#pragma unroll
                for (int ks = 0; ks < 4; ++ks) kf[ks] = *(const GAS bf16x8*)(KB + (size_t)(q0 + n) * 1024 + head * 64 + 16 * ks + 8 * h);
#pragma unroll
                for (int i = 0; i < 4; ++i) vv[i] = *(const GAS v4u*)(VB + (size_t)(q0 + n) * 1024 + head * 64 + 32 * h + 8 * i);
                { const int kt = q0;
                    f32x16 S;
#pragma unroll
                    for (int i = 0; i < 16; ++i) S[i] = 0.f;
#pragma unroll
                    for (int ks = 0; ks < 4; ++ks) S = __builtin_amdgcn_mfma_f32_32x32x16_bf16(kf[ks], qf[ks], S, 0, 0, 0);
#pragma unroll
                    for (int i = 0; i < 4; ++i) *(LAS v4u*)(vl + n * RW_PIT + (32 * h + 8 * i) * 2) = vv[i];
                    { const int ktn = kt >= 32 ? kt - 32 : 0;
#pragma unroll
                      for (int ks = 0; ks < 4; ++ks) kf[ks] = *(const GAS bf16x8*)(KB + (size_t)(ktn + n) * 1024 + head * 64 + 16 * ks + 8 * h);
#pragma unroll
                      for (int i = 0; i < 4; ++i) vv[i] = *(const GAS v4u*)(VB + (size_t)(ktn + n) * 1024 + head * 64 + 32 * h + 8 * i); }
                    float kp[16], ev[16], G[4], Gp[4];
#pragma unroll
                    for (int i = 0; i < 16; ++i) { const float z = fminf(S[i], 115.f); const bool valid = (kt + (i & 3) + 8 * (i >> 2) + 4 * h) < (q0 + n); const float e = __builtin_amdgcn_exp2f(z); const float k = __builtin_amdgcn_rcpf(1.0f + e); kp[i] = valid ? k : 1.f; ev[i] = valid ? e : 0.f; }
#pragma unroll
                    for (int q = 0; q < 4; ++q) { kp[4 * q + 2] *= kp[4 * q + 3]; kp[4 * q + 1] *= kp[4 * q + 2]; kp[4 * q] *= kp[4 * q + 1]; G[q] = kp[4 * q]; }
#pragma unroll
                    for (int q = 0; q < 4; ++q) Gp[q] = __shfl_xor(G[q], 32);
                    float off[4]; float later = 1.f;
#pragma unroll
                    for (int q = 3; q >= 0; --q) { off[q] = later * (h == 0 ? Gp[q] : 1.f); later *= G[q] * Gp[q]; }
                    bf16x8 wf[2];
                    { float w[16];
#pragma unroll
                      for (int i = 0; i < 16; ++i) w[i] = ev[i] * kp[i] * (off[i >> 2] * carry);
#pragma unroll
                      for (int s2 = 0; s2 < 2; ++s2) { v4u pw; pw.x = pk2(w[8 * s2], w[8 * s2 + 1]); pw.y = pk2(w[8 * s2 + 2], w[8 * s2 + 3]); pw.z = pk2(w[8 * s2 + 4], w[8 * s2 + 5]); pw.w = pk2(w[8 * s2 + 6], w[8 * s2 + 7]); wf[s2] = __builtin_bit_cast(bf16x8, pw); } }
                    carry *= later;
#pragma unroll
                    for (int s2 = 0; s2 < 2; ++s2) {
#pragma unroll
                        for (int m2 = 0; m2 < 2; ++m2) { const LAS unsigned char* ap = vl + (16 * s2 + 4 * h + (i16 >> 2)) * RW_PIT + (32 * m2 + dcol + 4 * (i16 & 3)) * 2;
                            const v4i16_t lo = __builtin_amdgcn_ds_read_tr16_b64_v4i16((LAS v4i16_t*)ap), hi = __builtin_amdgcn_ds_read_tr16_b64_v4i16((LAS v4i16_t*)(ap + 8 * RW_PIT));
                            const bf16x8 af = __builtin_shufflevector(lo, hi, 0, 1, 2, 3, 4, 5, 6, 7);
                            if (m2 == 0) O0 = __builtin_amdgcn_mfma_f32_32x32x16_bf16(af, wf[s2], O0, 0, 0, 0); else O1 = __builtin_amdgcn_mfma_f32_32x32x16_bf16(af, wf[s2], O1, 0, 0, 0); } }
                }
                if (!__all(carry < 1.0e-44f))
                for (int kt = q0 - 32; kt >= 0; kt -= 32) {
                    f32x16 S;
#pragma unroll
                    for (int i = 0; i < 16; ++i) S[i] = 0.f;
#pragma unroll
                    for (int ks = 0; ks < 4; ++ks) S = __builtin_amdgcn_mfma_f32_32x32x16_bf16(kf[ks], qf[ks], S, 0, 0, 0);
#pragma unroll
                    for (int i = 0; i < 4; ++i) *(LAS v4u*)(vl + n * RW_PIT + (32 * h + 8 * i) * 2) = vv[i];
                    { const int ktn = kt >= 32 ? kt - 32 : 0;
#pragma unroll
                      for (int ks = 0; ks < 4; ++ks) kf[ks] = *(const GAS bf16x8*)(KB + (size_t)(ktn + n) * 1024 + head * 64 + 16 * ks + 8 * h);
#pragma unroll
                      for (int i = 0; i < 4; ++i) vv[i] = *(const GAS v4u*)(VB + (size_t)(ktn + n) * 1024 + head * 64 + 32 * h + 8 * i); }
                    float kp[16], ev[16], G[4], Gp[4];
#pragma unroll
                    for (int i = 0; i < 16; ++i) { const float z = fminf(S[i], 115.f); const bool valid = true; const float e = __builtin_amdgcn_exp2f(z); const float k = __builtin_amdgcn_rcpf(1.0f + e); kp[i] = valid ? k : 1.f; ev[i] = valid ? e : 0.f; }
#pragma unroll
                    for (int q = 0; q < 4; ++q) { kp[4 * q + 2] *= kp[4 * q + 3]; kp[4 * q + 1] *= kp[4 * q + 2]; kp[4 * q] *= kp[4 * q + 1]; G[q] = kp[4 * q]; }
#pragma unroll
                    for (int q = 0; q < 4; ++q) Gp[q] = __shfl_xor(G[q], 32);
                    float off[4]; float later = 1.f;
#pragma unroll
                    for (int q = 3; q >= 0; --q) { off[q] = later * (h == 0 ? Gp[q] : 1.f); later *= G[q] * Gp[q]; }
                    bf16x8 wf[2];
                    { float w[16];
#pragma unroll
                      for (int i = 0; i < 16; ++i) w[i] = ev[i] * kp[i] * (off[i >> 2] * carry);
#pragma unroll
                      for (int s2 = 0; s2 < 2; ++s2) { v4u pw; pw.x = pk2(w[8 * s2], w[8 * s2 + 1]); pw.y = pk2(w[8 * s2 + 2], w[8 * s2 + 3]); pw.z = pk2(w[8 * s2 + 4], w[8 * s2 + 5]); pw.w = pk2(w[8 * s2 + 6], w[8 * s2 + 7]); wf[s2] = __builtin_bit_cast(bf16x8, pw); } }
                    carry *= later;
#pragma unroll
                    for (int s2 = 0; s2 < 2; ++s2) {
#pragma unroll
                        for (int m2 = 0; m2 < 2; ++m2) { const LAS unsigned char* ap = vl + (16 * s2 + 4 * h + (i16 >> 2)) * RW_PIT + (32 * m2 + dcol + 4 * (i16 & 3)) * 2;
                            const v4i16_t lo = __builtin_amdgcn_ds_read_tr16_b64_v4i16((LAS v4i16_t*)ap), hi = __builtin_amdgcn_ds_read_tr16_b64_v4i16((LAS v4i16_t*)(ap + 8 * RW_PIT));
                            const bf16x8 af = __builtin_shufflevector(lo, hi, 0, 1, 2, 3, 4, 5, 6, 7);
                            if (m2 == 0) O0 = __builtin_amdgcn_mfma_f32_32x32x16_bf16(af, wf[s2], O0, 0, 0, 0); else O1 = __builtin_amdgcn_mfma_f32_32x32x16_bf16(af, wf[s2], O1, 0, 0, 0); } }
                    if (__all(carry < 1.0e-44f)) break;
                }
#pragma unroll
                for (int q = 0; q < 4; ++q) {
                    *(GAS unsigned*)((unsigned char*)YA + (size_t)(q0 + n) * 1024 + head * 64 + 8 * q + 4 * h) = ({ int w8_ = 0; w8_ = __builtin_amdgcn_cvt_pk_fp8_f32(O0[4 * q], O0[4 * q + 1], w8_, false); w8_ = __builtin_amdgcn_cvt_pk_fp8_f32(O0[4 * q + 2], O0[4 * q + 3], w8_, true); (unsigned)w8_; });
                    *(GAS unsigned*)((unsigned char*)YA + (size_t)(q0 + n) * 1024 + head * 64 + 32 + 8 * q + 4 * h) = ({ int w8_ = 0; w8_ = __builtin_amdgcn_cvt_pk_fp8_f32(O1[4 * q], O1[4 * q + 1], w8_, false); w8_ = __builtin_amdgcn_cvt_pk_fp8_f32(O1[4 * q + 2], O1[4 * q + 3], w8_, true); (unsigned)w8_; }); }
            }
        }
        }
#endif
        REP_END(2)
    }
    SEAM(2);
    if (IN(3)) {
        LOCALS
        REP_BEGIN(3)
        constexpr int NCHB = 16; const int NRB = (int)gridDim.x - NCHB;
        gu32* rcnt = (gu32*)(args.ws + WS_CTL) + CW_RCNT;
        const bool chb = (int)blockIdx.x >= NRB; const int u_first = chb ? (int)blockIdx.x - NRB : 16 + (int)blockIdx.x, u_stride = chb ? 4096 : NRB;
        {
        const int idx = lane & 15, g = lane >> 4, mt = wave >> 1, ntb = 2 * (wave & 1);
#define RW_IMG(sl) (LDSP + RING_OFF + (sl) * RW_SLOT)
        LAS float* tot = (LAS float*)(LDSP + RING_OFF + 13 * RW_SLOT); LAS float* gam = tot + 512;
        float nl[8]; bf16 nr[8], nk[8], nv[8], na[8]; bf16 npr = 0, npk = 0, npv = 0;
#define RW_FETCH(un) { const int ch_ = ((un) & 15) * 64 + lane, tb_ = ((un) >> 4) * 64 + 8 * wave; \
            _Pragma("unroll") for (int j = 0; j < 8; ++j) { const size_t o_ = (size_t)(tb_ + j) * 1024 + ch_; nl[j] = LW[o_]; nr[j] = RR[o_]; nk[j] = RK[o_]; nv[j] = RV[o_]; na[j] = AA[o_]; } \
            if (tb_ > 0) { const size_t o_ = (size_t)(tb_ - 1) * 1024 + ch_; npr = RR[o_]; npk = RK[o_]; npv = RV[o_]; } else { npr = 0; npk = 0; npv = 0; } }
        if (u_first < 4096) RW_FETCH(u_first)
        int pub_chunk = -1;
        for (int unit = u_first; unit < 4096; unit += u_stride) {
            const int head = unit & 15, chunk = unit >> 4, t0 = chunk * 64, ch = head * 64 + lane;
            float lwv[8], cumv[8]; float cum = 0.f; float rcur[8], kcur[8], vcur[8], acur[8];
#pragma unroll
            for (int j = 0; j < 8; ++j) { lwv[j] = nl[j]; cum += lwv[j]; cumv[j] = cum; rcur[j] = bf1(nr[j]); kcur[j] = bf1(nk[j]); vcur[j] = bf1(nv[j]); acur[j] = bf1(na[j]); }
            float rp = bf1(npr), kp = bf1(npk), vp = bf1(npv);
            tot[wave * 64 + lane] = cum;
            __syncthreads();
            float off = 0.f, total = 0.f;
#pragma unroll
            for (int w2 = 0; w2 < 8; ++w2) { const float x = tot[w2 * 64 + lane]; total += x; off += (w2 < wave) ? x : 0.f; }
            const float etot = __expf(total);
            if (wave == 0) gam[lane] = etot;
            const float mur = mu[ch], muk = mu[1024 + ch], muv = mu[2048 + ch], ckk = k_k[ch], cka = k_a[ch], crk = r_k[ch];
            {
#pragma unroll
              for (int j = 0; j < 8; ++j) { const int tl = 8 * wave + j;
                const float rc = rcur[j], kc = kcur[j], vc = vcur[j], av = acur[j];
                const float rs = rc + (rp - rc) * mur, ks = kc + (kp - kc) * muk, vs = vc + (vp - vc) * muv; rp = rc; kp = kc; vp = vc;
                float kk = ks * ckk; const float nrm = wave_sum(kk * kk); kk = kk * __builtin_amdgcn_rsqf(fmaxf(nrm, 1e-24f));
                const float km = ks * (1.0f + (av - 1.0f) * cka); const float rkc = wave_sum(rs * km * crk);
                if (lane == 0) RKC[(t0 + tl) * 16 + head] = rkc;
                const float cumt = off + cumv[j], cump = cumt - lwv[j];
                const float eg = __expf(cumt), egp = __expf(cump), ig = __expf(-cumt), eb = etot * ig;
                const int bo = tl * RW_PIT + lane * 2;
                *(LAS bf16*)(RW_IMG(0) + bo) = (bf16)f2bf(-egp * kk);
                *(LAS bf16*)(RW_IMG(1) + bo) = (bf16)f2bf(ig * kk * av);
                *(LAS bf16*)(RW_IMG(2) + bo) = (bf16)f2bf(ig * km);
                *(LAS bf16*)(RW_IMG(3) + bo) = (bf16)f2bf(eg * rs);
                *(LAS bf16*)(RW_IMG(4) + bo) = (bf16)f2bf(eb * kk * av);
                *(LAS bf16*)(RW_IMG(5) + bo) = (bf16)f2bf(eb * km);
                *(LAS bf16*)(RW_IMG(6) + bo) = (bf16)f2bf(vs); } }
            asm volatile("s_waitcnt vmcnt(0)" ::: "memory");
            __syncthreads();
            if (tid == 0 && pub_chunk >= 0) __hip_atomic_fetch_add(rcnt + pub_chunk * 16, 1u, RLX_AGENT);
            if (unit + u_stride < 4096) RW_FETCH(unit + u_stride)
            const f32x4 Z4 = (f32x4){0.f, 0.f, 0.f, 0.f};
            { f32x4 c[4][2];
#pragma unroll
              for (int q = 0; q < 4; ++q) { c[q][0] = Z4; c[q][1] = Z4; }
              rw_mm2<0, 0>(RW_IMG(0), RW_IMG(1), mt, ntb, c[0][0], c[0][1], idx, g); rw_mm2<0, 0>(RW_IMG(0), RW_IMG(2), mt, ntb, c[1][0], c[1][1], idx, g);
              rw_mm2<0, 0>(RW_IMG(3), RW_IMG(1), mt, ntb, c[2][0], c[2][1], idx, g); rw_mm2<0, 0>(RW_IMG(3), RW_IMG(2), mt, ntb, c[3][0], c[3][1], idx, g);
#pragma unroll
              for (int q2 = 0; q2 < 2; ++q2) { const int n = 16 * (ntb + q2) + idx; f32x4 one = Z4;
#pragma unroll
                  for (int i = 0; i < 4; ++i) { const int m = 16 * mt + 4 * g + i; if (!(n < m)) { c[0][q2][i] = 0.f; c[1][q2][i] = 0.f; } if (!(n <= m)) { c[2][q2][i] = 0.f; c[3][q2][i] = 0.f; } one[i] = (n == m) ? 1.f : 0.f; }
                  rw_st(RW_IMG(7), mt, ntb + q2, c[0][q2], idx, g); rw_st(RW_IMG(11), mt, ntb + q2, c[0][q2] + one, idx, g); rw_st(RW_IMG(8), mt, ntb + q2, c[1][q2], idx, g);
                  rw_st(RW_IMG(9), mt, ntb + q2, c[2][q2], idx, g); rw_st(RW_IMG(10), mt, ntb + q2, c[3][q2], idx, g); } }
            __syncthreads();
            const int tmA = (0x33103322 >> (4 * wave)) & 15, tnA = (0x32101010 >> (4 * wave)) & 15; const bool kA0 = (0x3F >> wave) & 1, kA1 = (0xCF >> wave) & 1;
            const bool hasB = wave == 4 || wave == 5, kB0 = wave == 4, kB1 = wave == 5; const int tmB = wave == 4 ? 1 : 2, tnB = wave == 4 ? 0 : 2;
#define RW_TRI_P(tm, tn, k0, k1) { f32x4 pp = Z4; \
                if (k0) { const bf16x8 a_ = rw_ft(RW_IMG(7), 16 * (tm), 0, idx, g), b_ = rw_fd(RW_IMG(7), 16 * (tn), 0, idx, g); RW_MF(a_, b_, pp); } \
                if (k1) { const bf16x8 a_ = rw_ft(RW_IMG(7), 16 * (tm), 1, idx, g), b_ = rw_fd(RW_IMG(7), 16 * (tn), 1, idx, g); RW_MF(a_, b_, pp); } \
                rw_st(RW_IMG(1), tm, tn, pp, idx, g); }
            RW_TRI_P(tmA, tnA, kA0, kA1)
            if (hasB) RW_TRI_P(tmB, tnB, kB0, kB1)
#undef RW_TRI_P
            if (wave < 6) { const int um_ = (0x211000 >> (4 * wave)) & 15, un_ = (0x332321 >> (4 * wave)) & 15; rw_st(RW_IMG(12), um_, un_, Z4, idx, g); rw_st(RW_IMG(1), um_, un_, Z4, idx, g); }
            __syncthreads();
#define RW_Z22(c) { c[0][0] = Z4; c[0][1] = Z4; c[1][0] = Z4; c[1][1] = Z4; }
#define RW_LD22(c, img) { c[0][0] = rw_ld(img, mt0, nt0, idx, g); c[0][1] = rw_ld(img, mt0, nt0 + 1, idx, g); c[1][0] = rw_ld(img, mt0 + 1, nt0, idx, g); c[1][1] = rw_ld(img, mt0 + 1, nt0 + 1, idx, g); }
#define RW_ST22(img, c) { rw_st(img, mt0, nt0, c[0][0], idx, g); rw_st(img, mt0, nt0 + 1, c[0][1], idx, g); rw_st(img, mt0 + 1, nt0, c[1][0], idx, g); rw_st(img, mt0 + 1, nt0 + 1, c[1][1], idx, g); }
#define RW_STG22(fn, p, c) { fn(p, mt0, nt0, c[0][0], idx, g); fn(p, mt0, nt0 + 1, c[0][1], idx, g); fn(p, mt0 + 1, nt0, c[1][0], idx, g); fn(p, mt0 + 1, nt0 + 1, c[1][1], idx, g); }
            const int wh = wave >> 2, mt0 = 2 * ((wave >> 1) & 1), nt0 = 2 * (wave & 1);
#pragma unroll
            for (int it = 0; it < 5; ++it) {
                const int ps = (it & 1) ? 7 : 1, pd = (it & 1) ? 1 : 7, ns = (it & 1) ? 12 : 11, nd = (it & 1) ? 11 : 12;
#define RW_TRI(tm, tn, k0, k1) { f32x4 nn = rw_ld(RW_IMG(ns), tm, tn, idx, g), pp = Z4; \
                    if (k0) { const bf16x8 a_ = rw_ft(RW_IMG(ps), 16 * (tm), 0, idx, g), bn_ = rw_fd(RW_IMG(ns), 16 * (tn), 0, idx, g); RW_MF(a_, bn_, nn); if (it < 4) { const bf16x8 bp_ = rw_fd(RW_IMG(ps), 16 * (tn), 0, idx, g); RW_MF(a_, bp_, pp); } } \
                    if (k1) { const bf16x8 a_ = rw_ft(RW_IMG(ps), 16 * (tm), 1, idx, g), bn_ = rw_fd(RW_IMG(ns), 16 * (tn), 1, idx, g); RW_MF(a_, bn_, nn); if (it < 4) { const bf16x8 bp_ = rw_fd(RW_IMG(ps), 16 * (tn), 1, idx, g); RW_MF(a_, bp_, pp); } } \
                    rw_st(RW_IMG(nd), tm, tn, nn, idx, g); if (it < 4) rw_st(RW_IMG(pd), tm, tn, pp, idx, g); }
                RW_TRI(tmA, tnA, kA0, kA1)
                if (hasB) RW_TRI(tmB, tnB, kB0, kB1)
#undef RW_TRI
                __syncthreads();
            }
            if (wh == 0) { f32x4 ah[2][2]; RW_Z22(ah) rw_mm22<1, 1>(RW_IMG(0), RW_IMG(12), mt0, nt0, ah, idx, g, true, nt0 == 2); RW_ST22(RW_IMG(2), ah) }
            else { f32x4 wq[2][2]; RW_Z22(wq) rw_mm22<1, 0>(RW_IMG(12), RW_IMG(8), mt0, nt0, wq, idx, g, nt0 == 0, mt0 == 2); RW_ST22(RW_IMG(11), wq) }
            __syncthreads();
            if (wh == 0) { bf16* gt_ = GTC + (size_t)unit * 4096; bf16* tt_ = TTC + (size_t)unit * 4096;
              f32x4 gq[2][2], tq[2][2]; RW_LD22(gq, RW_IMG(3)) RW_Z22(tq)
              rw_mm22_shareA<1, 1, 1>(RW_IMG(2), RW_IMG(9), RW_IMG(4), mt0, nt0, gq, tq, idx, g, nt0 == 2);
              RW_STG22(rw_stg, gt_, gq)
#pragma unroll
              for (int a_ = 0; a_ < 2; ++a_)
#pragma unroll
                  for (int b_ = 0; b_ < 2; ++b_)
#pragma unroll
                      for (int i = 0; i < 4; ++i) { const int m = 16 * (mt0 + a_) + 4 * g + i; if (16 * (nt0 + b_) + idx == m) tq[a_][b_][i] += gam[m]; }
              RW_STG22(rw_stg_wt, tt_, tq) }
            else { f32x4 zq[2][2], xq[2][2]; RW_LD22(zq, RW_IMG(10)) RW_LD22(xq, RW_IMG(5))
              rw_mm22_shareB<1, 1, 0>(RW_IMG(9), RW_IMG(4), RW_IMG(11), mt0, nt0, zq, xq, idx, g, nt0 == 0, mt0 == 2, nt0 == 0);
              RW_ST22(RW_IMG(7), zq) RW_ST22(RW_IMG(1), xq) }
            __syncthreads();
            if (wh == 0) { bf16* yl_ = YLC + (size_t)unit * 4096; f32x4 yq[2][2]; RW_Z22(yq) rw_mm22<1, 1>(RW_IMG(6), RW_IMG(7), mt0, nt0, yq, idx, g, true, nt0 == 2); RW_STG22(rw_stg, yl_, yq) }
            else { bf16* qc_ = QC + (size_t)unit * 4096; f32x4 qq[2][2]; RW_Z22(qq) rw_mm22<1, 1>(RW_IMG(1), RW_IMG(6), mt0, nt0, qq, idx, g); RW_STG22(rw_stg_wt, qc_, qq) }
            __syncthreads();
#undef RW_Z22
#undef RW_LD22
#undef RW_ST22
#undef RW_STG22
            pub_chunk = chunk;
        }
        if (pub_chunk >= 0) { asm volatile("s_waitcnt vmcnt(0)" ::: "memory"); __syncthreads(); if (tid == 0) __hip_atomic_fetch_add(rcnt + pub_chunk * 16, 1u, RLX_AGENT); }
#undef RW_IMG
#undef RW_FETCH
        }
        if (chb) {
            typedef unsigned long long u64;
            volatile LAS unsigned* cw = (volatile LAS unsigned*)(LDSP + RING_OFF);
            LAS unsigned char* ring = LDSP + RING_OFF + 1024;
            constexpr int CH_SLOT = 2 * RW_SLOT, CH_NS = 6; constexpr unsigned CH_CAP = 1u << 24;
            if (tid < 64) cw[tid] = 0u;
            __syncthreads();
            const int head = (int)blockIdx.x - NRB;
            if (wave == 4) {
                int c = 0; unsigned spins = 0;
                while (c < 256) {
                    const int cc = c + lane; const unsigned v = cc < 256 ? __hip_atomic_load(rcnt + cc * 16, RLX_AGENT) : 0u;
                    const unsigned long long m = __ballot(v >= 16u); const int nready = m == ~0ull ? 64 : __builtin_ctzll(~m);
                    if (nready > 0) { __builtin_amdgcn_fence(__ATOMIC_ACQUIRE, "agent"); c += nready; if (lane == 0) cw[0] = (unsigned)c; spins = 0; }
                    else { __builtin_amdgcn_s_sleep(4); if (++spins > (1u << 22)) break; }
                }
            } else if (wave > 4) {
                const int L = wave - 5, lrow = lane >> 3, lc = lane & 7;
                v4u A[16], B[16];
#define LD_WAIT_RDY(c) { unsigned sp_ = 0; while ((unsigned)__builtin_amdgcn_readfirstlane((int)cw[0]) < (unsigned)(c) + 1u) { __builtin_amdgcn_s_sleep(1); if (++sp_ > CH_CAP) break; } asm volatile("" ::: "memory"); }
#define LD_WAIT_FREE(c) { if ((c) >= CH_NS) { unsigned sp_ = 0; for (;;) { const unsigned d_ = cw[16 + 6 * (lane & 3) + (c) % CH_NS]; if (__all(d_ >= (unsigned)((c) - CH_NS) + 1u)) break; __builtin_amdgcn_s_sleep(1); if (++sp_ > CH_CAP) break; } } asm volatile("" ::: "memory"); }
#define LD_LOAD(R, c) { const bf16* tt_ = TTC + (size_t)((c) * 16 + head) * 4096; const bf16* qc_ = QC + (size_t)((c) * 16 + head) * 4096; \
                  _Pragma("unroll") for (int i = 0; i < 8; ++i) { R[i] = *(const GAS v4u*)(tt_ + (8 * i + lrow) * 64 + lc * 8); R[8 + i] = *(const GAS v4u*)(qc_ + (8 * i + lrow) * 64 + lc * 8); } }
#define LD_STORE(R, c) { LAS unsigned char* sl_ = ring + ((c) % CH_NS) * CH_SLOT; \
                  _Pragma("unroll") for (int i = 0; i < 8; ++i) { *(LAS v4u*)(sl_ + (8 * i + lrow) * RW_PIT + lc * 16) = R[i]; *(LAS v4u*)(sl_ + RW_SLOT + (8 * i + lrow) * RW_PIT + lc * 16) = R[8 + i]; } \
                  LDS_WAIT(); if (lane == 0) cw[8 + (c) % CH_NS] = (unsigned)(c) + 1u; }
                LD_WAIT_RDY(L) LD_LOAD(A, L)
                for (int c = L; c < 256; c += 6) {
                    const int c1 = c + 3, c2 = c + 6;
                    if (c1 < 256) { LD_WAIT_RDY(c1) LD_LOAD(B, c1) }
                    LD_WAIT_FREE(c) LD_STORE(A, c)
                    if (c2 < 256) { LD_WAIT_RDY(c2) LD_LOAD(A, c2) }
                    if (c1 < 256) { LD_WAIT_FREE(c1) LD_STORE(B, c1) }
                }
#undef LD_WAIT_RDY
#undef LD_WAIT_FREE
#undef LD_LOAD
#undef LD_STORE
            } else {
                const int vg = wave, idx = lane & 15, g = lane >> 4;
                f32x4 S[4];
#pragma unroll
                for (int m = 0; m < 4; ++m) S[m] = (f32x4){0.f, 0.f, 0.f, 0.f};
                for (int c = 0; c < 256; ++c) {
                    const int slot = c % CH_NS, unit = c * 16 + head;
                    { unsigned sp_ = 0; while ((unsigned)__builtin_amdgcn_readfirstlane((int)cw[8 + slot]) < (unsigned)c + 1u) { __builtin_amdgcn_s_sleep(1); if (++sp_ > CH_CAP) break; } asm volatile("" ::: "memory"); }
                    const LAS unsigned char* sl_ = ring + slot * CH_SLOT;
                    u64 pq[4], pa[4][2][2];
#pragma unroll
                    for (int m = 0; m < 4; ++m) { pq[m] = *(const LAS u64*)(sl_ + RW_SLOT + (16 * vg + idx) * RW_PIT + (16 * m + 4 * g) * 2);
#pragma unroll
                        for (int ks = 0; ks < 2; ++ks) { pa[m][ks][0] = *(const LAS u64*)(sl_ + (16 * m + idx) * RW_PIT + (32 * ks + 4 * g) * 2); pa[m][ks][1] = *(const LAS u64*)(sl_ + (16 * m + idx) * RW_PIT + (32 * ks + 16 + 4 * g) * 2); } }
                    bf16x8 sf[2];
#pragma unroll
                    for (int ks = 0; ks < 2; ++ks) { v4u w; w.x = pk2(S[2 * ks][0], S[2 * ks][1]); w.y = pk2(S[2 * ks][2], S[2 * ks][3]); w.z = pk2(S[2 * ks + 1][0], S[2 * ks + 1][1]); w.w = pk2(S[2 * ks + 1][2], S[2 * ks + 1][3]);
                        sf[ks] = __builtin_bit_cast(bf16x8, w); *(GAS v4u*)(SBF + (((size_t)unit * 4 + vg) * 2 + ks) * 512 + lane * 8) = w; }
                    LDS_WAIT(); asm volatile("" ::: "memory");
                    if (lane == 0) cw[16 + 6 * vg + slot] = (unsigned)c + 1u;
#pragma unroll
                    for (int m = 0; m < 4; ++m) { const unsigned lo = (unsigned)pq[m], hi = (unsigned)(pq[m] >> 32); f32x4 acc = (f32x4){bflo(lo), bfhi(lo), bflo(hi), bfhi(hi)};
#pragma unroll
                        for (int ks = 0; ks < 2; ++ks) { const v4u aw = (v4u){(unsigned)pa[m][ks][0], (unsigned)(pa[m][ks][0] >> 32), (unsigned)pa[m][ks][1], (unsigned)(pa[m][ks][1] >> 32)};
                            acc = __builtin_amdgcn_mfma_f32_16x16x32_bf16(__builtin_bit_cast(bf16x8, aw), sf[ks], acc, 0, 0, 0); }
                        S[m] = acc; }
                }
            }
        }
        REP_END(3)
    }
    SEAM(3);
    if (IN(4)) {
        LOCALS
        REP_BEGIN(4)
        if ((vcu & 1) == 0) {
            pg8::Gemm g{XB, WIN_T + (size_t)7168 * D / 2, T, 4096, D / 2}; pg8::StaticOrder S; S.init(T, 4096, (int)gridDim.x, (int)blockIdx.x);
            pg8::EpiB16<pg8::FnGate> E{{GATE}};
            pg8::gemm_phase<pg8::EpiB16<pg8::FnGate>, pg8::StaticOrder, PG8_ALIGN, PG8_SP2, 122>(LDSP + RING_OFF, g, S, E);
        }
        REP_END(4)
    }
    if (IN(5)) {
        LOCALS
        REP_BEGIN(5)
        typedef unsigned long long u64;
        const int idx = lane & 15, g = lane >> 4;
#pragma unroll 2
        for (int task = gw; task < 16384; task += NGW) {
            const int unit = task >> 2, nt = task & 3, head = unit & 15, t = (unit >> 4) * 64 + 16 * nt + idx;
            const bf16* gt_ = GTC + (size_t)unit * 4096 + (16 * nt + idx) * 64; const bf16* yl_ = YLC + (size_t)unit * 4096 + (16 * nt + idx) * 64;
            bf16x8 bfr[2];
#pragma unroll
            for (int ks = 0; ks < 2; ++ks) { const u64 lo = *(const GAS u64*)(gt_ + 32 * ks + 4 * g), hi = *(const GAS u64*)(gt_ + 32 * ks + 16 + 4 * g);
                bfr[ks] = __builtin_bit_cast(bf16x8, (v4u){(unsigned)lo, (unsigned)(lo >> 32), (unsigned)hi, (unsigned)(hi >> 32)}); }
            f32x4 y[4]; float s1 = 0.f;
#pragma unroll
            for (int vg = 0; vg < 4; ++vg) { const u64 yw = *(const GAS u64*)(yl_ + 16 * vg + 4 * g); const unsigned lo = (unsigned)yw, hi = (unsigned)(yw >> 32); f32x4 acc = (f32x4){bflo(lo), bfhi(lo), bflo(hi), bfhi(hi)};
#pragma unroll
                for (int ks = 0; ks < 2; ++ks) { const bf16x8 af = *(const GAS bf16x8*)(SBF + (((size_t)unit * 4 + vg) * 2 + ks) * 512 + lane * 8); acc = __builtin_amdgcn_mfma_f32_16x16x32_bf16(af, bfr[ks], acc, 0, 0, 0); }
                y[vg] = acc; s1 += (acc[0] + acc[1]) + (acc[2] + acc[3]); }
            s1 += __shfl_xor(s1, 16); s1 += __shfl_xor(s1, 32); const float mean = s1 * (1.0f / 64.0f); float s2 = 0.f;
#pragma unroll
            for (int vg = 0; vg < 4; ++vg) { y[vg] = y[vg] - mean; s2 += (y[vg][0] * y[vg][0] + y[vg][1] * y[vg][1]) + (y[vg][2] * y[vg][2] + y[vg][3] * y[vg][3]); }
            s2 += __shfl_xor(s2, 16); s2 += __shfl_xor(s2, 32); const float rstd = 1.0f / sqrtf(s2 * (1.0f / 64.0f) + GN_EPS);
            const float rk = RKC[t * 16 + head];
#pragma unroll
            for (int vg = 0; vg < 4; ++vg) { const int ch = head * 64 + 16 * vg + 4 * g; const size_t o = (size_t)t * 1024 + ch;
                const f32x4 lwt = *(const GAS f32x4*)(lnx_w + ch), lbt = *(const GAS f32x4*)(lnx_b + ch), mv = *(const GAS f32x4*)(mu + 2048 + ch);
                const u64 vcw = *(const GAS u64*)(RV + o), vpw = t > 0 ? *(const GAS u64*)(RV + o - 1024) : 0ull, gw_ = 0ull; const unsigned g8_ = *(const GAS unsigned*)((const unsigned char*)GG + o); (void)gw_;
                const float vc[4] = {bflo((unsigned)vcw), bfhi((unsigned)vcw), bflo((unsigned)(vcw >> 32)), bfhi((unsigned)(vcw >> 32))};
                const float vp[4] = {bflo((unsigned)vpw), bfhi((unsigned)vpw), bflo((unsigned)(vpw >> 32)), bfhi((unsigned)(vpw >> 32))};
                typedef float f32x2g_ __attribute__((ext_vector_type(2))); const f32x2g_ glo_ = __builtin_amdgcn_cvt_pk_f32_fp8((int)g8_, false), ghi_ = __builtin_amdgcn_cvt_pk_f32_fp8((int)g8_, true); const float gg[4] = {glo_.x, glo_.y, ghi_.x, ghi_.y};
                float ov[4];
#pragma unroll
                for (int i = 0; i < 4; ++i) { const float vs = vc[i] + (vp[i] - vc[i]) * mv[i]; ov[i] = (y[vg][i] * rstd * lwt[i] + lbt[i] + rk * vs) * gg[i]; }
                *(GAS unsigned*)((unsigned char*)YB + o) = ({ int w8_ = 0; w8_ = __builtin_amdgcn_cvt_pk_fp8_f32(ov[0], ov[1], w8_, false); w8_ = __builtin_amdgcn_cvt_pk_fp8_f32(ov[2], ov[3], w8_, true); (unsigned)w8_; }); }
        }
        {
            __syncthreads();
            LAS float* scr = (LAS float*)(LDSP + RING_OFF + wave * 16384);
            constexpr int I_UA = (1024 / 64) * (D / 32), I_SQ = (D / 64) * (D / 32), I_PE = (256 / 64) * (D / 32);
            constexpr int NITEMS = 2 * I_UA + 3 * I_SQ + I_PE;
            for (int it = gw; it < NITEMS; it += NGW) {
                int r = it;
                if (r < I_UA) { p0_transpose_item8(w_up_a, 1024, D, (unsigned char*)WUA_T, 32.0f, scr, r, lane); continue; } r -= I_UA;
                if (r < I_UA) { p0_transpose_item8(w_up_b, 1024, D, (unsigned char*)WUB_T, 32.0f, scr, r, lane); continue; } r -= I_UA;
                if (r < I_SQ) { p0_transpose_item8(w_o, D, D, (unsigned char*)WO_T, 64.0f, scr, r, lane); continue; } r -= I_SQ;
                if (r < I_SQ) { p0_transpose_item(peer_wq, D, D, WQ_T, scr, r, lane); continue; } r -= I_SQ;
                if (r < I_SQ) { p0_transpose_item8(ple_wg, D, D, (unsigned char*)WPG_T, 32.0f, scr, r, lane); continue; } r -= I_SQ;
                p0_transpose_item(ple_wp, 256, D, WPE_T, scr, r, lane);
            }
            cvt_rows_bf16(p_in, PB, (size_t)T * 256 / 8, gt, NGT);
            __syncthreads();
        }
        if ((vcu & 1) != 0) {
            pg8::Gemm g{XB, WIN_T + (size_t)7168 * D / 2, T, 4096, D / 2}; pg8::StaticOrder S; S.init(T, 4096, (int)gridDim.x, (int)blockIdx.x);
            pg8::EpiB16<pg8::FnGate> E{{GATE}};
            pg8::gemm_phase<pg8::EpiB16<pg8::FnGate>, pg8::StaticOrder, PG8_ALIGN, PG8_SP2, 122>(LDSP + RING_OFF, g, S, E);
        }
        REP_END(5)
    }
    SEAM(5);
    if (IN(7)) {
        LOCALS
        REP_BEGIN(7)
        if ((vcu & 1) == 0) { cvt_rows_fp6(peer_u, UB, 16384, U_SCALE, gw, NGW, lane); cvt_rows_fp6(peer_v, VB2, 16384, V_SCALE, gw, NGW, lane); __syncthreads(); }
        { pg8::Gemm g{YA, WUA_T, T, D, 512}; pg8::StaticOrder S; S.init(T, D, (int)gridDim.x, (int)blockIdx.x);
          pg8::EpiB16<pg8::FnMix<0>> E{{GATE, MIX}};
          pg8::gemm_phase<pg8::EpiB16<pg8::FnMix<0>>, pg8::StaticOrder, PG8_ALIGN, PG8_SP2, 122>(LDSP + RING_OFF, g, S, E); }
        __syncthreads();
        { pg8::Gemm g{YB, WUB_T, T, D, 512}; pg8::StaticOrder S; S.init(T, D, (int)gridDim.x, (int)blockIdx.x);
          pg8::EpiB16<pg8::FnMixF8> E{{(const bf16*)((const unsigned char*)GATE + (size_t)T * 2048), MIX, MIX8}};
          pg8::gemm_phase<pg8::EpiB16<pg8::FnMixF8>, pg8::StaticOrder, PG8_ALIGN, PG8_SP2, 122>(LDSP + RING_OFF, g, S, E); }
        if ((vcu & 1) != 0) { cvt_rows_fp6(peer_u, UB, 16384, U_SCALE, gw, NGW, lane); cvt_rows_fp6(peer_v, VB2, 16384, V_SCALE, gw, NGW, lane); }
        REP_END(7)
    }
    SEAM(7);
    if (IN(8)) {
        LOCALS
        REP_BEGIN(8)
        pg8::Gemm g{(const bf16*)MIX8, WO_T, T, D, D / 2}; pg8::StaticOrder S; S.init(T, D, (int)gridDim.x, (int)blockIdx.x);
        pg8::EpiB16<pg8::FnWoB16> E{{x_in, (bf16*)H1, ALPHA}};
        pg8::gemm_phase<pg8::EpiB16<pg8::FnWoB16>, pg8::StaticOrder, PG8_ALIGN, PG8_SP2, 121>(LDSP + RING_OFF, g, S, E);
        REP_END(8)
    }
    SEAM(8);
    if (IN(9)) {
        LOCALS
        REP_BEGIN(9)
        for (int t = gw; t < T; t += NGW) {
            const bf16* hr = (const bf16*)H1 + (size_t)t * D + 8 * lane; float v[32]; float s = 0.f;
#pragma unroll
            for (int i = 0; i < 4; ++i) { const v4u w = *(const GAS v4u*)(hr + 512 * i);
                v[8 * i + 0] = bflo(w.x); v[8 * i + 1] = bfhi(w.x); v[8 * i + 2] = bflo(w.y); v[8 * i + 3] = bfhi(w.y); v[8 * i + 4] = bflo(w.z); v[8 * i + 5] = bfhi(w.z); v[8 * i + 6] = bflo(w.w); v[8 * i + 7] = bfhi(w.w); }
#pragma unroll
            for (int i = 0; i < 32; ++i) s += v[i];
            const float mean = wave_sum(s) * (1.0f / D); float q = 0.f;
#pragma unroll
            for (int i = 0; i < 32; ++i) { v[i] -= mean; q += v[i] * v[i]; }
            const float rstd = 1.0f / sqrtf(wave_sum(q) * (1.0f / D) + LN_EPS);
#pragma unroll
            for (int i = 0; i < 4; ++i) { const int c0 = 8 * lane + 512 * i;
                const f32x4 ga = *(const GAS f32x4*)(ln1_w + c0), gb = *(const GAS f32x4*)(ln1_w + c0 + 4), ba = *(const GAS f32x4*)(ln1_b + c0), bb = *(const GAS f32x4*)(ln1_b + c0 + 4);
                float o[8] = {v[8 * i + 0] * rstd * ga.x + ba.x, v[8 * i + 1] * rstd * ga.y + ba.y, v[8 * i + 2] * rstd * ga.z + ba.z, v[8 * i + 3] * rstd * ga.w + ba.w,
                              v[8 * i + 4] * rstd * gb.x + bb.x, v[8 * i + 5] * rstd * gb.y + bb.y, v[8 * i + 6] * rstd * gb.z + bb.z, v[8 * i + 7] * rstd * gb.w + bb.w};
                v4u w; w.x = pk2(o[0], o[1]); w.y = pk2(o[2], o[3]); w.z = pk2(o[4], o[5]); w.w = pk2(o[6], o[7]); *(GAS v4u*)(X1B + (size_t)t * D + c0) = w;
                int w0_ = 0, w1_ = 0; w0_ = __builtin_amdgcn_cvt_pk_fp8_f32(o[0], o[1], w0_, false); w0_ = __builtin_amdgcn_cvt_pk_fp8_f32(o[2], o[3], w0_, true);
                w1_ = __builtin_amdgcn_cvt_pk_fp8_f32(o[4], o[5], w1_, false); w1_ = __builtin_amdgcn_cvt_pk_fp8_f32(o[6], o[7], w1_, true);
                *(GAS unsigned long long*)(X1B8 + (size_t)t * D + c0) = (unsigned long long)(unsigned)w0_ | ((unsigned long long)(unsigned)w1_ << 32); }
        }
        REP_END(9)
    }
    SEAM(9);
    if (IN(10)) {
        LOCALS
        REP_BEGIN(10)
        { pg8::Gemm g{X1B, WQ_T, T, D, D}; pg8::StaticOrder S; S.init(T, D, (int)gridDim.x, (int)blockIdx.x);
          pg8::EpiB16<pg8::FnPlain16> E{{PQ, D}};
          pg8::gemm_phase<pg8::EpiB16<pg8::FnPlain16>, pg8::StaticOrder, PG8_ALIGN, PG8_SP2>(LDSP + RING_OFF, g, S, E); }
        REP_END(10)
    }
    SEAM(10);
    if (IN(11)) {
        LOCALS
        REP_BEGIN(11)
        { pg8::Gemm g{PB, WPE_T, T, D, 256}; pg8::StaticOrder S; S.init(T, D, (int)gridDim.x, (int)blockIdx.x);
          pg8::EpiB16<pg8::FnPlain16> E{{PE, D}};
          pg8::gemm_phase<pg8::EpiB16<pg8::FnPlain16>, pg8::StaticOrder, PG8_ALIGN, PG8_SP2>(LDSP + RING_OFF, g, S, E); }
        __syncthreads();
        { pg8::Gemm g{(const bf16*)X1B8, WPG_T, T, D, D / 2}; pg8::StaticOrder S; S.init(T, D, (int)gridDim.x, (int)blockIdx.x);
          pg8::EpiB16<pg8::FnPle> E{{PE}};
          pg8::gemm_phase<pg8::EpiB16<pg8::FnPle>, pg8::StaticOrder, PG8_ALIGN, PG8_SP2, 122>(LDSP + RING_OFF, g, S, E); }
        __syncthreads();
        LAS unsigned char* SK = LDSP + RING_OFF;
        for (int i = tid; i < 32768; i += 512) { const int row = i >> 7, d = i & 127; *(LAS bf16*)(SK + row * 272 + d * 2) = (bf16)f2bf(sub_keys[i]); }
        __syncthreads();
        {
            const int n = lane & 31, hh = lane >> 5;
            const float NEGINF = __uint_as_float(0xff800000u);
            for (int batch = gw; batch < T / 4; batch += NGW) {
                const int t = 4 * batch + (n >> 3), h = n & 7;
                float L[2][16];
#pragma unroll
                for (int c = 0; c < 2; ++c) {
                    f32x16 acc[4];
#pragma unroll
                    for (int m = 0; m < 4; ++m)
#pragma unroll
                        for (int i = 0; i < 16; ++i) acc[m][i] = 0.f;
                    bf16x8 qfr[8];
#pragma unroll
                    for (int ks = 0; ks < 8; ++ks) qfr[ks] = *(const GAS bf16x8*)(PQ + (size_t)t * D + h * 256 + c * 128 + 16 * ks + 8 * hh);
#pragma unroll
                    for (int ks = 0; ks < 8; ++ks) {
#pragma unroll
                        for (int m = 0; m < 4; ++m) { const bf16x8 kf = *(const LAS bf16x8*)(SK + (c * 128 + 32 * m + n) * 272 + (16 * ks + 8 * hh) * 2); acc[m] = __builtin_amdgcn_mfma_f32_32x32x16_bf16(kf, qfr[ks], acc[m], 0, 0, 0); }
                        __builtin_amdgcn_sched_barrier(0); }
                    float Lc[16], Gx[16];
#pragma unroll
                    for (int m = 0; m < 4; ++m) {
#pragma unroll
                        for (int i = 0; i < 16; ++i) { const float x = __uint_as_float((__float_as_uint(acc[m][i]) & 0xffffff80u) | (unsigned)(32 * m + (i & 3) + 8 * (i >> 2)) | (unsigned)(4 * hh)); if (m == 0) Lc[i] = x; else Gx[i] = x; }
                        if (m == 0) bitonic_sort16_desc(Lc); else { bitonic_sort16_desc(Gx); top16_merge_desc(Lc, Gx); } }
                    { float Pn[16];
#pragma unroll
                      for (int k = 0; k < 16; ++k) Pn[k] = __shfl_xor(Lc[k], 32);
                      top16_merge_desc(Lc, Pn); }
#pragma unroll
                    for (int k = 0; k < 16; ++k) L[c][k] = Lc[k];
                }
                float F[16];
#pragma unroll
                for (int k = 0; k < 16; ++k) F[k] = NEGINF;
#define PK_CAND(i, j) { float x = __uint_as_float((__float_as_uint(L[0][i] + L[1][j]) & 0xffffff00u) | (unsigned)(((i) << 4) | (j))); _Pragma("unroll") for (int k = 0; k < 16; ++k) { const float hi = fmaxf(x, F[k]); x = fminf(x, F[k]); F[k] = hi; } }
#define PK_ROW1(i) PK_CAND(i, 0)
#define PK_ROW2(i) PK_ROW1(i) PK_CAND(i, 1)
#define PK_ROW3(i) PK_ROW2(i) PK_CAND(i, 2)
#define PK_ROW4(i) PK_ROW3(i) PK_CAND(i, 3)
#define PK_ROW5(i) PK_ROW4(i) PK_CAND(i, 4)
#define PK_ROW8(i) PK_ROW5(i) PK_CAND(i, 5) PK_CAND(i, 6) PK_CAND(i, 7)
#define PK_ROW16(i) PK_ROW8(i) PK_CAND(i, 8) PK_CAND(i, 9) PK_CAND(i, 10) PK_CAND(i, 11) PK_CAND(i, 12) PK_CAND(i, 13) PK_CAND(i, 14) PK_CAND(i, 15)
                PK_ROW16(0) PK_ROW8(1) PK_ROW5(2) PK_ROW4(3) PK_ROW3(4) PK_ROW2(5) PK_ROW2(6) PK_ROW2(7)
                PK_ROW1(8) PK_ROW1(9) PK_ROW1(10) PK_ROW1(11) PK_ROW1(12) PK_ROW1(13) PK_ROW1(14) PK_ROW1(15)
                float ex[16]; float sum = 0.f; const float mx = __uint_as_float(__float_as_uint(F[0]) & 0xffffff00u);
#pragma unroll
                for (int k = 0; k < 16; ++k) { ex[k] = __expf(__uint_as_float(__float_as_uint(F[k]) & 0xffffff00u) - mx); sum += ex[k]; }
                const float rs = 1.0f / sum;
                int eid[16];
#pragma unroll
                for (int k = 0; k < 16; ++k) { const unsigned pay = __float_as_uint(F[k]) & 255u; const unsigned ii = pay >> 4, jj = pay & 15u; unsigned i0 = 0u, i1 = 0u;
#pragma unroll
                    for (int i = 0; i < 16; ++i) { i0 = (ii == (unsigned)i) ? (__float_as_uint(L[0][i]) & 127u) : i0; i1 = (jj == (unsigned)i) ? (__float_as_uint(L[1][i]) & 127u) : i1; }
                    eid[k] = (int)(i0 * 128u + i1); }
                if (hh == 0) {
#pragma unroll
                    for (int k4 = 0; k4 < 4; ++k4) { *(GAS v4u*)(IDX + (size_t)t * 128 + h * 16 + 4 * k4) = (v4u){(unsigned)eid[4 * k4], (unsigned)eid[4 * k4 + 1], (unsigned)eid[4 * k4 + 2], (unsigned)eid[4 * k4 + 3]};
                        *(GAS f32x4*)(PG + (size_t)t * 128 + h * 16 + 4 * k4) = (f32x4){ex[4 * k4] * rs, ex[4 * k4 + 1] * rs, ex[4 * k4 + 2] * rs, ex[4 * k4 + 3] * rs}; }
                }
            }
        }
        REP_END(11)
    }
    SEAM(11);
    if (IN(12)) {
        LOCALS
        REP_BEGIN(12)
        LAS float* actl = (LAS float*)(LDSP + RING_OFF) + wave * 128;
        LAS float* lnw = (LAS float*)(LDSP + RING_OFF + 8192); LAS float* lnb = lnw + 2048;
        *(LAS f32x4*)(lnw + 4 * tid) = *(const GAS f32x4*)(ln2_w + 4 * tid); *(LAS f32x4*)(lnb + 4 * tid) = *(const GAS f32x4*)(ln2_b + 4 * tid);
        __syncthreads();
        const int r4 = lane >> 4, c16 = lane & 15;
        for (int t = gw; t < T; t += NGW) {
            typedef unsigned long long u64;
            const int idv0 = IDX[(size_t)t * 128 + lane], idv1 = IDX[(size_t)t * 128 + 64 + lane]; const float gtv0 = PG[(size_t)t * 128 + lane], gtv1 = PG[(size_t)t * 128 + 64 + lane];
            u64 xq[32];
#pragma unroll
            for (int i = 0; i < 4; ++i)
#pragma unroll
                for (int q = 0; q < 8; ++q) xq[8 * i + q] = *(const GAS u64*)(X1B + (size_t)t * D + 256 * q + 4 * (c16 + 16 * i));
            LAS float* hraw = actl;
#define P1_LOAD(Dst, grp) { const int j_ = 4 * (grp) + r4; const int e_ = __shfl((grp) < 16 ? idv0 : idv1, j_ & 63); const GAS u64* ur_ = (const GAS u64*)(UB + (size_t)e_ * ROW6 + 24 * c16); \
                _Pragma("unroll") for (int i = 0; i < 4; ++i) { Dst[3 * i] = ur_[48 * i]; Dst[3 * i + 1] = ur_[48 * i + 1]; Dst[3 * i + 2] = ur_[48 * i + 2]; } }
#define P1_COMP(Src, grp) { float h0_ = 0.f, h1_ = 0.f; \
                _Pragma("unroll") for (int i = 0; i < 4; ++i) { const v6u_t pk_ = {(unsigned)Src[3 * i], (unsigned)(Src[3 * i] >> 32), (unsigned)Src[3 * i + 1], (unsigned)(Src[3 * i + 1] >> 32), (unsigned)Src[3 * i + 2], (unsigned)(Src[3 * i + 2] >> 32)}; \
                    const v16u_t f = __builtin_bit_cast(v16u_t, __builtin_amdgcn_cvt_scalef32_pk32_bf16_fp6(pk_, 1.0f));        \
                    _Pragma("unroll") for (int q = 0; q < 8; ++q) { const u64 xx = xq[8 * i + q]; h0_ = dot2(f[2 * q], (unsigned)xx, h0_); h1_ = dot2(f[2 * q + 1], (unsigned)(xx >> 32), h1_); } __builtin_amdgcn_sched_barrier(0); } \
                const float h_ = row16_sum(h0_ + h1_) * (1.0f / U_SCALE); if (c16 == 0) hraw[4 * (grp) + r4] = h_; }
            { u64 ua[12], ub[12];
              P1_LOAD(ua, 0)
              for (int grp = 0; grp < 32; grp += 2) { P1_LOAD(ub, grp + 1) P1_COMP(ua, grp) if (grp + 2 < 32) P1_LOAD(ua, grp + 2) P1_COMP(ub, grp + 1) } }
#undef P1_LOAD
#undef P1_COMP
            asm volatile("s_waitcnt lgkmcnt(0)" ::: "memory");
            { const float ha_ = hraw[lane], hb_ = hraw[64 + lane];
              asm volatile("s_waitcnt lgkmcnt(0)" ::: "memory");
              actl[lane] = 0.5f * ha_ * (1.0f + erff(ha_ * 0.70710678118f)) * gtv0 * (1.0f / V_SCALE); actl[64 + lane] = 0.5f * hb_ * (1.0f + erff(hb_ * 0.70710678118f)) * gtv1 * (1.0f / V_SCALE); }
            asm volatile("s_waitcnt lgkmcnt(0)" ::: "memory");
            float acc[32];
#pragma unroll
            for (int i = 0; i < 32; ++i) acc[i] = 0.f;
#define P2_LOAD(Dst, jb) { _Pragma("unroll") for (int r = 0; r < 4; ++r) { const int e_ = __builtin_amdgcn_readlane((jb) < 64 ? idv0 : idv1, ((jb) + r) & 63); const GAS u64* vr_ = (const GAS u64*)(VB2 + (size_t)e_ * ROW6 + 24 * lane); \
                Dst[3 * r] = vr_[0]; Dst[3 * r + 1] = vr_[1]; Dst[3 * r + 2] = vr_[2]; } }
#define P2_COMP(Src, jb) { const f32x4 a4_ = *(const LAS f32x4*)(actl + (jb)); \
                _Pragma("unroll") for (int r = 0; r < 4; ++r) { const v6u_t pk_ = {(unsigned)Src[3 * r], (unsigned)(Src[3 * r] >> 32), (unsigned)Src[3 * r + 1], (unsigned)(Src[3 * r + 1] >> 32), (unsigned)Src[3 * r + 2], (unsigned)(Src[3 * r + 2] >> 32)}; \
                    const v32f_t f = __builtin_amdgcn_cvt_scalef32_pk32_f32_fp6(pk_, 1.0f); const float a_ = a4_[r]; \
                    _Pragma("unroll") for (int i = 0; i < 32; ++i) acc[i] += a_ * f[i]; __builtin_amdgcn_sched_barrier(0); } }
            { u64 va[12], vb[12];
              P2_LOAD(va, 0)
              for (int jb = 0; jb < 128; jb += 8) { P2_LOAD(vb, jb + 4) P2_COMP(va, jb) if (jb + 8 < 128) P2_LOAD(va, jb + 8) P2_COMP(vb, jb + 4) } }
#undef P2_LOAD
#undef P2_COMP
            asm volatile("s_waitcnt lgkmcnt(0)" ::: "memory");
            float s1 = 0.f;
#pragma unroll
            for (int i = 0; i < 8; ++i) { const size_t o = (size_t)t * D + 256 * i + 4 * lane;
                const unsigned long long xw_ = *(const GAS unsigned long long*)(X1B + o), pw = *(const GAS unsigned long long*)(PE + o);
                acc[4 * i + 0] += ALPHA * bflo((unsigned)xw_) + bflo((unsigned)pw); acc[4 * i + 1] += ALPHA * bfhi((unsigned)xw_) + bfhi((unsigned)pw);
                acc[4 * i + 2] += ALPHA * bflo((unsigned)(xw_ >> 32)) + bflo((unsigned)(pw >> 32)); acc[4 * i + 3] += ALPHA * bfhi((unsigned)(xw_ >> 32)) + bfhi((unsigned)(pw >> 32)); }
#pragma unroll
            for (int i = 0; i < 32; ++i) s1 += acc[i];
            const float mean = wave_sum(s1) * (1.0f / D); float s2 = 0.f;
#pragma unroll
            for (int i = 0; i < 32; ++i) { acc[i] -= mean; s2 += acc[i] * acc[i]; }
            const float rstd = 1.0f / sqrtf(wave_sum(s2) * (1.0f / D) + LN_EPS);
#pragma unroll
            for (int i = 0; i < 8; ++i) { const int c0 = 256 * i + 4 * lane; const f32x4 ga = *(const LAS f32x4*)(lnw + c0), ba = *(const LAS f32x4*)(lnb + c0);
                *(GAS f32x4*)(args.out + (size_t)t * D + c0) = (f32x4){acc[4 * i + 0] * rstd * ga.x + ba.x, acc[4 * i + 1] * rstd * ga.y + ba.y, acc[4 * i + 2] * rstd * ga.z + ba.z, acc[4 * i + 3] * rstd * ga.w + ba.w}; }
        }
        REP_END(12)
    }

#ifdef DIAG_FP6
    { typedef float v32f_ __attribute__((ext_vector_type(32))); typedef float v16f_ __attribute__((ext_vector_type(16))); typedef unsigned v6u_ __attribute__((ext_vector_type(6)));
      v16f_ a_, b_; float mv_[32];
#pragma unroll
      for (int k = 0; k < 32; ++k) mv_[k] = k < 8 ? k * 0.125f : (k < 16 ? 1.f + (k - 8) * 0.125f : (k < 24 ? 2.f + (k - 16) * 0.25f : 4.f + (k - 24) * 0.5f));
#pragma unroll
      for (int k = 0; k < 16; ++k) { a_[k] = mv_[k]; b_[k] = mv_[16 + k]; }
      const v6u_ p_ = __builtin_amdgcn_cvt_scalef32_2xpk16_fp6_f32(a_, b_, 1.0f); const v32f_ o_ = __builtin_amdgcn_cvt_scalef32_pk32_f32_fp6(p_, 1.0f);
      bool id_ = true, il_ = true;
#pragma unroll
      for (int k = 0; k < 16; ++k) { id_ = id_ && (o_[k] == mv_[k]) && (o_[16 + k] == mv_[16 + k]); il_ = il_ && (o_[2 * k] == mv_[k]) && (o_[2 * k + 1] == mv_[16 + k]); }
      const float c_ = id_ ? 2.f : (il_ ? 3.f : 4.f);
      xcd_barrier(bar);
      LOCALS
      for (size_t e = gt; e < (size_t)T * D; e += NGT) args.out[e] = c_; }
#endif

#ifdef DIAG_TIME
    xcd_barrier(bar);
    { LOCALS
      const unsigned long long t0_ = __hip_atomic_load((unsigned long long*)(args.ws + WS_CTL) + 8, __ATOMIC_RELAXED, __HIP_MEMORY_SCOPE_AGENT);
      const float ms_ = (float)(__builtin_amdgcn_s_memrealtime() - t0_) * (1.0f / 100000.0f);
      float u_ = (float)DIAG_UNIT_MS; float c_ = 1.0f;
      for (int b_ = 0; b_ < 6; ++b_) { if (ms_ > u_) c_ += 1.f; u_ *= (float)DIAG_RATIO; }
      for (size_t e = gt; e < (size_t)T * D; e += NGT) args.out[e] = c_; }
#endif
#if DIAG_LAST >= 0
    xcd_barrier(bar);
    { LOCALS
      constexpr size_t N1 = (size_t)T * 1024;
      int used = 0;
#if DIAG_LAST == 1
      digest<bf16>(args.out, 0, QB, N1, gt, NGT); digest<bf16>(args.out, 1, KB, N1, gt, NGT); digest<bf16>(args.out, 2, VB, N1, gt, NGT);
      digest<bf16>(args.out, 3, RR, N1, gt, NGT); digest<bf16>(args.out, 4, RK, N1, gt, NGT); digest<bf16>(args.out, 5, RV, N1, gt, NGT); digest<bf16>(args.out, 6, RC, N1, gt, NGT); used = 7;
#elif DIAG_LAST == 2
      digest<bf16>(args.out, 0, YA, N1, gt, NGT); digest<float>(args.out, 1, LW, N1, gt, NGT); digest<bf16>(args.out, 2, AA, N1, gt, NGT); digest<bf16>(args.out, 3, GG, N1, gt, NGT); used = 4;
#elif DIAG_LAST == 3
      digest<float>(args.out, 0, YRAW, N1, gt, NGT); digest<float>(args.out, 1, RKC, (size_t)T * 16, gt, NGT); used = 2;
#elif DIAG_LAST == 4
      digest<bf16>(args.out, 0, YB, N1, gt, NGT); used = 1;
#elif DIAG_LAST == 5
      digest<bf16>(args.out, 0, GATE, 4 * N1, gt, NGT); used = 1;
#elif DIAG_LAST == 7
      digest<bf16>(args.out, 0, MIX, 2 * N1, gt, NGT); used = 1;
#elif DIAG_LAST == 8
      digest<float>(args.out, 0, H1, 2 * N1, gt, NGT); used = 1;
#elif DIAG_LAST == 9
      digest<bf16>(args.out, 0, X1B, 2 * N1, gt, NGT); used = 1;
#elif DIAG_LAST == 10
      digest<bf16>(args.out, 0, PQ, 2 * N1, gt, NGT); digest<bf16>(args.out, 1, PE, 2 * N1, gt, NGT); used = 2;
#elif DIAG_LAST == 11
      digest<int>(args.out, 0, IDX, (size_t)T * 128, gt, NGT); digest<float>(args.out, 1, PG, (size_t)T * 128, gt, NGT); digest<bf16>(args.out, 2, PE, 2 * N1, gt, NGT); used = 3;
#endif
      for (size_t e = gt + (size_t)used * 2097152; e < (size_t)T * D; e += NGT) args.out[e] = 1.0f;
    }
#endif
#undef IN
#undef SEAM
}


#ifdef DIAG_CHECK
__device__ __forceinline__ unsigned hsh(unsigned x) { x ^= x >> 16; x *= 0x7feb352dU; x ^= x >> 15; x *= 0x846ca68bU; x ^= x >> 16; return x; }
__device__ __forceinline__ void chk_acc(unsigned char* ws, int id, float ref, float got) { float* a = (float*)(ws + WS_CTL) + 1024 + 2 * id; const float d = ref - got; atomicAdd(a, d * d); atomicAdd(a + 1, ref * ref); }
__global__ void __launch_bounds__(512) mk_check(Args args) {
    extern __shared__ __attribute__((aligned(16))) unsigned char lds[];
    LOCALS
    const int id = args.pad - 1;
    if (id == 0) {
        for (size_t i = gt; i < 8192; i += NGT) { const unsigned hh = hsh((unsigned)i * 2u + 1u); const int t = (int)(hh % T), col = (int)(hsh(hh) % 7168u);
            float ref = 0.f; for (int k = 0; k < D; ++k) ref += x_in[(size_t)t * D + k] * w_in[(size_t)k * NIN + col];
            const int reg = col >> 10, c = col & 1023; const float got = bf1(QB[(size_t)reg * ((size_t)T * 1024) + (size_t)t * 1024 + c]) * (reg == 0 ? 8.f : 1.f);
            chk_acc(args.ws, 0, ref, got); }
    } else if (id == 1) {
        for (int smp = gw; smp < 256; smp += NGW) { const unsigned hh = hsh(7777u + smp); const int t = (int)(hh % T), head = (int)(hsh(hh) % 16u);
            const float q = bf1(QB[(size_t)t * 1024 + head * 64 + lane]); float o = 0.f;
            for (int sk = 0; sk < t; ++sk) { const float z = wave_sum(q * bf1(KB[(size_t)sk * 1024 + head * 64 + lane])); const float beta = 1.0f / (1.0f + expf(-z));
                o = o * (1.0f - beta) + beta * bf1(VB[(size_t)sk * 1024 + head * 64 + lane]); }
            chk_acc(args.ws, 1, o, bf1(YA[(size_t)t * 1024 + head * 64 + lane])); }
    } else if (id == 2) {
        LAS float* xs = (LAS float*)lds + wave * 3072;
        for (int smp = gw; smp < 512; smp += NGW) { const unsigned hh = hsh(991u + smp); const int t = (int)(hh % T), c = (int)(hsh(hh) % 1024u);
            for (int k = lane; k < 1024; k += 64) { const float cv = bf1(RC[(size_t)t * 1024 + k]), pv = t > 0 ? bf1(RC[(size_t)(t - 1) * 1024 + k]) : 0.f;
                xs[k] = cv + (pv - cv) * mu[3 * 1024 + k]; xs[1024 + k] = cv + (pv - cv) * mu[4 * 1024 + k]; xs[2048 + k] = cv + (pv - cv) * mu[5 * 1024 + k]; }
            asm volatile("s_waitcnt lgkmcnt(0)" ::: "memory");
            float hw = 0.f, ha = 0.f, hg0 = 0.f, hg1 = 0.f, hg2 = 0.f;
            for (int k = 0; k < 1024; ++k) { hw += xs[k] * wl1[(size_t)k * 64 + lane]; ha += xs[1024 + k] * al1[(size_t)k * 64 + lane];
                hg0 += xs[2048 + k] * gl1[(size_t)k * 160 + lane]; hg1 += xs[2048 + k] * gl1[(size_t)k * 160 + 64 + lane]; if (lane < 32) hg2 += xs[2048 + k] * gl1[(size_t)k * 160 + 128 + lane]; }
            hw = tanhf(hw); hg0 = 1.f / (1.f + expf(-hg0)); hg1 = 1.f / (1.f + expf(-hg1)); hg2 = 1.f / (1.f + expf(-hg2));
            const float wpre = w0[c] + wave_sum(hw * wl2[(size_t)lane * 1024 + c]);
            const float apre = a0[c] + wave_sum(ha * al2[(size_t)lane * 1024 + c]);
            const float gref = wave_sum(hg0 * gl2[(size_t)lane * 1024 + c] + hg1 * gl2[(size_t)(64 + lane) * 1024 + c] + (lane < 32 ? hg2 * gl2[(size_t)(128 + lane) * 1024 + c] : 0.f));
            const float sp = -wpre > 20.f ? -wpre : log1pf(expf(-wpre)); const float lwref = -expf(-sp - 0.5f); const float aref = 1.f / (1.f + expf(-apre));
            if (lane == 0) { chk_acc(args.ws, 2, lwref, LW[(size_t)t * 1024 + c]); chk_acc(args.ws, 3, aref, bf1(AA[(size_t)t * 1024 + c])); chk_acc(args.ws, 4, gref, bf1(GG[(size_t)t * 1024 + c])); }
            asm volatile("s_waitcnt lgkmcnt(0)" ::: "memory"); }
    } else if (id == 5) {
        LAS float* vs_ = (LAS float*)lds + wave * 512;
        for (int smp = gw; smp < 128; smp += NGW) { const unsigned hh = hsh(4242u + smp); const int t1 = 800 + (int)(hh % (T - 800)), head = (int)(hsh(hh) % 16u), ch = head * 64 + lane;
            float S[64];
#pragma unroll
            for (int k = 0; k < 64; ++k) S[k] = 0.f;
            float y = 0.f;
            for (int t = t1 - 768; t <= t1; ++t) { const size_t o = (size_t)t * 1024 + ch;
                const float rc = bf1(RR[o]), rp = bf1(RR[o - 1024]), kc = bf1(RK[o]), kp = bf1(RK[o - 1024]), vc = bf1(RV[o]), vp = bf1(RV[o - 1024]);
                const float rs = rc + (rp - rc) * mu[ch], ks = kc + (kp - kc) * mu[1024 + ch], vsv = vc + (vp - vc) * mu[2048 + ch];
                const float a = bf1(AA[o]); float kk = ks * k_k[ch]; const float nrm = sqrtf(wave_sum(kk * kk)); kk = kk / fmaxf(nrm, 1e-12f);
                const float km = ks * (1.0f + (a - 1.0f) * k_a[ch]);
                vs_[lane] = expf(LW[o]); vs_[64 + lane] = -kk; vs_[128 + lane] = kk * a; vs_[192 + lane] = km; vs_[256 + lane] = rs;
                asm volatile("s_waitcnt lgkmcnt(0)" ::: "memory");
                float sa = 0.f;
#pragma unroll
                for (int k = 0; k < 64; ++k) sa += S[k] * vs_[64 + k];
                y = 0.f;
#pragma unroll
                for (int k = 0; k < 64; ++k) { S[k] = S[k] * vs_[k] + sa * vs_[128 + k] + vsv * vs_[192 + k]; y += S[k] * vs_[256 + k]; }
                asm volatile("s_waitcnt lgkmcnt(0)" ::: "memory"); }
            { const size_t o = (size_t)t1 * 1024 + ch; const float mean = wave_sum(y) / 64.f; const float var = wave_sum((y - mean) * (y - mean)) / 64.f;
              const float rc = bf1(RR[o]), rp = bf1(RR[o - 1024]), kc = bf1(RK[o]), kp = bf1(RK[o - 1024]), vc = bf1(RV[o]), vp = bf1(RV[o - 1024]);
              const float rs = rc + (rp - rc) * mu[ch], ks = kc + (kp - kc) * mu[1024 + ch], vsv = vc + (vp - vc) * mu[2048 + ch];
              const float km = ks * (1.0f + (bf1(AA[o]) - 1.0f) * k_a[ch]); const float rk = wave_sum(rs * km * r_k[ch]);
              const float ref = ((y - mean) / sqrtf(var + GN_EPS) * lnx_w[ch] + lnx_b[ch] + rk * vsv) * bf1(GG[o]);
              chk_acc(args.ws, 5, ref, bf1(YB[o])); } }
    } else if (id == 6) {
        for (int smp = gw; smp < 512; smp += NGW) { const unsigned hh = hsh(31337u + smp); const int t = 1 + (int)(hh % (T - 1)), head = (int)(hsh(hh) % 16u), ch = head * 64 + lane; const size_t o = (size_t)t * 1024 + ch;
            const float rc = bf1(RR[o]), rp = bf1(RR[o - 1024]), kc = bf1(RK[o]), kp = bf1(RK[o - 1024]), vc = bf1(RV[o]), vp = bf1(RV[o - 1024]);
            const float rs = rc + (rp - rc) * mu[ch], ks = kc + (kp - kc) * mu[1024 + ch], vsv = vc + (vp - vc) * mu[2048 + ch];
            const float km = ks * (1.0f + (bf1(AA[o]) - 1.0f) * k_a[ch]); const float rk = wave_sum(rs * km * r_k[ch]);
            const float y = YRAW[o]; const float mean = wave_sum(y) / 64.f; const float var = wave_sum((y - mean) * (y - mean)) / 64.f;
            const float ref = ((y - mean) / sqrtf(var + GN_EPS) * lnx_w[ch] + lnx_b[ch] + rk * vsv) * bf1(GG[o]);
            chk_acc(args.ws, 6, ref, bf1(YB[o])); }
    } else if (id == 7) {
        for (size_t i = gt; i < 4096; i += NGT) { const unsigned hh = hsh((unsigned)i * 2u + 5u); const int t = (int)(hh % T), col = (int)(hsh(hh) % 4096u);
            float ref = 0.f; for (int k = 0; k < D; ++k) ref += x_in[(size_t)t * D + k] * w_in[(size_t)k * NIN + 7168 + col];
#ifndef DIAG_RAWGATE
            ref = 1.f / (1.f + expf(-ref));
#endif
            chk_acc(args.ws, 7, ref, bf1(GATE[(size_t)(col >> 11) * ((size_t)T * 2048) + (size_t)t * 2048 + (col & 2047)])); }
    } else if (id == 15) {
        for (size_t i = gt; i < 262144; i += NGT) { const unsigned hh = hsh((unsigned)i * 2u + 77u); const int k = (int)(hh % D), col = (int)(hsh(hh) % NIN);
            chk_acc(args.ws, col < 7168 ? 15 : 16, w_in[(size_t)k * NIN + col], bf1(WIN_T[(size_t)col * D + k])); }
    } else if (id == 17) {
        for (size_t i = gt; i < 262144; i += NGT) { const unsigned hh = hsh((unsigned)i * 2u + 177u); const size_t e = ((size_t)hh * 8191u + hsh(hh)) % ((size_t)T * D); chk_acc(args.ws, 17, x_in[e], bf1(XB[e])); }
    } else if (id == 8) {
        for (size_t i = gt; i < 4096; i += NGT) { const unsigned hh = hsh((unsigned)i * 2u + 9u); const int t = (int)(hh % T), col = (int)(hsh(hh) % 2048u);
            float ya = 0.f, yb = 0.f; for (int k = 0; k < 1024; ++k) { ya += bf1(YA[(size_t)t * 1024 + k]) * w_up_a[(size_t)k * D + col]; yb += bf1(YB[(size_t)t * 1024 + k]) * w_up_b[(size_t)k * D + col]; }
            const float ref = bf1(GATE[(size_t)t * 2048 + col]) * ya + bf1(GATE[(size_t)T * 2048 + (size_t)t * 2048 + col]) * yb; chk_acc(args.ws, 8, ref, bf1(MIX[(size_t)t * 2048 + col])); }
    } else if (id == 9) {
        for (size_t i = gt; i < 4096; i += NGT) { const unsigned hh = hsh((unsigned)i * 2u + 13u); const int t = (int)(hh % T), col = (int)(hsh(hh) % 2048u);
            float ref = 0.f; for (int k = 0; k < D; ++k) ref += bf1(MIX[(size_t)t * D + k]) * w_o[(size_t)k * D + col];
            ref += ALPHA * x_in[(size_t)t * D + col]; chk_acc(args.ws, 9, ref, H1[(size_t)t * D + col]); }
    } else if (id == 10) {
        for (size_t i = gt; i < 4096; i += NGT) { const unsigned hh = hsh((unsigned)i * 2u + 21u); const int t = (int)(hh % T), col = (int)(hsh(hh) % 2048u);
            float ref = 0.f; for (int k = 0; k < D; ++k) ref += bf1(X1B[(size_t)t * D + k]) * peer_wq[(size_t)k * D + col];
            chk_acc(args.ws, 10, ref, bf1(PQ[(size_t)t * D + col]));
            float r2 = 0.f; for (int k = 0; k < 256; ++k) r2 += p_in[(size_t)t * 256 + k] * ple_wp[(size_t)k * D + col];
            chk_acc(args.ws, 11, r2, bf1(PE[(size_t)t * D + col])); }
    } else if (id == 12) {
        for (size_t i = gt; i < 4096; i += NGT) { const unsigned hh = hsh((unsigned)i * 2u + 29u); const int t = (int)(hh % T), col = (int)(hsh(hh) % 2048u);
            float ref = 0.f; for (int k = 0; k < D; ++k) ref += bf1(X1B[(size_t)t * D + k]) * ple_wg[(size_t)k * D + col];
            float r2 = 0.f; for (int k = 0; k < 256; ++k) r2 += p_in[(size_t)t * 256 + k] * ple_wp[(size_t)k * D + col];
            chk_acc(args.ws, 12, r2 / (1.f + expf(-ref)), bf1(PE[(size_t)t * D + col])); }
        LAS float* sc = (LAS float*)lds + wave * 256;
        for (int smp = gw; smp < 512; smp += NGW) { const unsigned hh = hsh(555u + smp); const int t = (int)(hh % T), h = (int)(hsh(hh) % 8u);
            for (int r = lane; r < 256; r += 64) { const int c = r >> 7, nn = r & 127; float s = 0.f; for (int d = 0; d < 128; ++d) s += bf1(PQ[(size_t)t * D + h * 256 + c * 128 + d]) * sub_keys[(size_t)(c * 128 + nn) * 128 + d]; sc[r] = s; }
            asm volatile("s_waitcnt lgkmcnt(0)" ::: "memory");
            const int e = IDX[(size_t)t * 128 + h * 16 + (lane & 15)]; const float mys = sc[e >> 7] + sc[128 + (e & 127)];
            float mn = mys, mxv = mys;
#pragma unroll
            for (int o2 = 1; o2 < 16; o2 <<= 1) { mn = fminf(mn, __shfl_xor(mn, o2)); mxv = fmaxf(mxv, __shfl_xor(mxv, o2)); }
            float ex = expf(mys - mxv), sm = ex;
#pragma unroll
            for (int o2 = 1; o2 < 16; o2 <<= 1) sm += __shfl_xor(sm, o2);
            if (lane < 16) chk_acc(args.ws, 13, ex / sm, PG[(size_t)t * 128 + h * 16 + lane]);
            int cnt = 0; for (int pr = lane; pr < 16384; pr += 64) cnt += (sc[pr >> 7] + sc[128 + (pr & 127)] > mn + 1e-6f) ? 1 : 0;
#pragma unroll
            for (int o2 = 1; o2 < 64; o2 <<= 1) cnt += __shfl_xor(cnt, o2);
            if (lane == 0) chk_acc(args.ws, 14, 15.f, (float)cnt);
            asm volatile("s_waitcnt lgkmcnt(0)" ::: "memory"); }
    } else if (id == 98) {
        const float* a = (const float*)(args.ws + WS_CTL) + 1024; float c = 1.f; unsigned long long sel = DIAG_CHECK;
        for (int b = 4; b >= 0; --b) { const int k = (int)(sel % 100ull); sel /= 100ull; const float rel = sqrtf(a[2 * k] / fmaxf(a[2 * k + 1], 1e-30f)); if (!(rel < DIAG_TOL)) c += (float)(1 << b); }
#ifdef DIAG_LADDER
        { c = 1.f; const float rel = sqrtf(a[2 * DIAG_LADDER] / fmaxf(a[2 * DIAG_LADDER + 1], 1e-30f)); const float th[5] = {0.01f, 0.03f, 0.1f, 0.3f, 1.0f}; for (int b = 0; b < 5; ++b) if (!(rel < th[b])) c += 1.f; }
#endif
        for (size_t e = gt; e < (size_t)T * D; e += NGT) args.out[e] = c;
    }
}
#endif

extern "C" void kernel_launch(void* const* d_in, const int* in_sizes, int n_in, void* d_out, int out_size, void* d_ws, size_t ws_size, hipStream_t stream) {
    static int grid = 0;
    if (grid == 0) {
        if (n_in != 30 || in_sizes[0] != T * D || out_size != T * D || ws_size < WS_END) { fprintf(stderr, "kernel_launch: unexpected shapes / workspace (n_in %d, ws %zu); nothing launched\n", n_in, ws_size); grid = -1; return; }
        int dev = 0, cus = 0, per_cu = 0;
        if (hipGetDevice(&dev) != hipSuccess || hipDeviceGetAttribute(&cus, hipDeviceAttributeMultiprocessorCount, dev) != hipSuccess) { grid = -1; return; }
        if (hipFuncSetAttribute((const void*)mk_fwd, hipFuncAttributeMaxDynamicSharedMemorySize, LDS_BYTES) != hipSuccess) { fprintf(stderr, "kernel_launch: hipFuncSetAttribute failed\n"); grid = -1; return; }
        if (hipOccupancyMaxActiveBlocksPerMultiprocessor(&per_cu, (const void*)mk_fwd, NWAVES * 64, LDS_BYTES) != hipSuccess || per_cu < 1) fprintf(stderr, "kernel_launch: occupancy query says %d\n", per_cu);
        (void)hipGetLastError();
#ifdef DIAG_CHECK
        (void)hipFuncSetAttribute((const void*)mk_check, hipFuncAttributeMaxDynamicSharedMemorySize, 131072);
#endif
        grid = cus;
    }
    if (grid < 0) return;
    if (hipMemsetAsync((char*)d_ws + WS_CTL, 0, CTL_ZERO_BYTES, stream) != hipSuccess) return;
    Args a{};
    for (int i = 0; i < 30; ++i) a.in[i] = (const float*)d_in[i];
    a.out = (float*)d_out; a.ws = (unsigned char*)d_ws;
#if MK_ONE_LAUNCH
    a.ph_lo = 0; a.ph_hi = (DIAG_LAST >= 0) ? DIAG_LAST + 1 : NPHASE;
#ifdef DIAG_TIME
    a.ph_hi = DIAG_TIME + 1;
#endif a.li = 0;
    hipLaunchKernelGGL(mk_fwd, dim3(grid), dim3(NWAVES * 64), LDS_BYTES, stream, a);
#else
    for (int li = 0; li < NPHASE; ++li) { a.ph_lo = li; a.ph_hi = li + 1; a.li = li; a.pad = 0; hipLaunchKernelGGL(mk_fwd, dim3(grid), dim3(NWAVES * 64), LDS_BYTES, stream, a);
#ifdef DIAG_CHECK
        static const int chk_after[][2] = {{0, 15}, {1, 0}, {2, 1}, {2, 2}, {3, 18}, {4, 19}, {5, 5}, {6, 7}, {7, 8}, {8, 9}, {10, 10}, {11, 12}};
        for (auto& ca : chk_after) if (ca[0] == li) { a.pad = ca[1] + 1; hipLaunchKernelGGL(mk_check, dim3(grid), dim3(512), 131072, stream, a); }
        if (li == NPHASE - 1) { a.pad = 99; hipLaunchKernelGGL(mk_check, dim3(grid), dim3(512), 131072, stream, a); }
#endif
    }
#endif
}
```

```cpp
#define MK_ONE_LAUNCH 1
#define P2_SPLIT 1
#include <hip/hip_runtime.h>
#include <cstdio>
#include <cstdint>
namespace pg8 {
#define PG8_LAS __attribute__((address_space(3)))
typedef unsigned short bf16_t;
typedef short bf16x8 __attribute__((ext_vector_type(8)));
typedef float f32x4 __attribute__((ext_vector_type(4)));
typedef unsigned u32x4 __attribute__((ext_vector_type(4)));
constexpr int BM = 256, BK = 64, HALF = 128, HTB = HALF * BK * 2  , STAGE_BYTES = 8 * HTB, NXCD = 8, WGM = 8;

__host__ __device__ __forceinline__ int lds_byte(int r, int c) { const int st = (r >> 4) * 2 + (c >> 5), rr = r & 15, cc = c & 31, ob = rr * 64 + cc * 2; return st * 1024 + (ob ^ (((ob >> 9) & 1) << 5)); }
__host__ __device__ __forceinline__ void stage_rc(int b, int& R, int& C) { const int st = b / 1024, sb = b % 1024, swz = sb ^ (((sb >> 9) & 1) << 5); R = (st >> 1) * 16 + swz / 64; C = (st & 1) * 32 + (swz % 64) / 2; }
__host__ __device__ __forceinline__ int perm32(int rho) { const int n = rho >> 4, i = rho & 15; return 8 * (i >> 2) + 4 * n + (i & 3); }

struct Unit { int pm, pn; };
struct Gemm { const bf16_t* A; const bf16_t* Bt; int M, N, K; };

struct StaticOrder {
    int nM, nN, nwg, G, c;
    __host__ __device__ void init(int M, int N, int G_, int c_) { nM = M / BM; nN = N / BM; nwg = nM * nN; G = G_; c = c_; }
    __host__ __device__ bool next(int i, Unit& u) const {
        const long L = (long)i * G + c; if (L >= nwg) return false;
        int wgid = (int)L; { const int q = nwg / NXCD, r = nwg % NXCD, xcd = wgid % NXCD, off = wgid / NXCD; wgid = (xcd < r ? xcd * (q + 1) : r * (q + 1) + (xcd - r) * q) + off; }
        const int nig = WGM * nN, gid = wgid / nig, fm = gid * WGM, gsz = (nM - fm) < WGM ? (nM - fm) : WGM;
        u.pm = fm + ((wgid % nig) % gsz); u.pn = (wgid % nig) / gsz; return true;
    }
    __device__ __forceinline__ void a_ready(const Unit&) const {}
    __device__ __forceinline__ void done(const Unit&) const {}
};

typedef float cvt_f32x2 __attribute__((ext_vector_type(2))); typedef __bf16 cvt_bf16x2 __attribute__((ext_vector_type(2)));
__device__ __forceinline__ unsigned cvt_pk_bf16(float lo, float hi) { const cvt_f32x2 v = {lo, hi}; return __builtin_bit_cast(unsigned, __builtin_convertvector(v, cvt_bf16x2)); }
typedef float f32x2 __attribute__((ext_vector_type(2)));
__device__ __forceinline__ f32x2 gelu_pk(f32x2 v) {
    const f32x2 av = __builtin_elementwise_abs(v), d = av * 0.2316418882f + 1.0f;
    f32x2 t; t.x = __builtin_amdgcn_rcpf(d.x); t.y = __builtin_amdgcn_rcpf(d.y);
    f32x2 q = t * 0.5307027145f + (-0.7265760135f); q = q * t + 0.7107068705f; q = q * t + (-0.142248368f); q = q * t + 0.127414796f; q = q * t;
    const f32x2 s = (v * v) * (-0.72134752044f);
    f32x2 e; e.x = __builtin_amdgcn_exp2f(s.x); e.y = __builtin_amdgcn_exp2f(s.y);
    const f32x2 m = v * (q * e), r = v - m;
    f32x2 o; o.x = v.x < 0.f ? m.x : r.x; o.y = v.y < 0.f ? m.y : r.y; return o;
}


__device__ __forceinline__ float bf_lo(unsigned w) { return __uint_as_float(w << 16); }
__device__ __forceinline__ float bf_hi(unsigned w) { return __uint_as_float(w & 0xffff0000u); }
__device__ __forceinline__ float fsigmoid(float x) { return __builtin_amdgcn_rcpf(1.0f + __expf(-x)); }
__device__ __forceinline__ float ftanh(float x) { return 1.0f - 2.0f * __builtin_amdgcn_rcpf(__expf(2.0f * x) + 1.0f); }
__device__ __forceinline__ float fsoftplus(float x) { return fmaxf(x, 0.f) + __logf(1.0f + __expf(-fabsf(x))); }
__device__ __forceinline__ u32x4 pack8(const f32x4& a, const f32x4& b) { u32x4 w; w.x = cvt_pk_bf16(a[0], a[1]); w.y = cvt_pk_bf16(a[2], a[3]); w.z = cvt_pk_bf16(b[0], b[1]); w.w = cvt_pk_bf16(b[2], b[3]); return w; }
__device__ __forceinline__ void unpack8(const u32x4& w, f32x4& a, f32x4& b) { a = (f32x4){bf_lo(w.x), bf_hi(w.x), bf_lo(w.y), bf_hi(w.y)}; b = (f32x4){bf_lo(w.z), bf_hi(w.z), bf_lo(w.w), bf_hi(w.w)}; }

template <class Fn> struct EpiB16 {
    static constexpr bool PERM = true, AFTER_DRAIN = false;
    Fn f;
    __device__ __forceinline__ void operator()(const f32x4 (&acc)[2][2][4][2], const Unit& u, int wr, int wc, int fr, int fq) const {
        const int row0 = u.pm * BM + wr * 64 + fr, col0 = u.pn * BM + wc * 32 + 8 * fq;
#pragma unroll
        for (int ai = 0; ai < 2; ++ai)
#pragma unroll
            for (int m = 0; m < 4; ++m)
#pragma unroll
                for (int bj = 0; bj < 2; ++bj) f(row0 + ai * HALF + m * 16, col0 + bj * HALF, acc[ai][bj][m][0], acc[ai][bj][m][1]);
    }
};
template <class Fn> struct EpiF32x {
    static constexpr bool PERM = false, AFTER_DRAIN = false;
    Fn f;
    __device__ __forceinline__ void operator()(const f32x4 (&acc)[2][2][4][2], const Unit& u, int wr, int wc, int fr, int fq) const {
        const int row0 = u.pm * BM + wr * 64 + fr, col0 = u.pn * BM + wc * 32 + 4 * fq;
#pragma unroll
        for (int ai = 0; ai < 2; ++ai)
#pragma unroll
            for (int m = 0; m < 4; ++m)
#pragma unroll
                for (int bj = 0; bj < 2; ++bj)
#pragma unroll
                    for (int n = 0; n < 2; ++n) f(row0 + ai * HALF + m * 16, col0 + bj * HALF + n * 16, acc[ai][bj][m][n]);
    }
};
constexpr int TT = 16384;
__device__ __forceinline__ unsigned long long pack8f8(const f32x4& a, const f32x4& b) { int w0_ = 0, w1_ = 0; w0_ = __builtin_amdgcn_cvt_pk_fp8_f32(a[0], a[1], w0_, false); w0_ = __builtin_amdgcn_cvt_pk_fp8_f32(a[2], a[3], w0_, true);
    w1_ = __builtin_amdgcn_cvt_pk_fp8_f32(b[0], b[1], w1_, false); w1_ = __builtin_amdgcn_cvt_pk_fp8_f32(b[2], b[3], w1_, true); return (unsigned long long)(unsigned)w0_ | ((unsigned long long)(unsigned)w1_ << 32); }
typedef float epi_f32x2 __attribute__((ext_vector_type(2)));
__device__ __forceinline__ void unpack8f8(unsigned long long w, float sc, f32x4& a, f32x4& b) { const int lo = (int)(unsigned)w, hi = (int)(unsigned)(w >> 32);
    const epi_f32x2 a0 = __builtin_amdgcn_cvt_pk_f32_fp8(lo, false), a1 = __builtin_amdgcn_cvt_pk_f32_fp8(lo, true), b0 = __builtin_amdgcn_cvt_pk_f32_fp8(hi, false), b1 = __builtin_amdgcn_cvt_pk_f32_fp8(hi, true);
    a = (f32x4){a0.x, a0.y, a1.x, a1.y} * sc; b = (f32x4){b0.x, b0.y, b1.x, b1.y} * sc; }
struct FnProj { bf16_t* base;
    __device__ __forceinline__ void operator()(int row, int col, f32x4 a, f32x4 b) const {
        const int reg = col >> 10, c = col & 1023; const float sc = reg == 0 ? 0.125f * 1.44269504088896f   : 1.0f; a = a * sc; b = b * sc;
        *(u32x4*)(base + (size_t)reg * ((size_t)TT * 1024) + (size_t)row * 1024 + c) = pack8(a, b); } };
struct FnGate { bf16_t* base;
    __device__ __forceinline__ void operator()(int row, int col, f32x4 a, f32x4 b) const {
        const int reg = col >> 11, c = col & 2047;
#pragma unroll
        for (int j = 0; j < 4; ++j) {
#ifndef DIAG_RAWGATE
            a[j] = fsigmoid(a[j]); b[j] = fsigmoid(b[j]);
#endif
        }
        a = a * 256.0f; b = b * 256.0f;
        *(unsigned long long*)((unsigned char*)base + (size_t)reg * ((size_t)TT * 2048) + (size_t)row * 2048 + c) = pack8f8(a, b); } };
struct FnLora1 { bf16_t* out; int act;
    __device__ __forceinline__ void operator()(int row, int col, f32x4 a, f32x4 b) const {
#pragma unroll
        for (int j = 0; j < 4; ++j) { if (act == 0) { a[j] = ftanh(a[j]); b[j] = ftanh(b[j]); } else if (act == 2) { a[j] = fsigmoid(a[j]); b[j] = fsigmoid(b[j]); } }
        *(u32x4*)(out + (size_t)row * 256 + col) = pack8(a, b); } };
struct FnLora2 { float* lw; bf16_t* aa; bf16_t* gg; const float* w0; const float* a0;
    __device__ __forceinline__ void operator()(int row, int col, f32x4 a, f32x4 b) const {
        const int which = col >> 10, c = col & 1023, t = row - which * TT;
        if (which == 0) { a = a + *(const f32x4*)(w0 + c); b = b + *(const f32x4*)(w0 + c + 4);
            *(f32x4*)(lw + (size_t)t * 1024 + c) = a; *(f32x4*)(lw + (size_t)t * 1024 + c + 4) = b; }
        else if (which == 1) { a = a + *(const f32x4*)(a0 + c); b = b + *(const f32x4*)(a0 + c + 4);
            *(u32x4*)(aa + (size_t)t * 1024 + c) = pack8(a, b); }
        else { *(u32x4*)(gg + (size_t)t * 1024 + c) = pack8(a, b); } } };

template <int W> struct FnLora2S { float* lw; bf16_t* aa; bf16_t* gg; const float* w0; const float* a0;
    __device__ __forceinline__ void operator()(int row, int col, f32x4 a, f32x4 b) const { const FnLora2 f{lw, aa, gg, w0, a0}; f(row + W * TT, col + W * 1024, a, b); } };
template <int ADD> struct FnMix { const bf16_t* gate; bf16_t* mix;
    __device__ __forceinline__ void operator()(int row, int col, f32x4 a, f32x4 b) const {
        const size_t o = (size_t)row * 2048 + col; f32x4 g0, g1; unpack8f8(*(const unsigned long long*)((const unsigned char*)gate + o), 1.0f / 256.0f, g0, g1); a = a * g0; b = b * g1;
        if (ADD) { f32x4 m0, m1; unpack8(*(const u32x4*)(mix + o), m0, m1); a = a + m0; b = b + m1; }
        *(u32x4*)(mix + o) = pack8(a, b); } };
struct FnMixF8 { const bf16_t* gate; const bf16_t* mixp; unsigned char* mix8;
    __device__ __forceinline__ void operator()(int row, int col, f32x4 a, f32x4 b) const {
        const size_t o = (size_t)row * 2048 + col; f32x4 g0, g1, m0, m1; unpack8f8(*(const unsigned long long*)((const unsigned char*)gate + o), 1.0f / 256.0f, g0, g1); unpack8(*(const u32x4*)(mixp + o), m0, m1); a = a * g0 + m0; b = b * g1 + m1;
        int w0_ = 0, w1_ = 0; w0_ = __builtin_amdgcn_cvt_pk_fp8_f32(a[0], a[1], w0_, false); w0_ = __builtin_amdgcn_cvt_pk_fp8_f32(a[2], a[3], w0_, true);
        w1_ = __builtin_amdgcn_cvt_pk_fp8_f32(b[0], b[1], w1_, false); w1_ = __builtin_amdgcn_cvt_pk_fp8_f32(b[2], b[3], w1_, true);
        *(unsigned long long*)(mix8 + o) = (unsigned long long)(unsigned)w0_ | ((unsigned long long)(unsigned)w1_ << 32); } };
struct FnWo { const float* x; float* h1; float alpha;
    __device__ __forceinline__ void operator()(int row, int col, f32x4 a) const {
        const size_t o = (size_t)row * 2048 + col; *(f32x4*)(h1 + o) = *(const f32x4*)(x + o) * alpha + a; } };
struct FnWoB16 { const float* x; bf16_t* h1; float alpha;
    __device__ __forceinline__ void operator()(int row, int col, f32x4 a, f32x4 b) const {
        const size_t o = (size_t)row * 2048 + col; a = a + *(const f32x4*)(x + o) * alpha; b = b + *(const f32x4*)(x + o + 4) * alpha; *(u32x4*)(h1 + o) = pack8(a, b); } };
struct FnPlain16 { bf16_t* out; int ld;
    __device__ __forceinline__ void operator()(int row, int col, f32x4 a, f32x4 b) const { *(u32x4*)(out + (size_t)row * ld + col) = pack8(a, b); } };
struct FnPle { bf16_t* pe;
    __device__ __forceinline__ void operator()(int row, int col, f32x4 a, f32x4 b) const {
        const size_t o = (size_t)row * 2048 + col; f32x4 p0, p1; unpack8(*(const u32x4*)(pe + o), p0, p1);
#pragma unroll
        for (int j = 0; j < 4; ++j) { a[j] = fsigmoid(a[j]) * p0[j]; b[j] = fsigmoid(b[j]) * p1[j]; }
        *(u32x4*)(pe + o) = pack8(a, b); } };
struct DiagOrder { int G, c;
    __device__ __forceinline__ bool next(int i, Unit& u) const { const int L = i * G + c; if (L >= 768) return false; const int which = L >> 8, r = L & 255; u.pm = which * 64 + (r & 63); u.pn = which * 4 + (r >> 6); return true; }
    __device__ __forceinline__ void a_ready(const Unit&) const {}
    __device__ __forceinline__ void done(const Unit&) const {}
};
typedef int pg8_v4i __attribute__((ext_vector_type(4))); typedef int pg8_v8i __attribute__((ext_vector_type(8)));
template <class Epi, class Sched, bool ALIGN_EPI = false, bool SP2 = false, int F8SCALE = 0>
__device__ __forceinline__ void gemm_phase(PG8_LAS unsigned char* lds, const Gemm g, const Sched& S, const Epi& E) {
    const int tid = threadIdx.x, wid = __builtin_amdgcn_readfirstlane(tid >> 6), lane = tid & 63, wr = wid >> 2, wc = wid & 3, fr = lane & 15, fq = lane >> 4;
    const int K = g.K, nt = K / BK;
    unsigned voffA[2], voffB[2];
#pragma unroll
    for (int i = 0; i < 2; ++i) { int R, C; stage_rc(tid * 16 + i * 8192, R, C); const int Rb = Epi::PERM ? ((R & ~31) + perm32(R & 31)) : R;
        voffA[i] = (unsigned)(R * K + C) * 2u; voffB[i] = (unsigned)(Rb * K + C) * 2u; }
    const size_t kstep = (size_t)(BK * 2);
    const size_t hstep = (size_t)HALF * K * 2;
    const size_t tstep = 2 * hstep;
    const unsigned ldsw = (unsigned)wid * 1024u;
    const int aoff = lds_byte(wr * 64 + fr, fq * 8), boff = lds_byte(wc * 32 + fr, fq * 8);
#define PG8_SA(b, h) (((b) * 2 + (h)) * HTB)
#define PG8_SB(b, h) ((4 + (b) * 2 + (h)) * HTB)
#define PG8_STAGE(bufoff, gbase, voff) do { _Pragma("unroll") for (int _i = 0; _i < 2; ++_i) \
        __builtin_amdgcn_global_load_lds((const unsigned*)((const char*)(gbase) + (voff)[_i]), (PG8_LAS unsigned*)(lds + (bufoff) + ldsw + _i * 8192), 16, 0, 0); } while (0)
#define PG8_LDA(dst, b, h) do { _Pragma("unroll") for (int m = 0; m < 4; ++m) dst[m] = __builtin_shufflevector(*(const PG8_LAS pg8_v4i*)(lds + PG8_SA(b, h) + aoff + m * 2048), *(const PG8_LAS pg8_v4i*)(lds + PG8_SA(b, h) + aoff + m * 2048 + 1024), 0, 1, 2, 3, 4, 5, 6, 7); } while (0)
#define PG8_LDB(dst, b, h) do { _Pragma("unroll") for (int n = 0; n < 2; ++n) dst[n] = __builtin_shufflevector(*(const PG8_LAS pg8_v4i*)(lds + PG8_SB(b, h) + boff + n * 2048), *(const PG8_LAS pg8_v4i*)(lds + PG8_SB(b, h) + boff + n * 2048 + 1024), 0, 1, 2, 3, 4, 5, 6, 7); } while (0)
#define PG8_LO(v) __builtin_bit_cast(bf16x8, __builtin_shufflevector(v, v, 0, 1, 2, 3))
#define PG8_HI(v) __builtin_bit_cast(bf16x8, __builtin_shufflevector(v, v, 4, 5, 6, 7))
#define PG8_MMA(ai, bj, At, Bt) do { __builtin_amdgcn_s_setprio(1); _Pragma("unroll") for (int m = 0; m < 4; ++m) _Pragma("unroll") for (int n = 0; n < 2; ++n) { \
        if constexpr (F8SCALE == 0) { acc[ai][bj][m][n] = __builtin_amdgcn_mfma_f32_16x16x32_bf16(PG8_LO(Bt[n]), PG8_LO(At[m]), acc[ai][bj][m][n], 0, 0, 0); \
                                      acc[ai][bj][m][n] = __builtin_amdgcn_mfma_f32_16x16x32_bf16(PG8_HI(Bt[n]), PG8_HI(At[m]), acc[ai][bj][m][n], 0, 0, 0); } \
        else asm volatile("v_mfma_scale_f32_16x16x128_f8f6f4 %0, %1, %2, %0, %3, %4 op_sel_hi:[0,0,0]" : "+v"(acc[ai][bj][m][n]) : "v"(Bt[n]), "v"(At[m]), "v"(f8_sw_), "v"(f8_sa_)); } \
        __builtin_amdgcn_s_setprio(0); } while (0)
#define PG8_WAIT_V(n) asm volatile("s_waitcnt vmcnt(" #n ")" ::: "memory")
#define PG8_WAIT_L(n) asm volatile("s_waitcnt lgkmcnt(" #n ")" ::: "memory")
#define PG8_BAR __builtin_amdgcn_s_barrier()
#define PG8_SCHED __builtin_amdgcn_sched_barrier(0)
    Unit cur, nxt; int ui = 0;
    if (!S.next(0, cur)) return;
    f32x4 acc[2][2][4][2];
#pragma unroll
    for (int a = 0; a < 2; ++a)
#pragma unroll
        for (int b = 0; b < 2; ++b)
#pragma unroll
            for (int m = 0; m < 4; ++m)
#pragma unroll
                for (int n = 0; n < 2; ++n) acc[a][b][m][n] = (f32x4){0.f, 0.f, 0.f, 0.f};
    pg8_v8i At[4], B0[2], B1[2]; const int f8_sw_ = F8SCALE * 0x01010101, f8_sa_ = 0x7f7f7f7f; (void)f8_sw_; (void)f8_sa_;
    const char* cA = (const char*)g.A + (size_t)cur.pm * tstep; const char* cB = (const char*)g.Bt + (size_t)cur.pn * tstep;
    S.a_ready(cur);
    if constexpr (SP2) {
        PG8_STAGE(PG8_SB(0, 0), cB, voffB); PG8_STAGE(PG8_SB(0, 1), cB + hstep, voffB); PG8_STAGE(PG8_SA(0, 0), cA, voffA); PG8_STAGE(PG8_SA(0, 1), cA + hstep, voffA);
        if (wr == 1) PG8_BAR;
        PG8_WAIT_V(2); PG8_BAR;
        PG8_STAGE(PG8_SB(1, 0), cB + kstep, voffB); PG8_STAGE(PG8_SA(1, 0), cA + kstep, voffA); PG8_STAGE(PG8_SB(1, 1), cB + hstep + kstep, voffB);
        PG8_WAIT_V(6); PG8_BAR;
    } else {
        PG8_STAGE(PG8_SB(0, 0), cB, voffB); PG8_STAGE(PG8_SA(0, 0), cA, voffA); PG8_STAGE(PG8_SB(0, 1), cB + hstep, voffB); PG8_STAGE(PG8_SA(0, 1), cA + hstep, voffA);
        if (wr == 1) PG8_BAR;
        PG8_WAIT_V(4); PG8_BAR;
        PG8_STAGE(PG8_SB(1, 0), cB + kstep, voffB); PG8_STAGE(PG8_SA(1, 0), cA + kstep, voffA); PG8_STAGE(PG8_SB(1, 1), cB + hstep + kstep, voffB);
        PG8_WAIT_V(6); PG8_BAR;
    }
    for (;;) {
        const bool has_next = S.next(ui + 1, nxt);
        const char* nA = has_next ? (const char*)g.A + (size_t)nxt.pm * tstep : cA; const char* nB = has_next ? (const char*)g.Bt + (size_t)nxt.pn * tstep : cB;
        for (int t = 0; t < nt; t += 2) {
            const bool last = (t == nt - 2);
            const char* a1 = cA + (size_t)(t + 1) * kstep;
            const char* a2 = last ? nA : cA + (size_t)(t + 2) * kstep; const char* b2 = last ? nB : cB + (size_t)(t + 2) * kstep;
            const char* a3 = a2 + kstep; const char* b3 = b2 + kstep;
            if (last && has_next) S.a_ready(nxt);
            if constexpr (SP2) {
            PG8_LDB(B0, 0, 0); PG8_LDB(B1, 0, 1); PG8_SCHED; PG8_LDA(At, 0, 0); PG8_STAGE(PG8_SA(1, 1), a1 + hstep, voffA);
            PG8_WAIT_V(8); PG8_WAIT_L(0); PG8_BAR; PG8_MMA(0, 0, At, B0); PG8_MMA(0, 1, At, B1); PG8_BAR; PG8_SCHED;
            PG8_LDA(At, 0, 1); PG8_STAGE(PG8_SB(0, 0), b2, voffB); PG8_STAGE(PG8_SB(0, 1), b2 + hstep, voffB); PG8_STAGE(PG8_SA(0, 0), a2, voffA);
            PG8_WAIT_V(8); PG8_WAIT_L(0); PG8_BAR; PG8_MMA(1, 0, At, B0); PG8_MMA(1, 1, At, B1); PG8_BAR; PG8_SCHED;
            PG8_LDB(B0, 1, 0); PG8_LDB(B1, 1, 1); PG8_SCHED; PG8_LDA(At, 1, 0); PG8_STAGE(PG8_SA(0, 1), a2 + hstep, voffA);
            PG8_WAIT_V(8); PG8_WAIT_L(0); PG8_BAR; PG8_MMA(0, 0, At, B0); PG8_MMA(0, 1, At, B1); PG8_BAR; PG8_SCHED;
            PG8_LDA(At, 1, 1); PG8_STAGE(PG8_SB(1, 0), b3, voffB); PG8_STAGE(PG8_SB(1, 1), b3 + hstep, voffB); PG8_STAGE(PG8_SA(1, 0), a3, voffA);
            PG8_WAIT_V(8); PG8_WAIT_L(0); PG8_BAR; PG8_MMA(1, 0, At, B0); PG8_MMA(1, 1, At, B1); PG8_BAR; PG8_SCHED;
            } else {
            PG8_LDB(B0, 0, 0); PG8_SCHED; PG8_LDA(At, 0, 0); PG8_STAGE(PG8_SA(1, 1), a1 + hstep, voffA);
            PG8_WAIT_L(8); PG8_BAR; PG8_WAIT_L(0); PG8_MMA(0, 0, At, B0); PG8_BAR; PG8_SCHED;
            PG8_LDB(B1, 0, 1); PG8_STAGE(PG8_SB(0, 0), b2, voffB);
            PG8_BAR; PG8_WAIT_L(0); PG8_MMA(0, 1, At, B1); PG8_BAR;
            PG8_LDA(At, 0, 1); PG8_STAGE(PG8_SA(0, 0), a2, voffA);
            PG8_BAR; PG8_WAIT_L(0); PG8_MMA(1, 0, At, B0); PG8_BAR; PG8_SCHED;
            PG8_STAGE(PG8_SB(0, 1), b2 + hstep, voffB);
            PG8_WAIT_V(6); PG8_BAR; PG8_MMA(1, 1, At, B1); PG8_BAR;
            PG8_LDB(B0, 1, 0); PG8_SCHED; PG8_LDA(At, 1, 0); PG8_STAGE(PG8_SA(0, 1), a2 + hstep, voffA);
            PG8_WAIT_L(8); PG8_BAR; PG8_WAIT_L(0); PG8_MMA(0, 0, At, B0); PG8_BAR; PG8_SCHED;
            PG8_LDB(B1, 1, 1); PG8_STAGE(PG8_SB(1, 0), b3, voffB);
            PG8_BAR; PG8_WAIT_L(0); PG8_MMA(0, 1, At, B1); PG8_BAR;
            PG8_LDA(At, 1, 1); PG8_STAGE(PG8_SA(1, 0), a3, voffA);
            PG8_BAR; PG8_WAIT_L(0); PG8_MMA(1, 0, At, B0); PG8_BAR; PG8_SCHED;
            PG8_STAGE(PG8_SB(1, 1), b3 + hstep, voffB);
            PG8_WAIT_V(6); PG8_BAR; PG8_MMA(1, 1, At, B1); PG8_BAR;
            }
        }
        if constexpr (ALIGN_EPI) { if (wr == 0) PG8_BAR; }
        if constexpr (!Epi::AFTER_DRAIN) { E(acc, cur, wr, wc, fr, fq); S.done(cur); }
        if (!has_next) break;
#pragma unroll
        for (int a = 0; a < 2; ++a)
#pragma unroll
            for (int b = 0; b < 2; ++b)
#pragma unroll
                for (int m = 0; m < 4; ++m)
#pragma unroll
                    for (int n = 0; n < 2; ++n) acc[a][b][m][n] = (f32x4){0.f, 0.f, 0.f, 0.f};
        cur = nxt; cA = nA; cB = nB; ++ui;
        if constexpr (ALIGN_EPI) { if (wr == 1) PG8_BAR; }
    }
    PG8_WAIT_V(0);
    if constexpr (!ALIGN_EPI) { if (wr == 0) PG8_BAR; }
    PG8_BAR;
    if constexpr (Epi::AFTER_DRAIN) { E.fused(acc, cur, wr, wc, fr, fq, lds, wid, lane); S.done(cur); }
#undef PG8_SA
#undef PG8_SB
#undef PG8_STAGE
#undef PG8_LDA
#undef PG8_LDB
#undef PG8_MMA
#undef PG8_WAIT_V
#undef PG8_WAIT_L
#undef PG8_BAR
#undef PG8_SCHED
}
}

#ifndef PG8_SP2
#define PG8_SP2 true
#endif
#ifndef PG8_ALIGN
#define PG8_ALIGN true
#endif
#define GAS __attribute__((address_space(1)))
#define LAS __attribute__((address_space(3)))
typedef unsigned short bf16;
typedef unsigned v4u __attribute__((ext_vector_type(4)));
typedef float f32x4 __attribute__((ext_vector_type(4)));
typedef short bf16x8 __attribute__((ext_vector_type(8)));
typedef GAS unsigned gu32;
typedef GAS unsigned long long gu64;
#define RLX_AGENT __ATOMIC_RELAXED, __HIP_MEMORY_SCOPE_AGENT
#define LDS_WAIT() asm volatile("s_waitcnt lgkmcnt(0)" ::: "memory")
#define VM_WAIT() asm volatile("s_waitcnt vmcnt(0)" ::: "memory")
__device__ __forceinline__ unsigned long long rt() { return __builtin_amdgcn_s_memrealtime(); }
__device__ __forceinline__ unsigned f2bf(float f) { return pg8::cvt_pk_bf16(f, f) & 0xffffu; }
__device__ __forceinline__ unsigned pk2(float lo, float hi) { return pg8::cvt_pk_bf16(lo, hi); }

#define XB_TMO      128
#define XB_XCNT(j)  (256  + 64 * (j))
#define XB_XSUB(j)  (1280 + 64 * (j))
#define XB_XGEN(j)  (2304 + 64 * (j))
#define XB_TOP      3328
#define XB_TOPGEN   3392
#define XCD_BAR_WORDS 3456
#define XB_SPIN_CAP (1u << 18)

__device__ __forceinline__ unsigned xb_ld(unsigned* p)              { return __hip_atomic_load(p, __ATOMIC_RELAXED, __HIP_MEMORY_SCOPE_AGENT); }
__device__ __forceinline__ unsigned xb_add(unsigned* p, unsigned v) { return __hip_atomic_fetch_add(p, v, __ATOMIC_RELAXED, __HIP_MEMORY_SCOPE_AGENT); }
__device__ __forceinline__ unsigned xb_xcc_id() { return (unsigned)__builtin_amdgcn_s_getreg((3 << 11) | 20) & 0xFu; }
#define XB_SPIN(cond, bar) do { unsigned _sp = 0; while (cond) { __builtin_amdgcn_s_sleep(1); \
    if ((++_sp & 255u) == 0u) { if (xb_ld(&(bar)[XB_TMO])) break; if (_sp > XB_SPIN_CAP) { atomicAdd(&(bar)[XB_TMO], 1u); break; } } } } while (0)

struct XcdBarrier {
    unsigned* bar; unsigned x;
    volatile LAS unsigned* st;
};

__device__ __forceinline__ XcdBarrier xcd_barrier_post(unsigned* bar, volatile LAS unsigned* st) {
    XcdBarrier b; b.bar = bar; b.x = xb_xcc_id(); b.st = st;
    if (threadIdx.x == 0) (void)xb_add(&bar[XB_XCNT(b.x)], 1u);
    return b;
}
__device__ __forceinline__ void xcd_barrier_complete(unsigned* bar, unsigned x, unsigned& nloc, unsigned& nx) {
    const unsigned G = gridDim.x * gridDim.y * gridDim.z;
    unsigned sum, cnt, mine, sp = 0u;
    for (;;) {
        sum = 0u; cnt = 0u; mine = 0u;
#pragma unroll
        for (unsigned j = 0; j < 16; ++j) { const unsigned c = xb_ld(&bar[XB_XCNT(j)]); sum += c; cnt += (c > 0u) ? 1u : 0u; mine = (j == x) ? c : mine; }
        if (sum == G) break;
        __builtin_amdgcn_s_sleep(1);
        if ((++sp & 255u) == 0u) { if (xb_ld(&bar[XB_TMO])) break; if (sp > XB_SPIN_CAP) { atomicAdd(&bar[XB_TMO], 1u); break; } }
    }
    nloc = mine > 0u ? mine : 1u; nx = cnt > 0u ? cnt : 1u;
}

__device__ __forceinline__ void xcd_barrier(const XcdBarrier& b) {
    asm volatile("s_waitcnt vmcnt(0)" ::: "memory");
    __syncthreads();
    if (threadIdx.x == 0) {
        unsigned* bar = b.bar;
        __builtin_amdgcn_s_waitcnt(0);
        unsigned nloc = b.st[0], nx = b.st[1];
        if (nloc == 0u) { xcd_barrier_complete(bar, b.x, nloc, nx); b.st[0] = nloc; b.st[1] = nx; }
        const unsigned old = xb_add(&bar[XB_XSUB(b.x)], 1u);
        const unsigned gen = old / nloc;
        if (old + 1u == (gen + 1u) * nloc) {
            __builtin_amdgcn_fence(__ATOMIC_RELEASE, "agent");
            asm volatile("s_waitcnt vmcnt(0)" ::: "memory");
            const unsigned og = xb_add(&bar[XB_TOP], 1u);
            const unsigned tg = og / nx;
            if (og + 1u == (tg + 1u) * nx) xb_add(&bar[XB_TOPGEN], 1u);
            else XB_SPIN(xb_ld(&bar[XB_TOPGEN]) == tg, bar);
            __builtin_amdgcn_fence(__ATOMIC_ACQUIRE, "agent");
            xb_add(&bar[XB_XGEN(b.x)], 1u);
            asm volatile("s_waitcnt vmcnt(0)" ::: "memory");
        } else {
            XB_SPIN(xb_ld(&bar[XB_XGEN(b.x)]) == gen, bar);
            __builtin_amdgcn_fence(__ATOMIC_ACQUIRE, "agent");
            asm volatile("s_waitcnt vmcnt(0)" ::: "memory");
        }
    }
    __syncthreads();
}

constexpr int NWAVES = 8;
constexpr int T = 16384, D = 2048, NIN = 11264;
constexpr float LN_EPS = 1e-5f, GN_EPS = 64e-5f, ALPHA = 1.189207115002721f;
constexpr size_t MiB = 1u << 20;
constexpr size_t WS_CTL = 0, CTL_ZERO_BYTES = 1 * MiB;
constexpr size_t WS_WIN = 1 * MiB, WS_WUA = 45 * MiB, WS_WUB = 49 * MiB, WS_WO = 53 * MiB, WS_WQ = 61 * MiB, WS_WPG = 69 * MiB, WS_WPE = 77 * MiB;
constexpr size_t WS_L1 = 78 * MiB;
constexpr size_t WS_L2 = 79 * MiB + MiB / 2;
constexpr size_t WS_PB = 81 * MiB;
constexpr size_t WS_XB = 90 * MiB;
constexpr size_t WS_PROJ = 154 * MiB;
constexpr size_t WS_Q = WS_PROJ, WS_K = WS_PROJ + 32 * MiB, WS_V = WS_PROJ + 64 * MiB, WS_RR = WS_PROJ + 96 * MiB, WS_RK = WS_PROJ + 128 * MiB, WS_RV = WS_PROJ + 160 * MiB, WS_RC = WS_PROJ + 192 * MiB;
constexpr size_t WS_YB = WS_RK;
constexpr size_t WS_QC = WS_Q, WS_GTC = WS_K, WS_YLC = WS_V, WS_TTC = WS_RC, WS_SB = WS_XB + 32 * MiB;
constexpr size_t WS_YRAW = WS_K;
constexpr size_t WS_GG = 522 * MiB;
constexpr size_t WS_DREG = 378 * MiB;
constexpr size_t WS_HID = WS_DREG;
constexpr size_t WS_XW = WS_DREG + 24 * MiB;
constexpr size_t WS_LW = WS_DREG;
constexpr size_t WS_AA = WS_DREG + 64 * MiB;
constexpr size_t WS_GATE = WS_DREG;
constexpr size_t WS_MIX = WS_XB, WS_PQ = WS_XB;
constexpr size_t WS_MIX8 = WS_Q;
constexpr size_t WS_X1B8 = 378 * MiB;
constexpr size_t WS_H1 = 186 * MiB;
constexpr size_t WS_X1 = 314 * MiB;
constexpr size_t WS_X1B = 442 * MiB;
constexpr size_t WS_PE = 154 * MiB;
constexpr size_t WS_YA = 506 * MiB;
constexpr size_t WS_IDX = 506 * MiB, WS_PG = 514 * MiB;
constexpr size_t WS_UB = 314 * MiB, WS_VB = 346 * MiB;
constexpr float U_SCALE = 64.0f, V_SCALE = 2.0f;
constexpr int ROW6 = 1536;
constexpr size_t WS_RKC = 538 * MiB;
constexpr size_t WS_END = 539 * MiB;
constexpr int CW_BAR = 4096, CW_RCNT = 16384;
constexpr int RING_OFF = 0, RING_BYTES = 131072, LDSCTL_OFF = RING_BYTES, MISC_OFF = LDSCTL_OFF + 320, LDS_BYTES = 147456;
constexpr int NPHASE = 13;
#ifndef MK_ONE_LAUNCH
#define MK_ONE_LAUNCH 0
#endif

struct Frame {
    LAS unsigned char* lds; volatile LAS unsigned* MISC; gu32* ctl;
    int tid, lane, wave, vcu, G;
};
template <int CTRL> __device__ __forceinline__ float dpp_addc(float x) { return x + __builtin_bit_cast(float, __builtin_amdgcn_mov_dpp(__builtin_bit_cast(int, x), CTRL, 0xf, 0xf, true)); }
__device__ __forceinline__ float row16_sum(float x) { x = dpp_addc<0xB1>(x); x = dpp_addc<0x4E>(x); x = dpp_addc<0x141>(x); x = dpp_addc<0x140>(x); return x; }
__device__ __forceinline__ float wave_sum(float v) {
    v = row16_sum(v);
    const float a = __builtin_bit_cast(float, __builtin_amdgcn_readlane(__builtin_bit_cast(int, v), 0)), b = __builtin_bit_cast(float, __builtin_amdgcn_readlane(__builtin_bit_cast(int, v), 16));
    const float c = __builtin_bit_cast(float, __builtin_amdgcn_readlane(__builtin_bit_cast(int, v), 32)), d = __builtin_bit_cast(float, __builtin_amdgcn_readlane(__builtin_bit_cast(int, v), 48));
    return (a + b) + (c + d);
}
__device__ __forceinline__ float wave_max(float v) {
#pragma unroll
    for (int o = 1; o < 64; o <<= 1) v = fmaxf(v, __shfl_xor(v, o));
    return v;
}
__device__ __forceinline__ float bflo(unsigned w) { return __uint_as_float(w << 16); }
__device__ __forceinline__ float bfhi(unsigned w) { return __uint_as_float(w & 0xffff0000u); }
__device__ __forceinline__ float bf1(bf16 b) { return __uint_as_float(((unsigned)b) << 16); }
typedef __attribute__((ext_vector_type(2))) __bf16 bf16x2_t;
typedef float f32x16 __attribute__((ext_vector_type(16)));
__device__ __forceinline__ float dot2(unsigned a, unsigned b, float c) { return __builtin_amdgcn_fdot2_f32_bf16(__builtin_bit_cast(bf16x2_t, a), __builtin_bit_cast(bf16x2_t, b), c, false); }
__device__ __forceinline__ float rdlane(float v, int l) { return __builtin_bit_cast(float, __builtin_amdgcn_readlane(__builtin_bit_cast(int, v), l)); }
__device__ __forceinline__ int rdlanei(int v, int l) { return __builtin_amdgcn_readlane(v, l); }

__device__ __forceinline__ void p0_transpose_item(const float* W, int K, int N, bf16* WT, LAS float* scr, int item, int lane) {
    const int nblk = N / 32, kb = item / nblk, nb = item % nblk, k0 = 64 * kb, n0 = 32 * nb;
#pragma unroll 8
    for (int i = 0; i < 32; ++i) { const int kk = 2 * i + (lane >> 5); scr[kk * 33 + (lane & 31)] = W[(size_t)(k0 + kk) * N + n0 + (lane & 31)]; }
    LDS_WAIT(); asm volatile("" ::: "memory");
    const int c = lane & 7;
#pragma unroll
    for (int j = 0; j < 4; ++j) { const int n = (lane >> 3) + 8 * j; const LAS float* s = scr + (8 * c) * 33 + n;
        v4u o; o.x = pk2(s[0 * 33], s[1 * 33]); o.y = pk2(s[2 * 33], s[3 * 33]); o.z = pk2(s[4 * 33], s[5 * 33]); o.w = pk2(s[6 * 33], s[7 * 33]);
        *(GAS v4u*)(WT + (size_t)(n0 + n) * K + k0 + 8 * c) = o; }
    LDS_WAIT(); asm volatile("" ::: "memory");
}
__device__ __forceinline__ void p0_transpose_item8(const float* W, int K, int N, unsigned char* WT, float scale, LAS float* scr, int item, int lane) {
    const int nblk = N / 32, kb = item / nblk, nb = item % nblk, k0 = 64 * kb, n0 = 32 * nb;
#pragma unroll 8
    for (int i = 0; i < 32; ++i) { const int kk = 2 * i + (lane >> 5); scr[kk * 33 + (lane & 31)] = W[(size_t)(k0 + kk) * N + n0 + (lane & 31)] * scale; }
    LDS_WAIT(); asm volatile("" ::: "memory");
    const int c = lane & 7;
#pragma unroll
    for (int j = 0; j < 4; ++j) { const int n = (lane >> 3) + 8 * j; const LAS float* s = scr + (8 * c) * 33 + n;
        int w0_ = 0, w1_ = 0; w0_ = __builtin_amdgcn_cvt_pk_fp8_f32(s[0 * 33], s[1 * 33], w0_, false); w0_ = __builtin_amdgcn_cvt_pk_fp8_f32(s[2 * 33], s[3 * 33], w0_, true);
        w1_ = __builtin_amdgcn_cvt_pk_fp8_f32(s[4 * 33], s[5 * 33], w1_, false); w1_ = __builtin_amdgcn_cvt_pk_fp8_f32(s[6 * 33], s[7 * 33], w1_, true);
        *(GAS unsigned long long*)(WT + (size_t)(n0 + n) * K + k0 + 8 * c) = (unsigned long long)(unsigned)w0_ | ((unsigned long long)(unsigned)w1_ << 32); }
    LDS_WAIT(); asm volatile("" ::: "memory");
}
__device__ __forceinline__ void cvt_rows_bf16(const float* src, bf16* dst, size_t n8, size_t i0, size_t stride) {
    for (size_t i = i0; i < n8; i += stride) { const f32x4 a = ((const GAS f32x4*)src)[2 * i], b = ((const GAS f32x4*)src)[2 * i + 1];
        v4u o; o.x = pk2(a.x, a.y); o.y = pk2(a.z, a.w); o.z = pk2(b.x, b.y); o.w = pk2(b.z, b.w); ((GAS v4u*)dst)[i] = o; }
}


typedef short v4i16_t __attribute__((ext_vector_type(4)));
constexpr int RW_PIT = 144, RW_SLOT = 64 * RW_PIT;
__device__ __forceinline__ bf16x8 rw_fd(const LAS unsigned char* img, int r0, int ks, int idx, int g) { return *(const LAS bf16x8*)(img + (r0 + idx) * RW_PIT + (32 * ks + 8 * g) * 2); }
__device__ __forceinline__ bf16x8 rw_ft(const LAS unsigned char* img, int c0, int ks, int idx, int g) {
    const LAS unsigned char* a = img + (32 * ks + 8 * g + (idx >> 2)) * RW_PIT + (c0 + 4 * (idx & 3)) * 2;
    const v4i16_t lo = __builtin_amdgcn_ds_read_tr16_b64_v4i16((LAS v4i16_t*)a), hi = __builtin_amdgcn_ds_read_tr16_b64_v4i16((LAS v4i16_t*)(a + 4 * RW_PIT));
    return __builtin_shufflevector(lo, hi, 0, 1, 2, 3, 4, 5, 6, 7); }
template <int MX, int MY> __device__ __forceinline__ void rw_mm2(const LAS unsigned char* X, const LAS unsigned char* Y, int mt, int ntb, f32x4& c0, f32x4& c1, int idx, int g) {
#pragma unroll
    for (int ks = 0; ks < 2; ++ks) {
        const bf16x8 a = MX ? rw_ft(X, 16 * mt, ks, idx, g) : rw_fd(X, 16 * mt, ks, idx, g);
        const bf16x8 b0 = MY ? rw_ft(Y, 16 * ntb, ks, idx, g) : rw_fd(Y, 16 * ntb, ks, idx, g);
        const bf16x8 b1 = MY ? rw_ft(Y, 16 * ntb + 16, ks, idx, g) : rw_fd(Y, 16 * ntb + 16, ks, idx, g);
        c0 = __builtin_amdgcn_mfma_f32_16x16x32_bf16(a, b0, c0, 0, 0, 0); c1 = __builtin_amdgcn_mfma_f32_16x16x32_bf16(a, b1, c1, 0, 0, 0); }
}
template <int MX, int MY, int MZ> __device__ __forceinline__ void rw_mm2_shareA(const LAS unsigned char* X, const LAS unsigned char* Y, const LAS unsigned char* Z, int mt, int ntb, f32x4& c0, f32x4& c1, f32x4& d0, f32x4& d1, int idx, int g) {
#pragma unroll
    for (int ks = 0; ks < 2; ++ks) {
        const bf16x8 a = MX ? rw_ft(X, 16 * mt, ks, idx, g) : rw_fd(X, 16 * mt, ks, idx, g);
        const bf16x8 y0 = MY ? rw_ft(Y, 16 * ntb, ks, idx, g) : rw_fd(Y, 16 * ntb, ks, idx, g), y1 = MY ? rw_ft(Y, 16 * ntb + 16, ks, idx, g) : rw_fd(Y, 16 * ntb + 16, ks, idx, g);
        const bf16x8 z0 = MZ ? rw_ft(Z, 16 * ntb, ks, idx, g) : rw_fd(Z, 16 * ntb, ks, idx, g), z1 = MZ ? rw_ft(Z, 16 * ntb + 16, ks, idx, g) : rw_fd(Z, 16 * ntb + 16, ks, idx, g);
        c0 = __builtin_amdgcn_mfma_f32_16x16x32_bf16(a, y0, c0, 0, 0, 0); c1 = __builtin_amdgcn_mfma_f32_16x16x32_bf16(a, y1, c1, 0, 0, 0);
        d0 = __builtin_amdgcn_mfma_f32_16x16x32_bf16(a, z0, d0, 0, 0, 0); d1 = __builtin_amdgcn_mfma_f32_16x16x32_bf16(a, z1, d1, 0, 0, 0); }
}
template <int MX, int MW, int MY> __device__ __forceinline__ void rw_mm2_shareB(const LAS unsigned char* X, const LAS unsigned char* W, const LAS unsigned char* Y, int mt, int ntb, f32x4& c0, f32x4& c1, f32x4& d0, f32x4& d1, int idx, int g) {
#pragma unroll
    for (int ks = 0; ks < 2; ++ks) {
        const bf16x8 a = MX ? rw_ft(X, 16 * mt, ks, idx, g) : rw_fd(X, 16 * mt, ks, idx, g), w = MW ? rw_ft(W, 16 * mt, ks, idx, g) : rw_fd(W, 16 * mt, ks, idx, g);
        const bf16x8 y0 = MY ? rw_ft(Y, 16 * ntb, ks, idx, g) : rw_fd(Y, 16 * ntb, ks, idx, g), y1 = MY ? rw_ft(Y, 16 * ntb + 16, ks, idx, g) : rw_fd(Y, 16 * ntb + 16, ks, idx, g);
        c0 = __builtin_amdgcn_mfma_f32_16x16x32_bf16(a, y0, c0, 0, 0, 0); c1 = __builtin_amdgcn_mfma_f32_16x16x32_bf16(a, y1, c1, 0, 0, 0);
        d0 = __builtin_amdgcn_mfma_f32_16x16x32_bf16(w, y0, d0, 0, 0, 0); d1 = __builtin_amdgcn_mfma_f32_16x16x32_bf16(w, y1, d1, 0, 0, 0); }
}
#define RW_FR(M, img, r0, ks) ((M) ? rw_ft(img, r0, ks, idx, g) : rw_fd(img, r0, ks, idx, g))
#define RW_MF(a, b, c) c = __builtin_amdgcn_mfma_f32_16x16x32_bf16(a, b, c, 0, 0, 0)
template <int MX, int MY> __device__ __forceinline__ void rw_mm22(const LAS unsigned char* X, const LAS unsigned char* Y, int mt0, int nt0, f32x4 (&c)[2][2], int idx, int g, bool k0 = true, bool k1 = true) {
#pragma unroll
    for (int ks = 0; ks < 2; ++ks) if (ks == 0 ? k0 : k1) { const bf16x8 a0 = RW_FR(MX, X, 16 * mt0, ks), a1 = RW_FR(MX, X, 16 * mt0 + 16, ks), b0 = RW_FR(MY, Y, 16 * nt0, ks), b1 = RW_FR(MY, Y, 16 * nt0 + 16, ks);
        RW_MF(a0, b0, c[0][0]); RW_MF(a0, b1, c[0][1]); RW_MF(a1, b0, c[1][0]); RW_MF(a1, b1, c[1][1]); }
}
template <int MX, int MY, int MZ> __device__ __forceinline__ void rw_mm22_shareA(const LAS unsigned char* X, const LAS unsigned char* Y, const LAS unsigned char* Z, int mt0, int nt0, f32x4 (&c)[2][2], f32x4 (&d)[2][2], int idx, int g, bool cy1 = true) {
#pragma unroll
    for (int ks = 0; ks < 2; ++ks) { const bf16x8 a0 = RW_FR(MX, X, 16 * mt0, ks), a1 = RW_FR(MX, X, 16 * mt0 + 16, ks), z0 = RW_FR(MZ, Z, 16 * nt0, ks), z1 = RW_FR(MZ, Z, 16 * nt0 + 16, ks);
        if (ks == 0 || cy1) { const bf16x8 y0 = RW_FR(MY, Y, 16 * nt0, ks), y1 = RW_FR(MY, Y, 16 * nt0 + 16, ks); RW_MF(a0, y0, c[0][0]); RW_MF(a0, y1, c[0][1]); RW_MF(a1, y0, c[1][0]); RW_MF(a1, y1, c[1][1]); }
        RW_MF(a0, z0, d[0][0]); RW_MF(a0, z1, d[0][1]); RW_MF(a1, z0, d[1][0]); RW_MF(a1, z1, d[1][1]); }
}
template <int MX, int MW, int MY> __device__ __forceinline__ void rw_mm22_shareB(const LAS unsigned char* X, const LAS unsigned char* W, const LAS unsigned char* Y, int mt0, int nt0, f32x4 (&c)[2][2], f32x4 (&d)[2][2], int idx, int g, bool cx0 = true, bool cx1 = true, bool dw0 = true) {
#pragma unroll
    for (int ks = 0; ks < 2; ++ks) { const bool cx = ks == 0 ? cx0 : cx1, dw = ks == 0 ? dw0 : true;
        if (cx || dw) { const bf16x8 y0 = RW_FR(MY, Y, 16 * nt0, ks), y1 = RW_FR(MY, Y, 16 * nt0 + 16, ks);
            if (cx) { const bf16x8 a0 = RW_FR(MX, X, 16 * mt0, ks), a1 = RW_FR(MX, X, 16 * mt0 + 16, ks); RW_MF(a0, y0, c[0][0]); RW_MF(a0, y1, c[0][1]); RW_MF(a1, y0, c[1][0]); RW_MF(a1, y1, c[1][1]); }
            if (dw) { const bf16x8 w0 = RW_FR(MW, W, 16 * mt0, ks), w1 = RW_FR(MW, W, 16 * mt0 + 16, ks); RW_MF(w0, y0, d[0][0]); RW_MF(w0, y1, d[0][1]); RW_MF(w1, y0, d[1][0]); RW_MF(w1, y1, d[1][1]); } } }
}
__device__ __forceinline__ void rw_st(LAS unsigned char* E, int mt, int nt, const f32x4& c, int idx, int g) {
    *(LAS unsigned long long*)(E + (16 * nt + idx) * RW_PIT + (16 * mt + 4 * g) * 2) = (unsigned long long)pk2(c[0], c[1]) | ((unsigned long long)pk2(c[2], c[3]) << 32); }
__device__ __forceinline__ f32x4 rw_ld(const LAS unsigned char* E, int mt, int nt, int idx, int g) {
    const unsigned long long w = *(const LAS unsigned long long*)(E + (16 * nt + idx) * RW_PIT + (16 * mt + 4 * g) * 2); const unsigned lo = (unsigned)w, hi = (unsigned)(w >> 32);
    return (f32x4){bflo(lo), bfhi(lo), bflo(hi), bfhi(hi)}; }
__device__ __forceinline__ void rw_stg_wt(bf16* E, int mt, int nt, const f32x4& c, int idx, int g) {
    __hip_atomic_store((gu64*)(E + (16 * nt + idx) * 64 + 16 * mt + 4 * g), (unsigned long long)pk2(c[0], c[1]) | ((unsigned long long)pk2(c[2], c[3]) << 32), RLX_AGENT); }
__device__ __forceinline__ void rw_stg(bf16* E, int mt, int nt, const f32x4& c, int idx, int g) {
    *(GAS unsigned long long*)(E + (16 * nt + idx) * 64 + 16 * mt + 4 * g) = (unsigned long long)pk2(c[0], c[1]) | ((unsigned long long)pk2(c[2], c[3]) << 32); }

__device__ __forceinline__ void bitonic_merge16_desc(float (&v)[16]) {
#pragma unroll
    for (int j = 8; j > 0; j >>= 1)
#pragma unroll
        for (int i = 0; i < 16; ++i) { const int l = i ^ j; if (l > i) { const float hi = fmaxf(v[i], v[l]), lo = fminf(v[i], v[l]); v[i] = hi; v[l] = lo; } }
}
__device__ __forceinline__ void bitonic_sort16_desc(float (&v)[16]) {
#pragma unroll
    for (int k = 2; k <= 16; k <<= 1)
#pragma unroll
        for (int j = k >> 1; j > 0; j >>= 1)
#pragma unroll
            for (int i = 0; i < 16; ++i) { const int l = i ^ j; if (l > i) { const float hi = fmaxf(v[i], v[l]), lo = fminf(v[i], v[l]); const bool desc = (i & k) == 0; v[i] = desc ? hi : lo; v[l] = desc ? lo : hi; } }
}
__device__ __forceinline__ void top16_merge_desc(float (&a)[16], const float (&b)[16]) {
#pragma unroll
    for (int i = 0; i < 16; ++i) a[i] = fmaxf(a[i], b[15 - i]);
    bitonic_merge16_desc(a);
}

#ifndef P4_VARIANT
#define P4_VARIANT 0
#endif
#ifndef P4_ALIGN
#define P4_ALIGN PG8_ALIGN
#endif
#ifndef P4_SP2
#define P4_SP2 PG8_SP2
#endif
#ifndef DIAG_TOL
#define DIAG_TOL 0.03f
#endif
#ifndef REPEAT_SUB
#define REPEAT_SUB 0
#endif
#ifndef REPEAT_PHASE
#define REPEAT_PHASE -1
#endif
#define REP_BEGIN(k) for (int rep_ = 0; rep_ < ((REPEAT_PHASE) == (k) ? 2 : 1); ++rep_) {
#define REP_END(k) if ((REPEAT_PHASE) == (k) && rep_ == 0) xcd_barrier(bar); }
#ifndef DIAG_RATIO
#define DIAG_RATIO 2.0
#endif
#ifndef DIAG_UNIT_MS
#define DIAG_UNIT_MS 10
#endif
#ifndef DIAG_LAST
#define DIAG_LAST -1
#endif
template <class TT_> __device__ __forceinline__ float dg_val(const TT_* p, size_t i);
template <> __device__ __forceinline__ float dg_val<float>(const float* p, size_t i) { return p[i]; }
template <> __device__ __forceinline__ float dg_val<bf16>(const bf16* p, size_t i) { return bf1(p[i]); }
template <> __device__ __forceinline__ float dg_val<int>(const int* p, size_t i) { return (float)p[i] * (1.0f / 1024.0f); }
template <class TT_> __device__ __forceinline__ void digest(float* out, int slot, const TT_* buf, size_t n, size_t gt, size_t NGT) {
    constexpr size_t M = (size_t)1024 * 2048;
    for (size_t e = gt; e < M; e += NGT) { float s = 0.f; for (size_t j = e; j < n; j += M) s += dg_val<TT_>(buf, j); out[(size_t)slot * M + e] = s; }
}

__device__ __forceinline__ void cvt_rows_fp8(const float* src, unsigned char* dst, size_t n16, float scale, size_t i0, size_t stride) {
    for (size_t i = i0; i < n16; i += stride) { v4u o;
#pragma unroll
        for (int q = 0; q < 4; ++q) { const f32x4 a = ((const GAS f32x4*)src)[4 * i + q] * scale; int w = 0; w = __builtin_amdgcn_cvt_pk_fp8_f32(a.x, a.y, w, false); w = __builtin_amdgcn_cvt_pk_fp8_f32(a.z, a.w, w, true); o[q] = (unsigned)w; }
        ((GAS v4u*)dst)[i] = o; }
}

typedef unsigned v16u_t __attribute__((ext_vector_type(16))); typedef float v32f_t __attribute__((ext_vector_type(32))); typedef float v16f_t __attribute__((ext_vector_type(16))); typedef unsigned v6u_t __attribute__((ext_vector_type(6)));
__device__ __forceinline__ void cvt_rows_fp6(const float* src, unsigned char* dst, int nrows, float scale, int gw, int ngw, int lane) {
    for (int row = gw; row < nrows; row += ngw) { v16f_t a, b;
#pragma unroll
        for (int q = 0; q < 8; ++q) { const f32x4 v = *(const GAS f32x4*)(src + (size_t)row * 2048 + 256 * q + 4 * lane) * scale; a[2 * q] = v.x; b[2 * q] = v.y; a[2 * q + 1] = v.z; b[2 * q + 1] = v.w; }
        const v6u_t p = __builtin_amdgcn_cvt_scalef32_2xpk16_fp6_f32(a, b, 1.0f); GAS unsigned long long* d = (GAS unsigned long long*)(dst + (size_t)row * 1536 + 24 * lane);
        d[0] = (unsigned long long)p[0] | ((unsigned long long)p[1] << 32); d[1] = (unsigned long long)p[2] | ((unsigned long long)p[3] << 32); d[2] = (unsigned long long)p[4] | ((unsigned long long)p[5] << 32); }
}
__device__ __forceinline__ v32f_t ld_fp6x32(const unsigned char* p) { const GAS unsigned long long* q = (const GAS unsigned long long*)p; const unsigned long long w0 = q[0], w1 = q[1], w2 = q[2];
    const v6u_t v = {(unsigned)w0, (unsigned)(w0 >> 32), (unsigned)w1, (unsigned)(w1 >> 32), (unsigned)w2, (unsigned)(w2 >> 32)}; return __builtin_amdgcn_cvt_scalef32_pk32_f32_fp6(v, 1.0f); }

struct Args { const float* in[30]; float* out; unsigned char* ws; int ph_lo, ph_hi, li, pad; };

__global__ void __launch_bounds__(NWAVES * 64, 2) mk_fwd(Args args) {
    extern __shared__ __attribute__((aligned(16))) unsigned char lds[];
    for (int u = threadIdx.x; u < (LDS_BYTES - LDSCTL_OFF) / 4; u += NWAVES * 64) ((LAS unsigned*)((LAS unsigned char*)lds + LDSCTL_OFF))[u] = 0u;
    __syncthreads();
    XcdBarrier bar; bar.bar = (unsigned*)(args.ws + WS_CTL) + CW_BAR; bar.x = 0; bar.st = nullptr;
    if (MK_ONE_LAUNCH) bar = xcd_barrier_post((unsigned*)(args.ws + WS_CTL) + CW_BAR, (volatile LAS unsigned*)((LAS unsigned char*)lds + MISC_OFF) + 8);
    const int lo = args.ph_lo, hi = args.ph_hi;
#ifdef DIAG_TIME
    if (blockIdx.x == 0 && threadIdx.x == 0) { const unsigned long long t0_ = __builtin_amdgcn_s_memrealtime(); ((unsigned long long*)(args.ws + WS_CTL))[8] = t0_; }
#endif
#ifndef PHMASK
#define PHMASK 0xffffffffu
#endif
#define IN(k) (((PHMASK >> (k)) & 1u) && lo <= (k) && (k) < hi)
#define SEAM(k) do { if (IN(k) && IN((k) + 1)) xcd_barrier(bar); } while (0)
#define LOCALS const int tid = threadIdx.x, lane = tid & 63, wave = __builtin_amdgcn_readfirstlane(tid >> 6); const int G_ = gridDim.x, bx_ = blockIdx.x, vcu = (G_ % 8 == 0) ? (bx_ % 8) * (G_ / 8) + bx_ / 8 : bx_; \
    const int gw = vcu * NWAVES + wave, NGW = G_ * NWAVES; const size_t gt = (size_t)vcu * 512 + tid, NGT = (size_t)G_ * 512; (void)lane; (void)gw; (void)NGW; (void)gt; (void)NGT;
#define LDSP ((LAS unsigned char*)lds)
#define x_in (args.in[0])
#define p_in (args.in[1])
#define w_in (args.in[2])
#define mu (args.in[3])
#define w0 (args.in[4])
#define wl1 (args.in[5])
#define wl2 (args.in[6])
#define a0 (args.in[7])
#define al1 (args.in[8])
#define al2 (args.in[9])
#define gl1 (args.in[10])
#define gl2 (args.in[11])
#define k_k (args.in[12])
#define k_a (args.in[13])
#define r_k (args.in[14])
#define lnx_w (args.in[15])
#define lnx_b (args.in[16])
#define w_up_a (args.in[17])
#define w_up_b (args.in[18])
#define w_o (args.in[19])
#define ln1_w (args.in[20])
#define ln1_b (args.in[21])
#define peer_wq (args.in[22])
#define sub_keys (args.in[23])
#define peer_u (args.in[24])
#define peer_v (args.in[25])
#define ple_wg (args.in[26])
#define ple_wp (args.in[27])
#define ln2_w (args.in[28])
#define ln2_b (args.in[29])
#define WIN_T ((bf16*)(args.ws + WS_WIN))
#define WUA_T ((bf16*)(args.ws + WS_WUA))
#define WUB_T ((bf16*)(args.ws + WS_WUB))
#define WO_T ((bf16*)(args.ws + WS_WO))
#define WQ_T ((bf16*)(args.ws + WS_WQ))
#define WPG_T ((bf16*)(args.ws + WS_WPG))
#define WPE_T ((bf16*)(args.ws + WS_WPE))
#define L1_T ((bf16*)(args.ws + WS_L1))
#define L2_T ((bf16*)(args.ws + WS_L2))
#define PB ((bf16*)(args.ws + WS_PB))
#define XB ((bf16*)(args.ws + WS_XB))
#define QB ((bf16*)(args.ws + WS_Q))
#define KB ((bf16*)(args.ws + WS_K))
#define VB ((bf16*)(args.ws + WS_V))
#define RR ((bf16*)(args.ws + WS_RR))
#define RK ((bf16*)(args.ws + WS_RK))
#define RV ((bf16*)(args.ws + WS_RV))
#define RC ((bf16*)(args.ws + WS_RC))
#define YA ((bf16*)(args.ws + WS_YA))
#define YB ((bf16*)(args.ws + WS_YB))
#define YRAW ((float*)(args.ws + WS_YRAW))
#define QC ((bf16*)(args.ws + WS_QC))
#define GTC ((bf16*)(args.ws + WS_GTC))
#define YLC ((bf16*)(args.ws + WS_YLC))
#define TTC ((bf16*)(args.ws + WS_TTC))
#define SBF ((bf16*)(args.ws + WS_SB))
#define MIX8 ((unsigned char*)(args.ws + WS_MIX8))
#define X1B8 ((unsigned char*)(args.ws + WS_X1B8))
#define UB ((unsigned char*)(args.ws + WS_UB))
#define VB2 ((unsigned char*)(args.ws + WS_VB))
#define GG ((bf16*)(args.ws + WS_GG))
#define HID ((bf16*)(args.ws + WS_HID))
#define XW ((bf16*)(args.ws + WS_XW))
#define LW ((float*)(args.ws + WS_LW))
#define AA ((bf16*)(args.ws + WS_AA))
#define GATE ((bf16*)(args.ws + WS_GATE))
#define MIX ((bf16*)(args.ws + WS_MIX))
#define PQ ((bf16*)(args.ws + WS_PQ))
#define H1 ((float*)(args.ws + WS_H1))
#define X1 ((float*)(args.ws + WS_X1))
#define X1B ((bf16*)(args.ws + WS_X1B))
#define PE ((bf16*)(args.ws + WS_PE))
#define IDX ((int*)(args.ws + WS_IDX))
#define PG ((float*)(args.ws + WS_PG))
#define RKC ((float*)(args.ws + WS_RKC))
    if (IN(0)) {
        LOCALS
        LAS float* scr = (LAS float*)(LDSP + RING_OFF + wave * 16384);
        constexpr int I_IN = (D / 64) * (NIN / 32), I_UA = (1024 / 64) * (D / 32), I_SQ = (D / 64) * (D / 32), I_PE = (256 / 64) * (D / 32);
        for (int it = gw; it < I_IN; it += NGW) p0_transpose_item8(w_in, D, NIN, (unsigned char*)WIN_T, 32.0f, scr, it, lane);
        for (size_t i = gt; i < (size_t)2 * 294912; i += NGT) {
            if (i < 294912) { const int j = (int)(i & 7), ln = (int)(i >> 3) & 63, ks = (int)(i >> 9) & 63, m = (int)(i >> 15); const int row = m * 32 + (ln & 31), col = ks * 16 + 8 * (ln >> 5) + j;
                const float v = row < 64 ? wl1[(size_t)col * 64 + row] : (row < 128 ? al1[(size_t)col * 64 + (row - 64)] : gl1[(size_t)col * 160 + (row - 128)]);
                L1_T[i] = (bf16)f2bf(v); }
            else { const int e = (int)(i - 294912); float v;
                if (e < 131072) { const int e2 = e & 65535, jj = e2 & 7, ln = (e2 >> 3) & 63, sx = (e2 >> 9) & 3, ct = e2 >> 11; const int c = ct * 32 + (ln & 31), jh = 16 * sx + 8 * (jj >> 2) + 4 * (ln >> 5) + (jj & 3);
                    v = (e < 65536 ? wl2 : al2)[(size_t)jh * 1024 + c]; }
                else { const int e2 = e - 131072, jj = e2 & 7, ln = (e2 >> 3) & 63, rest = e2 >> 9, sx = rest % 10, ct = rest / 10; const int c = ct * 32 + (ln & 31), jh = 16 * sx + 8 * (jj >> 2) + 4 * (ln >> 5) + (jj & 3);
                    v = gl2[(size_t)jh * 1024 + c]; }
                L2_T[e] = (bf16)f2bf(v); }
        }
        cvt_rows_fp8(x_in, (unsigned char*)XB, (size_t)T * D / 16, 1.0f, gt, NGT);
    }
    SEAM(0);
    if (IN(1)) {
        LOCALS
        REP_BEGIN(1)
        pg8::Gemm g{XB, WIN_T, T, 7168, D / 2}; pg8::StaticOrder S; S.init(T, 7168, (int)gridDim.x, (int)blockIdx.x);
        pg8::EpiB16<pg8::FnProj> E{{QB}};
        pg8::gemm_phase<pg8::EpiB16<pg8::FnProj>, pg8::StaticOrder, PG8_ALIGN, PG8_SP2, 122>(LDSP + RING_OFF, g, S, E);
        REP_END(1)
    }
    SEAM(1);
    if (IN(2)) {
        LOCALS
        REP_BEGIN(2)
#ifdef P2_SPLIT
        { volatile LAS unsigned* lb = (volatile LAS unsigned*)(LDSP + RING_OFF + 130048);
          if (tid == 0) *lb = 0u;
          __syncthreads();
#define LB4() { asm volatile("s_waitcnt lgkmcnt(0)" ::: "memory"); lbe += 4u; if (lane == 0) __hip_atomic_fetch_add((LAS unsigned*)(LDSP + RING_OFF + 130048), 1u, __ATOMIC_RELAXED, __HIP_MEMORY_SCOPE_WORKGROUP); while ((unsigned)__builtin_amdgcn_readfirstlane((int)*lb) < lbe) __builtin_amdgcn_s_sleep(0); asm volatile("" ::: "memory"); }
          if (wave >= 4) {
        {
            typedef unsigned long long u64;
            LAS unsigned char* hl = LDSP + RING_OFF + 73728;
            LAS unsigned char* cst = LDSP + RING_OFF;
            const int w4 = wave & 3, n = lane & 31, h = lane >> 5; unsigned lbe = 0u;
            const int m0 = w4 == 0 ? 0 : (w4 == 1 ? 2 : (w4 == 2 ? 4 : 7)), cnt = w4 == 2 ? 3 : 2, xsel = w4 < 2 ? w4 : 2;
            for (int pair = (int)blockIdx.x; pair < T / 64; pair += (int)gridDim.x) {
                const int tb = 64 * pair;
                f32x16 Ca[3], Cb[3];
#pragma unroll
                for (int m = 0; m < 3; ++m)
#pragma unroll
                    for (int i = 0; i < 16; ++i) { Ca[m][i] = 0.f; Cb[m][i] = 0.f; }
#pragma unroll 1
                for (int kh = 0; kh < 2; ++kh) {
                    for (int i = tid - 256; i < 65 * 64; i += 256) { const int row = i >> 6, c16 = i & 63; const int tr = tb - 1 + row;
                        const v4u v = tr >= 0 ? *(const GAS v4u*)(RC + (size_t)tr * 1024 + kh * 512 + c16 * 8) : (v4u){0u, 0u, 0u, 0u};
                        *(LAS v4u*)(cst + row * 1040 + c16 * 16) = v; }
                    LB4()
#pragma unroll 2
                    for (int k2 = 0; k2 < 32; ++k2) {
                        const int ks = kh * 32 + k2, k0 = ks * 16 + 8 * h, kl = k2 * 16 + 8 * h;
                        const GAS f32x4* mm = (const GAS f32x4*)(mu + (3 + xsel) * 1024 + k0); const f32x4 ma = mm[0], mb = mm[1];
                        const float mv[8] = {ma.x, ma.y, ma.z, ma.w, mb.x, mb.y, mb.z, mb.w};
                        const GAS bf16x8* af = (const GAS bf16x8*)(L1_T + ((size_t)m0 * 64 + ks) * 512) + lane;
                        const bf16x8 f0 = af[0], f1 = af[64 * 64], f2 = cnt == 3 ? af[2 * 64 * 64] : f0;
#pragma unroll
                        for (int tl = 0; tl < 2; ++tl) {
                            const v4u cv = *(const LAS v4u*)(cst + (32 * tl + n + 1) * 1040 + kl * 2), pv = *(const LAS v4u*)(cst + (32 * tl + n) * 1040 + kl * 2);
                            const float c[8] = {bflo(cv.x), bfhi(cv.x), bflo(cv.y), bfhi(cv.y), bflo(cv.z), bfhi(cv.z), bflo(cv.w), bfhi(cv.w)};
                            const float p[8] = {bflo(pv.x), bfhi(pv.x), bflo(pv.y), bfhi(pv.y), bflo(pv.z), bfhi(pv.z), bflo(pv.w), bfhi(pv.w)};
                            float o[8];
#pragma unroll
                            for (int j = 0; j < 8; ++j) o[j] = c[j] + (p[j] - c[j]) * mv[j];
                            v4u xw_; xw_.x = pk2(o[0], o[1]); xw_.y = pk2(o[2], o[3]); xw_.z = pk2(o[4], o[5]); xw_.w = pk2(o[6], o[7]); const bf16x8 xf = __builtin_bit_cast(bf16x8, xw_);
                            if (tl == 0) { Ca[0] = __builtin_amdgcn_mfma_f32_32x32x16_bf16(f0, xf, Ca[0], 0, 0, 0); Ca[1] = __builtin_amdgcn_mfma_f32_32x32x16_bf16(f1, xf, Ca[1], 0, 0, 0); if (cnt == 3) Ca[2] = __builtin_amdgcn_mfma_f32_32x32x16_bf16(f2, xf, Ca[2], 0, 0, 0); }
                            else { Cb[0] = __builtin_amdgcn_mfma_f32_32x32x16_bf16(f0, xf, Cb[0], 0, 0, 0); Cb[1] = __builtin_amdgcn_mfma_f32_32x32x16_bf16(f1, xf, Cb[1], 0, 0, 0); if (cnt == 3) Cb[2] = __builtin_amdgcn_mfma_f32_32x32x16_bf16(f2, xf, Cb[2], 0, 0, 0); }
                        }
                    }
                    LB4()
                }
#define LX_ACT(C, tl_) { _Pragma("unroll") for (int m = 0; m < 3; ++m) if (m < cnt) { \
                    _Pragma("unroll") for (int s2 = 0; s2 < 2; ++s2) { float v[8]; \
                        _Pragma("unroll") for (int j = 0; j < 8; ++j) { const float x = C[m][8 * s2 + j]; v[j] = w4 == 0 ? pg8::ftanh(x) : (w4 == 1 ? x : pg8::fsigmoid(x)); } \
                        v4u w; w.x = pk2(v[0], v[1]); w.y = pk2(v[2], v[3]); w.z = pk2(v[4], v[5]); w.w = pk2(v[6], v[7]); \
                        *(LAS v4u*)(hl + (((tl_) * 18 + 2 * (m0 + m) + s2) * 64 + lane) * 16) = w; } } }
                LX_ACT(Ca, 0) LX_ACT(Cb, 1)
#undef LX_ACT
                LB4()
#pragma unroll 1
                for (int c4 = 0; c4 < 8; ++c4) {
                    const int ct = w4 * 8 + c4;
                    const GAS bf16x8* fw = (const GAS bf16x8*)(L2_T + (size_t)ct * 4 * 512) + lane; const GAS bf16x8* fa = (const GAS bf16x8*)(L2_T + 65536 + (size_t)ct * 4 * 512) + lane;
                    const GAS bf16x8* fg = (const GAS bf16x8*)(L2_T + 131072 + (size_t)ct * 10 * 512) + lane;
                    bf16x8 wfr[18];
#pragma unroll
                    for (int s2 = 0; s2 < 4; ++s2) { wfr[s2] = fw[64 * s2]; wfr[4 + s2] = fa[64 * s2]; }
#pragma unroll
                    for (int s2 = 0; s2 < 10; ++s2) wfr[8 + s2] = fg[64 * s2];
#pragma unroll 1
                    for (int tl = 0; tl < 2; ++tl) {
                        const int tt_ = (2 * pair + tl) * 32 + n;
                        f32x16 Yw, Ya, Yg;
#pragma unroll
                        for (int i = 0; i < 16; ++i) { Yw[i] = 0.f; Ya[i] = 0.f; Yg[i] = 0.f; }
#pragma unroll
                        for (int s2 = 0; s2 < 4; ++s2) { Yw = __builtin_amdgcn_mfma_f32_32x32x16_bf16(wfr[s2], *(const LAS bf16x8*)(hl + ((tl * 18 + s2) * 64 + lane) * 16), Yw, 0, 0, 0);
                            Ya = __builtin_amdgcn_mfma_f32_32x32x16_bf16(wfr[4 + s2], *(const LAS bf16x8*)(hl + ((tl * 18 + 4 + s2) * 64 + lane) * 16), Ya, 0, 0, 0); }
#pragma unroll
                        for (int s2 = 0; s2 < 10; ++s2) Yg = __builtin_amdgcn_mfma_f32_32x32x16_bf16(wfr[8 + s2], *(const LAS bf16x8*)(hl + ((tl * 18 + 8 + s2) * 64 + lane) * 16), Yg, 0, 0, 0);
#pragma unroll
                        for (int q = 0; q < 4; ++q) { const int c0 = ct * 32 + 8 * q + 4 * h;
                            const f32x4 wb = *(const GAS f32x4*)(w0 + c0), ab = *(const GAS f32x4*)(a0 + c0); f32x4 lwv; float av[4], gv[4];
#pragma unroll
                            for (int j = 0; j < 4; ++j) { lwv[j] = -__expf(-pg8::fsoftplus(-(wb[j] + Yw[4 * q + j])) - 0.5f); av[j] = pg8::fsigmoid(ab[j] + Ya[4 * q + j]); gv[j] = Yg[4 * q + j]; }
                            *(GAS f32x4*)(LW + (size_t)tt_ * 1024 + c0) = lwv;
                            *(GAS u64*)(AA + (size_t)tt_ * 1024 + c0) = (u64)pk2(av[0], av[1]) | ((u64)pk2(av[2], av[3]) << 32);
                            { int w8_ = 0; w8_ = __builtin_amdgcn_cvt_pk_fp8_f32(gv[0], gv[1], w8_, false); w8_ = __builtin_amdgcn_cvt_pk_fp8_f32(gv[2], gv[3], w8_, true); *(GAS unsigned*)((unsigned char*)GG + (size_t)tt_ * 1024 + c0) = (unsigned)w8_; } }
                    }
                }
                LB4()
            }
        }
          } else {
        {
            LAS unsigned char* vl = LDSP + RING_OFF + 110592 + wave * 4608;
            const int n = lane & 31, h = lane >> 5, i16 = lane & 15, dcol = 16 * ((lane >> 4) & 1);
            for (int task = vcu * 4 + wave; task < 16 * (T / 32); task += NGW / 2) {
                const int head = task & 15, q0 = (task >> 4) * 32;
                bf16x8 qf[4];
#pragma unroll
                for (int ks = 0; ks < 4; ++ks) qf[ks] = *(const GAS bf16x8*)(QB + (size_t)(q0 + n) * 1024 + head * 64 + 16 * ks + 8 * h);
                f32x16 O0, O1;
#pragma unroll
                for (int i = 0; i < 16; ++i) { O0[i] = 0.f; O1[i] = 0.f; }
                float carry = 1.f;
                bf16x8 kf[4]; v4u vv[4];
#pragma unroll
                for (int ks = 0; ks < 4; ++ks) kf[ks] = *(const GAS bf16x8*)(KB + (size_t)(q0 + n) * 1024 + head * 64 + 16 * ks + 8 * h);
#pragma unroll
                for (int i = 0; i < 4; ++i) vv[i] = *(const GAS v4u*)(VB + (size_t)(q0 + n) * 1024 + head * 64 + 32 * h + 8 * i);
                { const int kt = q0;
                    f32x16 S;
#pragma unroll
                    for (int i = 0; i < 16; ++i) S[i] = 0.f;
#pragma unroll
                    for (int ks = 0; ks < 4; ++ks) S = __builtin_amdgcn_mfma_f32_32x32x16_bf16(kf[ks], qf[ks], S, 0, 0, 0);
#pragma unroll
                    for (int i = 0; i < 4; ++i) *(LAS v4u*)(vl + n * RW_PIT + (32 * h + 8 * i) * 2) = vv[i];
                    { const int ktn = kt >= 32 ? kt - 32 : 0;
#pragma unroll
                      for (int ks = 0; ks < 4; ++ks) kf[ks] = *(const GAS bf16x8*)(KB + (size_t)(ktn + n) * 1024 + head * 64 + 16 * ks + 8 * h);
#pragma unroll
                      for (int i = 0; i < 4; ++i) vv[i] = *(const GAS v4u*)(VB + (size_t)(ktn + n) * 1024 + head * 64 + 32 * h + 8 * i); }
                    float kp[16], ev[16], G[4], Gp[4];
#pragma unroll
                    for (int i = 0; i < 16; ++i) { const float z = fminf(S[i], 115.f); const bool valid = (kt + (i & 3) + 8 * (i >> 2) + 4 * h) < (q0 + n); const float e = __builtin_amdgcn_exp2f(z); const float k = __builtin_amdgcn_rcpf(1.0f + e); kp[i] = valid ? k : 1.f; ev[i] = valid ? e : 0.f; }
#pragma unroll
                    for (int q = 0; q < 4; ++q) { kp[4 * q + 2] *= kp[4 * q + 3]; kp[4 * q + 1] *= kp[4 * q + 2]; kp[4 * q] *= kp[4 * q + 1]; G[q] = kp[4 * q]; }
#pragma unroll
                    for (int q = 0; q < 4; ++q) Gp[q] = __shfl_xor(G[q], 32);
                    float off[4]; float later = 1.f;
#pragma unroll
                    for (int q = 3; q >= 0; --q) { off[q] = later * (h == 0 ? Gp[q] : 1.f); later *= G[q] * Gp[q]; }
                    bf16x8 wf[2];
                    { float w[16];
#pragma unroll
                      for (int i = 0; i < 16; ++i) w[i] = ev[i] * kp[i] * (off[i >> 2] * carry);
#pragma unroll
                      for (int s2 = 0; s2 < 2; ++s2) { v4u pw; pw.x = pk2(w[8 * s2], w[8 * s2 + 1]); pw.y = pk2(w[8 * s2 + 2], w[8 * s2 + 3]); pw.z = pk2(w[8 * s2 + 4], w[8 * s2 + 5]); pw.w = pk2(w[8 * s2 + 6], w[8 * s2 + 7]); wf[s2] = __builtin_bit_cast(bf16x8, pw); } }
                    carry *= later;
#pragma unroll
                    for (int s2 = 0; s2 < 2; ++s2) {
#pragma unroll
                        for (int m2 = 0; m2 < 2; ++m2) { const LAS unsigned char* ap = vl + (16 * s2 + 4 * h + (i16 >> 2)) * RW_PIT + (32 * m2 + dcol + 4 * (i16 & 3)) * 2;
                            const v4i16_t lo = __builtin_amdgcn_ds_read_tr16_b64_v4i16((LAS v4i16_t*)ap), hi = __builtin_amdgcn_ds_read_tr16_b64_v4i16((LAS v4i16_t*)(ap + 8 * RW_PIT));
                            const bf16x8 af = __builtin_shufflevector(lo, hi, 0, 1, 2, 3, 4, 5, 6, 7);
                            if (m2 == 0) O0 = __builtin_amdgcn_mfma_f32_32x32x16_bf16(af, wf[s2], O0, 0, 0, 0); else O1 = __builtin_amdgcn_mfma_f32_32x32x16_bf16(af, wf[s2], O1, 0, 0, 0); } }
                }
                if (!__all(carry < 1.0e-44f))
                for (int kt = q0 - 32; kt >= 0; kt -= 32) {
                    f32x16 S;
#pragma unroll
                    for (int i = 0; i < 16; ++i) S[i] = 0.f;
#pragma unroll
                    for (int ks = 0; ks < 4; ++ks) S = __builtin_amdgcn_mfma_f32_32x32x16_bf16(kf[ks], qf[ks], S, 0, 0, 0);
#pragma unroll
                    for (int i = 0; i < 4; ++i) *(LAS v4u*)(vl + n * RW_PIT + (32 * h + 8 * i) * 2) = vv[i];
                    { const int ktn = kt >= 32 ? kt - 32 : 0;
#pragma unroll
                      for (int ks = 0; ks < 4; ++ks) kf[ks] = *(const GAS bf16x8*)(KB + (size_t)(ktn + n) * 1024 + head * 64 + 16 * ks + 8 * h);
#pragma unroll
                      for (int i = 0; i < 4; ++i) vv[i] = *(const GAS v4u*)(VB + (size_t)(ktn + n) * 1024 + head * 64 + 32 * h + 8 * i); }
                    float kp[16], ev[16], G[4], Gp[4];
#pragma unroll
                    for (int i = 0; i < 16; ++i) { const float z = fminf(S[i], 115.f); const bool valid = true; const float e = __builtin_amdgcn_exp2f(z); const float k = __builtin_amdgcn_rcpf(1.0f + e); kp[i] = valid ? k : 1.f; ev[i] = valid ? e : 0.f; }
#pragma unroll
                    for (int q = 0; q < 4; ++q) { kp[4 * q + 2] *= kp[4 * q + 3]; kp[4 * q + 1] *= kp[4 * q + 2]; kp[4 * q] *= kp[4 * q + 1]; G[q] = kp[4 * q]; }
#pragma unroll
                    for (int q = 0; q < 4; ++q) Gp[q] = __shfl_xor(G[q], 32);
                    float off[4]; float later = 1.f;
#pragma unroll
                    for (int q = 3; q >= 0; --q) { off[q] = later * (h == 0 ? Gp[q] : 1.f); later *= G[q] * Gp[q]; }
                    bf16x8 wf[2];
                    { float w[16];
#pragma unroll
                      for (int i = 0; i < 16; ++i) w[i] = ev[i] * kp[i] * (off[i >> 2] * carry);
#pragma unroll
                      for (int s2 = 0; s2 < 2; ++s2) { v4u pw; pw.x = pk2(w[8 * s2], w[8 * s2 + 1]); pw.y = pk2(w[8 * s2 + 2], w[8 * s2 + 3]); pw.z = pk2(w[8 * s2 + 4], w[8 * s2 + 5]); pw.w = pk2(w[8 * s2 + 6], w[8 * s2 + 7]); wf[s2] = __builtin_bit_cast(bf16x8, pw); } }
                    carry *= later;
#pragma unroll
                    for (int s2 = 0; s2 < 2; ++s2) {
#pragma unroll
                        for (int m2 = 0; m2 < 2; ++m2) { const LAS unsigned char* ap = vl + (16 * s2 + 4 * h + (i16 >> 2)) * RW_PIT + (32 * m2 + dcol + 4 * (i16 & 3)) * 2;
                            const v4i16_t lo = __builtin_amdgcn_ds_read_tr16_b64_v4i16((LAS v4i16_t*)ap), hi = __builtin_amdgcn_ds_read_tr16_b64_v4i16((LAS v4i16_t*)(ap + 8 * RW_PIT));
                            const bf16x8 af = __builtin_shufflevector(lo, hi, 0, 1, 2, 3, 4, 5, 6, 7);
                            if (m2 == 0) O0 = __builtin_amdgcn_mfma_f32_32x32x16_bf16(af, wf[s2], O0, 0, 0, 0); else O1 = __builtin_amdgcn_mfma_f32_32x32x16_bf16(af, wf[s2], O1, 0, 0, 0); } }
                    if (__all(carry < 1.0e-44f)) break;
                }
#pragma unroll
                for (int q = 0; q < 4; ++q) {
                    *(GAS unsigned*)((unsigned char*)YA + (size_t)(q0 + n) * 1024 + head * 64 + 8 * q + 4 * h) = ({ int w8_ = 0; w8_ = __builtin_amdgcn_cvt_pk_fp8_f32(O0[4 * q], O0[4 * q + 1], w8_, false); w8_ = __builtin_amdgcn_cvt_pk_fp8_f32(O0[4 * q + 2], O0[4 * q + 3], w8_, true); (unsigned)w8_; });
                    *(GAS unsigned*)((unsigned char*)YA + (size_t)(q0 + n) * 1024 + head * 64 + 32 + 8 * q + 4 * h) = ({ int w8_ = 0; w8_ = __builtin_amdgcn_cvt_pk_fp8_f32(O1[4 * q], O1[4 * q + 1], w8_, false); w8_ = __builtin_amdgcn_cvt_pk_fp8_f32(O1[4 * q + 2], O1[4 * q + 3], w8_, true); (unsigned)w8_; }); }
            }
        }
          }
#undef LB4
        }
#else
#ifndef SKIP_LORA
        for (int rl_ = 0; rl_ < (REPEAT_SUB == 1 ? 2 : 1); ++rl_) {
        {
            typedef unsigned long long u64;
            LAS unsigned char* hl = LDSP + RING_OFF + 73728;
            LAS unsigned char* cst = LDSP + RING_OFF;
            const int w4 = wave & 3, half = wave >> 2, n = lane & 31, h = lane >> 5;
            const int m0 = w4 == 0 ? 0 : (w4 == 1 ? 2 : (w4 == 2 ? 4 : 7)), cnt = w4 == 2 ? 3 : 2, xsel = w4 < 2 ? w4 : 2;
            for (int pair = (int)blockIdx.x; pair < T / 64; pair += (int)gridDim.x) {
                const int tb = 64 * pair;
                f32x16 Ca[3], Cb[3];
#pragma unroll
                for (int m = 0; m < 3; ++m)
#pragma unroll
                    for (int i = 0; i < 16; ++i) { Ca[m][i] = 0.f; Cb[m][i] = 0.f; }
#pragma unroll 1
                for (int kh = 0; kh < 2; ++kh) {
                    for (int i = tid; i < 65 * 64; i += 512) { const int row = i >> 6, c16 = i & 63; const int tr = tb - 1 + row;
                        const v4u v = tr >= 0 ? *(const GAS v4u*)(RC + (size_t)tr * 1024 + kh * 512 + c16 * 8) : (v4u){0u, 0u, 0u, 0u};
                        *(LAS v4u*)(cst + row * 1040 + c16 * 16) = v; }
                    __syncthreads();
#pragma unroll 2
                    for (int k2 = 16 * half; k2 < 16 * half + 16; ++k2) {
                        const int ks = kh * 32 + k2, k0 = ks * 16 + 8 * h, kl = k2 * 16 + 8 * h;
                        const GAS f32x4* mm = (const GAS f32x4*)(mu + (3 + xsel) * 1024 + k0); const f32x4 ma = mm[0], mb = mm[1];
                        const float mv[8] = {ma.x, ma.y, ma.z, ma.w, mb.x, mb.y, mb.z, mb.w};
                        const GAS bf16x8* af = (const GAS bf16x8*)(L1_T + ((size_t)m0 * 64 + ks) * 512) + lane;
                        const bf16x8 f0 = af[0], f1 = af[64 * 64], f2 = cnt == 3 ? af[2 * 64 * 64] : f0;
#pragma unroll
                        for (int tl = 0; tl < 2; ++tl) {
                            const v4u cv = *(const LAS v4u*)(cst + (32 * tl + n + 1) * 1040 + kl * 2), pv = *(const LAS v4u*)(cst + (32 * tl + n) * 1040 + kl * 2);
                            const float c[8] = {bflo(cv.x), bfhi(cv.x), bflo(cv.y), bfhi(cv.y), bflo(cv.z), bfhi(cv.z), bflo(cv.w), bfhi(cv.w)};
                            const float p[8] = {bflo(pv.x), bfhi(pv.x), bflo(pv.y), bfhi(pv.y), bflo(pv.z), bfhi(pv.z), bflo(pv.w), bfhi(pv.w)};
                            float o[8];
#pragma unroll
                            for (int j = 0; j < 8; ++j) o[j] = c[j] + (p[j] - c[j]) * mv[j];
                            v4u xw_; xw_.x = pk2(o[0], o[1]); xw_.y = pk2(o[2], o[3]); xw_.z = pk2(o[4], o[5]); xw_.w = pk2(o[6], o[7]); const bf16x8 xf = __builtin_bit_cast(bf16x8, xw_);
                            if (tl == 0) { Ca[0] = __builtin_amdgcn_mfma_f32_32x32x16_bf16(f0, xf, Ca[0], 0, 0, 0); Ca[1] = __builtin_amdgcn_mfma_f32_32x32x16_bf16(f1, xf, Ca[1], 0, 0, 0); if (cnt == 3) Ca[2] = __builtin_amdgcn_mfma_f32_32x32x16_bf16(f2, xf, Ca[2], 0, 0, 0); }
                            else { Cb[0] = __builtin_amdgcn_mfma_f32_32x32x16_bf16(f0, xf, Cb[0], 0, 0, 0); Cb[1] = __builtin_amdgcn_mfma_f32_32x32x16_bf16(f1, xf, Cb[1], 0, 0, 0); if (cnt == 3) Cb[2] = __builtin_amdgcn_mfma_f32_32x32x16_bf16(f2, xf, Cb[2], 0, 0, 0); }
                        }
                    }
                    __syncthreads();
                }
                { LAS unsigned char* px = LDSP + RING_OFF;
#define LX_EXPORT(C) { _Pragma("unroll") for (int m = 0; m < 3; ++m) if (m < cnt) { _Pragma("unroll") for (int q = 0; q < 4; ++q) *(LAS f32x4*)(px + ((((half * 9 + m0 + m) * 4 + q) * 64 + lane) * 16)) = (f32x4){C[m][4 * q], C[m][4 * q + 1], C[m][4 * q + 2], C[m][4 * q + 3]}; } }
#define LX_FINISH(C) { _Pragma("unroll") for (int m = 0; m < 3; ++m) if (m < cnt) { _Pragma("unroll") for (int q = 0; q < 4; ++q) { const f32x4 v_ = *(const LAS f32x4*)(px + (((((1 - half) * 9 + m0 + m) * 4 + q) * 64 + lane) * 16)); C[m][4 * q] += v_[0]; C[m][4 * q + 1] += v_[1]; C[m][4 * q + 2] += v_[2]; C[m][4 * q + 3] += v_[3]; } \
                    _Pragma("unroll") for (int s2 = 0; s2 < 2; ++s2) { float v[8]; \
                        _Pragma("unroll") for (int j = 0; j < 8; ++j) { const float x = C[m][8 * s2 + j]; v[j] = w4 == 0 ? pg8::ftanh(x) : (w4 == 1 ? x : pg8::fsigmoid(x)); } \
                        v4u w; w.x = pk2(v[0], v[1]); w.y = pk2(v[2], v[3]); w.z = pk2(v[4], v[5]); w.w = pk2(v[6], v[7]); \
                        *(LAS v4u*)(hl + ((half * 18 + 2 * (m0 + m) + s2) * 64 + lane) * 16) = w; } } }
                  if (half == 0) LX_EXPORT(Cb) else LX_EXPORT(Ca)
                  __syncthreads();
                  if (half == 0) LX_FINISH(Ca) else LX_FINISH(Cb)
#undef LX_EXPORT
#undef LX_FINISH
                }
                __syncthreads();
#pragma unroll 1
                for (int c4 = 0; c4 < 4; ++c4) {
                    const int ct = w4 * 8 + 4 * half + c4;
                    const GAS bf16x8* fw = (const GAS bf16x8*)(L2_T + (size_t)ct * 4 * 512) + lane; const GAS bf16x8* fa = (const GAS bf16x8*)(L2_T + 65536 + (size_t)ct * 4 * 512) + lane;
                    const GAS bf16x8* fg = (const GAS bf16x8*)(L2_T + 131072 + (size_t)ct * 10 * 512) + lane;
                    bf16x8 wfr[18];
#pragma unroll
                    for (int s2 = 0; s2 < 4; ++s2) { wfr[s2] = fw[64 * s2]; wfr[4 + s2] = fa[64 * s2]; }
#pragma unroll
                    for (int s2 = 0; s2 < 10; ++s2) wfr[8 + s2] = fg[64 * s2];
#pragma unroll 1
                    for (int tl = 0; tl < 2; ++tl) {
                        const int tt_ = (2 * pair + tl) * 32 + n;
                        f32x16 Yw, Ya, Yg;
#pragma unroll
                        for (int i = 0; i < 16; ++i) { Yw[i] = 0.f; Ya[i] = 0.f; Yg[i] = 0.f; }
#pragma unroll
                        for (int s2 = 0; s2 < 4; ++s2) { Yw = __builtin_amdgcn_mfma_f32_32x32x16_bf16(wfr[s2], *(const LAS bf16x8*)(hl + ((tl * 18 + s2) * 64 + lane) * 16), Yw, 0, 0, 0);
                            Ya = __builtin_amdgcn_mfma_f32_32x32x16_bf16(wfr[4 + s2], *(const LAS bf16x8*)(hl + ((tl * 18 + 4 + s2) * 64 + lane) * 16), Ya, 0, 0, 0); }
#pragma unroll
                        for (int s2 = 0; s2 < 10; ++s2) Yg = __builtin_amdgcn_mfma_f32_32x32x16_bf16(wfr[8 + s2], *(const LAS bf16x8*)(hl + ((tl * 18 + 8 + s2) * 64 + lane) * 16), Yg, 0, 0, 0);
#pragma unroll
                        for (int q = 0; q < 4; ++q) { const int c0 = ct * 32 + 8 * q + 4 * h;
                            const f32x4 wb = *(const GAS f32x4*)(w0 + c0), ab = *(const GAS f32x4*)(a0 + c0); f32x4 lwv; float av[4], gv[4];
#pragma unroll
                            for (int j = 0; j < 4; ++j) { lwv[j] = -__expf(-pg8::fsoftplus(-(wb[j] + Yw[4 * q + j])) - 0.5f); av[j] = pg8::fsigmoid(ab[j] + Ya[4 * q + j]); gv[j] = Yg[4 * q + j]; }
                            *(GAS f32x4*)(LW + (size_t)tt_ * 1024 + c0) = lwv;
                            *(GAS u64*)(AA + (size_t)tt_ * 1024 + c0) = (u64)pk2(av[0], av[1]) | ((u64)pk2(av[2], av[3]) << 32);
                            { int w8_ = 0; w8_ = __builtin_amdgcn_cvt_pk_fp8_f32(gv[0], gv[1], w8_, false); w8_ = __builtin_amdgcn_cvt_pk_fp8_f32(gv[2], gv[3], w8_, true); *(GAS unsigned*)((unsigned char*)GG + (size_t)tt_ * 1024 + c0) = (unsigned)w8_; } }
                    }
                }
                __syncthreads();
            }
        }
        if (REPEAT_SUB == 1) __syncthreads(); }
#endif
#ifndef SKIP_ATTN
        for (int ra_ = 0; ra_ < (REPEAT_SUB == 2 ? 2 : 1); ++ra_) {
        {
            LAS unsigned char* vl = LDSP + RING_OFF + wave * 4608;
            const int n = lane & 31, h = lane >> 5, i16 = lane & 15, dcol = 16 * ((lane >> 4) & 1);
            for (int task = gw; task < 16 * (T / 32); task += NGW) {
                const int head = task & 15, q0 = (task >> 4) * 32;
                bf16x8 qf[4];
#pragma unroll
                for (int ks = 0; ks < 4; ++ks) qf[ks] = *(const GAS bf16x8*)(QB + (size_t)(q0 + n) * 1024 + head * 64 + 16 * ks + 8 * h);
                f32x16 O0, O1;
#pragma unroll
                for (int i = 0; i < 16; ++i) { O0[i] = 0.f; O1[i] = 0.f; }
                float carry = 1.f;
                bf16x8 kf[4]; v4u vv[4];
#pragma unroll
                for (int ks = 0; ks < 4; ++ks) kf[ks] = *(const GAS bf16x8*)(KB + (size_t)(q0 + n) * 1024 + head * 64 + 16 * ks + 8 * h);
#pragma unroll
                for (int i = 0; i < 4; ++i) vv[i] = *(const GAS v4u*)(VB + (size_t)(q0 + n) * 1024 + head * 64 + 32 * h + 8 * i);
                { const int kt = q0;
                    f32x16 S;
#pragma unroll
                    for (int i = 0; i < 16; ++i) S[i] = 0.f;
#pragma unroll
                    for (int ks = 0; ks < 4; ++ks) S = __builtin_amdgcn_mfma_f32_32x32x16_bf16(kf[ks], qf[ks], S, 0, 0, 0);
#pragma unroll
                    for (int i = 0; i < 4; ++i) *(LAS v4u*)(vl + n * RW_PIT + (32 * h + 8 * i) * 2) = vv[i];
                    { const int ktn = kt >= 32 ? kt - 32 : 0;
#pragma unroll
                      for (int ks = 0; ks < 4; ++ks) kf[ks] = *(const GAS bf16x8*)(KB + (size_t)(ktn + n) * 1024 + head * 64 + 16 * ks + 8 * h);
#pragma unroll
                      for (int i = 0; i < 4; ++i) vv[i] = *(const GAS v4u*)(VB + (size_t)(ktn + n) * 1024 + head * 64 + 32 * h + 8 * i); }
                    float kp[16], ev[16], G[4], Gp[4];
#pragma unroll
                    for (int i = 0; i < 16; ++i) { const float z = fminf(S[i], 115.f); const bool valid = (kt + (i & 3) + 8 * (i >> 2) + 4 * h) < (q0 + n); const float e = __builtin_amdgcn_exp2f(z); const float k = __builtin_amdgcn_rcpf(1.0f + e); kp[i] = valid ? k : 1.f; ev[i] = valid ? e : 0.f; }
#pragma unroll
                    for (int q = 0; q < 4; ++q) { kp[4 * q + 2] *= kp[4 * q + 3]; kp[4 * q + 1] *= kp[4 * q + 2]; kp[4 * q] *= kp[4 * q + 1]; G[q] = kp[4 * q]; }
#pragma unroll
                    for (int q = 0; q < 4; ++q) Gp[q] = __shfl_xor(G[q], 32);
                    float off[4]; float later = 1.f;
#pragma unroll
                    for (int q = 3; q >= 0; --q) { off[q] = later * (h == 0 ? Gp[q] : 1.f); later *= G[q] * Gp[q]; }
                    bf16x8 wf[2];
                    { float w[16];
#pragma unroll
                      for (int i = 0; i < 16; ++i) w[i] = ev[i] * kp[i] * (off[i >> 2] * carry);
#pragma unroll
                      for (int s2 = 0; s2 < 2; ++s2) { v4u pw; pw.x = pk2(w[8 * s2], w[8 * s2 + 1]); pw.y = pk2(w[8 * s2 + 2], w[8 * s2 + 3]); pw.z = pk2(w[8 * s2 + 4], w[8 * s2 + 5]); pw.w = pk2(w[8 * s2 + 6], w[8 * s2 + 7]); wf[s2] = __builtin_bit_cast(bf16x8, pw); } }
                    carry *= later;
#pragma unroll
                    for (int s2 = 0; s2 < 2; ++s2) {
#pragma unroll
                        for (int m2 = 0; m2 < 2; ++m2) { const LAS unsigned char* ap = vl + (16 * s2 + 4 * h + (i16 >> 2)) * RW_PIT + (32 * m2 + dcol + 4 * (i16 & 3)) * 2;
                            const v4i16_t lo = __builtin_amdgcn_ds_read_tr16_b64_v4i16((LAS v4i16_t*)ap), hi = __builtin_amdgcn_ds_read_tr16_b64_v4i16((LAS v4i16_t*)(ap + 8 * RW_PIT));
                            const bf16x8 af = __builtin_shufflevector(lo, hi, 0, 1, 2, 3, 4, 5, 6, 7);
                            if (m2 == 0) O0 = __builtin_amdgcn_mfma_f32_32x32x16_bf16(af, wf[s2], O0, 0, 0, 0); else O1 = __builtin_amdgcn_mfma_f32_32x32x16_bf16(af, wf[s2], O1, 0, 0, 0); } }
                }
                if (!__all(carry < 1.0e-44f))
                for (int kt = q0 - 32; kt >= 0; kt -= 32) {
                    f32x16 S;
#pragma unroll
                    for (int i = 0; i < 16; ++i) S[i] = 0.f;
#pragma unroll
                    for (int ks = 0; ks < 4; ++ks) S = __builtin_amdgcn_mfma_f32_32x32x16_bf16(kf[ks], qf[ks], S, 0, 0, 0);
#pragma unroll
                    for (int i = 0; i < 4; ++i) *(LAS v4u*)(vl + n * RW_PIT + (32 * h + 8 * i) * 2) = vv[i];
                    { const int ktn = kt >= 32 ? kt - 32 : 0;
#pragma unroll
                      for (int ks = 0; ks < 4; ++ks) kf[ks] = *(const GAS bf16x8*)(KB + (size_t)(ktn + n) * 1024 + head * 64 + 16 * ks + 8 * h);
#pragma unroll
                      for (int i = 0; i < 4; ++i) vv[i] = *(const GAS v4u*)(VB + (size_t)(ktn + n) * 1024 + head * 64 + 32 * h + 8 * i); }
                    float kp[16], ev[16], G[4], Gp[4];
#pragma unroll
                    for (int i = 0; i < 16; ++i) { const float z = fminf(S[i], 115.f); const bool valid = true; const float e = __builtin_amdgcn_exp2f(z); const float k = __builtin_amdgcn_rcpf(1.0f + e); kp[i] = valid ? k : 1.f; ev[i] = valid ? e : 0.f; }
#pragma unroll
                    for (int q = 0; q < 4; ++q) { kp[4 * q + 2] *= kp[4 * q + 3]; kp[4 * q + 1] *= kp[4 * q + 2]; kp[4 * q] *= kp[4 * q + 1]; G[q] = kp[4 * q]; }
#pragma unroll
                    for (int q = 0; q < 4; ++q) Gp[q] = __shfl_xor(G[q], 32);
                    float off[4]; float later = 1.f;
#pragma unroll
                    for (int q = 3; q >= 0; --q) { off[q] = later * (h == 0 ? Gp[q] : 1.f); later *= G[q] * Gp[q]; }
                    bf16x8 wf[2];
                    { float w[16];
#pragma unroll
                      for (int i = 0; i < 16; ++i) w[i] = ev[i] * kp[i] * (off[i >> 2] * carry);
#pragma unroll
                      for (int s2 = 0; s2 < 2; ++s2) { v4u pw; pw.x = pk2(w[8 * s2], w[8 * s2 + 1]); pw.y = pk2(w[8 * s2 + 2], w[8 * s2 + 3]); pw.z = pk2(w[8 * s2 + 4], w[8 * s2 + 5]); pw.w = pk2(w[8 * s2 + 6], w[8 * s2 + 7]); wf[s2] = __builtin_bit_cast(bf16x8, pw); } }
                    carry *= later;
#pragma unroll
                    for (int s2 = 0; s2 < 2; ++s2) {
#pragma unroll
                        for (int m2 = 0; m2 < 2; ++m2) { const LAS unsigned char* ap = vl + (16 * s2 + 4 * h + (i16 >> 2)) * RW_PIT + (32 * m2 + dcol + 4 * (i16 & 3)) * 2;
                            const v4i16_t lo = __builtin_amdgcn_ds_read_tr16_b64_v4i16((LAS v4i16_t*)ap), hi = __builtin_amdgcn_ds_read_tr16_b64_v4i16((LAS v4i16_t*)(ap + 8 * RW_PIT));
                            const bf16x8 af = __builtin_shufflevector(lo, hi, 0, 1, 2, 3, 4, 5, 6, 7);
                            if (m2 == 0) O0 = __builtin_amdgcn_mfma_f32_32x32x16_bf16(af, wf[s2], O0, 0, 0, 0); else O1 = __builtin_amdgcn_mfma_f32_32x32x16_bf16(af, wf[s2], O1, 0, 0, 0); } }
                    if (__all(carry < 1.0e-44f)) break;
                }
#pragma unroll
                for (int q = 0; q < 4; ++q) {
                    *(GAS unsigned*)((unsigned char*)YA + (size_t)(q0 + n) * 1024 + head * 64 + 8 * q + 4 * h) = ({ int w8_ = 0; w8_ = __builtin_amdgcn_cvt_pk_fp8_f32(O0[4 * q], O0[4 * q + 1], w8_, false); w8_ = __builtin_amdgcn_cvt_pk_fp8_f32(O0[4 * q + 2], O0[4 * q + 3], w8_, true); (unsigned)w8_; });
                    *(GAS unsigned*)((unsigned char*)YA + (size_t)(q0 + n) * 1024 + head * 64 + 32 + 8 * q + 4 * h) = ({ int w8_ = 0; w8_ = __builtin_amdgcn_cvt_pk_fp8_f32(O1[4 * q], O1[4 * q + 1], w8_, false); w8_ = __builtin_amdgcn_cvt_pk_fp8_f32(O1[4 * q + 2], O1[4 * q + 3], w8_, true); (unsigned)w8_; }); }
            }
        }
        }
#endif
#endif
        REP_END(2)
    }
    SEAM(2);
    if (IN(3)) {
        LOCALS
        REP_BEGIN(3)
        constexpr int NCHB = 16; const int NRB = (int)gridDim.x - NCHB;
        gu32* rcnt = (gu32*)(args.ws + WS_CTL) + CW_RCNT;
        const bool chb = (int)blockIdx.x >= NRB; const int u_first = chb ? (int)blockIdx.x - NRB : 16 + (int)blockIdx.x, u_stride = chb ? 4096 : NRB;
        {
        const int idx = lane & 15, g = lane >> 4, mt = wave >> 1, ntb = 2 * (wave & 1);
#define RW_IMG(sl) (LDSP + RING_OFF + (sl) * RW_SLOT)
        LAS float* tot = (LAS float*)(LDSP + RING_OFF + 13 * RW_SLOT); LAS float* gam = tot + 512;
        float nl[8]; bf16 nr[8], nk[8], nv[8], na[8]; bf16 npr = 0, npk = 0, npv = 0;
#define RW_FETCH(un) { const int ch_ = ((un) & 15) * 64 + lane, tb_ = ((un) >> 4) * 64 + 8 * wave; \
            _Pragma("unroll") for (int j = 0; j < 8; ++j) { const size_t o_ = (size_t)(tb_ + j) * 1024 + ch_; nl[j] = LW[o_]; nr[j] = RR[o_]; nk[j] = RK[o_]; nv[j] = RV[o_]; na[j] = AA[o_]; } \
            if (tb_ > 0) { const size_t o_ = (size_t)(tb_ - 1) * 1024 + ch_; npr = RR[o_]; npk = RK[o_]; npv = RV[o_]; } else { npr = 0; npk = 0; npv = 0; } }
        if (u_first < 4096) RW_FETCH(u_first)
        int pub_chunk = -1;
        for (int unit = u_first; unit < 4096; unit += u_stride) {
            const int head = unit & 15, chunk = unit >> 4, t0 = chunk * 64, ch = head * 64 + lane;
            float lwv[8], cumv[8]; float cum = 0.f; float rcur[8], kcur[8], vcur[8], acur[8];
#pragma unroll
            for (int j = 0; j < 8; ++j) { lwv[j] = nl[j]; cum += lwv[j]; cumv[j] = cum; rcur[j] = bf1(nr[j]); kcur[j] = bf1(nk[j]); vcur[j] = bf1(nv[j]); acur[j] = bf1(na[j]); }
            float rp = bf1(npr), kp = bf1(npk), vp = bf1(npv);
            tot[wave * 64 + lane] = cum;
            __syncthreads();
            float off = 0.f, total = 0.f;
#pragma unroll
            for (int w2 = 0; w2 < 8; ++w2) { const float x = tot[w2 * 64 + lane]; total += x; off += (w2 < wave) ? x : 0.f; }
            const float etot = __expf(total);
            if (wave == 0) gam[lane] = etot;
            const float mur = mu[ch], muk = mu[1024 + ch], muv = mu[2048 + ch], ckk = k_k[ch], cka = k_a[ch], crk = r_k[ch];
            {
#pragma unroll
              for (int j = 0; j < 8; ++j) { const int tl = 8 * wave + j;
                const float rc = rcur[j], kc = kcur[j], vc = vcur[j], av = acur[j];
                const float rs = rc + (rp - rc) * mur, ks = kc + (kp - kc) * muk, vs = vc + (vp - vc) * muv; rp = rc; kp = kc; vp = vc;
                float kk = ks * ckk; const float nrm = wave_sum(kk * kk); kk = kk * __builtin_amdgcn_rsqf(fmaxf(nrm, 1e-24f));
                const float km = ks * (1.0f + (av - 1.0f) * cka); const float rkc = wave_sum(rs * km * crk);
                if (lane == 0) RKC[(t0 + tl) * 16 + head] = rkc;
                const float cumt = off + cumv[j], cump = cumt - lwv[j];
                const float eg = __expf(cumt), egp = __expf(cump), ig = __expf(-cumt), eb = etot * ig;
                const int bo = tl * RW_PIT + lane * 2;
                *(LAS bf16*)(RW_IMG(0) + bo) = (bf16)f2bf(-egp * kk);
                *(LAS bf16*)(RW_IMG(1) + bo) = (bf16)f2bf(ig * kk * av);
                *(LAS bf16*)(RW_IMG(2) + bo) = (bf16)f2bf(ig * km);
                *(LAS bf16*)(RW_IMG(3) + bo) = (bf16)f2bf(eg * rs);
                *(LAS bf16*)(RW_IMG(4) + bo) = (bf16)f2bf(eb * kk * av);
                *(LAS bf16*)(RW_IMG(5) + bo) = (bf16)f2bf(eb * km);
                *(LAS bf16*)(RW_IMG(6) + bo) = (bf16)f2bf(vs); } }
            asm volatile("s_waitcnt vmcnt(0)" ::: "memory");
            __syncthreads();
            if (tid == 0 && pub_chunk >= 0) __hip_atomic_fetch_add(rcnt + pub_chunk * 16, 1u, RLX_AGENT);
            if (unit + u_stride < 4096) RW_FETCH(unit + u_stride)
            const f32x4 Z4 = (f32x4){0.f, 0.f, 0.f, 0.f};
            { f32x4 c[4][2];
#pragma unroll
              for (int q = 0; q < 4; ++q) { c[q][0] = Z4; c[q][1] = Z4; }
              rw_mm2<0, 0>(RW_IMG(0), RW_IMG(1), mt, ntb, c[0][0], c[0][1], idx, g); rw_mm2<0, 0>(RW_IMG(0), RW_IMG(2), mt, ntb, c[1][0], c[1][1], idx, g);
              rw_mm2<0, 0>(RW_IMG(3), RW_IMG(1), mt, ntb, c[2][0], c[2][1], idx, g); rw_mm2<0, 0>(RW_IMG(3), RW_IMG(2), mt, ntb, c[3][0], c[3][1], idx, g);
#pragma unroll
              for (int q2 = 0; q2 < 2; ++q2) { const int n = 16 * (ntb + q2) + idx; f32x4 one = Z4;
#pragma unroll
                  for (int i = 0; i < 4; ++i) { const int m = 16 * mt + 4 * g + i; if (!(n < m)) { c[0][q2][i] = 0.f; c[1][q2][i] = 0.f; } if (!(n <= m)) { c[2][q2][i] = 0.f; c[3][q2][i] = 0.f; } one[i] = (n == m) ? 1.f : 0.f; }
                  rw_st(RW_IMG(7), mt, ntb + q2, c[0][q2], idx, g); rw_st(RW_IMG(11), mt, ntb + q2, c[0][q2] + one, idx, g); rw_st(RW_IMG(8), mt, ntb + q2, c[1][q2], idx, g);
                  rw_st(RW_IMG(9), mt, ntb + q2, c[2][q2], idx, g); rw_st(RW_IMG(10), mt, ntb + q2, c[3][q2], idx, g); } }
            __syncthreads();
            const int tmA = (0x33103322 >> (4 * wave)) & 15, tnA = (0x32101010 >> (4 * wave)) & 15; const bool kA0 = (0x3F >> wave) & 1, kA1 = (0xCF >> wave) & 1;
            const bool hasB = wave == 4 || wave == 5, kB0 = wave == 4, kB1 = wave == 5; const int tmB = wave == 4 ? 1 : 2, tnB = wave == 4 ? 0 : 2;
#define RW_TRI_P(tm, tn, k0, k1) { f32x4 pp = Z4; \
                if (k0) { const bf16x8 a_ = rw_ft(RW_IMG(7), 16 * (tm), 0, idx, g), b_ = rw_fd(RW_IMG(7), 16 * (tn), 0, idx, g); RW_MF(a_, b_, pp); } \
                if (k1) { const bf16x8 a_ = rw_ft(RW_IMG(7), 16 * (tm), 1, idx, g), b_ = rw_fd(RW_IMG(7), 16 * (tn), 1, idx, g); RW_MF(a_, b_, pp); } \
                rw_st(RW_IMG(1), tm, tn, pp, idx, g); }
            RW_TRI_P(tmA, tnA, kA0, kA1)
            if (hasB) RW_TRI_P(tmB, tnB, kB0, kB1)
#undef RW_TRI_P
            if (wave < 6) { const int um_ = (0x211000 >> (4 * wave)) & 15, un_ = (0x332321 >> (4 * wave)) & 15; rw_st(RW_IMG(12), um_, un_, Z4, idx, g); rw_st(RW_IMG(1), um_, un_, Z4, idx, g); }
            __syncthreads();
#define RW_Z22(c) { c[0][0] = Z4; c[0][1] = Z4; c[1][0] = Z4; c[1][1] = Z4; }
#define RW_LD22(c, img) { c[0][0] = rw_ld(img, mt0, nt0, idx, g); c[0][1] = rw_ld(img, mt0, nt0 + 1, idx, g); c[1][0] = rw_ld(img, mt0 + 1, nt0, idx, g); c[1][1] = rw_ld(img, mt0 + 1, nt0 + 1, idx, g); }
#define RW_ST22(img, c) { rw_st(img, mt0, nt0, c[0][0], idx, g); rw_st(img, mt0, nt0 + 1, c[0][1], idx, g); rw_st(img, mt0 + 1, nt0, c[1][0], idx, g); rw_st(img, mt0 + 1, nt0 + 1, c[1][1], idx, g); }
#define RW_STG22(fn, p, c) { fn(p, mt0, nt0, c[0][0], idx, g); fn(p, mt0, nt0 + 1, c[0][1], idx, g); fn(p, mt0 + 1, nt0, c[1][0], idx, g); fn(p, mt0 + 1, nt0 + 1, c[1][1], idx, g); }
            const int wh = wave >> 2, mt0 = 2 * ((wave >> 1) & 1), nt0 = 2 * (wave & 1);
#pragma unroll
            for (int it = 0; it < 5; ++it) {
                const int ps = (it & 1) ? 7 : 1, pd = (it & 1) ? 1 : 7, ns = (it & 1) ? 12 : 11, nd = (it & 1) ? 11 : 12;
#define RW_TRI(tm, tn, k0, k1) { f32x4 nn = rw_ld(RW_IMG(ns), tm, tn, idx, g), pp = Z4; \
                    if (k0) { const bf16x8 a_ = rw_ft(RW_IMG(ps), 16 * (tm), 0, idx, g), bn_ = rw_fd(RW_IMG(ns), 16 * (tn), 0, idx, g); RW_MF(a_, bn_, nn); if (it < 4) { const bf16x8 bp_ = rw_fd(RW_IMG(ps), 16 * (tn), 0, idx, g); RW_MF(a_, bp_, pp); } } \
                    if (k1) { const bf16x8 a_ = rw_ft(RW_IMG(ps), 16 * (tm), 1, idx, g), bn_ = rw_fd(RW_IMG(ns), 16 * (tn), 1, idx, g); RW_MF(a_, bn_, nn); if (it < 4) { const bf16x8 bp_ = rw_fd(RW_IMG(ps), 16 * (tn), 1, idx, g); RW_MF(a_, bp_, pp); } } \
                    rw_st(RW_IMG(nd), tm, tn, nn, idx, g); if (it < 4) rw_st(RW_IMG(pd), tm, tn, pp, idx, g); }
                RW_TRI(tmA, tnA, kA0, kA1)
                if (hasB) RW_TRI(tmB, tnB, kB0, kB1)
#undef RW_TRI
                __syncthreads();
            }
            if (wh == 0) { f32x4 ah[2][2]; RW_Z22(ah) rw_mm22<1, 1>(RW_IMG(0), RW_IMG(12), mt0, nt0, ah, idx, g, true, nt0 == 2); RW_ST22(RW_IMG(2), ah) }
            else { f32x4 wq[2][2]; RW_Z22(wq) rw_mm22<1, 0>(RW_IMG(12), RW_IMG(8), mt0, nt0, wq, idx, g, nt0 == 0, mt0 == 2); RW_ST22(RW_IMG(11), wq) }
            __syncthreads();
            if (wh == 0) { bf16* gt_ = GTC + (size_t)unit * 4096; bf16* tt_ = TTC + (size_t)unit * 4096;
              f32x4 gq[2][2], tq[2][2]; RW_LD22(gq, RW_IMG(3)) RW_Z22(tq)
              rw_mm22_shareA<1, 1, 1>(RW_IMG(2), RW_IMG(9), RW_IMG(4), mt0, nt0, gq, tq, idx, g, nt0 == 2);
              RW_STG22(rw_stg, gt_, gq)
#pragma unroll
              for (int a_ = 0; a_ < 2; ++a_)
#pragma unroll
                  for (int b_ = 0; b_ < 2; ++b_)
#pragma unroll
                      for (int i = 0; i < 4; ++i) { const int m = 16 * (mt0 + a_) + 4 * g + i; if (16 * (nt0 + b_) + idx == m) tq[a_][b_][i] += gam[m]; }
              RW_STG22(rw_stg_wt, tt_, tq) }
            else { f32x4 zq[2][2], xq[2][2]; RW_LD22(zq, RW_IMG(10)) RW_LD22(xq, RW_IMG(5))
              rw_mm22_shareB<1, 1, 0>(RW_IMG(9), RW_IMG(4), RW_IMG(11), mt0, nt0, zq, xq, idx, g, nt0 == 0, mt0 == 2, nt0 == 0);
              RW_ST22(RW_IMG(7), zq) RW_ST22(RW_IMG(1), xq) }
            __syncthreads();
            if (wh == 0) { bf16* yl_ = YLC + (size_t)unit * 4096; f32x4 yq[2][2]; RW_Z22(yq) rw_mm22<1, 1>(RW_IMG(6), RW_IMG(7), mt0, nt0, yq, idx, g, true, nt0 == 2); RW_STG22(rw_stg, yl_, yq) }
            else { bf16* qc_ = QC + (size_t)unit * 4096; f32x4 qq[2][2]; RW_Z22(qq) rw_mm22<1, 1>(RW_IMG(1), RW_IMG(6), mt0, nt0, qq, idx, g); RW_STG22(rw_stg_wt, qc_, qq) }
            __syncthreads();
#undef RW_Z22
#undef RW_LD22
#undef RW_ST22
#undef RW_STG22
            pub_chunk = chunk;
        }
        if (pub_chunk >= 0) { asm volatile("s_waitcnt vmcnt(0)" ::: "memory"); __syncthreads(); if (tid == 0) __hip_atomic_fetch_add(rcnt + pub_chunk * 16, 1u, RLX_AGENT); }
#undef RW_IMG
#undef RW_FETCH
        }
        if (chb) {
            typedef unsigned long long u64;
            volatile LAS unsigned* cw = (volatile LAS unsigned*)(LDSP + RING_OFF);
            LAS unsigned char* ring = LDSP + RING_OFF + 1024;
            constexpr int CH_SLOT = 2 * RW_SLOT, CH_NS = 6; constexpr unsigned CH_CAP = 1u << 24;
            if (tid < 64) cw[tid] = 0u;
            __syncthreads();
            const int head = (int)blockIdx.x - NRB;
            if (wave == 4) {
                int c = 0; unsigned spins = 0;
                while (c < 256) {
                    const int cc = c + lane; const unsigned v = cc < 256 ? __hip_atomic_load(rcnt + cc * 16, RLX_AGENT) : 0u;
                    const unsigned long long m = __ballot(v >= 16u); const int nready = m == ~0ull ? 64 : __builtin_ctzll(~m);
                    if (nready > 0) { __builtin_amdgcn_fence(__ATOMIC_ACQUIRE, "agent"); c += nready; if (lane == 0) cw[0] = (unsigned)c; spins = 0; }
                    else { __builtin_amdgcn_s_sleep(4); if (++spins > (1u << 22)) break; }
                }
            } else if (wave > 4) {
                const int L = wave - 5, lrow = lane >> 3, lc = lane & 7;
                v4u A[16], B[16];
#define LD_WAIT_RDY(c) { unsigned sp_ = 0; while ((unsigned)__builtin_amdgcn_readfirstlane((int)cw[0]) < (unsigned)(c) + 1u) { __builtin_amdgcn_s_sleep(1); if (++sp_ > CH_CAP) break; } asm volatile("" ::: "memory"); }
#define LD_WAIT_FREE(c) { if ((c) >= CH_NS) { unsigned sp_ = 0; for (;;) { const unsigned d_ = cw[16 + 6 * (lane & 3) + (c) % CH_NS]; if (__all(d_ >= (unsigned)((c) - CH_NS) + 1u)) break; __builtin_amdgcn_s_sleep(1); if (++sp_ > CH_CAP) break; } } asm volatile("" ::: "memory"); }
#define LD_LOAD(R, c) { const bf16* tt_ = TTC + (size_t)((c) * 16 + head) * 4096; const bf16* qc_ = QC + (size_t)((c) * 16 + head) * 4096; \
                  _Pragma("unroll") for (int i = 0; i < 8; ++i) { R[i] = *(const GAS v4u*)(tt_ + (8 * i + lrow) * 64 + lc * 8); R[8 + i] = *(const GAS v4u*)(qc_ + (8 * i + lrow) * 64 + lc * 8); } }
#define LD_STORE(R, c) { LAS unsigned char* sl_ = ring + ((c) % CH_NS) * CH_SLOT; \
                  _Pragma("unroll") for (int i = 0; i < 8; ++i) { *(LAS v4u*)(sl_ + (8 * i + lrow) * RW_PIT + lc * 16) = R[i]; *(LAS v4u*)(sl_ + RW_SLOT + (8 * i + lrow) * RW_PIT + lc * 16) = R[8 + i]; } \
                  LDS_WAIT(); if (lane == 0) cw[8 + (c) % CH_NS] = (unsigned)(c) + 1u; }
                LD_WAIT_RDY(L) LD_LOAD(A, L)
                for (int c = L; c < 256; c += 6) {
                    const int c1 = c + 3, c2 = c + 6;
                    if (c1 < 256) { LD_WAIT_RDY(c1) LD_LOAD(B, c1) }
                    LD_WAIT_FREE(c) LD_STORE(A, c)
                    if (c2 < 256) { LD_WAIT_RDY(c2) LD_LOAD(A, c2) }
                    if (c1 < 256) { LD_WAIT_FREE(c1) LD_STORE(B, c1) }
                }
#undef LD_WAIT_RDY
#undef LD_WAIT_FREE
#undef LD_LOAD
#undef LD_STORE
            } else {
                const int vg = wave, idx = lane & 15, g = lane >> 4;
                f32x4 S[4];
#pragma unroll
                for (int m = 0; m < 4; ++m) S[m] = (f32x4){0.f, 0.f, 0.f, 0.f};
                for (int c = 0; c < 256; ++c) {
                    const int slot = c % CH_NS, unit = c * 16 + head;
                    { unsigned sp_ = 0; while ((unsigned)__builtin_amdgcn_readfirstlane((int)cw[8 + slot]) < (unsigned)c + 1u) { __builtin_amdgcn_s_sleep(1); if (++sp_ > CH_CAP) break; } asm volatile("" ::: "memory"); }
                    const LAS unsigned char* sl_ = ring + slot * CH_SLOT;
                    u64 pq[4], pa[4][2][2];
#pragma unroll
                    for (int m = 0; m < 4; ++m) { pq[m] = *(const LAS u64*)(sl_ + RW_SLOT + (16 * vg + idx) * RW_PIT + (16 * m + 4 * g) * 2);
#pragma unroll
                        for (int ks = 0; ks < 2; ++ks) { pa[m][ks][0] = *(const LAS u64*)(sl_ + (16 * m + idx) * RW_PIT + (32 * ks + 4 * g) * 2); pa[m][ks][1] = *(const LAS u64*)(sl_ + (16 * m + idx) * RW_PIT + (32 * ks + 16 + 4 * g) * 2); } }
                    bf16x8 sf[2];
#pragma unroll
                    for (int ks = 0; ks < 2; ++ks) { v4u w; w.x = pk2(S[2 * ks][0], S[2 * ks][1]); w.y = pk2(S[2 * ks][2], S[2 * ks][3]); w.z = pk2(S[2 * ks + 1][0], S[2 * ks + 1][1]); w.w = pk2(S[2 * ks + 1][2], S[2 * ks + 1][3]);
                        sf[ks] = __builtin_bit_cast(bf16x8, w); *(GAS v4u*)(SBF + (((size_t)unit * 4 + vg) * 2 + ks) * 512 + lane * 8) = w; }
                    LDS_WAIT(); asm volatile("" ::: "memory");
                    if (lane == 0) cw[16 + 6 * vg + slot] = (unsigned)c + 1u;
#pragma unroll
                    for (int m = 0; m < 4; ++m) { const unsigned lo = (unsigned)pq[m], hi = (unsigned)(pq[m] >> 32); f32x4 acc = (f32x4){bflo(lo), bfhi(lo), bflo(hi), bfhi(hi)};
#pragma unroll
                        for (int ks = 0; ks < 2; ++ks) { const v4u aw = (v4u){(unsigned)pa[m][ks][0], (unsigned)(pa[m][ks][0] >> 32), (unsigned)pa[m][ks][1], (unsigned)(pa[m][ks][1] >> 32)};
                            acc = __builtin_amdgcn_mfma_f32_16x16x32_bf16(__builtin_bit_cast(bf16x8, aw), sf[ks], acc, 0, 0, 0); }
                        S[m] = acc; }
                }
            }
        }
        REP_END(3)
    }
    SEAM(3);
    if (IN(4)) {
        LOCALS
        REP_BEGIN(4)
        if ((vcu & 1) == 0) {
            pg8::Gemm g{XB, WIN_T + (size_t)7168 * D / 2, T, 4096, D / 2}; pg8::StaticOrder S; S.init(T, 4096, (int)gridDim.x, (int)blockIdx.x);
            pg8::EpiB16<pg8::FnGate> E{{GATE}};
            pg8::gemm_phase<pg8::EpiB16<pg8::FnGate>, pg8::StaticOrder, PG8_ALIGN, PG8_SP2, 122>(LDSP + RING_OFF, g, S, E);
        }
        REP_END(4)
    }
    if (IN(5)) {
        LOCALS
        REP_BEGIN(5)
        typedef unsigned long long u64;
        const int idx = lane & 15, g = lane >> 4;
#pragma unroll 2
        for (int task = gw; task < 16384; task += NGW) {
            const int unit = task >> 2, nt = task & 3, head = unit & 15, t = (unit >> 4) * 64 + 16 * nt + idx;
            const bf16* gt_ = GTC + (size_t)unit * 4096 + (16 * nt + idx) * 64; const bf16* yl_ = YLC + (size_t)unit * 4096 + (16 * nt + idx) * 64;
            bf16x8 bfr[2];
#pragma unroll
            for (int ks = 0; ks < 2; ++ks) { const u64 lo = *(const GAS u64*)(gt_ + 32 * ks + 4 * g), hi = *(const GAS u64*)(gt_ + 32 * ks + 16 + 4 * g);
                bfr[ks] = __builtin_bit_cast(bf16x8, (v4u){(unsigned)lo, (unsigned)(lo >> 32), (unsigned)hi, (unsigned)(hi >> 32)}); }
            f32x4 y[4]; float s1 = 0.f;
#pragma unroll
            for (int vg = 0; vg < 4; ++vg) { const u64 yw = *(const GAS u64*)(yl_ + 16 * vg + 4 * g); const unsigned lo = (unsigned)yw, hi = (unsigned)(yw >> 32); f32x4 acc = (f32x4){bflo(lo), bfhi(lo), bflo(hi), bfhi(hi)};
#pragma unroll
                for (int ks = 0; ks < 2; ++ks) { const bf16x8 af = *(const GAS bf16x8*)(SBF + (((size_t)unit * 4 + vg) * 2 + ks) * 512 + lane * 8); acc = __builtin_amdgcn_mfma_f32_16x16x32_bf16(af, bfr[ks], acc, 0, 0, 0); }
                y[vg] = acc; s1 += (acc[0] + acc[1]) + (acc[2] + acc[3]); }
            s1 += __shfl_xor(s1, 16); s1 += __shfl_xor(s1, 32); const float mean = s1 * (1.0f / 64.0f); float s2 = 0.f;
#pragma unroll
            for (int vg = 0; vg < 4; ++vg) { y[vg] = y[vg] - mean; s2 += (y[vg][0] * y[vg][0] + y[vg][1] * y[vg][1]) + (y[vg][2] * y[vg][2] + y[vg][3] * y[vg][3]); }
            s2 += __shfl_xor(s2, 16); s2 += __shfl_xor(s2, 32); const float rstd = 1.0f / sqrtf(s2 * (1.0f / 64.0f) + GN_EPS);
            const float rk = RKC[t * 16 + head];
#pragma unroll
            for (int vg = 0; vg < 4; ++vg) { const int ch = head * 64 + 16 * vg + 4 * g; const size_t o = (size_t)t * 1024 + ch;
                const f32x4 lwt = *(const GAS f32x4*)(lnx_w + ch), lbt = *(const GAS f32x4*)(lnx_b + ch), mv = *(const GAS f32x4*)(mu + 2048 + ch);
                const u64 vcw = *(const GAS u64*)(RV + o), vpw = t > 0 ? *(const GAS u64*)(RV + o - 1024) : 0ull, gw_ = 0ull; const unsigned g8_ = *(const GAS unsigned*)((const unsigned char*)GG + o); (void)gw_;
                const float vc[4] = {bflo((unsigned)vcw), bfhi((unsigned)vcw), bflo((unsigned)(vcw >> 32)), bfhi((unsigned)(vcw >> 32))};
                const float vp[4] = {bflo((unsigned)vpw), bfhi((unsigned)vpw), bflo((unsigned)(vpw >> 32)), bfhi((unsigned)(vpw >> 32))};
                typedef float f32x2g_ __attribute__((ext_vector_type(2))); const f32x2g_ glo_ = __builtin_amdgcn_cvt_pk_f32_fp8((int)g8_, false), ghi_ = __builtin_amdgcn_cvt_pk_f32_fp8((int)g8_, true); const float gg[4] = {glo_.x, glo_.y, ghi_.x, ghi_.y};
                float ov[4];
#pragma unroll
                for (int i = 0; i < 4; ++i) { const float vs = vc[i] + (vp[i] - vc[i]) * mv[i]; ov[i] = (y[vg][i] * rstd * lwt[i] + lbt[i] + rk * vs) * gg[i]; }
                *(GAS unsigned*)((unsigned char*)YB + o) = ({ int w8_ = 0; w8_ = __builtin_amdgcn_cvt_pk_fp8_f32(ov[0], ov[1], w8_, false); w8_ = __builtin_amdgcn_cvt_pk_fp8_f32(ov[2], ov[3], w8_, true); (unsigned)w8_; }); }
        }
        {
            __syncthreads();
            LAS float* scr = (LAS float*)(LDSP + RING_OFF + wave * 16384);
            constexpr int I_UA = (1024 / 64) * (D / 32), I_SQ = (D / 64) * (D / 32), I_PE = (256 / 64) * (D / 32);
            constexpr int NITEMS = 2 * I_UA + 3 * I_SQ + I_PE;
            for (int it = gw; it < NITEMS; it += NGW) {
                int r = it;
                if (r < I_UA) { p0_transpose_item8(w_up_a, 1024, D, (unsigned char*)WUA_T, 32.0f, scr, r, lane); continue; } r -= I_UA;
                if (r < I_UA) { p0_transpose_item8(w_up_b, 1024, D, (unsigned char*)WUB_T, 32.0f, scr, r, lane); continue; } r -= I_UA;
                if (r < I_SQ) { p0_transpose_item8(w_o, D, D, (unsigned char*)WO_T, 64.0f, scr, r, lane); continue; } r -= I_SQ;
                if (r < I_SQ) { p0_transpose_item(peer_wq, D, D, WQ_T, scr, r, lane); continue; } r -= I_SQ;
                if (r < I_SQ) { p0_transpose_item8(ple_wg, D, D, (unsigned char*)WPG_T, 32.0f, scr, r, lane); continue; } r -= I_SQ;
                p0_transpose_item(ple_wp, 256, D, WPE_T, scr, r, lane);
            }
            cvt_rows_bf16(p_in, PB, (size_t)T * 256 / 8, gt, NGT);
            __syncthreads();
        }
        if ((vcu & 1) != 0) {
            pg8::Gemm g{XB, WIN_T + (size_t)7168 * D / 2, T, 4096, D / 2}; pg8::StaticOrder S; S.init(T, 4096, (int)gridDim.x, (int)blockIdx.x);
            pg8::EpiB16<pg8::FnGate> E{{GATE}};
            pg8::gemm_phase<pg8::EpiB16<pg8::FnGate>, pg8::StaticOrder, PG8_ALIGN, PG8_SP2, 122>(LDSP + RING_OFF, g, S, E);
        }
        REP_END(5)
    }
    SEAM(5);
    if (IN(7)) {
        LOCALS
        REP_BEGIN(7)
        if ((vcu & 1) == 0) { cvt_rows_fp6(peer_u, UB, 16384, U_SCALE, gw, NGW, lane); cvt_rows_fp6(peer_v, VB2, 16384, V_SCALE, gw, NGW, lane); __syncthreads(); }
        { pg8::Gemm g{YA, WUA_T, T, D, 512}; pg8::StaticOrder S; S.init(T, D, (int)gridDim.x, (int)blockIdx.x);
          pg8::EpiB16<pg8::FnMix<0>> E{{GATE, MIX}};
          pg8::gemm_phase<pg8::EpiB16<pg8::FnMix<0>>, pg8::StaticOrder, PG8_ALIGN, PG8_SP2, 122>(LDSP + RING_OFF, g, S, E); }
        __syncthreads();
        { pg8::Gemm g{YB, WUB_T, T, D, 512}; pg8::StaticOrder S; S.init(T, D, (int)gridDim.x, (int)blockIdx.x);
          pg8::EpiB16<pg8::FnMixF8> E{{(const bf16*)((const unsigned char*)GATE + (size_t)T * 2048), MIX, MIX8}};
          pg8::gemm_phase<pg8::EpiB16<pg8::FnMixF8>, pg8::StaticOrder, PG8_ALIGN, PG8_SP2, 122>(LDSP + RING_OFF, g, S, E); }
        if ((vcu & 1) != 0) { cvt_rows_fp6(peer_u, UB, 16384, U_SCALE, gw, NGW, lane); cvt_rows_fp6(peer_v, VB2, 16384, V_SCALE, gw, NGW, lane); }
        REP_END(7)
    }
    SEAM(7);
    if (IN(8)) {
        LOCALS
        REP_BEGIN(8)
        pg8::Gemm g{(const bf16*)MIX8, WO_T, T, D, D / 2}; pg8::StaticOrder S; S.init(T, D, (int)gridDim.x, (int)blockIdx.x);
        pg8::EpiB16<pg8::FnWoB16> E{{x_in, (bf16*)H1, ALPHA}};
        pg8::gemm_phase<pg8::EpiB16<pg8::FnWoB16>, pg8::StaticOrder, PG8_ALIGN, PG8_SP2, 121>(LDSP + RING_OFF, g, S, E);
        REP_END(8)
    }
    SEAM(8);
    if (IN(9)) {
        LOCALS
        REP_BEGIN(9)
        for (int t = gw; t < T; t += NGW) {
            const bf16* hr = (const bf16*)H1 + (size_t)t * D + 8 * lane; float v[32]; float s = 0.f;
#pragma unroll
            for (int i = 0; i < 4; ++i) { const v4u w = *(const GAS v4u*)(hr + 512 * i);
                v[8 * i + 0] = bflo(w.x); v[8 * i + 1] = bfhi(w.x); v[8 * i + 2] = bflo(w.y); v[8 * i + 3] = bfhi(w.y); v[8 * i + 4] = bflo(w.z); v[8 * i + 5] = bfhi(w.z); v[8 * i + 6] = bflo(w.w); v[8 * i + 7] = bfhi(w.w); }
#pragma unroll
            for (int i = 0; i < 32; ++i) s += v[i];
            const float mean = wave_sum(s) * (1.0f / D); float q = 0.f;
#pragma unroll
            for (int i = 0; i < 32; ++i) { v[i] -= mean; q += v[i] * v[i]; }
            const float rstd = 1.0f / sqrtf(wave_sum(q) * (1.0f / D) + LN_EPS);
#pragma unroll
            for (int i = 0; i < 4; ++i) { const int c0 = 8 * lane + 512 * i;
                const f32x4 ga = *(const GAS f32x4*)(ln1_w + c0), gb = *(const GAS f32x4*)(ln1_w + c0 + 4), ba = *(const GAS f32x4*)(ln1_b + c0), bb = *(const GAS f32x4*)(ln1_b + c0 + 4);
                float o[8] = {v[8 * i + 0] * rstd * ga.x + ba.x, v[8 * i + 1] * rstd * ga.y + ba.y, v[8 * i + 2] * rstd * ga.z + ba.z, v[8 * i + 3] * rstd * ga.w + ba.w,
                              v[8 * i + 4] * rstd * gb.x + bb.x, v[8 * i + 5] * rstd * gb.y + bb.y, v[8 * i + 6] * rstd * gb.z + bb.z, v[8 * i + 7] * rstd * gb.w + bb.w};
                v4u w; w.x = pk2(o[0], o[1]); w.y = pk2(o[2], o[3]); w.z = pk2(o[4], o[5]); w.w = pk2(o[6], o[7]); *(GAS v4u*)(X1B + (size_t)t * D + c0) = w;
                int w0_ = 0, w1_ = 0; w0_ = __builtin_amdgcn_cvt_pk_fp8_f32(o[0], o[1], w0_, false); w0_ = __builtin_amdgcn_cvt_pk_fp8_f32(o[2], o[3], w0_, true);
                w1_ = __builtin_amdgcn_cvt_pk_fp8_f32(o[4], o[5], w1_, false); w1_ = __builtin_amdgcn_cvt_pk_fp8_f32(o[6], o[7], w1_, true);
                *(GAS unsigned long long*)(X1B8 + (size_t)t * D + c0) = (unsigned long long)(unsigned)w0_ | ((unsigned long long)(unsigned)w1_ << 32); }
        }
        REP_END(9)
    }
    SEAM(9);
    if (IN(10)) {
        LOCALS
        REP_BEGIN(10)
        { pg8::Gemm g{X1B, WQ_T, T, D, D}; pg8::StaticOrder S; S.init(T, D, (int)gridDim.x, (int)blockIdx.x);
          pg8::EpiB16<pg8::FnPlain16> E{{PQ, D}};
          pg8::gemm_phase<pg8::EpiB16<pg8::FnPlain16>, pg8::StaticOrder, PG8_ALIGN, PG8_SP2>(LDSP + RING_OFF, g, S, E); }
        REP_END(10)
    }
    SEAM(10);
    if (IN(11)) {
        LOCALS
        REP_BEGIN(11)
        { pg8::Gemm g{PB, WPE_T, T, D, 256}; pg8::StaticOrder S; S.init(T, D, (int)gridDim.x, (int)blockIdx.x);
          pg8::EpiB16<pg8::FnPlain16> E{{PE, D}};
          pg8::gemm_phase<pg8::EpiB16<pg8::FnPlain16>, pg8::StaticOrder, PG8_ALIGN, PG8_SP2>(LDSP + RING_OFF, g, S, E); }
        __syncthreads();
        { pg8::Gemm g{(const bf16*)X1B8, WPG_T, T, D, D / 2}; pg8::StaticOrder S; S.init(T, D, (int)gridDim.x, (int)blockIdx.x);
          pg8::EpiB16<pg8::FnPle> E{{PE}};
          pg8::gemm_phase<pg8::EpiB16<pg8::FnPle>, pg8::StaticOrder, PG8_ALIGN, PG8_SP2, 122>(LDSP + RING_OFF, g, S, E); }
        __syncthreads();
        LAS unsigned char* SK = LDSP + RING_OFF;
        for (int i = tid; i < 32768; i += 512) { const int row = i >> 7, d = i & 127; *(LAS bf16*)(SK + row * 272 + d * 2) = (bf16)f2bf(sub_keys[i]); }
        __syncthreads();
        {
            const int n = lane & 31, hh = lane >> 5;
            const float NEGINF = __uint_as_float(0xff800000u);
            for (int batch = gw; batch < T / 4; batch += NGW) {
                const int t = 4 * batch + (n >> 3), h = n & 7;
                float L[2][16];
#pragma unroll
                for (int c = 0; c < 2; ++c) {
                    f32x16 acc[4];
#pragma unroll
                    for (int m = 0; m < 4; ++m)
#pragma unroll
                        for (int i = 0; i < 16; ++i) acc[m][i] = 0.f;
                    bf16x8 qfr[8];
#pragma unroll
                    for (int ks = 0; ks < 8; ++ks) qfr[ks] = *(const GAS bf16x8*)(PQ + (size_t)t * D + h * 256 + c * 128 + 16 * ks + 8 * hh);
#pragma unroll
                    for (int ks = 0; ks < 8; ++ks) {
#pragma unroll
                        for (int m = 0; m < 4; ++m) { const bf16x8 kf = *(const LAS bf16x8*)(SK + (c * 128 + 32 * m + n) * 272 + (16 * ks + 8 * hh) * 2); acc[m] = __builtin_amdgcn_mfma_f32_32x32x16_bf16(kf, qfr[ks], acc[m], 0, 0, 0); }
                        __builtin_amdgcn_sched_barrier(0); }
                    float Lc[16], Gx[16];
#pragma unroll
                    for (int m = 0; m < 4; ++m) {
#pragma unroll
                        for (int i = 0; i < 16; ++i) { const float x = __uint_as_float((__float_as_uint(acc[m][i]) & 0xffffff80u) | (unsigned)(32 * m + (i & 3) + 8 * (i >> 2)) | (unsigned)(4 * hh)); if (m == 0) Lc[i] = x; else Gx[i] = x; }
                        if (m == 0) bitonic_sort16_desc(Lc); else { bitonic_sort16_desc(Gx); top16_merge_desc(Lc, Gx); } }
                    { float Pn[16];
#pragma unroll
                      for (int k = 0; k < 16; ++k) Pn[k] = __shfl_xor(Lc[k], 32);
                      top16_merge_desc(Lc, Pn); }
#pragma unroll
                    for (int k = 0; k < 16; ++k) L[c][k] = Lc[k];
                }
                float F[16];
#pragma unroll
                for (int k = 0; k < 16; ++k) F[k] = NEGINF;
#define PK_CAND(i, j) { float x = __uint_as_float((__float_as_uint(L[0][i] + L[1][j]) & 0xffffff00u) | (unsigned)(((i) << 4) | (j))); _Pragma("unroll") for (int k = 0; k < 16; ++k) { const float hi = fmaxf(x, F[k]); x = fminf(x, F[k]); F[k] = hi; } }
#define PK_ROW1(i) PK_CAND(i, 0)
#define PK_ROW2(i) PK_ROW1(i) PK_CAND(i, 1)
#define PK_ROW3(i) PK_ROW2(i) PK_CAND(i, 2)
#define PK_ROW4(i) PK_ROW3(i) PK_CAND(i, 3)
#define PK_ROW5(i) PK_ROW4(i) PK_CAND(i, 4)
#define PK_ROW8(i) PK_ROW5(i) PK_CAND(i, 5) PK_CAND(i, 6) PK_CAND(i, 7)
#define PK_ROW16(i) PK_ROW8(i) PK_CAND(i, 8) PK_CAND(i, 9) PK_CAND(i, 10) PK_CAND(i, 11) PK_CAND(i, 12) PK_CAND(i, 13) PK_CAND(i, 14) PK_CAND(i, 15)
                PK_ROW16(0) PK_ROW8(1) PK_ROW5(2) PK_ROW4(3) PK_ROW3(4) PK_ROW2(5) PK_ROW2(6) PK_ROW2(7)
                PK_ROW1(8) PK_ROW1(9) PK_ROW1(10) PK_ROW1(11) PK_ROW1(12) PK_ROW1(13) PK_ROW1(14) PK_ROW1(15)
                float ex[16]; float sum = 0.f; const float mx = __uint_as_float(__float_as_uint(F[0]) & 0xffffff00u);
#pragma unroll
                for (int k = 0; k < 16; ++k) { ex[k] = __expf(__uint_as_float(__float_as_uint(F[k]) & 0xffffff00u) - mx); sum += ex[k]; }
                const float rs = 1.0f / sum;
                int eid[16];
#pragma unroll
                for (int k = 0; k < 16; ++k) { const unsigned pay = __float_as_uint(F[k]) & 255u; const unsigned ii = pay >> 4, jj = pay & 15u; unsigned i0 = 0u, i1 = 0u;
#pragma unroll
                    for (int i = 0; i < 16; ++i) { i0 = (ii == (unsigned)i) ? (__float_as_uint(L[0][i]) & 127u) : i0; i1 = (jj == (unsigned)i) ? (__float_as_uint(L[1][i]) & 127u) : i1; }
                    eid[k] = (int)(i0 * 128u + i1); }
                if (hh == 0) {
#pragma unroll
                    for (int k4 = 0; k4 < 4; ++k4) { *(GAS v4u*)(IDX + (size_t)t * 128 + h * 16 + 4 * k4) = (v4u){(unsigned)eid[4 * k4], (unsigned)eid[4 * k4 + 1], (unsigned)eid[4 * k4 + 2], (unsigned)eid[4 * k4 + 3]};
                        *(GAS f32x4*)(PG + (size_t)t * 128 + h * 16 + 4 * k4) = (f32x4){ex[4 * k4] * rs, ex[4 * k4 + 1] * rs, ex[4 * k4 + 2] * rs, ex[4 * k4 + 3] * rs}; }
                }
            }
        }
        REP_END(11)
    }
    SEAM(11);
    if (IN(12)) {
        LOCALS
        REP_BEGIN(12)
        LAS float* actl = (LAS float*)(LDSP + RING_OFF) + wave * 128;
        LAS float* lnw = (LAS float*)(LDSP + RING_OFF + 8192); LAS float* lnb = lnw + 2048;
        *(LAS f32x4*)(lnw + 4 * tid) = *(const GAS f32x4*)(ln2_w + 4 * tid); *(LAS f32x4*)(lnb + 4 * tid) = *(const GAS f32x4*)(ln2_b + 4 * tid);
        __syncthreads();
        const int r4 = lane >> 4, c16 = lane & 15;
        for (int t = gw; t < T; t += NGW) {
            typedef unsigned long long u64;
            const int idv0 = IDX[(size_t)t * 128 + lane], idv1 = IDX[(size_t)t * 128 + 64 + lane]; const float gtv0 = PG[(size_t)t * 128 + lane], gtv1 = PG[(size_t)t * 128 + 64 + lane];
            u64 xq[32];
#pragma unroll
            for (int i = 0; i < 4; ++i)
#pragma unroll
                for (int q = 0; q < 8; ++q) xq[8 * i + q] = *(const GAS u64*)(X1B + (size_t)t * D + 256 * q + 4 * (c16 + 16 * i));
            LAS float* hraw = actl;
#define P1_LOAD(Dst, grp) { const int j_ = 4 * (grp) + r4; const int e_ = __shfl((grp) < 16 ? idv0 : idv1, j_ & 63); const GAS u64* ur_ = (const GAS u64*)(UB + (size_t)e_ * ROW6 + 24 * c16); \
                _Pragma("unroll") for (int i = 0; i < 4; ++i) { Dst[3 * i] = ur_[48 * i]; Dst[3 * i + 1] = ur_[48 * i + 1]; Dst[3 * i + 2] = ur_[48 * i + 2]; } }
#define P1_COMP(Src, grp) { float h0_ = 0.f, h1_ = 0.f; \
                _Pragma("unroll") for (int i = 0; i < 4; ++i) { const v6u_t pk_ = {(unsigned)Src[3 * i], (unsigned)(Src[3 * i] >> 32), (unsigned)Src[3 * i + 1], (unsigned)(Src[3 * i + 1] >> 32), (unsigned)Src[3 * i + 2], (unsigned)(Src[3 * i + 2] >> 32)}; \
                    const v16u_t f = __builtin_bit_cast(v16u_t, __builtin_amdgcn_cvt_scalef32_pk32_bf16_fp6(pk_, 1.0f));        \
                    _Pragma("unroll") for (int q = 0; q < 8; ++q) { const u64 xx = xq[8 * i + q]; h0_ = dot2(f[2 * q], (unsigned)xx, h0_); h1_ = dot2(f[2 * q + 1], (unsigned)(xx >> 32), h1_); } __builtin_amdgcn_sched_barrier(0); } \
                const float h_ = row16_sum(h0_ + h1_) * (1.0f / U_SCALE); if (c16 == 0) hraw[4 * (grp) + r4] = h_; }
            { u64 ua[12], ub[12];
              P1_LOAD(ua, 0)
              for (int grp = 0; grp < 32; grp += 2) { P1_LOAD(ub, grp + 1) P1_COMP(ua, grp) if (grp + 2 < 32) P1_LOAD(ua, grp + 2) P1_COMP(ub, grp + 1) } }
#undef P1_LOAD
#undef P1_COMP
            asm volatile("s_waitcnt lgkmcnt(0)" ::: "memory");
            { const float ha_ = hraw[lane], hb_ = hraw[64 + lane];
              asm volatile("s_waitcnt lgkmcnt(0)" ::: "memory");
              actl[lane] = 0.5f * ha_ * (1.0f + erff(ha_ * 0.70710678118f)) * gtv0 * (1.0f / V_SCALE); actl[64 + lane] = 0.5f * hb_ * (1.0f + erff(hb_ * 0.70710678118f)) * gtv1 * (1.0f / V_SCALE); }
            asm volatile("s_waitcnt lgkmcnt(0)" ::: "memory");
            float acc[32];
#pragma unroll
            for (int i = 0; i < 32; ++i) acc[i] = 0.f;
#define P2_LOAD(Dst, jb) { _Pragma("unroll") for (int r = 0; r < 4; ++r) { const int e_ = __builtin_amdgcn_readlane((jb) < 64 ? idv0 : idv1, ((jb) + r) & 63); const GAS u64* vr_ = (const GAS u64*)(VB2 + (size_t)e_ * ROW6 + 24 * lane); \
                Dst[3 * r] = vr_[0]; Dst[3 * r + 1] = vr_[1]; Dst[3 * r + 2] = vr_[2]; } }
#define P2_COMP(Src, jb) { const f32x4 a4_ = *(const LAS f32x4*)(actl + (jb)); \
                _Pragma("unroll") for (int r = 0; r < 4; ++r) { const v6u_t pk_ = {(unsigned)Src[3 * r], (unsigned)(Src[3 * r] >> 32), (unsigned)Src[3 * r + 1], (unsigned)(Src[3 * r + 1] >> 32), (unsigned)Src[3 * r + 2], (unsigned)(Src[3 * r + 2] >> 32)}; \
                    const v32f_t f = __builtin_amdgcn_cvt_scalef32_pk32_f32_fp6(pk_, 1.0f); const float a_ = a4_[r]; \
                    _Pragma("unroll") for (int i = 0; i < 32; ++i) acc[i] += a_ * f[i]; __builtin_amdgcn_sched_barrier(0); } }
            { u64 va[12], vb[12];
              P2_LOAD(va, 0)
              for (int jb = 0; jb < 128; jb += 8) { P2_LOAD(vb, jb + 4) P2_COMP(va, jb) if (jb + 8 < 128) P2_LOAD(va, jb + 8) P2_COMP(vb, jb + 4) } }
#undef P2_LOAD
#undef P2_COMP
            asm volatile("s_waitcnt lgkmcnt(0)" ::: "memory");
            float s1 = 0.f;
#pragma unroll
            for (int i = 0; i < 8; ++i) { const size_t o = (size_t)t * D + 256 * i + 4 * lane;
                const unsigned long long xw_ = *(const GAS unsigned long long*)(X1B + o), pw = *(const GAS unsigned long long*)(PE + o);
                acc[4 * i + 0] += ALPHA * bflo((unsigned)xw_) + bflo((unsigned)pw); acc[4 * i + 1] += ALPHA * bfhi((unsigned)xw_) + bfhi((unsigned)pw);
                acc[4 * i + 2] += ALPHA * bflo((unsigned)(xw_ >> 32)) + bflo((unsigned)(pw >> 32)); acc[4 * i + 3] += ALPHA * bfhi((unsigned)(xw_ >> 32)) + bfhi((unsigned)(pw >> 32)); }
#pragma unroll
            for (int i = 0; i < 32; ++i) s1 += acc[i];
            const float mean = wave_sum(s1) * (1.0f / D); float s2 = 0.f;
#pragma unroll
            for (int i = 0; i < 32; ++i) { acc[i] -= mean; s2 += acc[i] * acc[i]; }
            const float rstd = 1.0f / sqrtf(wave_sum(s2) * (1.0f / D) + LN_EPS);
#pragma unroll
            for (int i = 0; i < 8; ++i) { const int c0 = 256 * i + 4 * lane; const f32x4 ga = *(const LAS f32x4*)(lnw + c0), ba = *(const LAS f32x4*)(lnb + c0);
                *(GAS f32x4*)(args.out + (size_t)t * D + c0) = (f32x4){acc[4 * i + 0] * rstd * ga.x + ba.x, acc[4 * i + 1] * rstd * ga.y + ba.y, acc[4 * i + 2] * rstd * ga.z + ba.z, acc[4 * i + 3] * rstd * ga.w + ba.w}; }
        }
        REP_END(12)
    }

#ifdef DIAG_FP6
    { typedef float v32f_ __attribute__((ext_vector_type(32))); typedef float v16f_ __attribute__((ext_vector_type(16))); typedef unsigned v6u_ __attribute__((ext_vector_type(6)));
      v16f_ a_, b_; float mv_[32];
#pragma unroll
      for (int k = 0; k < 32; ++k) mv_[k] = k < 8 ? k * 0.125f : (k < 16 ? 1.f + (k - 8) * 0.125f : (k < 24 ? 2.f + (k - 16) * 0.25f : 4.f + (k - 24) * 0.5f));
#pragma unroll
      for (int k = 0; k < 16; ++k) { a_[k] = mv_[k]; b_[k] = mv_[16 + k]; }
      const v6u_ p_ = __builtin_amdgcn_cvt_scalef32_2xpk16_fp6_f32(a_, b_, 1.0f); const v32f_ o_ = __builtin_amdgcn_cvt_scalef32_pk32_f32_fp6(p_, 1.0f);
      bool id_ = true, il_ = true;
#pragma unroll
      for (int k = 0; k < 16; ++k) { id_ = id_ && (o_[k] == mv_[k]) && (o_[16 + k] == mv_[16 + k]); il_ = il_ && (o_[2 * k] == mv_[k]) && (o_[2 * k + 1] == mv_[16 + k]); }
      const float c_ = id_ ? 2.f : (il_ ? 3.f : 4.f);
      xcd_barrier(bar);
      LOCALS
      for (size_t e = gt; e < (size_t)T * D; e += NGT) args.out[e] = c_; }
#endif

#ifdef DIAG_TIME
    xcd_barrier(bar);
    { LOCALS
      const unsigned long long t0_ = __hip_atomic_load((unsigned long long*)(args.ws + WS_CTL) + 8, __ATOMIC_RELAXED, __HIP_MEMORY_SCOPE_AGENT);
      const float ms_ = (float)(__builtin_amdgcn_s_memrealtime() - t0_) * (1.0f / 100000.0f);
      float u_ = (float)DIAG_UNIT_MS; float c_ = 1.0f;
      for (int b_ = 0; b_ < 6; ++b_) { if (ms_ > u_) c_ += 1.f; u_ *= (float)DIAG_RATIO; }
      for (size_t e = gt; e < (size_t)T * D; e += NGT) args.out[e] = c_; }
#endif
#if DIAG_LAST >= 0
    xcd_barrier(bar);
    { LOCALS
      constexpr size_t N1 = (size_t)T * 1024;
      int used = 0;
#if DIAG_LAST == 1
      digest<bf16>(args.out, 0, QB, N1, gt, NGT); digest<bf16>(args.out, 1, KB, N1, gt, NGT); digest<bf16>(args.out, 2, VB, N1, gt, NGT);
      digest<bf16>(args.out, 3, RR, N1, gt, NGT); digest<bf16>(args.out, 4, RK, N1, gt, NGT); digest<bf16>(args.out, 5, RV, N1, gt, NGT); digest<bf16>(args.out, 6, RC, N1, gt, NGT); used = 7;
#elif DIAG_LAST == 2
      digest<bf16>(args.out, 0, YA, N1, gt, NGT); digest<float>(args.out, 1, LW, N1, gt, NGT); digest<bf16>(args.out, 2, AA, N1, gt, NGT); digest<bf16>(args.out, 3, GG, N1, gt, NGT); used = 4;
#elif DIAG_LAST == 3
      digest<float>(args.out, 0, YRAW, N1, gt, NGT); digest<float>(args.out, 1, RKC, (size_t)T * 16, gt, NGT); used = 2;
#elif DIAG_LAST == 4
      digest<bf16>(args.out, 0, YB, N1, gt, NGT); used = 1;
#elif DIAG_LAST == 5
      digest<bf16>(args.out, 0, GATE, 4 * N1, gt, NGT); used = 1;
#elif DIAG_LAST == 7
      digest<bf16>(args.out, 0, MIX, 2 * N1, gt, NGT); used = 1;
#elif DIAG_LAST == 8
      digest<float>(args.out, 0, H1, 2 * N1, gt, NGT); used = 1;
#elif DIAG_LAST == 9
      digest<bf16>(args.out, 0, X1B, 2 * N1, gt, NGT); used = 1;
#elif DIAG_LAST == 10
      digest<bf16>(args.out, 0, PQ, 2 * N1, gt, NGT); digest<bf16>(args.out, 1, PE, 2 * N1, gt, NGT); used = 2;
#elif DIAG_LAST == 11
      digest<int>(args.out, 0, IDX, (size_t)T * 128, gt, NGT); digest<float>(args.out, 1, PG, (size_t)T * 128, gt, NGT); digest<bf16>(args.out, 2, PE, 2 * N1, gt, NGT); used = 3;
#endif
      for (size_t e = gt + (size_t)used * 2097152; e < (size_t)T * D; e += NGT) args.out[e] = 1.0f;
    }
#endif
#undef IN
#undef SEAM
}


#ifdef DIAG_CHECK
__device__ __forceinline__ unsigned hsh(unsigned x) { x ^= x >> 16; x *= 0x7feb352dU; x ^= x >> 15; x *= 0x846ca68bU; x ^= x >> 16; return x; }
__device__ __forceinline__ void chk_acc(unsigned char* ws, int id, float ref, float got) { float* a = (float*)(ws + WS_CTL) + 1024 + 2 * id; const float d = ref - got; atomicAdd(a, d * d); atomicAdd(a + 1, ref * ref); }
__global__ void __launch_bounds__(512) mk_check(Args args) {
    extern __shared__ __attribute__((aligned(16))) unsigned char lds[];
    LOCALS
    const int id = args.pad - 1;
    if (id == 0) {
        for (size_t i = gt; i < 8192; i += NGT) { const unsigned hh = hsh((unsigned)i * 2u + 1u); const int t = (int)(hh % T), col = (int)(hsh(hh) % 7168u);
            float ref = 0.f; for (int k = 0; k < D; ++k) ref += x_in[(size_t)t * D + k] * w_in[(size_t)k * NIN + col];
            const int reg = col >> 10, c = col & 1023; const float got = bf1(QB[(size_t)reg * ((size_t)T * 1024) + (size_t)t * 1024 + c]) * (reg == 0 ? 8.f : 1.f);
            chk_acc(args.ws, 0, ref, got); }
    } else if (id == 1) {
        for (int smp = gw; smp < 256; smp += NGW) { const unsigned hh = hsh(7777u + smp); const int t = (int)(hh % T), head = (int)(hsh(hh) % 16u);
            const float q = bf1(QB[(size_t)t * 1024 + head * 64 + lane]); float o = 0.f;
            for (int sk = 0; sk < t; ++sk) { const float z = wave_sum(q * bf1(KB[(size_t)sk * 1024 + head * 64 + lane])); const float beta = 1.0f / (1.0f + expf(-z));
                o = o * (1.0f - beta) + beta * bf1(VB[(size_t)sk * 1024 + head * 64 + lane]); }
            chk_acc(args.ws, 1, o, bf1(YA[(size_t)t * 1024 + head * 64 + lane])); }
    } else if (id == 2) {
        LAS float* xs = (LAS float*)lds + wave * 3072;
        for (int smp = gw; smp < 512; smp += NGW) { const unsigned hh = hsh(991u + smp); const int t = (int)(hh % T), c = (int)(hsh(hh) % 1024u);
            for (int k = lane; k < 1024; k += 64) { const float cv = bf1(RC[(size_t)t * 1024 + k]), pv = t > 0 ? bf1(RC[(size_t)(t - 1) * 1024 + k]) : 0.f;
                xs[k] = cv + (pv - cv) * mu[3 * 1024 + k]; xs[1024 + k] = cv + (pv - cv) * mu[4 * 1024 + k]; xs[2048 + k] = cv + (pv - cv) * mu[5 * 1024 + k]; }
            asm volatile("s_waitcnt lgkmcnt(0)" ::: "memory");
            float hw = 0.f, ha = 0.f, hg0 = 0.f, hg1 = 0.f, hg2 = 0.f;
            for (int k = 0; k < 1024; ++k) { hw += xs[k] * wl1[(size_t)k * 64 + lane]; ha += xs[1024 + k] * al1[(size_t)k * 64 + lane];
                hg0 += xs[2048 + k] * gl1[(size_t)k * 160 + lane]; hg1 += xs[2048 + k] * gl1[(size_t)k * 160 + 64 + lane]; if (lane < 32) hg2 += xs[2048 + k] * gl1[(size_t)k * 160 + 128 + lane]; }
            hw = tanhf(hw); hg0 = 1.f / (1.f + expf(-hg0)); hg1 = 1.f / (1.f + expf(-hg1)); hg2 = 1.f / (1.f + expf(-hg2));
            const float wpre = w0[c] + wave_sum(hw * wl2[(size_t)lane * 1024 + c]);
            const float apre = a0[c] + wave_sum(ha * al2[(size_t)lane * 1024 + c]);
            const float gref = wave_sum(hg0 * gl2[(size_t)lane * 1024 + c] + hg1 * gl2[(size_t)(64 + lane) * 1024 + c] + (lane < 32 ? hg2 * gl2[(size_t)(128 + lane) * 1024 + c] : 0.f));
            const float sp = -wpre > 20.f ? -wpre : log1pf(expf(-wpre)); const float lwref = -expf(-sp - 0.5f); const float aref = 1.f / (1.f + expf(-apre));
            if (lane == 0) { chk_acc(args.ws, 2, lwref, LW[(size_t)t * 1024 + c]); chk_acc(args.ws, 3, aref, bf1(AA[(size_t)t * 1024 + c])); chk_acc(args.ws, 4, gref, bf1(GG[(size_t)t * 1024 + c])); }
            asm volatile("s_waitcnt lgkmcnt(0)" ::: "memory"); }
    } else if (id == 5) {
        LAS float* vs_ = (LAS float*)lds + wave * 512;
        for (int smp = gw; smp < 128; smp += NGW) { const unsigned hh = hsh(4242u + smp); const int t1 = 800 + (int)(hh % (T - 800)), head = (int)(hsh(hh) % 16u), ch = head * 64 + lane;
            float S[64];
#pragma unroll
            for (int k = 0; k < 64; ++k) S[k] = 0.f;
            float y = 0.f;
            for (int t = t1 - 768; t <= t1; ++t) { const size_t o = (size_t)t * 1024 + ch;
                const float rc = bf1(RR[o]), rp = bf1(RR[o - 1024]), kc = bf1(RK[o]), kp = bf1(RK[o - 1024]), vc = bf1(RV[o]), vp = bf1(RV[o - 1024]);
                const float rs = rc + (rp - rc) * mu[ch], ks = kc + (kp - kc) * mu[1024 + ch], vsv = vc + (vp - vc) * mu[2048 + ch];
                const float a = bf1(AA[o]); float kk = ks * k_k[ch]; const float nrm = sqrtf(wave_sum(kk * kk)); kk = kk / fmaxf(nrm, 1e-12f);
                const float km = ks * (1.0f + (a - 1.0f) * k_a[ch]);
                vs_[lane] = expf(LW[o]); vs_[64 + lane] = -kk; vs_[128 + lane] = kk * a; vs_[192 + lane] = km; vs_[256 + lane] = rs;
                asm volatile("s_waitcnt lgkmcnt(0)" ::: "memory");
                float sa = 0.f;
#pragma unroll
                for (int k = 0; k < 64; ++k) sa += S[k] * vs_[64 + k];
                y = 0.f;
#pragma unroll
                for (int k = 0; k < 64; ++k) { S[k] = S[k] * vs_[k] + sa * vs_[128 + k] + vsv * vs_[192 + k]; y += S[k] * vs_[256 + k]; }
                asm volatile("s_waitcnt lgkmcnt(0)" ::: "memory"); }
            { const size_t o = (size_t)t1 * 1024 + ch; const float mean = wave_sum(y) / 64.f; const float var = wave_sum((y - mean) * (y - mean)) / 64.f;
              const float rc = bf1(RR[o]), rp = bf1(RR[o - 1024]), kc = bf1(RK[o]), kp = bf1(RK[o - 1024]), vc = bf1(RV[o]), vp = bf1(RV[o - 1024]);
              const float rs = rc + (rp - rc) * mu[ch], ks = kc + (kp - kc) * mu[1024 + ch], vsv = vc + (vp - vc) * mu[2048 + ch];
              const float km = ks * (1.0f + (bf1(AA[o]) - 1.0f) * k_a[ch]); const float rk = wave_sum(rs * km * r_k[ch]);
              const float ref = ((y - mean) / sqrtf(var + GN_EPS) * lnx_w[ch] + lnx_b[ch] + rk * vsv) * bf1(GG[o]);
              chk_acc(args.ws, 5, ref, bf1(YB[o])); } }
    } else if (id == 6) {
        for (int smp = gw; smp < 512; smp += NGW) { const unsigned hh = hsh(31337u + smp); const int t = 1 + (int)(hh % (T - 1)), head = (int)(hsh(hh) % 16u), ch = head * 64 + lane; const size_t o = (size_t)t * 1024 + ch;
            const float rc = bf1(RR[o]), rp = bf1(RR[o - 1024]), kc = bf1(RK[o]), kp = bf1(RK[o - 1024]), vc = bf1(RV[o]), vp = bf1(RV[o - 1024]);
            const float rs = rc + (rp - rc) * mu[ch], ks = kc + (kp - kc) * mu[1024 + ch], vsv = vc + (vp - vc) * mu[2048 + ch];
            const float km = ks * (1.0f + (bf1(AA[o]) - 1.0f) * k_a[ch]); const float rk = wave_sum(rs * km * r_k[ch]);
            const float y = YRAW[o]; const float mean = wave_sum(y) / 64.f; const float var = wave_sum((y - mean) * (y - mean)) / 64.f;
            const float ref = ((y - mean) / sqrtf(var + GN_EPS) * lnx_w[ch] + lnx_b[ch] + rk * vsv) * bf1(GG[o]);
            chk_acc(args.ws, 6, ref, bf1(YB[o])); }
    } else if (id == 7) {
        for (size_t i = gt; i < 4096; i += NGT) { const unsigned hh = hsh((unsigned)i * 2u + 5u); const int t = (int)(hh % T), col = (int)(hsh(hh) % 4096u);
            float ref = 0.f; for (int k = 0; k < D; ++k) ref += x_in[(size_t)t * D + k] * w_in[(size_t)k * NIN + 7168 + col];
#ifndef DIAG_RAWGATE
            ref = 1.f / (1.f + expf(-ref));
#endif
            chk_acc(args.ws, 7, ref, bf1(GATE[(size_t)(col >> 11) * ((size_t)T * 2048) + (size_t)t * 2048 + (col & 2047)])); }
    } else if (id == 15) {
        for (size_t i = gt; i < 262144; i += NGT) { const unsigned hh = hsh((unsigned)i * 2u + 77u); const int k = (int)(hh % D), col = (int)(hsh(hh) % NIN);
            chk_acc(args.ws, col < 7168 ? 15 : 16, w_in[(size_t)k * NIN + col], bf1(WIN_T[(size_t)col * D + k])); }
    } else if (id == 17) {
        for (size_t i = gt; i < 262144; i += NGT) { const unsigned hh = hsh((unsigned)i * 2u + 177u); const size_t e = ((size_t)hh * 8191u + hsh(hh)) % ((size_t)T * D); chk_acc(args.ws, 17, x_in[e], bf1(XB[e])); }
    } else if (id == 8) {
        for (size_t i = gt; i < 4096; i += NGT) { const unsigned hh = hsh((unsigned)i * 2u + 9u); const int t = (int)(hh % T), col = (int)(hsh(hh) % 2048u);
            float ya = 0.f, yb = 0.f; for (int k = 0; k < 1024; ++k) { ya += bf1(YA[(size_t)t * 1024 + k]) * w_up_a[(size_t)k * D + col]; yb += bf1(YB[(size_t)t * 1024 + k]) * w_up_b[(size_t)k * D + col]; }
            const float ref = bf1(GATE[(size_t)t * 2048 + col]) * ya + bf1(GATE[(size_t)T * 2048 + (size_t)t * 2048 + col]) * yb; chk_acc(args.ws, 8, ref, bf1(MIX[(size_t)t * 2048 + col])); }
    } else if (id == 9) {
        for (size_t i = gt; i < 4096; i += NGT) { const unsigned hh = hsh((unsigned)i * 2u + 13u); const int t = (int)(hh % T), col = (int)(hsh(hh) % 2048u);
            float ref = 0.f; for (int k = 0; k < D; ++k) ref += bf1(MIX[(size_t)t * D + k]) * w_o[(size_t)k * D + col];
            ref += ALPHA * x_in[(size_t)t * D + col]; chk_acc(args.ws, 9, ref, H1[(size_t)t * D + col]); }
    } else if (id == 10) {
        for (size_t i = gt; i < 4096; i += NGT) { const unsigned hh = hsh((unsigned)i * 2u + 21u); const int t = (int)(hh % T), col = (int)(hsh(hh) % 2048u);
            float ref = 0.f; for (int k = 0; k < D; ++k) ref += bf1(X1B[(size_t)t * D + k]) * peer_wq[(size_t)k * D + col];
            chk_acc(args.ws, 10, ref, bf1(PQ[(size_t)t * D + col]));
            float r2 = 0.f; for (int k = 0; k < 256; ++k) r2 += p_in[(size_t)t * 256 + k] * ple_wp[(size_t)k * D + col];
            chk_acc(args.ws, 11, r2, bf1(PE[(size_t)t * D + col])); }
    } else if (id == 12) {
        for (size_t i = gt; i < 4096; i += NGT) { const unsigned hh = hsh((unsigned)i * 2u + 29u); const int t = (int)(hh % T), col = (int)(hsh(hh) % 2048u);
            float ref = 0.f; for (int k = 0; k < D; ++k) ref += bf1(X1B[(size_t)t * D + k]) * ple_wg[(size_t)k * D + col];
            float r2 = 0.f; for (int k = 0; k < 256; ++k) r2 += p_in[(size_t)t * 256 + k] * ple_wp[(size_t)k * D + col];
            chk_acc(args.ws, 12, r2 / (1.f + expf(-ref)), bf1(PE[(size_t)t * D + col])); }
        LAS float* sc = (LAS float*)lds + wave * 256;
        for (int smp = gw; smp < 512; smp += NGW) { const unsigned hh = hsh(555u + smp); const int t = (int)(hh % T), h = (int)(hsh(hh) % 8u);
            for (int r = lane; r < 256; r += 64) { const int c = r >> 7, nn = r & 127; float s = 0.f; for (int d = 0; d < 128; ++d) s += bf1(PQ[(size_t)t * D + h * 256 + c * 128 + d]) * sub_keys[(size_t)(c * 128 + nn) * 128 + d]; sc[r] = s; }
            asm volatile("s_waitcnt lgkmcnt(0)" ::: "memory");
            const int e = IDX[(size_t)t * 128 + h * 16 + (lane & 15)]; const float mys = sc[e >> 7] + sc[128 + (e & 127)];
            float mn = mys, mxv = mys;
#pragma unroll
            for (int o2 = 1; o2 < 16; o2 <<= 1) { mn = fminf(mn, __shfl_xor(mn, o2)); mxv = fmaxf(mxv, __shfl_xor(mxv, o2)); }
            float ex = expf(mys - mxv), sm = ex;
#pragma unroll
            for (int o2 = 1; o2 < 16; o2 <<= 1) sm += __shfl_xor(sm, o2);
            if (lane < 16) chk_acc(args.ws, 13, ex / sm, PG[(size_t)t * 128 + h * 16 + lane]);
            int cnt = 0; for (int pr = lane; pr < 16384; pr += 64) cnt += (sc[pr >> 7] + sc[128 + (pr & 127)] > mn + 1e-6f) ? 1 : 0;
#pragma unroll
            for (int o2 = 1; o2 < 64; o2 <<= 1) cnt += __shfl_xor(cnt, o2);
            if (lane == 0) chk_acc(args.ws, 14, 15.f, (float)cnt);
            asm volatile("s_waitcnt lgkmcnt(0)" ::: "memory"); }
    } else if (id == 98) {
        const float* a = (const float*)(args.ws + WS_CTL) + 1024; float c = 1.f; unsigned long long sel = DIAG_CHECK;
        for (int b = 4; b >= 0; --b) { const int k = (int)(sel % 100ull); sel /= 100ull; const float rel = sqrtf(a[2 * k] / fmaxf(a[2 * k + 1], 1e-30f)); if (!(rel < DIAG_TOL)) c += (float)(1 << b); }
#ifdef DIAG_LADDER
        { c = 1.f; const float rel = sqrtf(a[2 * DIAG_LADDER] / fmaxf(a[2 * DIAG_LADDER + 1], 1e-30f)); const float th[5] = {0.01f, 0.03f, 0.1f, 0.3f, 1.0f}; for (int b = 0; b < 5; ++b) if (!(rel < th[b])) c += 1.f; }
#endif
        for (size_t e = gt; e < (size_t)T * D; e += NGT) args.out[e] = c;
    }
}
#endif

extern "C" void kernel_launch(void* const* d_in, const int* in_sizes, int n_in, void* d_out, int out_size, void* d_ws, size_t ws_size, hipStream_t stream) {
    static int grid = 0;
    if (grid == 0) {
        if (n_in != 30 || in_sizes[0] != T * D || out_size != T * D || ws_size < WS_END) { fprintf(stderr, "kernel_launch: unexpected shapes / workspace (n_in %d, ws %zu); nothing launched\n", n_in, ws_size); grid = -1; return; }
        int dev = 0, cus = 0, per_cu = 0;
        if (hipGetDevice(&dev) != hipSuccess || hipDeviceGetAttribute(&cus, hipDeviceAttributeMultiprocessorCount, dev) != hipSuccess) { grid = -1; return; }
        if (hipFuncSetAttribute((const void*)mk_fwd, hipFuncAttributeMaxDynamicSharedMemorySize, LDS_BYTES) != hipSuccess) { fprintf(stderr, "kernel_launch: hipFuncSetAttribute failed\n"); grid = -1; return; }
        if (hipOccupancyMaxActiveBlocksPerMultiprocessor(&per_cu, (const void*)mk_fwd, NWAVES * 64, LDS_BYTES) != hipSuccess || per_cu < 1) fprintf(stderr, "kernel_launch: occupancy query says %d\n", per_cu);
        (void)hipGetLastError();
#ifdef DIAG_CHECK
        (void)hipFuncSetAttribute((const void*)mk_check, hipFuncAttributeMaxDynamicSharedMemorySize, 131072);
#endif
        grid = cus;
    }
    if (grid < 0) return;
    if (hipMemsetAsync((char*)d_ws + WS_CTL, 0, CTL_ZERO_BYTES, stream) != hipSuccess) return;
    Args a{};
    for (int i = 0; i < 30; ++i) a.in[i] = (const float*)d_in[i];
    a.out = (float*)d_out; a.ws = (unsigned char*)d_ws;
#if MK_ONE_LAUNCH
    a.ph_lo = 0; a.ph_hi = (DIAG_LAST >= 0) ? DIAG_LAST + 1 : NPHASE;
#ifdef DIAG_TIME
    a.ph_hi = DIAG_TIME + 1;
#endif a.li = 0;
    hipLaunchKernelGGL(mk_fwd, dim3(grid), dim3(NWAVES * 64), LDS_BYTES, stream, a);
#else
    for (int li = 0; li < NPHASE; ++li) { a.ph_lo = li; a.ph_hi = li + 1; a.li = li; a.pad = 0; hipLaunchKernelGGL(mk_fwd, dim3(grid), dim3(NWAVES * 64), LDS_BYTES, stream, a);
#ifdef DIAG_CHECK
        static const int chk_after[][2] = {{0, 15}, {1, 0}, {2, 1}, {2, 2}, {3, 18}, {4, 19}, {5, 5}, {6, 7}, {7, 8}, {8, 9}, {10, 10}, {11, 12}};
        for (auto& ca : chk_after) if (ca[0] == li) { a.pad = ca[1] + 1; hipLaunchKernelGGL(mk_check, dim3(grid), dim3(512), 131072, stream, a); }
        if (li == NPHASE - 1) { a.pad = 99; hipLaunchKernelGGL(mk_check, dim3(grid), dim3(512), 131072, stream, a); }
#endif
    }
#endif
}
```

```cpp
#define MK_ONE_LAUNCH 1
#define P2_SPLIT 1
#include <hip/hip_runtime.h>
#include <cstdio>
#include <cstdint>
namespace pg8 {
#define PG8_LAS __attribute__((address_space(3)))
typedef unsigned short bf16_t;
typedef short bf16x8 __attribute__((ext_vector_type(8)));
typedef float f32x4 __attribute__((ext_vector_type(4)));
typedef unsigned u32x4 __attribute__((ext_vector_type(4)));
constexpr int BM = 256, BK = 64, HALF = 128, HTB = HALF * BK * 2  , STAGE_BYTES = 8 * HTB, NXCD = 8, WGM = 8;

__host__ __device__ __forceinline__ int lds_byte(int r, int c) { const int st = (r >> 4) * 2 + (c >> 5), rr = r & 15, cc = c & 31, ob = rr * 64 + cc * 2; return st * 1024 + (ob ^ (((ob >> 9) & 1) << 5)); }
__host__ __device__ __forceinline__ void stage_rc(int b, int& R, int& C) { const int st = b / 1024, sb = b % 1024, swz = sb ^ (((sb >> 9) & 1) << 5); R = (st >> 1) * 16 + swz / 64; C = (st & 1) * 32 + (swz % 64) / 2; }
__host__ __device__ __forceinline__ int perm32(int rho) { const int n = rho >> 4, i = rho & 15; return 8 * (i >> 2) + 4 * n + (i & 3); }

struct Unit { int pm, pn; };
struct Gemm { const bf16_t* A; const bf16_t* Bt; int M, N, K; };

struct StaticOrder {
    int nM, nN, nwg, G, c;
    __host__ __device__ void init(int M, int N, int G_, int c_) { nM = M / BM; nN = N / BM; nwg = nM * nN; G = G_; c = c_; }
    __host__ __device__ bool next(int i, Unit& u) const {
        const long L = (long)i * G + c; if (L >= nwg) return false;
        int wgid = (int)L; { const int q = nwg / NXCD, r = nwg % NXCD, xcd = wgid % NXCD, off = wgid / NXCD; wgid = (xcd < r ? xcd * (q + 1) : r * (q + 1) + (xcd - r) * q) + off; }
        const int nig = WGM * nN, gid = wgid / nig, fm = gid * WGM, gsz = (nM - fm) < WGM ? (nM - fm) : WGM;
        u.pm = fm + ((wgid % nig) % gsz); u.pn = (wgid % nig) / gsz; return true;
    }
    __device__ __forceinline__ void a_ready(const Unit&) const {}
    __device__ __forceinline__ void done(const Unit&) const {}
};

typedef float cvt_f32x2 __attribute__((ext_vector_type(2))); typedef __bf16 cvt_bf16x2 __attribute__((ext_vector_type(2)));
__device__ __forceinline__ unsigned cvt_pk_bf16(float lo, float hi) { const cvt_f32x2 v = {lo, hi}; return __builtin_bit_cast(unsigned, __builtin_convertvector(v, cvt_bf16x2)); }
typedef float f32x2 __attribute__((ext_vector_type(2)));
__device__ __forceinline__ f32x2 gelu_pk(f32x2 v) {
    const f32x2 av = __builtin_elementwise_abs(v), d = av * 0.2316418882f + 1.0f;
    f32x2 t; t.x = __builtin_amdgcn_rcpf(d.x); t.y = __builtin_amdgcn_rcpf(d.y);
    f32x2 q = t * 0.5307027145f + (-0.7265760135f); q = q * t + 0.7107068705f; q = q * t + (-0.142248368f); q = q * t + 0.127414796f; q = q * t;
    const f32x2 s = (v * v) * (-0.72134752044f);
    f32x2 e; e.x = __builtin_amdgcn_exp2f(s.x); e.y = __builtin_amdgcn_exp2f(s.y);
    const f32x2 m = v * (q * e), r = v - m;
    f32x2 o; o.x = v.x < 0.f ? m.x : r.x; o.y = v.y < 0.f ? m.y : r.y; return o;
}


__device__ __forceinline__ float bf_lo(unsigned w) { return __uint_as_float(w << 16); }
__device__ __forceinline__ float bf_hi(unsigned w) { return __uint_as_float(w & 0xffff0000u); }
__device__ __forceinline__ float fsigmoid(float x) { return __builtin_amdgcn_rcpf(1.0f + __expf(-x)); }
__device__ __forceinline__ float ftanh(float x) { return 1.0f - 2.0f * __builtin_amdgcn_rcpf(__expf(2.0f * x) + 1.0f); }
__device__ __forceinline__ float fsoftplus(float x) { return fmaxf(x, 0.f) + __logf(1.0f + __expf(-fabsf(x))); }
__device__ __forceinline__ u32x4 pack8(const f32x4& a, const f32x4& b) { u32x4 w; w.x = cvt_pk_bf16(a[0], a[1]); w.y = cvt_pk_bf16(a[2], a[3]); w.z = cvt_pk_bf16(b[0], b[1]); w.w = cvt_pk_bf16(b[2], b[3]); return w; }
__device__ __forceinline__ void unpack8(const u32x4& w, f32x4& a, f32x4& b) { a = (f32x4){bf_lo(w.x), bf_hi(w.x), bf_lo(w.y), bf_hi(w.y)}; b = (f32x4){bf_lo(w.z), bf_hi(w.z), bf_lo(w.w), bf_hi(w.w)}; }

template <class Fn> struct EpiB16 {
    static constexpr bool PERM = true, AFTER_DRAIN = false;
    Fn f;
    __device__ __forceinline__ void operator()(const f32x4 (&acc)[2][2][4][2], const Unit& u, int wr, int wc, int fr, int fq) const {
        const int row0 = u.pm * BM + wr * 64 + fr, col0 = u.pn * BM + wc * 32 + 8 * fq;
#pragma unroll
        for (int ai = 0; ai < 2; ++ai)
#pragma unroll
            for (int m = 0; m < 4; ++m)
#pragma unroll
                for (int bj = 0; bj < 2; ++bj) f(row0 + ai * HALF + m * 16, col0 + bj * HALF, acc[ai][bj][m][0], acc[ai][bj][m][1]);
    }
};
template <class Fn> struct EpiF32x {
    static constexpr bool PERM = false, AFTER_DRAIN = false;
    Fn f;
    __device__ __forceinline__ void operator()(const f32x4 (&acc)[2][2][4][2], const Unit& u, int wr, int wc, int fr, int fq) const {
        const int row0 = u.pm * BM + wr * 64 + fr, col0 = u.pn * BM + wc * 32 + 4 * fq;
#pragma unroll
        for (int ai = 0; ai < 2; ++ai)
#pragma unroll
            for (int m = 0; m < 4; ++m)
#pragma unroll
                for (int bj = 0; bj < 2; ++bj)
#pragma unroll
                    for (int n = 0; n < 2; ++n) f(row0 + ai * HALF + m * 16, col0 + bj * HALF + n * 16, acc[ai][bj][m][n]);
    }
};
constexpr int TT = 16384;
__device__ __forceinline__ unsigned long long pack8f8(const f32x4& a, const f32x4& b) { int w0_ = 0, w1_ = 0; w0_ = __builtin_amdgcn_cvt_pk_fp8_f32(a[0], a[1], w0_, false); w0_ = __builtin_amdgcn_cvt_pk_fp8_f32(a[2], a[3], w0_, true);
    w1_ = __builtin_amdgcn_cvt_pk_fp8_f32(b[0], b[1], w1_, false); w1_ = __builtin_amdgcn_cvt_pk_fp8_f32(b[2], b[3], w1_, true); return (unsigned long long)(unsigned)w0_ | ((unsigned long long)(unsigned)w1_ << 32); }
typedef float epi_f32x2 __attribute__((ext_vector_type(2)));
__device__ __forceinline__ void unpack8f8(unsigned long long w, float sc, f32x4& a, f32x4& b) { const int lo = (int)(unsigned)w, hi = (int)(unsigned)(w >> 32);
    const epi_f32x2 a0 = __builtin_amdgcn_cvt_pk_f32_fp8(lo, false), a1 = __builtin_amdgcn_cvt_pk_f32_fp8(lo, true), b0 = __builtin_amdgcn_cvt_pk_f32_fp8(hi, false), b1 = __builtin_amdgcn_cvt_pk_f32_fp8(hi, true);
    a = (f32x4){a0.x, a0.y, a1.x, a1.y} * sc; b = (f32x4){b0.x, b0.y, b1.x, b1.y} * sc; }
struct FnProj { bf16_t* base;
    __device__ __forceinline__ void operator()(int row, int col, f32x4 a, f32x4 b) const {
        const int reg = col >> 10, c = col & 1023; const float sc = reg == 0 ? 0.125f * 1.44269504088896f   : 1.0f; a = a * sc; b = b * sc;
        *(u32x4*)(base + (size_t)reg * ((size_t)TT * 1024) + (size_t)row * 1024 + c) = pack8(a, b); } };
struct FnGate { bf16_t* base;
    __device__ __forceinline__ void operator()(int row, int col, f32x4 a, f32x4 b) const {
        const int reg = col >> 11, c = col & 2047;
#pragma unroll
        for (int j = 0; j < 4; ++j) {
#ifndef DIAG_RAWGATE
            a[j] = fsigmoid(a[j]); b[j] = fsigmoid(b[j]);
#endif
        }
        a = a * 256.0f; b = b * 256.0f;
        *(unsigned long long*)((unsigned char*)base + (size_t)reg * ((size_t)TT * 2048) + (size_t)row * 2048 + c) = pack8f8(a, b); } };
struct FnLora1 { bf16_t* out; int act;
    __device__ __forceinline__ void operator()(int row, int col, f32x4 a, f32x4 b) const {
#pragma unroll
        for (int j = 0; j < 4; ++j) { if (act == 0) { a[j] = ftanh(a[j]); b[j] = ftanh(b[j]); } else if (act == 2) { a[j] = fsigmoid(a[j]); b[j] = fsigmoid(b[j]); } }
        *(u32x4*)(out + (size_t)row * 256 + col) = pack8(a, b); } };
struct FnLora2 { float* lw; bf16_t* aa; bf16_t* gg; const float* w0; const float* a0;
    __device__ __forceinline__ void operator()(int row, int col, f32x4 a, f32x4 b) const {
        const int which = col >> 10, c = col & 1023, t = row - which * TT;
        if (which == 0) { a = a + *(const f32x4*)(w0 + c); b = b + *(const f32x4*)(w0 + c + 4);
            *(f32x4*)(lw + (size_t)t * 1024 + c) = a; *(f32x4*)(lw + (size_t)t * 1024 + c + 4) = b; }
        else if (which == 1) { a = a + *(const f32x4*)(a0 + c); b = b + *(const f32x4*)(a0 + c + 4);
            *(u32x4*)(aa + (size_t)t * 1024 + c) = pack8(a, b); }
        else { *(u32x4*)(gg + (size_t)t * 1024 + c) = pack8(a, b); } } };

template <int W> struct FnLora2S { float* lw; bf16_t* aa; bf16_t* gg; const float* w0; const float* a0;
    __device__ __forceinline__ void operator()(int row, int col, f32x4 a, f32x4 b) const { const FnLora2 f{lw, aa, gg, w0, a0}; f(row + W * TT, col + W * 1024, a, b); } };
template <int ADD> struct FnMix { const bf16_t* gate; bf16_t* mix;
    __device__ __forceinline__ void operator()(int row, int col, f32x4 a, f32x4 b) const {
        const size_t o = (size_t)row * 2048 + col; f32x4 g0, g1; unpack8f8(*(const unsigned long long*)((const unsigned char*)gate + o), 1.0f / 256.0f, g0, g1); a = a * g0; b = b * g1;
        if (ADD) { f32x4 m0, m1; unpack8(*(const u32x4*)(mix + o), m0, m1); a = a + m0; b = b + m1; }
        *(u32x4*)(mix + o) = pack8(a, b); } };
struct FnMixF8 { const bf16_t* gate; const bf16_t* mixp; unsigned char* mix8;
    __device__ __forceinline__ void operator()(int row, int col, f32x4 a, f32x4 b) const {
        const size_t o = (size_t)row * 2048 + col; f32x4 g0, g1, m0, m1; unpack8f8(*(const unsigned long long*)((const unsigned char*)gate + o), 1.0f / 256.0f, g0, g1); unpack8(*(const u32x4*)(mixp + o), m0, m1); a = a * g0 + m0; b = b * g1 + m1;
        int w0_ = 0, w1_ = 0; w0_ = __builtin_amdgcn_cvt_pk_fp8_f32(a[0], a[1], w0_, false); w0_ = __builtin_amdgcn_cvt_pk_fp8_f32(a[2], a[3], w0_, true);
        w1_ = __builtin_amdgcn_cvt_pk_fp8_f32(b[0], b[1], w1_, false); w1_ = __builtin_amdgcn_cvt_pk_fp8_f32(b[2], b[3], w1_, true);
        *(unsigned long long*)(mix8 + o) = (unsigned long long)(unsigned)w0_ | ((unsigned long long)(unsigned)w1_ << 32); } };
struct FnWo { const float* x; float* h1; float alpha;
    __device__ __forceinline__ void operator()(int row, int col, f32x4 a) const {
        const size_t o = (size_t)row * 2048 + col; *(f32x4*)(h1 + o) = *(const f32x4*)(x + o) * alpha + a; } };
struct FnWoB16 { const float* x; bf16_t* h1; float alpha;
    __device__ __forceinline__ void operator()(int row, int col, f32x4 a, f32x4 b) const {
        const size_t o = (size_t)row * 2048 + col; a = a + *(const f32x4*)(x + o) * alpha; b = b + *(const f32x4*)(x + o + 4) * alpha; *(u32x4*)(h1 + o) = pack8(a, b); } };
struct FnPlain16 { bf16_t* out; int ld;
    __device__ __forceinline__ void operator()(int row, int col, f32x4 a, f32x4 b) const { *(u32x4*)(out + (size_t)row * ld + col) = pack8(a, b); } };
struct FnPle { bf16_t* pe;
    __device__ __forceinline__ void operator()(int row, int col, f32x4 a, f32x4 b) const {
        const size_t o = (size_t)row * 2048 + col; f32x4 p0, p1; unpack8(*(const u32x4*)(pe + o), p0, p1);
#pragma unroll
        for (int j = 0; j < 4; ++j) { a[j] = fsigmoid(a[j]) * p0[j]; b[j] = fsigmoid(b[j]) * p1[j]; }
        *(u32x4*)(pe + o) = pack8(a, b); } };
struct DiagOrder { int G, c;
    __device__ __forceinline__ bool next(int i, Unit& u) const { const int L = i * G + c; if (L >= 768) return false; const int which = L >> 8, r = L & 255; u.pm = which * 64 + (r & 63); u.pn = which * 4 + (r >> 6); return true; }
    __device__ __forceinline__ void a_ready(const Unit&) const {}
    __device__ __forceinline__ void done(const Unit&) const {}
};
typedef int pg8_v4i __attribute__((ext_vector_type(4))); typedef int pg8_v8i __attribute__((ext_vector_type(8)));
template <class Epi, class Sched, bool ALIGN_EPI = false, bool SP2 = false, int F8SCALE = 0>
__device__ __forceinline__ void gemm_phase(PG8_LAS unsigned char* lds, const Gemm g, const Sched& S, const Epi& E) {
    const int tid = threadIdx.x, wid = __builtin_amdgcn_readfirstlane(tid >> 6), lane = tid & 63, wr = wid >> 2, wc = wid & 3, fr = lane & 15, fq = lane >> 4;
    const int K = g.K, nt = K / BK;
    unsigned voffA[2], voffB[2];
#pragma unroll
    for (int i = 0; i < 2; ++i) { int R, C; stage_rc(tid * 16 + i * 8192, R, C); const int Rb = Epi::PERM ? ((R & ~31) + perm32(R & 31)) : R;
        voffA[i] = (unsigned)(R * K + C) * 2u; voffB[i] = (unsigned)(Rb * K + C) * 2u; }
    const size_t kstep = (size_t)(BK * 2);
    const size_t hstep = (size_t)HALF * K * 2;
    const size_t tstep = 2 * hstep;
    const unsigned ldsw = (unsigned)wid * 1024u;
    const int aoff = lds_byte(wr * 64 + fr, fq * 8), boff = lds_byte(wc * 32 + fr, fq * 8);
#define PG8_SA(b, h) (((b) * 2 + (h)) * HTB)
#define PG8_SB(b, h) ((4 + (b) * 2 + (h)) * HTB)
#define PG8_STAGE(bufoff, gbase, voff) do { _Pragma("unroll") for (int _i = 0; _i < 2; ++_i) \
        __builtin_amdgcn_global_load_lds((const unsigned*)((const char*)(gbase) + (voff)[_i]), (PG8_LAS unsigned*)(lds + (bufoff) + ldsw + _i * 8192), 16, 0, 0); } while (0)
#define PG8_LDA(dst, b, h) do { _Pragma("unroll") for (int m = 0; m < 4; ++m) dst[m] = __builtin_shufflevector(*(const PG8_LAS pg8_v4i*)(lds + PG8_SA(b, h) + aoff + m * 2048), *(const PG8_LAS pg8_v4i*)(lds + PG8_SA(b, h) + aoff + m * 2048 + 1024), 0, 1, 2, 3, 4, 5, 6, 7); } while (0)
#define PG8_LDB(dst, b, h) do { _Pragma("unroll") for (int n = 0; n < 2; ++n) dst[n] = __builtin_shufflevector(*(const PG8_LAS pg8_v4i*)(lds + PG8_SB(b, h) + boff + n * 2048), *(const PG8_LAS pg8_v4i*)(lds + PG8_SB(b, h) + boff + n * 2048 + 1024), 0, 1, 2, 3, 4, 5, 6, 7); } while (0)
#define PG8_LO(v) __builtin_bit_cast(bf16x8, __builtin_shufflevector(v, v, 0, 1, 2, 3))
#define PG8_HI(v) __builtin_bit_cast(bf16x8, __builtin_shufflevector(v, v, 4, 5, 6, 7))
#define PG8_MMA(ai, bj, At, Bt) do { __builtin_amdgcn_s_setprio(1); _Pragma("unroll") for (int m = 0; m < 4; ++m) _Pragma("unroll") for (int n = 0; n < 2; ++n) { \
        if constexpr (F8SCALE == 0) { acc[ai][bj][m][n] = __builtin_amdgcn_mfma_f32_16x16x32_bf16(PG8_LO(Bt[n]), PG8_LO(At[m]), acc[ai][bj][m][n], 0, 0, 0); \
                                      acc[ai][bj][m][n] = __builtin_amdgcn_mfma_f32_16x16x32_bf16(PG8_HI(Bt[n]), PG8_HI(At[m]), acc[ai][bj][m][n], 0, 0, 0); } \
        else asm volatile("v_mfma_scale_f32_16x16x128_f8f6f4 %0, %1, %2, %0, %3, %4 op_sel_hi:[0,0,0]" : "+v"(acc[ai][bj][m][n]) : "v"(Bt[n]), "v"(At[m]), "v"(f8_sw_), "v"(f8_sa_)); } \
        __builtin_amdgcn_s_setprio(0); } while (0)
#define PG8_WAIT_V(n) asm volatile("s_waitcnt vmcnt(" #n ")" ::: "memory")
#define PG8_WAIT_L(n) asm volatile("s_waitcnt lgkmcnt(" #n ")" ::: "memory")
#define PG8_BAR __builtin_amdgcn_s_barrier()
#define PG8_SCHED __builtin_amdgcn_sched_barrier(0)
    Unit cur, nxt; int ui = 0;
    if (!S.next(0, cur)) return;
    f32x4 acc[2][2][4][2];
#pragma unroll
    for (int a = 0; a < 2; ++a)
#pragma unroll
        for (int b = 0; b < 2; ++b)
#pragma unroll
            for (int m = 0; m < 4; ++m)
#pragma unroll
                for (int n = 0; n < 2; ++n) acc[a][b][m][n] = (f32x4){0.f, 0.f, 0.f, 0.f};
    pg8_v8i At[4], B0[2], B1[2]; const int f8_sw_ = F8SCALE * 0x01010101, f8_sa_ = 0x7f7f7f7f; (void)f8_sw_; (void)f8_sa_;
    const char* cA = (const char*)g.A + (size_t)cur.pm * tstep; const char* cB = (const char*)g.Bt + (size_t)cur.pn * tstep;
    S.a_ready(cur);
    if constexpr (SP2) {
        PG8_STAGE(PG8_SB(0, 0), cB, voffB); PG8_STAGE(PG8_SB(0, 1), cB + hstep, voffB); PG8_STAGE(PG8_SA(0, 0), cA, voffA); PG8_STAGE(PG8_SA(0, 1), cA + hstep, voffA);
        if (wr == 1) PG8_BAR;
        PG8_WAIT_V(2); PG8_BAR;
        PG8_STAGE(PG8_SB(1, 0), cB + kstep, voffB); PG8_STAGE(PG8_SA(1, 0), cA + kstep, voffA); PG8_STAGE(PG8_SB(1, 1), cB + hstep + kstep, voffB);
        PG8_WAIT_V(6); PG8_BAR;
    } else {
        PG8_STAGE(PG8_SB(0, 0), cB, voffB); PG8_STAGE(PG8_SA(0, 0), cA, voffA); PG8_STAGE(PG8_SB(0, 1), cB + hstep, voffB); PG8_STAGE(PG8_SA(0, 1), cA + hstep, voffA);
        if (wr == 1) PG8_BAR;
        PG8_WAIT_V(4); PG8_BAR;
        PG8_STAGE(PG8_SB(1, 0), cB + kstep, voffB); PG8_STAGE(PG8_SA(1, 0), cA + kstep, voffA); PG8_STAGE(PG8_SB(1, 1), cB + hstep + kstep, voffB);
        PG8_WAIT_V(6); PG8_BAR;
    }
    for (;;) {
        const bool has_next = S.next(ui + 1, nxt);
        const char* nA = has_next ? (const char*)g.A + (size_t)nxt.pm * tstep : cA; const char* nB = has_next ? (const char*)g.Bt + (size_t)nxt.pn * tstep : cB;
        for (int t = 0; t < nt; t += 2) {
            const bool last = (t == nt - 2);
            const char* a1 = cA + (size_t)(t + 1) * kstep;
            const char* a2 = last ? nA : cA + (size_t)(t + 2) * kstep; const char* b2 = last ? nB : cB + (size_t)(t + 2) * kstep;
            const char* a3 = a2 + kstep; const char* b3 = b2 + kstep;
            if (last && has_next) S.a_ready(nxt);
            if constexpr (SP2) {
            PG8_LDB(B0, 0, 0); PG8_LDB(B1, 0, 1); PG8_SCHED; PG8_LDA(At, 0, 0); PG8_STAGE(PG8_SA(1, 1), a1 + hstep, voffA);
            PG8_WAIT_V(8); PG8_WAIT_L(0); PG8_BAR; PG8_MMA(0, 0, At, B0); PG8_MMA(0, 1, At, B1); PG8_BAR; PG8_SCHED;
            PG8_LDA(At, 0, 1); PG8_STAGE(PG8_SB(0, 0), b2, voffB); PG8_STAGE(PG8_SB(0, 1), b2 + hstep, voffB); PG8_STAGE(PG8_SA(0, 0), a2, voffA);
            PG8_WAIT_V(8); PG8_WAIT_L(0); PG8_BAR; PG8_MMA(1, 0, At, B0); PG8_MMA(1, 1, At, B1); PG8_BAR; PG8_SCHED;
            PG8_LDB(B0, 1, 0); PG8_LDB(B1, 1, 1); PG8_SCHED; PG8_LDA(At, 1, 0); PG8_STAGE(PG8_SA(0, 1), a2 + hstep, voffA);
            PG8_WAIT_V(8); PG8_WAIT_L(0); PG8_BAR; PG8_MMA(0, 0, At, B0); PG8_MMA(0, 1, At, B1); PG8_BAR; PG8_SCHED;
            PG8_LDA(At, 1, 1); PG8_STAGE(PG8_SB(1, 0), b3, voffB); PG8_STAGE(PG8_SB(1, 1), b3 + hstep, voffB); PG8_STAGE(PG8_SA(1, 0), a3, voffA);
            PG8_WAIT_V(8); PG8_WAIT_L(0); PG8_BAR; PG8_MMA(1, 0, At, B0); PG8_MMA(1, 1, At, B1); PG8_BAR; PG8_SCHED;
            } else {
            PG8_LDB(B0, 0, 0); PG8_SCHED; PG8_LDA(At, 0, 0); PG8_STAGE(PG8_SA(1, 1), a1 + hstep, voffA);
            PG8_WAIT_L(8); PG8_BAR; PG8_WAIT_L(0); PG8_MMA(0, 0, At, B0); PG8_BAR; PG8_SCHED;
            PG8_LDB(B1, 0, 1); PG8_STAGE(PG8_SB(0, 0), b2, voffB);
            PG8_BAR; PG8_WAIT_L(0); PG8_MMA(0, 1, At, B1); PG8_BAR;
            PG8_LDA(At, 0, 1); PG8_STAGE(PG8_SA(0, 0), a2, voffA);
            PG8_BAR; PG8_WAIT_L(0); PG8_MMA(1, 0, At, B0); PG8_BAR; PG8_SCHED;
            PG8_STAGE(PG8_SB(0, 1), b2 + hstep, voffB);
            PG8_WAIT_V(6); PG8_BAR; PG8_MMA(1, 1, At, B1); PG8_BAR;
            PG8_LDB(B0, 1, 0); PG8_SCHED; PG8_LDA(At, 1, 0); PG8_STAGE(PG8_SA(0, 1), a2 + hstep, voffA);
            PG8_WAIT_L(8); PG8_BAR; PG8_WAIT_L(0); PG8_MMA(0, 0, At, B0); PG8_BAR; PG8_SCHED;
            PG8_LDB(B1, 1, 1); PG8_STAGE(PG8_SB(1, 0), b3, voffB);
            PG8_BAR; PG8_WAIT_L(0); PG8_MMA(0, 1, At, B1); PG8_BAR;
            PG8_LDA(At, 1, 1); PG8_STAGE(PG8_SA(1, 0), a3, voffA);
            PG8_BAR; PG8_WAIT_L(0); PG8_MMA(1, 0, At, B0); PG8_BAR; PG8_SCHED;
            PG8_STAGE(PG8_SB(1, 1), b3 + hstep, voffB);
            PG8_WAIT_V(6); PG8_BAR; PG8_MMA(1, 1, At, B1); PG8_BAR;
            }
        }
        if constexpr (ALIGN_EPI) { if (wr == 0) PG8_BAR; }
        if constexpr (!Epi::AFTER_DRAIN) { E(acc, cur, wr, wc, fr, fq); S.done(cur); }
        if (!has_next) break;
#pragma unroll
        for (int a = 0; a < 2; ++a)
#pragma unroll
            for (int b = 0; b < 2; ++b)
#pragma unroll
                for (int m = 0; m < 4; ++m)
#pragma unroll
                    for (int n = 0; n < 2; ++n) acc[a][b][m][n] = (f32x4){0.f, 0.f, 0.f, 0.f};
        cur = nxt; cA = nA; cB = nB; ++ui;
        if constexpr (ALIGN_EPI) { if (wr == 1) PG8_BAR; }
    }
    PG8_WAIT_V(0);
    if constexpr (!ALIGN_EPI) { if (wr == 0) PG8_BAR; }
    PG8_BAR;
    if constexpr (Epi::AFTER_DRAIN) { E.fused(acc, cur, wr, wc, fr, fq, lds, wid, lane); S.done(cur); }
#undef PG8_SA
#undef PG8_SB
#undef PG8_STAGE
#undef PG8_LDA
#undef PG8_LDB
#undef PG8_MMA
#undef PG8_WAIT_V
#undef PG8_WAIT_L
#undef PG8_BAR
#undef PG8_SCHED
}
}

#ifndef PG8_SP2
#define PG8_SP2 true
#endif
#ifndef PG8_ALIGN
#define PG8_ALIGN true
#endif
#define GAS __attribute__((address_space(1)))
#define LAS __attribute__((address_space(3)))
typedef unsigned short bf16;
typedef unsigned v4u __attribute__((ext_vector_type(4)));
typedef float f32x4 __attribute__((ext_vector_type(4)));
typedef short bf16x8 __attribute__((ext_vector_type(8)));
typedef GAS unsigned gu32;
typedef GAS unsigned long long gu64;
#define RLX_AGENT __ATOMIC_RELAXED, __HIP_MEMORY_SCOPE_AGENT
#define LDS_WAIT() asm volatile("s_waitcnt lgkmcnt(0)" ::: "memory")
#define VM_WAIT() asm volatile("s_waitcnt vmcnt(0)" ::: "memory")
__device__ __forceinline__ unsigned long long rt() { return __builtin_amdgcn_s_memrealtime(); }
__device__ __forceinline__ unsigned f2bf(float f) { return pg8::cvt_pk_bf16(f, f) & 0xffffu; }
__device__ __forceinline__ unsigned pk2(float lo, float hi) { return pg8::cvt_pk_bf16(lo, hi); }

#define XB_TMO      128
#define XB_XCNT(j)  (256  + 64 * (j))
#define XB_XSUB(j)  (1280 + 64 * (j))
#define XB_XGEN(j)  (2304 + 64 * (j))
#define XB_TOP      3328
#define XB_TOPGEN   3392
#define XCD_BAR_WORDS 3456
#define XB_SPIN_CAP (1u << 18)

__device__ __forceinline__ unsigned xb_ld(unsigned* p)              { return __hip_atomic_load(p, __ATOMIC_RELAXED, __HIP_MEMORY_SCOPE_AGENT); }
__device__ __forceinline__ unsigned xb_add(unsigned* p, unsigned v) { return __hip_atomic_fetch_add(p, v, __ATOMIC_RELAXED, __HIP_MEMORY_SCOPE_AGENT); }
__device__ __forceinline__ unsigned xb_xcc_id() { return (unsigned)__builtin_amdgcn_s_getreg((3 << 11) | 20) & 0xFu; }
#define XB_SPIN(cond, bar) do { unsigned _sp = 0; while (cond) { __builtin_amdgcn_s_sleep(1); \
    if ((++_sp & 255u) == 0u) { if (xb_ld(&(bar)[XB_TMO])) break; if (_sp > XB_SPIN_CAP) { atomicAdd(&(bar)[XB_TMO], 1u); break; } } } } while (0)

struct XcdBarrier {
    unsigned* bar; unsigned x;
    volatile LAS unsigned* st;
};

__device__ __forceinline__ XcdBarrier xcd_barrier_post(unsigned* bar, volatile LAS unsigned* st) {
    XcdBarrier b; b.bar = bar; b.x = xb_xcc_id(); b.st = st;
    if (threadIdx.x == 0) (void)xb_add(&bar[XB_XCNT(b.x)], 1u);
    return b;
}
__device__ __forceinline__ void xcd_barrier_complete(unsigned* bar, unsigned x, unsigned& nloc, unsigned& nx) {
    const unsigned G = gridDim.x * gridDim.y * gridDim.z;
    unsigned sum, cnt, mine, sp = 0u;
    for (;;) {
        sum = 0u; cnt = 0u; mine = 0u;
#pragma unroll
        for (unsigned j = 0; j < 16; ++j) { const unsigned c = xb_ld(&bar[XB_XCNT(j)]); sum += c; cnt += (c > 0u) ? 1u : 0u; mine = (j == x) ? c : mine; }
        if (sum == G) break;
        __builtin_amdgcn_s_sleep(1);
        if ((++sp & 255u) == 0u) { if (xb_ld(&bar[XB_TMO])) break; if (sp > XB_SPIN_CAP) { atomicAdd(&bar[XB_TMO], 1u); break; } }
    }
    nloc = mine > 0u ? mine : 1u; nx = cnt > 0u ? cnt : 1u;
}

__device__ __forceinline__ void xcd_barrier(const XcdBarrier& b) {
    asm volatile("s_waitcnt vmcnt(0)" ::: "memory");
    __syncthreads();
    if (threadIdx.x == 0) {
        unsigned* bar = b.bar;
        __builtin_amdgcn_s_waitcnt(0);
        unsigned nloc = b.st[0], nx = b.st[1];
        if (nloc == 0u) { xcd_barrier_complete(bar, b.x, nloc, nx); b.st[0] = nloc; b.st[1] = nx; }
        const unsigned old = xb_add(&bar[XB_XSUB(b.x)], 1u);
        const unsigned gen = old / nloc;
        if (old + 1u == (gen + 1u) * nloc) {
            __builtin_amdgcn_fence(__ATOMIC_RELEASE, "agent");
            asm volatile("s_waitcnt vmcnt(0)" ::: "memory");
            const unsigned og = xb_add(&bar[XB_TOP], 1u);
            const unsigned tg = og / nx;
            if (og + 1u == (tg + 1u) * nx) xb_add(&bar[XB_TOPGEN], 1u);
            else XB_SPIN(xb_ld(&bar[XB_TOPGEN]) == tg, bar);
            __builtin_amdgcn_fence(__ATOMIC_ACQUIRE, "agent");
            xb_add(&bar[XB_XGEN(b.x)], 1u);
            asm volatile("s_waitcnt vmcnt(0)" ::: "memory");
        } else {
            XB_SPIN(xb_ld(&bar[XB_XGEN(b.x)]) == gen, bar);
            __builtin_amdgcn_fence(__ATOMIC_ACQUIRE, "agent");
            asm volatile("s_waitcnt vmcnt(0)" ::: "memory");
        }
    }
    __syncthreads();
}

constexpr int NWAVES = 8;
constexpr int T = 16384, D = 2048, NIN = 11264;
constexpr float LN_EPS = 1e-5f, GN_EPS = 64e-5f, ALPHA = 1.189207115002721f;
constexpr size_t MiB = 1u << 20;
constexpr size_t WS_CTL = 0, CTL_ZERO_BYTES = 1 * MiB;
constexpr size_t WS_WIN = 1 * MiB, WS_WUA = 45 * MiB, WS_WUB = 49 * MiB, WS_WO = 53 * MiB, WS_WQ = 61 * MiB, WS_WPG = 69 * MiB, WS_WPE = 77 * MiB;
constexpr size_t WS_L1 = 78 * MiB;
constexpr size_t WS_L2 = 79 * MiB + MiB / 2;
constexpr size_t WS_PB = 81 * MiB;
constexpr size_t WS_XB = 90 * MiB;
constexpr size_t WS_PROJ = 154 * MiB;
constexpr size_t WS_Q = WS_PROJ, WS_K = WS_PROJ + 32 * MiB, WS_V = WS_PROJ + 64 * MiB, WS_RR = WS_PROJ + 96 * MiB, WS_RK = WS_PROJ + 128 * MiB, WS_RV = WS_PROJ + 160 * MiB, WS_RC = WS_PROJ + 192 * MiB;
constexpr size_t WS_YB = WS_RK;
constexpr size_t WS_QC = WS_Q, WS_GTC = WS_K, WS_YLC = WS_V, WS_TTC = WS_RC, WS_SB = WS_XB + 32 * MiB;
constexpr size_t WS_YRAW = WS_K;
constexpr size_t WS_GG = 522 * MiB;
constexpr size_t WS_DREG = 378 * MiB;
constexpr size_t WS_HID = WS_DREG;
constexpr size_t WS_XW = WS_DREG + 24 * MiB;
constexpr size_t WS_LW = WS_DREG;
constexpr size_t WS_AA = WS_DREG + 64 * MiB;
constexpr size_t WS_GATE = WS_DREG;
constexpr size_t WS_MIX = WS_XB, WS_PQ = WS_XB;
constexpr size_t WS_MIX8 = WS_Q;
constexpr size_t WS_X1B8 = 378 * MiB;
constexpr size_t WS_H1 = 186 * MiB;
constexpr size_t WS_X1 = 314 * MiB;
constexpr size_t WS_X1B = 442 * MiB;
constexpr size_t WS_PE = 154 * MiB;
constexpr size_t WS_YA = 506 * MiB;
constexpr size_t WS_IDX = 506 * MiB, WS_PG = 514 * MiB;
constexpr size_t WS_UB = 314 * MiB, WS_VB = 346 * MiB;
constexpr float U_SCALE = 64.0f, V_SCALE = 2.0f;
constexpr int ROW6 = 1536;
constexpr size_t WS_RKC = 538 * MiB;
constexpr size_t WS_END = 539 * MiB;
constexpr int CW_BAR = 4096, CW_RCNT = 16384;
constexpr int RING_OFF = 0, RING_BYTES = 131072, LDSCTL_OFF = RING_BYTES, MISC_OFF = LDSCTL_OFF + 320, LDS_BYTES = 147456;
constexpr int NPHASE = 13;
#ifndef MK_ONE_LAUNCH
#define MK_ONE_LAUNCH 0
#endif

struct Frame {
    LAS unsigned char* lds; volatile LAS unsigned* MISC; gu32* ctl;
    int tid, lane, wave, vcu, G;
};
template <int CTRL> __device__ __forceinline__ float dpp_addc(float x) { return x + __builtin_bit_cast(float, __builtin_amdgcn_mov_dpp(__builtin_bit_cast(int, x), CTRL, 0xf, 0xf, true)); }
__device__ __forceinline__ float row16_sum(float x) { x = dpp_addc<0xB1>(x); x = dpp_addc<0x4E>(x); x = dpp_addc<0x141>(x); x = dpp_addc<0x140>(x); return x; }
__device__ __forceinline__ float wave_sum(float v) {
    v = row16_sum(v);
    const float a = __builtin_bit_cast(float, __builtin_amdgcn_readlane(__builtin_bit_cast(int, v), 0)), b = __builtin_bit_cast(float, __builtin_amdgcn_readlane(__builtin_bit_cast(int, v), 16));
    const float c = __builtin_bit_cast(float, __builtin_amdgcn_readlane(__builtin_bit_cast(int, v), 32)), d = __builtin_bit_cast(float, __builtin_amdgcn_readlane(__builtin_bit_cast(int, v), 48));
    return (a + b) + (c + d);
}
__device__ __forceinline__ float wave_max(float v) {
#pragma unroll
    for (int o = 1; o < 64; o <<= 1) v = fmaxf(v, __shfl_xor(v, o));
    return v;
}
__device__ __forceinline__ float bflo(unsigned w) { return __uint_as_float(w << 16); }
__device__ __forceinline__ float bfhi(unsigned w) { return __uint_as_float(w & 0xffff0000u); }
__device__ __forceinline__ float bf1(bf16 b) { return __uint_as_float(((unsigned)b) << 16); }
typedef __attribute__((ext_vector_type(2))) __bf16 bf16x2_t;
typedef float f32x16 __attribute__((ext_vector_type(16)));
__device__ __forceinline__ float dot2(unsigned a, unsigned b, float c) { return __builtin_amdgcn_fdot2_f32_bf16(__builtin_bit_cast(bf16x2_t, a), __builtin_bit_cast(bf16x2_t, b), c, false); }
__device__ __forceinline__ float rdlane(float v, int l) { return __builtin_bit_cast(float, __builtin_amdgcn_readlane(__builtin_bit_cast(int, v), l)); }
__device__ __forceinline__ int rdlanei(int v, int l) { return __builtin_amdgcn_readlane(v, l); }

__device__ __forceinline__ void p0_transpose_item(const float* W, int K, int N, bf16* WT, LAS float* scr, int item, int lane) {
    const int nblk = N / 32, kb = item / nblk, nb = item % nblk, k0 = 64 * kb, n0 = 32 * nb;
#pragma unroll 8
    for (int i = 0; i < 32; ++i) { const int kk = 2 * i + (lane >> 5); scr[kk * 33 + (lane & 31)] = W[(size_t)(k0 + kk) * N + n0 + (lane & 31)]; }
    LDS_WAIT(); asm volatile("" ::: "memory");
    const int c = lane & 7;
#pragma unroll
    for (int j = 0; j < 4; ++j) { const int n = (lane >> 3) + 8 * j; const LAS float* s = scr + (8 * c) * 33 + n;
        v4u o; o.x = pk2(s[0 * 33], s[1 * 33]); o.y = pk2(s[2 * 33], s[3 * 33]); o.z = pk2(s[4 * 33], s[5 * 33]); o.w = pk2(s[6 * 33], s[7 * 33]);
        *(GAS v4u*)(WT + (size_t)(n0 + n) * K + k0 + 8 * c) = o; }
    LDS_WAIT(); asm volatile("" ::: "memory");
}
__device__ __forceinline__ void p0_transpose_item8(const float* W, int K, int N, unsigned char* WT, float scale, LAS float* scr, int item, int lane) {
    const int nblk = N / 32, kb = item / nblk, nb = item % nblk, k0 = 64 * kb, n0 = 32 * nb;
#pragma unroll 8
    for (int i = 0; i < 32; ++i) { const int kk = 2 * i + (lane >> 5); scr[kk * 33 + (lane & 31)] = W[(size_t)(k0 + kk) * N + n0 + (lane & 31)] * scale; }
    LDS_WAIT(); asm volatile("" ::: "memory");
    const int c = lane & 7;
#pragma unroll
    for (int j = 0; j < 4; ++j) { const int n = (lane >> 3) + 8 * j; const LAS float* s = scr + (8 * c) * 33 + n;
        int w0_ = 0, w1_ = 0; w0_ = __builtin_amdgcn_cvt_pk_fp8_f32(s[0 * 33], s[1 * 33], w0_, false); w0_ = __builtin_amdgcn_cvt_pk_fp8_f32(s[2 * 33], s[3 * 33], w0_, true);
        w1_ = __builtin_amdgcn_cvt_pk_fp8_f32(s[4 * 33], s[5 * 33], w1_, false); w1_ = __builtin_amdgcn_cvt_pk_fp8_f32(s[6 * 33], s[7 * 33], w1_, true);
        *(GAS unsigned long long*)(WT + (size_t)(n0 + n) * K + k0 + 8 * c) = (unsigned long long)(unsigned)w0_ | ((unsigned long long)(unsigned)w1_ << 32); }
    LDS_WAIT(); asm volatile("" ::: "memory");
}
__device__ __forceinline__ void cvt_rows_bf16(const float* src, bf16* dst, size_t n8, size_t i0, size_t stride) {
    for (size_t i = i0; i < n8; i += stride) { const f32x4 a = ((const GAS f32x4*)src)[2 * i], b = ((const GAS f32x4*)src)[2 * i + 1];
        v4u o; o.x = pk2(a.x, a.y); o.y = pk2(a.z, a.w); o.z = pk2(b.x, b.y); o.w = pk2(b.z, b.w); ((GAS v4u*)dst)[i] = o; }
}


typedef short v4i16_t __attribute__((ext_vector_type(4)));
constexpr int RW_PIT = 144, RW_SLOT = 64 * RW_PIT;
__device__ __forceinline__ bf16x8 rw_fd(const LAS unsigned char* img, int r0, int ks, int idx, int g) { return *(const LAS bf16x8*)(img + (r0 + idx) * RW_PIT + (32 * ks + 8 * g) * 2); }
__device__ __forceinline__ bf16x8 rw_ft(const LAS unsigned char* img, int c0, int ks, int idx, int g) {
    const LAS unsigned char* a = img + (32 * ks + 8 * g + (idx >> 2)) * RW_PIT + (c0 + 4 * (idx & 3)) * 2;
    const v4i16_t lo = __builtin_amdgcn_ds_read_tr16_b64_v4i16((LAS v4i16_t*)a), hi = __builtin_amdgcn_ds_read_tr16_b64_v4i16((LAS v4i16_t*)(a + 4 * RW_PIT));
    return __builtin_shufflevector(lo, hi, 0, 1, 2, 3, 4, 5, 6, 7); }
template <int MX, int MY> __device__ __forceinline__ void rw_mm2(const LAS unsigned char* X, const LAS unsigned char* Y, int mt, int ntb, f32x4& c0, f32x4& c1, int idx, int g) {
#pragma unroll
    for (int ks = 0; ks < 2; ++ks) {
        const bf16x8 a = MX ? rw_ft(X, 16 * mt, ks, idx, g) : rw_fd(X, 16 * mt, ks, idx, g);
        const bf16x8 b0 = MY ? rw_ft(Y, 16 * ntb, ks, idx, g) : rw_fd(Y, 16 * ntb, ks, idx, g);
        const bf16x8 b1 = MY ? rw_ft(Y, 16 * ntb + 16, ks, idx, g) : rw_fd(Y, 16 * ntb + 16, ks, idx, g);
        c0 = __builtin_amdgcn_mfma_f32_16x16x32_bf16(a, b0, c0, 0, 0, 0); c1 = __builtin_amdgcn_mfma_f32_16x16x32_bf16(a, b1, c1, 0, 0, 0); }
}
template <int MX, int MY, int MZ> __device__ __forceinline__ void rw_mm2_shareA(const LAS unsigned char* X, const LAS unsigned char* Y, const LAS unsigned char* Z, int mt, int ntb, f32x4& c0, f32x4& c1, f32x4& d0, f32x4& d1, int idx, int g) {
#pragma unroll
    for (int ks = 0; ks < 2; ++ks) {
        const bf16x8 a = MX ? rw_ft(X, 16 * mt, ks, idx, g) : rw_fd(X, 16 * mt, ks, idx, g);
        const bf16x8 y0 = MY ? rw_ft(Y, 16 * ntb, ks, idx, g) : rw_fd(Y, 16 * ntb, ks, idx, g), y1 = MY ? rw_ft(Y, 16 * ntb + 16, ks, idx, g) : rw_fd(Y, 16 * ntb + 16, ks, idx, g);
        const bf16x8 z0 = MZ ? rw_ft(Z, 16 * ntb, ks, idx, g) : rw_fd(Z, 16 * ntb, ks, idx, g), z1 = MZ ? rw_ft(Z, 16 * ntb + 16, ks, idx, g) : rw_fd(Z, 16 * ntb + 16, ks, idx, g);
        c0 = __builtin_amdgcn_mfma_f32_16x16x32_bf16(a, y0, c0, 0, 0, 0); c1 = __builtin_amdgcn_mfma_f32_16x16x32_bf16(a, y1, c1, 0, 0, 0);
        d0 = __builtin_amdgcn_mfma_f32_16x16x32_bf16(a, z0, d0, 0, 0, 0); d1 = __builtin_amdgcn_mfma_f32_16x16x32_bf16(a, z1, d1, 0, 0, 0); }
}
template <int MX, int MW, int MY> __device__ __forceinline__ void rw_mm2_shareB(const LAS unsigned char* X, const LAS unsigned char* W, const LAS unsigned char* Y, int mt, int ntb, f32x4& c0, f32x4& c1, f32x4& d0, f32x4& d1, int idx, int g) {
#pragma unroll
    for (int ks = 0; ks < 2; ++ks) {
        const bf16x8 a = MX ? rw_ft(X, 16 * mt, ks, idx, g) : rw_fd(X, 16 * mt, ks, idx, g), w = MW ? rw_ft(W, 16 * mt, ks, idx, g) : rw_fd(W, 16 * mt, ks, idx, g);
        const bf16x8 y0 = MY ? rw_ft(Y, 16 * ntb, ks, idx, g) : rw_fd(Y, 16 * ntb, ks, idx, g), y1 = MY ? rw_ft(Y, 16 * ntb + 16, ks, idx, g) : rw_fd(Y, 16 * ntb + 16, ks, idx, g);
        c0 = __builtin_amdgcn_mfma_f32_16x16x32_bf16(a, y0, c0, 0, 0, 0); c1 = __builtin_amdgcn_mfma_f32_16x16x32_bf16(a, y1, c1, 0, 0, 0);
        d0 = __builtin_amdgcn_mfma_f32_16x16x32_bf16(w, y0, d0, 0, 0, 0); d1 = __builtin_amdgcn_mfma_f32_16x16x32_bf16(w, y1, d1, 0, 0, 0); }
}
#define RW_FR(M, img, r0, ks) ((M) ? rw_ft(img, r0, ks, idx, g) : rw_fd(img, r0, ks, idx, g))
#define RW_MF(a, b, c) c = __builtin_amdgcn_mfma_f32_16x16x32_bf16(a, b, c, 0, 0, 0)
template <int MX, int MY> __device__ __forceinline__ void rw_mm22(const LAS unsigned char* X, const LAS unsigned char* Y, int mt0, int nt0, f32x4 (&c)[2][2], int idx, int g, bool k0 = true, bool k1 = true) {
#pragma unroll
    for (int ks = 0; ks < 2; ++ks) if (ks == 0 ? k0 : k1) { const bf16x8 a0 = RW_FR(MX, X, 16 * mt0, ks), a1 = RW_FR(MX, X, 16 * mt0 + 16, ks), b0 = RW_FR(MY, Y, 16 * nt0, ks), b1 = RW_FR(MY, Y, 16 * nt0 + 16, ks);
        RW_MF(a0, b0, c[0][0]); RW_MF(a0, b1, c[0][1]); RW_MF(a1, b0, c[1][0]); RW_MF(a1, b1, c[1][1]); }
}
template <int MX, int MY, int MZ> __device__ __forceinline__ void rw_mm22_shareA(const LAS unsigned char* X, const LAS unsigned char* Y, const LAS unsigned char* Z, int mt0, int nt0, f32x4 (&c)[2][2], f32x4 (&d)[2][2], int idx, int g, bool cy1 = true) {
#pragma unroll
    for (int ks = 0; ks < 2; ++ks) { const bf16x8 a0 = RW_FR(MX, X, 16 * mt0, ks), a1 = RW_FR(MX, X, 16 * mt0 + 16, ks), z0 = RW_FR(MZ, Z, 16 * nt0, ks), z1 = RW_FR(MZ, Z, 16 * nt0 + 16, ks);
        if (ks == 0 || cy1) { const bf16x8 y0 = RW_FR(MY, Y, 16 * nt0, ks), y1 = RW_FR(MY, Y, 16 * nt0 + 16, ks); RW_MF(a0, y0, c[0][0]); RW_MF(a0, y1, c[0][1]); RW_MF(a1, y0, c[1][0]); RW_MF(a1, y1, c[1][1]); }
        RW_MF(a0, z0, d[0][0]); RW_MF(a0, z1, d[0][1]); RW_MF(a1, z0, d[1][0]); RW_MF(a1, z1, d[1][1]); }
}
template <int MX, int MW, int MY> __device__ __forceinline__ void rw_mm22_shareB(const LAS unsigned char* X, const LAS unsigned char* W, const LAS unsigned char* Y, int mt0, int nt0, f32x4 (&c)[2][2], f32x4 (&d)[2][2], int idx, int g, bool cx0 = true, bool cx1 = true, bool dw0 = true) {
#pragma unroll
    for (int ks = 0; ks < 2; ++ks) { const bool cx = ks == 0 ? cx0 : cx1, dw = ks == 0 ? dw0 : true;
        if (cx || dw) { const bf16x8 y0 = RW_FR(MY, Y, 16 * nt0, ks), y1 = RW_FR(MY, Y, 16 * nt0 + 16, ks);
            if (cx) { const bf16x8 a0 = RW_FR(MX, X, 16 * mt0, ks), a1 = RW_FR(MX, X, 16 * mt0 + 16, ks); RW_MF(a0, y0, c[0][0]); RW_MF(a0, y1, c[0][1]); RW_MF(a1, y0, c[1][0]); RW_MF(a1, y1, c[1][1]); }
            if (dw) { const bf16x8 w0 = RW_FR(MW, W, 16 * mt0, ks), w1 = RW_FR(MW, W, 16 * mt0 + 16, ks); RW_MF(w0, y0, d[0][0]); RW_MF(w0, y1, d[0][1]); RW_MF(w1, y0, d[1][0]); RW_MF(w1, y1, d[1][1]); } } }
}
__device__ __forceinline__ void rw_st(LAS unsigned char* E, int mt, int nt, const f32x4& c, int idx, int g) {
    *(LAS unsigned long long*)(E + (16 * nt + idx) * RW_PIT + (16 * mt + 4 * g) * 2) = (unsigned long long)pk2(c[0], c[1]) | ((unsigned long long)pk2(c[2], c[3]) << 32); }
__device__ __forceinline__ f32x4 rw_ld(const LAS unsigned char* E, int mt, int nt, int idx, int g) {
    const unsigned long long w = *(const LAS unsigned long long*)(E + (16 * nt + idx) * RW_PIT + (16 * mt + 4 * g) * 2); const unsigned lo = (unsigned)w, hi = (unsigned)(w >> 32);
    return (f32x4){bflo(lo), bfhi(lo), bflo(hi), bfhi(hi)}; }
__device__ __forceinline__ void rw_stg_wt(bf16* E, int mt, int nt, const f32x4& c, int idx, int g) {
    __hip_atomic_store((gu64*)(E + (16 * nt + idx) * 64 + 16 * mt + 4 * g), (unsigned long long)pk2(c[0], c[1]) | ((unsigned long long)pk2(c[2], c[3]) << 32), RLX_AGENT); }
__device__ __forceinline__ void rw_stg(bf16* E, int mt, int nt, const f32x4& c, int idx, int g) {
    *(GAS unsigned long long*)(E + (16 * nt + idx) * 64 + 16 * mt + 4 * g) = (unsigned long long)pk2(c[0], c[1]) | ((unsigned long long)pk2(c[2], c[3]) << 32); }

__device__ __forceinline__ void bitonic_merge16_desc(float (&v)[16]) {
#pragma unroll
    for (int j = 8; j > 0; j >>= 1)
#pragma unroll
        for (int i = 0; i < 16; ++i) { const int l = i ^ j; if (l > i) { const float hi = fmaxf(v[i], v[l]), lo = fminf(v[i], v[l]); v[i] = hi; v[l] = lo; } }
}
__device__ __forceinline__ void bitonic_sort16_desc(float (&v)[16]) {
#pragma unroll
    for (int k = 2; k <= 16; k <<= 1)
#pragma unroll
        for (int j = k >> 1; j > 0; j >>= 1)
#pragma unroll
            for (int i = 0; i < 16; ++i) { const int l = i ^ j; if (l > i) { const float hi = fmaxf(v[i], v[l]), lo = fminf(v[i], v[l]); const bool desc = (i & k) == 0; v[i] = desc ? hi : lo; v[l] = desc ? lo : hi; } }
}
__device__ __forceinline__ void top16_merge_desc(float (&a)[16], const float (&b)[16]) {
#pragma unroll
    for (int i = 0; i < 16; ++i) a[i] = fmaxf(a[i], b[15 - i]);
    bitonic_merge16_desc(a);
}

#ifndef P4_VARIANT
#define P4_VARIANT 0
#endif
#ifndef P4_ALIGN
#define P4_ALIGN PG8_ALIGN
#endif
#ifndef P4_SP2
#define P4_SP2 PG8_SP2
#endif
#ifndef DIAG_TOL
#define DIAG_TOL 0.03f
#endif
#ifndef REPEAT_SUB
#define REPEAT_SUB 0
#endif
#ifndef REPEAT_PHASE
#define REPEAT_PHASE -1
#endif
#define REP_BEGIN(k) for (int rep_ = 0; rep_ < ((REPEAT_PHASE) == (k) ? 2 : 1); ++rep_) {
#define REP_END(k) if ((REPEAT_PHASE) == (k) && rep_ == 0) xcd_barrier(bar); }
#ifndef DIAG_RATIO
#define DIAG_RATIO 2.0
#endif
#ifndef DIAG_UNIT_MS
#define DIAG_UNIT_MS 10
#endif
#ifndef DIAG_LAST
#define DIAG_LAST -1
#endif
template <class TT_> __device__ __forceinline__ float dg_val(const TT_* p, size_t i);
template <> __device__ __forceinline__ float dg_val<float>(const float* p, size_t i) { return p[i]; }
template <> __device__ __forceinline__ float dg_val<bf16>(const bf16* p, size_t i) { return bf1(p[i]); }
template <> __device__ __forceinline__ float dg_val<int>(const int* p, size_t i) { return (float)p[i] * (1.0f / 1024.0f); }
template <class TT_> __device__ __forceinline__ void digest(float* out, int slot, const TT_* buf, size_t n, size_t gt, size_t NGT) {
    constexpr size_t M = (size_t)1024 * 2048;
    for (size_t e = gt; e < M; e += NGT) { float s = 0.f; for (size_t j = e; j < n; j += M) s += dg_val<TT_>(buf, j); out[(size_t)slot * M + e] = s; }
}

__device__ __forceinline__ void cvt_rows_fp8(const float* src, unsigned char* dst, size_t n16, float scale, size_t i0, size_t stride) {
    for (size_t i = i0; i < n16; i += stride) { v4u o;
#pragma unroll
        for (int q = 0; q < 4; ++q) { const f32x4 a = ((const GAS f32x4*)src)[4 * i + q] * scale; int w = 0; w = __builtin_amdgcn_cvt_pk_fp8_f32(a.x, a.y, w, false); w = __builtin_amdgcn_cvt_pk_fp8_f32(a.z, a.w, w, true); o[q] = (unsigned)w; }
        ((GAS v4u*)dst)[i] = o; }
}

typedef unsigned v16u_t __attribute__((ext_vector_type(16))); typedef float v32f_t __attribute__((ext_vector_type(32))); typedef float v16f_t __attribute__((ext_vector_type(16))); typedef unsigned v6u_t __attribute__((ext_vector_type(6)));
__device__ __forceinline__ void cvt_rows_fp6(const float* src, unsigned char* dst, int nrows, float scale, int gw, int ngw, int lane) {
    for (int row = gw; row < nrows; row += ngw) { v16f_t a, b;
#pragma unroll
        for (int q = 0; q < 8; ++q) { const f32x4 v = *(const GAS f32x4*)(src + (size_t)row * 2048 + 256 * q + 4 * lane) * scale; a[2 * q] = v.x; b[2 * q] = v.y; a[2 * q + 1] = v.z; b[2 * q + 1] = v.w; }
        const v6u_t p = __builtin_amdgcn_cvt_scalef32_2xpk16_fp6_f32(a, b, 1.0f); GAS unsigned long long* d = (GAS unsigned long long*)(dst + (size_t)row * 1536 + 24 * lane);
        d[0] = (unsigned long long)p[0] | ((unsigned long long)p[1] << 32); d[1] = (unsigned long long)p[2] | ((unsigned long long)p[3] << 32); d[2] = (unsigned long long)p[4] | ((unsigned long long)p[5] << 32); }
}
__device__ __forceinline__ v32f_t ld_fp6x32(const unsigned char* p) { const GAS unsigned long long* q = (const GAS unsigned long long*)p; const unsigned long long w0 = q[0], w1 = q[1], w2 = q[2];
    const v6u_t v = {(unsigned)w0, (unsigned)(w0 >> 32), (unsigned)w1, (unsigned)(w1 >> 32), (unsigned)w2, (unsigned)(w2 >> 32)}; return __builtin_amdgcn_cvt_scalef32_pk32_f32_fp6(v, 1.0f); }

struct Args { const float* in[30]; float* out; unsigned char* ws; int ph_lo, ph_hi, li, pad; };

__global__ void __launch_bounds__(NWAVES * 64, 2) mk_fwd(Args args) {
    extern __shared__ __attribute__((aligned(16))) unsigned char lds[];
    for (int u = threadIdx.x; u < (LDS_BYTES - LDSCTL_OFF) / 4; u += NWAVES * 64) ((LAS unsigned*)((LAS unsigned char*)lds + LDSCTL_OFF))[u] = 0u;
    __syncthreads();
    XcdBarrier bar; bar.bar = (unsigned*)(args.ws + WS_CTL) + CW_BAR; bar.x = 0; bar.st = nullptr;
    if (MK_ONE_LAUNCH) bar = xcd_barrier_post((unsigned*)(args.ws + WS_CTL) + CW_BAR, (volatile LAS unsigned*)((LAS unsigned char*)lds + MISC_OFF) + 8);
    const int lo = args.ph_lo, hi = args.ph_hi;
#ifdef DIAG_TIME
    if (blockIdx.x == 0 && threadIdx.x == 0) { const unsigned long long t0_ = __builtin_amdgcn_s_memrealtime(); ((unsigned long long*)(args.ws + WS_CTL))[8] = t0_; }
#endif
#ifndef PHMASK
#define PHMASK 0xffffffffu
#endif
#define IN(k) (((PHMASK >> (k)) & 1u) && lo <= (k) && (k) < hi)
#define SEAM(k) do { if (IN(k) && IN((k) + 1)) xcd_barrier(bar); } while (0)
#define LOCALS const int tid = threadIdx.x, lane = tid & 63, wave = __builtin_amdgcn_readfirstlane(tid >> 6); const int G_ = gridDim.x, bx_ = blockIdx.x, vcu = (G_ % 8 == 0) ? (bx_ % 8) * (G_ / 8) + bx_ / 8 : bx_; \
    const int gw = vcu * NWAVES + wave, NGW = G_ * NWAVES; const size_t gt = (size_t)vcu * 512 + tid, NGT = (size_t)G_ * 512; (void)lane; (void)gw; (void)NGW; (void)gt; (void)NGT;
#define LDSP ((LAS unsigned char*)lds)
#define x_in (args.in[0])
#define p_in (args.in[1])
#define w_in (args.in[2])
#define mu (args.in[3])
#define w0 (args.in[4])
#define wl1 (args.in[5])
#define wl2 (args.in[6])
#define a0 (args.in[7])
#define al1 (args.in[8])
#define al2 (args.in[9])
#define gl1 (args.in[10])
#define gl2 (args.in[11])
#define k_k (args.in[12])
#define k_a (args.in[13])
#define r_k (args.in[14])
#define lnx_w (args.in[15])
#define lnx_b (args.in[16])
#define w_up_a (args.in[17])
#define w_up_b (args.in[18])
#define w_o (args.in[19])
#define ln1_w (args.in[20])
#define ln1_b (args.in[21])
#define peer_wq (args.in[22])
#define sub_keys (args.in[23])
#define peer_u (args.in[24])
#define peer_v (args.in[25])
#define ple_wg (args.in[26])
#define ple_wp (args.in[27])
#define ln2_w (args.in[28])
#define ln2_b (args.in[29])
#define WIN_T ((bf16*)(args.ws + WS_WIN))
#define WUA_T ((bf16*)(args.ws + WS_WUA))
#define WUB_T ((bf16*)(args.ws + WS_WUB))
#define WO_T ((bf16*)(args.ws + WS_WO))
#define WQ_T ((bf16*)(args.ws + WS_WQ))
#define WPG_T ((bf16*)(args.ws + WS_WPG))
#define WPE_T ((bf16*)(args.ws + WS_WPE))
#define L1_T ((bf16*)(args.ws + WS_L1))
#define L2_T ((bf16*)(args.ws + WS_L2))
#define PB ((bf16*)(args.ws + WS_PB))
#define XB ((bf16*)(args.ws + WS_XB))
#define QB ((bf16*)(args.ws + WS_Q))
#define KB ((bf16*)(args.ws + WS_K))
#define VB ((bf16*)(args.ws + WS_V))
#define RR ((bf16*)(args.ws + WS_RR))
#define RK ((bf16*)(args.ws + WS_RK))
#define RV ((bf16*)(args.ws + WS_RV))
#define RC ((bf16*)(args.ws + WS_RC))
#define YA ((bf16*)(args.ws + WS_YA))
#define YB ((bf16*)(args.ws + WS_YB))
#define YRAW ((float*)(args.ws + WS_YRAW))
#define QC ((bf16*)(args.ws + WS_QC))
#define GTC ((bf16*)(args.ws + WS_GTC))
#define YLC ((bf16*)(args.ws + WS_YLC))
#define TTC ((bf16*)(args.ws + WS_TTC))
#define SBF ((bf16*)(args.ws + WS_SB))
#define MIX8 ((unsigned char*)(args.ws + WS_MIX8))
#define X1B8 ((unsigned char*)(args.ws + WS_X1B8))
#define UB ((unsigned char*)(args.ws + WS_UB))
#define VB2 ((unsigned char*)(args.ws + WS_VB))
#define GG ((bf16*)(args.ws + WS_GG))
#define HID ((bf16*)(args.ws + WS_HID))
#define XW ((bf16*)(args.ws + WS_XW))
#define LW ((float*)(args.ws + WS_LW))
#define AA ((bf16*)(args.ws + WS_AA))
#define GATE ((bf16*)(args.ws + WS_GATE))
#define MIX ((bf16*)(args.ws + WS_MIX))
#define PQ ((bf16*)(args.ws + WS_PQ))
#define H1 ((float*)(args.ws + WS_H1))
#define X1 ((float*)(args.ws + WS_X1))
#define X1B ((bf16*)(args.ws + WS_X1B))
#define PE ((bf16*)(args.ws + WS_PE))
#define IDX ((int*)(args.ws + WS_IDX))
#define PG ((float*)(args.ws + WS_PG))
#define RKC ((float*)(args.ws + WS_RKC))
    if (IN(0)) {
        LOCALS
        LAS float* scr = (LAS float*)(LDSP + RING_OFF + wave * 16384);
        constexpr int I_IN = (D / 64) * (NIN / 32), I_UA = (1024 / 64) * (D / 32), I_SQ = (D / 64) * (D / 32), I_PE = (256 / 64) * (D / 32);
        for (int it = gw; it < I_IN; it += NGW) p0_transpose_item8(w_in, D, NIN, (unsigned char*)WIN_T, 32.0f, scr, it, lane);
        for (size_t i = gt; i < (size_t)2 * 294912; i += NGT) {
            if (i < 294912) { const int j = (int)(i & 7), ln = (int)(i >> 3) & 63, ks = (int)(i >> 9) & 63, m = (int)(i >> 15); const int row = m * 32 + (ln & 31), col = ks * 16 + 8 * (ln >> 5) + j;
                const float v = row < 64 ? wl1[(size_t)col * 64 + row] : (row < 128 ? al1[(size_t)col * 64 + (row - 64)] : gl1[(size_t)col * 160 + (row - 128)]);
                L1_T[i] = (bf16)f2bf(v); }
            else { const int e = (int)(i - 294912); float v;
                if (e < 131072) { const int e2 = e & 65535, jj = e2 & 7, ln = (e2 >> 3) & 63, sx = (e2 >> 9) & 3, ct = e2 >> 11; const int c = ct * 32 + (ln & 31), jh = 16 * sx + 8 * (jj >> 2) + 4 * (ln >> 5) + (jj & 3);
                    v = (e < 65536 ? wl2 : al2)[(size_t)jh * 1024 + c]; }
                else { const int e2 = e - 131072, jj = e2 & 7, ln = (e2 >> 3) & 63, rest = e2 >> 9, sx = rest % 10, ct = rest / 10; const int c = ct * 32 + (ln & 31), jh = 16 * sx + 8 * (jj >> 2) + 4 * (ln >> 5) + (jj & 3);
                    v = gl2[(size_t)jh * 1024 + c]; }
                L2_T[e] = (bf16)f2bf(v); }
        }
        cvt_rows_fp8(x_in, (unsigned char*)XB, (size_t)T * D / 16, 1.0f, gt, NGT);
    }
    SEAM(0);
    if (IN(1)) {
        LOCALS
        REP_BEGIN(1)
        pg8::Gemm g{XB, WIN_T, T, 7168, D / 2}; pg8::StaticOrder S; S.init(T, 7168, (int)gridDim.x, (int)blockIdx.x);
        pg8::EpiB16<pg8::FnProj> E{{QB}};
        pg8::gemm_phase<pg8::EpiB16<pg8::FnProj>, pg8::StaticOrder, PG8_ALIGN, PG8_SP2, 122>(LDSP + RING_OFF, g, S, E);
        REP_END(1)
    }
    SEAM(1);
    if (IN(2)) {
        LOCALS
        REP_BEGIN(2)
#ifdef P2_SPLIT
        { volatile LAS unsigned* lb = (volatile LAS unsigned*)(LDSP + RING_OFF + 130048);
          volatile LAS unsigned* aq = lb + 1;
          if (tid < 4) lb[tid] = 0u;
          __syncthreads();
#define LB4() { asm volatile("s_waitcnt lgkmcnt(0)" ::: "memory"); lbe += 4u; if (lane == 0) __hip_atomic_fetch_add((LAS unsigned*)(LDSP + RING_OFF + 130048), 1u, __ATOMIC_RELAXED, __HIP_MEMORY_SCOPE_WORKGROUP); while ((unsigned)__builtin_amdgcn_readfirstlane((int)*lb) < lbe) __builtin_amdgcn_s_sleep(0); asm volatile("" ::: "memory"); }
          if (wave >= 4) {
        {
            typedef unsigned long long u64;
            LAS unsigned char* hl = LDSP + RING_OFF + 73728;
            LAS unsigned char* cst = LDSP + RING_OFF;
            const int w4 = wave & 3, n = lane & 31, h = lane >> 5; unsigned lbe = 0u;
            const int m0 = w4 == 0 ? 0 : (w4 == 1 ? 2 : (w4 == 2 ? 4 : 7)), cnt = w4 == 2 ? 3 : 2, xsel = w4 < 2 ? w4 : 2;
            { const int pair = (int)blockIdx.x;
                const int tb = 64 * pair;
                f32x16 Ca[3], Cb[3];
#pragma unroll
                for (int m = 0; m < 3; ++m)
#pragma unroll
                    for (int i = 0; i < 16; ++i) { Ca[m][i] = 0.f; Cb[m][i] = 0.f; }
#pragma unroll 1
                for (int kh = 0; kh < 2; ++kh) {
                    for (int i = tid - 256; i < 65 * 64; i += 256) { const int row = i >> 6, c16 = i & 63; const int tr = tb - 1 + row;
                        const v4u v = tr >= 0 ? *(const GAS v4u*)(RC + (size_t)tr * 1024 + kh * 512 + c16 * 8) : (v4u){0u, 0u, 0u, 0u};
                        *(LAS v4u*)(cst + row * 1040 + c16 * 16) = v; }
                    LB4()
#pragma unroll 8
                    for (int k2 = 0; k2 < 32; ++k2) {
                        const int ks = kh * 32 + k2, k0 = ks * 16 + 8 * h, kl = k2 * 16 + 8 * h;
                        const GAS f32x4* mm = (const GAS f32x4*)(mu + (3 + xsel) * 1024 + k0); const f32x4 ma = mm[0], mb = mm[1];
                        const float mv[8] = {ma.x, ma.y, ma.z, ma.w, mb.x, mb.y, mb.z, mb.w};
                        const GAS bf16x8* af = (const GAS bf16x8*)(L1_T + ((size_t)m0 * 64 + ks) * 512) + lane;
                        const bf16x8 f0 = af[0], f1 = af[64 * 64], f2 = cnt == 3 ? af[2 * 64 * 64] : f0;
#pragma unroll
                        for (int tl = 0; tl < 2; ++tl) {
                            const v4u cv = *(const LAS v4u*)(cst + (32 * tl + n + 1) * 1040 + kl * 2), pv = *(const LAS v4u*)(cst + (32 * tl + n) * 1040 + kl * 2);
                            const float c[8] = {bflo(cv.x), bfhi(cv.x), bflo(cv.y), bfhi(cv.y), bflo(cv.z), bfhi(cv.z), bflo(cv.w), bfhi(cv.w)};
                            const float p[8] = {bflo(pv.x), bfhi(pv.x), bflo(pv.y), bfhi(pv.y), bflo(pv.z), bfhi(pv.z), bflo(pv.w), bfhi(pv.w)};
                            float o[8];
#pragma unroll
                            for (int j = 0; j < 8; ++j) o[j] = c[j] + (p[j] - c[j]) * mv[j];
                            v4u xw_; xw_.x = pk2(o[0], o[1]); xw_.y = pk2(o[2], o[3]); xw_.z = pk2(o[4], o[5]); xw_.w = pk2(o[6], o[7]); const bf16x8 xf = __builtin_bit_cast(bf16x8, xw_);
                            if (tl == 0) { Ca[0] = __builtin_amdgcn_mfma_f32_32x32x16_bf16(f0, xf, Ca[0], 0, 0, 0); Ca[1] = __builtin_amdgcn_mfma_f32_32x32x16_bf16(f1, xf, Ca[1], 0, 0, 0); if (cnt == 3) Ca[2] = __builtin_amdgcn_mfma_f32_32x32x16_bf16(f2, xf, Ca[2], 0, 0, 0); }
                            else { Cb[0] = __builtin_amdgcn_mfma_f32_32x32x16_bf16(f0, xf, Cb[0], 0, 0, 0); Cb[1] = __builtin_amdgcn_mfma_f32_32x32x16_bf16(f1, xf, Cb[1], 0, 0, 0); if (cnt == 3) Cb[2] = __builtin_amdgcn_mfma_f32_32x32x16_bf16(f2, xf, Cb[2], 0, 0, 0); }
                        }
                    }
                    LB4()
                }
#define LX_ACT(C, tl_) { _Pragma("unroll") for (int m = 0; m < 3; ++m) if (m < cnt) { \
                    _Pragma("unroll") for (int s2 = 0; s2 < 2; ++s2) { float v[8]; \
                        _Pragma("unroll") for (int j = 0; j < 8; ++j) { const float x = C[m][8 * s2 + j]; v[j] = w4 == 0 ? pg8::ftanh(x) : (w4 == 1 ? x : pg8::fsigmoid(x)); } \
                        v4u w; w.x = pk2(v[0], v[1]); w.y = pk2(v[2], v[3]); w.z = pk2(v[4], v[5]); w.w = pk2(v[6], v[7]); \
                        *(LAS v4u*)(hl + (((tl_) * 18 + 2 * (m0 + m) + s2) * 64 + lane) * 16) = w; } } }
                LX_ACT(Ca, 0) LX_ACT(Cb, 1)
#undef LX_ACT
                LB4()
                if (lane == 0) lb[2] = 1u;
                LB4()
            }
        }
          }
          {
        {
            LAS unsigned char* vl = wave < 4 ? LDSP + RING_OFF + 110592 + wave * 4608 : LDSP + RING_OFF + (wave - 4) * 4608;
            const int n = lane & 31, h = lane >> 5, i16 = lane & 15, dcol = 16 * ((lane >> 4) & 1);
            for (;;) {
                unsigned s_ = 0u; if (lane == 0) s_ = __hip_atomic_fetch_add((LAS unsigned*)(LDSP + RING_OFF + 130052), 1u, __ATOMIC_RELAXED, __HIP_MEMORY_SCOPE_WORKGROUP); s_ = (unsigned)__builtin_amdgcn_readfirstlane((int)s_);
                if (s_ >= 32u) break;
                const int task = vcu * 8 + (int)(s_ & 7u) + NGW * (int)(s_ >> 3);
                const int head = task & 15, q0 = (task >> 4) * 32;
                bf16x8 qf[4];
#pragma unroll
                for (int ks = 0; ks < 4; ++ks) qf[ks] = *(const GAS bf16x8*)(QB + (size_t)(q0 + n) * 1024 + head * 64 + 16 * ks + 8 * h);
                f32x16 O0, O1;
#pragma unroll
                for (int i = 0; i < 16; ++i) { O0[i] = 0.f; O1[i] = 0.f; }
                float carry = 1.f;
                bf16x8 kf[4]; v4u vv[4];
#pragma unroll
                for (int ks = 0; ks < 4; ++ks) kf[ks] = *(const GAS bf16x8*)(KB + (size_t)(q0 + n) * 1024 + head * 64 + 16 * ks + 8 * h);
#pragma unroll
                for (int i = 0; i < 4; ++i) vv[i] = *(const GAS v4u*)(VB + (size_t)(q0 + n) * 1024 + head * 64 + 32 * h + 8 * i);
                { const int kt = q0;
                    f32x16 S;
#pragma unroll
                    for (int i = 0; i < 16; ++i) S[i] = 0.f;
#pragma unroll
                    for (int ks = 0; ks < 4; ++ks) S = __builtin_amdgcn_mfma_f32_32x32x16_bf16(kf[ks], qf[ks], S, 0, 0, 0);
#pragma unroll
                    for (int i = 0; i < 4; ++i) *(LAS v4u*)(vl + n * RW_PIT + (32 * h + 8 * i) * 2) = vv[i];
                    { const int ktn = kt >= 32 ? kt - 32 : 0;
#pragma unroll
                      for (int ks = 0; ks < 4; ++ks) kf[ks] = *(const GAS bf16x8*)(KB + (size_t)(ktn + n) * 1024 + head * 64 + 16 * ks + 8 * h);
#pragma unroll
                      for (int i = 0; i < 4; ++i) vv[i] = *(const GAS v4u*)(VB + (size_t)(ktn + n) * 1024 + head * 64 + 32 * h + 8 * i); }
                    float kp[16], ev[16], G[4], Gp[4];
#pragma unroll
                    for (int i = 0; i < 16; ++i) { const float z = fminf(S[i], 115.f); const bool valid = (kt + (i & 3) + 8 * (i >> 2) + 4 * h) < (q0 + n); const float e = __builtin_amdgcn_exp2f(z); const float k = __builtin_amdgcn_rcpf(1.0f + e); kp[i] = valid ? k : 1.f; ev[i] = valid ? e : 0.f; }
#pragma unroll
                    for (int q = 0; q < 4; ++q) { kp[4 * q + 2] *= kp[4 * q + 3]; kp[4 * q + 1] *= kp[4 * q + 2]; kp[4 * q] *= kp[4 * q + 1]; G[q] = kp[4 * q]; }
#pragma unroll
                    for (int q = 0; q < 4; ++q) Gp[q] = __shfl_xor(G[q], 32);
                    float off[4]; float later = 1.f;
#pragma unroll
                    for (int q = 3; q >= 0; --q) { off[q] = later * (h == 0 ? Gp[q] : 1.f); later *= G[q] * Gp[q]; }
                    bf16x8 wf[2];
                    { float w[16];
#pragma unroll
                      for (int i = 0; i < 16; ++i) w[i] = ev[i] * kp[i] * (off[i >> 2] * carry);
#pragma unroll
                      for (int s2 = 0; s2 < 2; ++s2) { v4u pw; pw.x = pk2(w[8 * s2], w[8 * s2 + 1]); pw.y = pk2(w[8 * s2 + 2], w[8 * s2 + 3]); pw.z = pk2(w[8 * s2 + 4], w[8 * s2 + 5]); pw.w = pk2(w[8 * s2 + 6], w[8 * s2 + 7]); wf[s2] = __builtin_bit_cast(bf16x8, pw); } }
                    carry *= later;
#pragma unroll
                    for (int s2 = 0; s2 < 2; ++s2) {
#pragma unroll
                        for (int m2 = 0; m2 < 2; ++m2) { const LAS unsigned char* ap = vl + (16 * s2 + 4 * h + (i16 >> 2)) * RW_PIT + (32 * m2 + dcol + 4 * (i16 & 3)) * 2;
                            const v4i16_t lo = __builtin_amdgcn_ds_read_tr16_b64_v4i16((LAS v4i16_t*)ap), hi = __builtin_amdgcn_ds_read_tr16_b64_v4i16((LAS v4i16_t*)(ap + 8 * RW_PIT));
                            const bf16x8 af = __builtin_shufflevector(lo, hi, 0, 1, 2, 3, 4, 5, 6, 7);
                            if (m2 == 0) O0 = __builtin_amdgcn_mfma_f32_32x32x16_bf16(af, wf[s2], O0, 0, 0, 0); else O1 = __builtin_amdgcn_mfma_f32_32x32x16_bf16(af, wf[s2], O1, 0, 0, 0); } }
                }
                if (!__all(carry < 1.0e-44f))
                for (int kt = q0 - 32; kt >= 0; kt -= 32) {
                    f32x16 S;
#pragma unroll
                    for (int i = 0; i < 16; ++i) S[i] = 0.f;
#pragma unroll
                    for (int ks = 0; ks < 4; ++ks) S = __builtin_amdgcn_mfma_f32_32x32x16_bf16(kf[ks], qf[ks], S, 0, 0, 0);
#pragma unroll
                    for (int i = 0; i < 4; ++i) *(LAS v4u*)(vl + n * RW_PIT + (32 * h + 8 * i) * 2) = vv[i];
                    { const int ktn = kt >= 32 ? kt - 32 : 0;
#pragma unroll
                      for (int ks = 0; ks < 4; ++ks) kf[ks] = *(const GAS bf16x8*)(KB + (size_t)(ktn + n) * 1024 + head * 64 + 16 * ks + 8 * h);
#pragma unroll
                      for (int i = 0; i < 4; ++i) vv[i] = *(const GAS v4u*)(VB + (size_t)(ktn + n) * 1024 + head * 64 + 32 * h + 8 * i); }
                    float kp[16], ev[16], G[4], Gp[4];
#pragma unroll
                    for (int i = 0; i < 16; ++i) { const float z = fminf(S[i], 115.f); const bool valid = true; const float e = __builtin_amdgcn_exp2f(z); const float k = __builtin_amdgcn_rcpf(1.0f + e); kp[i] = valid ? k : 1.f; ev[i] = valid ? e : 0.f; }
#pragma unroll
                    for (int q = 0; q < 4; ++q) { kp[4 * q + 2] *= kp[4 * q + 3]; kp[4 * q + 1] *= kp[4 * q + 2]; kp[4 * q] *= kp[4 * q + 1]; G[q] = kp[4 * q]; }
#pragma unroll
                    for (int q = 0; q < 4; ++q) Gp[q] = __shfl_xor(G[q], 32);
                    float off[4]; float later = 1.f;
#pragma unroll
                    for (int q = 3; q >= 0; --q) { off[q] = later * (h == 0 ? Gp[q] : 1.f); later *= G[q] * Gp[q]; }
                    bf16x8 wf[2];
                    { float w[16];
#pragma unroll
                      for (int i = 0; i < 16; ++i) w[i] = ev[i] * kp[i] * (off[i >> 2] * carry);
#pragma unroll
                      for (int s2 = 0; s2 < 2; ++s2) { v4u pw; pw.x = pk2(w[8 * s2], w[8 * s2 + 1]); pw.y = pk2(w[8 * s2 + 2], w[8 * s2 + 3]); pw.z = pk2(w[8 * s2 + 4], w[8 * s2 + 5]); pw.w = pk2(w[8 * s2 + 6], w[8 * s2 + 7]); wf[s2] = __builtin_bit_cast(bf16x8, pw); } }
                    carry *= later;
#pragma unroll
                    for (int s2 = 0; s2 < 2; ++s2) {
#pragma unroll
                        for (int m2 = 0; m2 < 2; ++m2) { const LAS unsigned char* ap = vl + (16 * s2 + 4 * h + (i16 >> 2)) * RW_PIT + (32 * m2 + dcol + 4 * (i16 & 3)) * 2;
                            const v4i16_t lo = __builtin_amdgcn_ds_read_tr16_b64_v4i16((LAS v4i16_t*)ap), hi = __builtin_amdgcn_ds_read_tr16_b64_v4i16((LAS v4i16_t*)(ap + 8 * RW_PIT));
                            const bf16x8 af = __builtin_shufflevector(lo, hi, 0, 1, 2, 3, 4, 5, 6, 7);
                            if (m2 == 0) O0 = __builtin_amdgcn_mfma_f32_32x32x16_bf16(af, wf[s2], O0, 0, 0, 0); else O1 = __builtin_amdgcn_mfma_f32_32x32x16_bf16(af, wf[s2], O1, 0, 0, 0); } }
                    if (__all(carry < 1.0e-44f)) break;
                }
#pragma unroll
                for (int q = 0; q < 4; ++q) {
                    *(GAS unsigned*)((unsigned char*)YA + (size_t)(q0 + n) * 1024 + head * 64 + 8 * q + 4 * h) = ({ int w8_ = 0; w8_ = __builtin_amdgcn_cvt_pk_fp8_f32(O0[4 * q], O0[4 * q + 1], w8_, false); w8_ = __builtin_amdgcn_cvt_pk_fp8_f32(O0[4 * q + 2], O0[4 * q + 3], w8_, true); (unsigned)w8_; });
                    *(GAS unsigned*)((unsigned char*)YA + (size_t)(q0 + n) * 1024 + head * 64 + 32 + 8 * q + 4 * h) = ({ int w8_ = 0; w8_ = __builtin_amdgcn_cvt_pk_fp8_f32(O1[4 * q], O1[4 * q + 1], w8_, false); w8_ = __builtin_amdgcn_cvt_pk_fp8_f32(O1[4 * q + 2], O1[4 * q + 3], w8_, true); (unsigned)w8_; }); }
            }
        }
          }
          {
            typedef unsigned long long u64;
            LAS unsigned char* hl = LDSP + RING_OFF + 73728; const int n = lane & 31, h = lane >> 5; const int pair = (int)blockIdx.x;
            while ((unsigned)__builtin_amdgcn_readfirstlane((int)lb[2]) == 0u) __builtin_amdgcn_s_sleep(1);
            asm volatile("" ::: "memory");
                for (;;) {
                    unsigned c_ = 0u; if (lane == 0) c_ = __hip_atomic_fetch_add((LAS unsigned*)(LDSP + RING_OFF + 130060), 1u, __ATOMIC_RELAXED, __HIP_MEMORY_SCOPE_WORKGROUP); c_ = (unsigned)__builtin_amdgcn_readfirstlane((int)c_);
                    if (c_ >= 32u) break;
                    const int ct = (int)c_;
                    const GAS bf16x8* fw = (const GAS bf16x8*)(L2_T + (size_t)ct * 4 * 512) + lane; const GAS bf16x8* fa = (const GAS bf16x8*)(L2_T + 65536 + (size_t)ct * 4 * 512) + lane;
                    const GAS bf16x8* fg = (const GAS bf16x8*)(L2_T + 131072 + (size_t)ct * 10 * 512) + lane;
                    bf16x8 wfr[18];
#pragma unroll
                    for (int s2 = 0; s2 < 4; ++s2) { wfr[s2] = fw[64 * s2]; wfr[4 + s2] = fa[64 * s2]; }
#pragma unroll
                    for (int s2 = 0; s2 < 10; ++s2) wfr[8 + s2] = fg[64 * s2];
#pragma unroll 1
                    for (int tl = 0; tl < 2; ++tl) {
                        const int tt_ = (2 * pair + tl) * 32 + n;
                        f32x16 Yw, Ya, Yg;
#pragma unroll
                        for (int i = 0; i < 16; ++i) { Yw[i] = 0.f; Ya[i] = 0.f; Yg[i] = 0.f; }
#pragma unroll
                        for (int s2 = 0; s2 < 4; ++s2) { Yw = __builtin_amdgcn_mfma_f32_32x32x16_bf16(wfr[s2], *(const LAS bf16x8*)(hl + ((tl * 18 + s2) * 64 + lane) * 16), Yw, 0, 0, 0);
                            Ya = __builtin_amdgcn_mfma_f32_32x32x16_bf16(wfr[4 + s2], *(const LAS bf16x8*)(hl + ((tl * 18 + 4 + s2) * 64 + lane) * 16), Ya, 0, 0, 0); }
#pragma unroll
                        for (int s2 = 0; s2 < 10; ++s2) Yg = __builtin_amdgcn_mfma_f32_32x32x16_bf16(wfr[8 + s2], *(const LAS bf16x8*)(hl + ((tl * 18 + 8 + s2) * 64 + lane) * 16), Yg, 0, 0, 0);
#pragma unroll
                        for (int q = 0; q < 4; ++q) { const int c0 = ct * 32 + 8 * q + 4 * h;
                            const f32x4 wb = *(const GAS f32x4*)(w0 + c0), ab = *(const GAS f32x4*)(a0 + c0); f32x4 lwv; float av[4], gv[4];
#pragma unroll
                            for (int j = 0; j < 4; ++j) { lwv[j] = -__expf(-pg8::fsoftplus(-(wb[j] + Yw[4 * q + j])) - 0.5f); av[j] = pg8::fsigmoid(ab[j] + Ya[4 * q + j]); gv[j] = Yg[4 * q + j]; }
                            *(GAS f32x4*)(LW + (size_t)tt_ * 1024 + c0) = lwv;
                            *(GAS u64*)(AA + (size_t)tt_ * 1024 + c0) = (u64)pk2(av[0], av[1]) | ((u64)pk2(av[2], av[3]) << 32);
                            { int w8_ = 0; w8_ = __builtin_amdgcn_cvt_pk_fp8_f32(gv[0], gv[1], w8_, false); w8_ = __builtin_amdgcn_cvt_pk_fp8_f32(gv[2], gv[3], w8_, true); *(GAS unsigned*)((unsigned char*)GG + (size_t)tt_ * 1024 + c0) = (unsigned)w8_; } }
                    }
                }
          }
#undef LB4
        }
#else
#ifndef SKIP_LORA
        for (int rl_ = 0; rl_ < (REPEAT_SUB == 1 ? 2 : 1); ++rl_) {
        {
            typedef unsigned long long u64;
            LAS unsigned char* hl = LDSP + RING_OFF + 73728;
            LAS unsigned char* cst = LDSP + RING_OFF;
            const int w4 = wave & 3, half = wave >> 2, n = lane & 31, h = lane >> 5;
            const int m0 = w4 == 0 ? 0 : (w4 == 1 ? 2 : (w4 == 2 ? 4 : 7)), cnt = w4 == 2 ? 3 : 2, xsel = w4 < 2 ? w4 : 2;
            for (int pair = (int)blockIdx.x; pair < T / 64; pair += (int)gridDim.x) {
                const int tb = 64 * pair;
                f32x16 Ca[3], Cb[3];
#pragma unroll
                for (int m = 0; m < 3; ++m)
#pragma unroll
                    for (int i = 0; i < 16; ++i) { Ca[m][i] = 0.f; Cb[m][i] = 0.f; }
#pragma unroll 1
                for (int kh = 0; kh < 2; ++kh) {
                    for (int i = tid; i < 65 * 64; i += 512) { const int row = i >> 6, c16 = i & 63; const int tr = tb - 1 + row;
                        const v4u v = tr >= 0 ? *(const GAS v4u*)(RC + (size_t)tr * 1024 + kh * 512 + c16 * 8) : (v4u){0u, 0u, 0u, 0u};
                        *(LAS v4u*)(cst + row * 1040 + c16 * 16) = v; }
                    __syncthreads();
#pragma unroll 2
                    for (int k2 = 16 * half; k2 < 16 * half + 16; ++k2) {
                        const int ks = kh * 32 + k2, k0 = ks * 16 + 8 * h, kl = k2 * 16 + 8 * h;
                        const GAS f32x4* mm = (const GAS f32x4*)(mu + (3 + xsel) * 1024 + k0); const f32x4 ma = mm[0], mb = mm[1];
                        const float mv[8] = {ma.x, ma.y, ma.z, ma.w, mb.x, mb.y, mb.z, mb.w};
                        const GAS bf16x8* af = (const GAS bf16x8*)(L1_T + ((size_t)m0 * 64 + ks) * 512) + lane;
                        const bf16x8 f0 = af[0], f1 = af[64 * 64], f2 = cnt == 3 ? af[2 * 64 * 64] : f0;
#pragma unroll
                        for (int tl = 0; tl < 2; ++tl) {
                            const v4u cv = *(const LAS v4u*)(cst + (32 * tl + n + 1) * 1040 + kl * 2), pv = *(const LAS v4u*)(cst + (32 * tl + n) * 1040 + kl * 2);
                            const float c[8] = {bflo(cv.x), bfhi(cv.x), bflo(cv.y), bfhi(cv.y), bflo(cv.z), bfhi(cv.z), bflo(cv.w), bfhi(cv.w)};
                            const float p[8] = {bflo(pv.x), bfhi(pv.x), bflo(pv.y), bfhi(pv.y), bflo(pv.z), bfhi(pv.z), bflo(pv.w), bfhi(pv.w)};
                            float o[8];
#pragma unroll
                            for (int j = 0; j < 8; ++j) o[j] = c[j] + (p[j] - c[j]) * mv[j];
                            v4u xw_; xw_.x = pk2(o[0], o[1]); xw_.y = pk2(o[2], o[3]); xw_.z = pk2(o[4], o[5]); xw_.w = pk2(o[6], o[7]); const bf16x8 xf = __builtin_bit_cast(bf16x8, xw_);
                            if (tl == 0) { Ca[0] = __builtin_amdgcn_mfma_f32_32x32x16_bf16(f0, xf, Ca[0], 0, 0, 0); Ca[1] = __builtin_amdgcn_mfma_f32_32x32x16_bf16(f1, xf, Ca[1], 0, 0, 0); if (cnt == 3) Ca[2] = __builtin_amdgcn_mfma_f32_32x32x16_bf16(f2, xf, Ca[2], 0, 0, 0); }
                            else { Cb[0] = __builtin_amdgcn_mfma_f32_32x32x16_bf16(f0, xf, Cb[0], 0, 0, 0); Cb[1] = __builtin_amdgcn_mfma_f32_32x32x16_bf16(f1, xf, Cb[1], 0, 0, 0); if (cnt == 3) Cb[2] = __builtin_amdgcn_mfma_f32_32x32x16_bf16(f2, xf, Cb[2], 0, 0, 0); }
                        }
                    }
                    __syncthreads();
                }
                { LAS unsigned char* px = LDSP + RING_OFF;
#define LX_EXPORT(C) { _Pragma("unroll") for (int m = 0; m < 3; ++m) if (m < cnt) { _Pragma("unroll") for (int q = 0; q < 4; ++q) *(LAS f32x4*)(px + ((((half * 9 + m0 + m) * 4 + q) * 64 + lane) * 16)) = (f32x4){C[m][4 * q], C[m][4 * q + 1], C[m][4 * q + 2], C[m][4 * q + 3]}; } }
#define LX_FINISH(C) { _Pragma("unroll") for (int m = 0; m < 3; ++m) if (m < cnt) { _Pragma("unroll") for (int q = 0; q < 4; ++q) { const f32x4 v_ = *(const LAS f32x4*)(px + (((((1 - half) * 9 + m0 + m) * 4 + q) * 64 + lane) * 16)); C[m][4 * q] += v_[0]; C[m][4 * q + 1] += v_[1]; C[m][4 * q + 2] += v_[2]; C[m][4 * q + 3] += v_[3]; } \
                    _Pragma("unroll") for (int s2 = 0; s2 < 2; ++s2) { float v[8]; \
                        _Pragma("unroll") for (int j = 0; j < 8; ++j) { const float x = C[m][8 * s2 + j]; v[j] = w4 == 0 ? pg8::ftanh(x) : (w4 == 1 ? x : pg8::fsigmoid(x)); } \
                        v4u w; w.x = pk2(v[0], v[1]); w.y = pk2(v[2], v[3]); w.z = pk2(v[4], v[5]); w.w = pk2(v[6], v[7]); \
                        *(LAS v4u*)(hl + ((half * 18 + 2 * (m0 + m) + s2) * 64 + lane) * 16) = w; } } }
                  if (half == 0) LX_EXPORT(Cb) else LX_EXPORT(Ca)
                  __syncthreads();
                  if (half == 0) LX_FINISH(Ca) else LX_FINISH(Cb)
#undef LX_EXPORT
#undef LX_FINISH
                }
                __syncthreads();
#pragma unroll 1
                for (int c4 = 0; c4 < 4; ++c4) {
                    const int ct = w4 * 8 + 4 * half + c4;
                    const GAS bf16x8* fw = (const GAS bf16x8*)(L2_T + (size_t)ct * 4 * 512) + lane; const GAS bf16x8* fa = (const GAS bf16x8*)(L2_T + 65536 + (size_t)ct * 4 * 512) + lane;
                    const GAS bf16x8* fg = (const GAS bf16x8*)(L2_T + 131072 + (size_t)ct * 10 * 512) + lane;
                    bf16x8 wfr[18];
#pragma unroll
                    for (int s2 = 0; s2 < 4; ++s2) { wfr[s2] = fw[64 * s2]; wfr[4 + s2] = fa[64 * s2]; }
#pragma unroll
                    for (int s2 = 0; s2 < 10; ++s2) wfr[8 + s2] = fg[64 * s2];
#pragma unroll 1
                    for (int tl = 0; tl < 2; ++tl) {
                        const int tt_ = (2 * pair + tl) * 32 + n;
                        f32x16 Yw, Ya, Yg;
#pragma unroll
                        for (int i = 0; i < 16; ++i) { Yw[i] = 0.f; Ya[i] = 0.f; Yg[i] = 0.f; }
#pragma unroll
                        for (int s2 = 0; s2 < 4; ++s2) { Yw = __builtin_amdgcn_mfma_f32_32x32x16_bf16(wfr[s2], *(const LAS bf16x8*)(hl + ((tl * 18 + s2) * 64 + lane) * 16), Yw, 0, 0, 0);
                            Ya = __builtin_amdgcn_mfma_f32_32x32x16_bf16(wfr[4 + s2], *(const LAS bf16x8*)(hl + ((tl * 18 + 4 + s2) * 64 + lane) * 16), Ya, 0, 0, 0); }
#pragma unroll
                        for (int s2 = 0; s2 < 10; ++s2) Yg = __builtin_amdgcn_mfma_f32_32x32x16_bf16(wfr[8 + s2], *(const LAS bf16x8*)(hl + ((tl * 18 + 8 + s2) * 64 + lane) * 16), Yg, 0, 0, 0);
#pragma unroll
                        for (int q = 0; q < 4; ++q) { const int c0 = ct * 32 + 8 * q + 4 * h;
                            const f32x4 wb = *(const GAS f32x4*)(w0 + c0), ab = *(const GAS f32x4*)(a0 + c0); f32x4 lwv; float av[4], gv[4];
#pragma unroll
                            for (int j = 0; j < 4; ++j) { lwv[j] = -__expf(-pg8::fsoftplus(-(wb[j] + Yw[4 * q + j])) - 0.5f); av[j] = pg8::fsigmoid(ab[j] + Ya[4 * q + j]); gv[j] = Yg[4 * q + j]; }
                            *(GAS f32x4*)(LW + (size_t)tt_ * 1024 + c0) = lwv;
                            *(GAS u64*)(AA + (size_t)tt_ * 1024 + c0) = (u64)pk2(av[0], av[1]) | ((u64)pk2(av[2], av[3]) << 32);
                            { int w8_ = 0; w8_ = __builtin_amdgcn_cvt_pk_fp8_f32(gv[0], gv[1], w8_, false); w8_ = __builtin_amdgcn_cvt_pk_fp8_f32(gv[2], gv[3], w8_, true); *(GAS unsigned*)((unsigned char*)GG + (size_t)tt_ * 1024 + c0) = (unsigned)w8_; } }
                    }
                }
                __syncthreads();
            }
        }
        if (REPEAT_SUB == 1) __syncthreads(); }
#endif
#ifndef SKIP_ATTN
        for (int ra_ = 0; ra_ < (REPEAT_SUB == 2 ? 2 : 1); ++ra_) {
        {
            LAS unsigned char* vl = LDSP + RING_OFF + wave * 4608;
            const int n = lane & 31, h = lane >> 5, i16 = lane & 15, dcol = 16 * ((lane >> 4) & 1);
            for (int task = gw; task < 16 * (T / 32); task += NGW) {
                const int head = task & 15, q0 = (task >> 4) * 32;
                bf16x8 qf[4];
#pragma unroll
                for (int ks = 0; ks < 4; ++ks) qf[ks] = *(const GAS bf16x8*)(QB + (size_t)(q0 + n) * 1024 + head * 64 + 16 * ks + 8 * h);
                f32x16 O0, O1;
#pragma unroll
                for (int i = 0; i < 16; ++i) { O0[i] = 0.f; O1[i] = 0.f; }
                float carry = 1.f;
                bf16x8 kf[4]; v4u vv[4];
#pragma unroll
                for (int ks = 0; ks < 4; ++ks) kf[ks] = *(const GAS bf16x8*)(KB + (size_t)(q0 + n) * 1024 + head * 64 + 16 * ks + 8 * h);
#pragma unroll
                for (int i = 0; i < 4; ++i) vv[i] = *(const GAS v4u*)(VB + (size_t)(q0 + n) * 1024 + head * 64 + 32 * h + 8 * i);
                { const int kt = q0;
                    f32x16 S;
#pragma unroll
                    for (int i = 0; i < 16; ++i) S[i] = 0.f;
#pragma unroll
                    for (int ks = 0; ks < 4; ++ks) S = __builtin_amdgcn_mfma_f32_32x32x16_bf16(kf[ks], qf[ks], S, 0, 0, 0);
#pragma unroll
                    for (int i = 0; i < 4; ++i) *(LAS v4u*)(vl + n * RW_PIT + (32 * h + 8 * i) * 2) = vv[i];
                    { const int ktn = kt >= 32 ? kt - 32 : 0;
#pragma unroll
                      for (int ks = 0; ks < 4; ++ks) kf[ks] = *(const GAS bf16x8*)(KB + (size_t)(ktn + n) * 1024 + head * 64 + 16 * ks + 8 * h);
#pragma unroll
                      for (int i = 0; i < 4; ++i) vv[i] = *(const GAS v4u*)(VB + (size_t)(ktn + n) * 1024 + head * 64 + 32 * h + 8 * i); }
                    float kp[16], ev[16], G[4], Gp[4];
#pragma unroll
                    for (int i = 0; i < 16; ++i) { const float z = fminf(S[i], 115.f); const bool valid = (kt + (i & 3) + 8 * (i >> 2) + 4 * h) < (q0 + n); const float e = __builtin_amdgcn_exp2f(z); const float k = __builtin_amdgcn_rcpf(1.0f + e); kp[i] = valid ? k : 1.f; ev[i] = valid ? e : 0.f; }
#pragma unroll
                    for (int q = 0; q < 4; ++q) { kp[4 * q + 2] *= kp[4 * q + 3]; kp[4 * q + 1] *= kp[4 * q + 2]; kp[4 * q] *= kp[4 * q + 1]; G[q] = kp[4 * q]; }
#pragma unroll
                    for (int q = 0; q < 4; ++q) Gp[q] = __shfl_xor(G[q], 32);
                    float off[4]; float later = 1.f;
#pragma unroll
                    for (int q = 3; q >= 0; --q) { off[q] = later * (h == 0 ? Gp[q] : 1.f); later *= G[q] * Gp[q]; }
                    bf16x8 wf[2];
                    { float w[16];
#pragma unroll
                      for (int i = 0; i < 16; ++i) w[i] = ev[i] * kp[i] * (off[i >> 2] * carry);
#pragma unroll
                      for (int s2 = 0; s2 < 2; ++s2) { v4u pw; pw.x = pk2(w[8 * s2], w[8 * s2 + 1]); pw.y = pk2(w[8 * s2 + 2], w[8 * s2 + 3]); pw.z = pk2(w[8 * s2 + 4], w[8 * s2 + 5]); pw.w = pk2(w[8 * s2 + 6], w[8 * s2 + 7]); wf[s2] = __builtin_bit_cast(bf16x8, pw); } }
                    carry *= later;
#pragma unroll
                    for (int s2 = 0; s2 < 2; ++s2) {
#pragma unroll
                        for (int m2 = 0; m2 < 2; ++m2) { const LAS unsigned char* ap = vl + (16 * s2 + 4 * h + (i16 >> 2)) * RW_PIT + (32 * m2 + dcol + 4 * (i16 & 3)) * 2;
                            const v4i16_t lo = __builtin_amdgcn_ds_read_tr16_b64_v4i16((LAS v4i16_t*)ap), hi = __builtin_amdgcn_ds_read_tr16_b64_v4i16((LAS v4i16_t*)(ap + 8 * RW_PIT));
                            const bf16x8 af = __builtin_shufflevector(lo, hi, 0, 1, 2, 3, 4, 5, 6, 7);
                            if (m2 == 0) O0 = __builtin_amdgcn_mfma_f32_32x32x16_bf16(af, wf[s2], O0, 0, 0, 0); else O1 = __builtin_amdgcn_mfma_f32_32x32x16_bf16(af, wf[s2], O1, 0, 0, 0); } }
                }
                if (!__all(carry < 1.0e-44f))
                for (int kt = q0 - 32; kt >= 0; kt -= 32) {
                    f32x16 S;
#pragma unroll
                    for (int i = 0; i < 16; ++i) S[i] = 0.f;
#pragma unroll
                    for (int ks = 0; ks < 4; ++ks) S = __builtin_amdgcn_mfma_f32_32x32x16_bf16(kf[ks], qf[ks], S, 0, 0, 0);
#pragma unroll
                    for (int i = 0; i < 4; ++i) *(LAS v4u*)(vl + n * RW_PIT + (32 * h + 8 * i) * 2) = vv[i];
                    { const int ktn = kt >= 32 ? kt - 32 : 0;
#pragma unroll
                      for (int ks = 0; ks < 4; ++ks) kf[ks] = *(const GAS bf16x8*)(KB + (size_t)(ktn + n) * 1024 + head * 64 + 16 * ks + 8 * h);
#pragma unroll
                      for (int i = 0; i < 4; ++i) vv[i] = *(const GAS v4u*)(VB + (size_t)(ktn + n) * 1024 + head * 64 + 32 * h + 8 * i); }
                    float kp[16], ev[16], G[4], Gp[4];
#pragma unroll
                    for (int i = 0; i < 16; ++i) { const float z = fminf(S[i], 115.f); const bool valid = true; const float e = __builtin_amdgcn_exp2f(z); const float k = __builtin_amdgcn_rcpf(1.0f + e); kp[i] = valid ? k : 1.f; ev[i] = valid ? e : 0.f; }
#pragma unroll
                    for (int q = 0; q < 4; ++q) { kp[4 * q + 2] *= kp[4 * q + 3]; kp[4 * q + 1] *= kp[4 * q + 2]; kp[4 * q] *= kp[4 * q + 1]; G[q] = kp[4 * q]; }
#pragma unroll
                    for (int q = 0; q < 4; ++q) Gp[q] = __shfl_xor(G[q], 32);
                    float off[4]; float later = 1.f;
#pragma unroll
                    for (int q = 3; q >= 0; --q) { off[q] = later * (h == 0 ? Gp[q] : 1.f); later *= G[q] * Gp[q]; }
                    bf16x8 wf[2];
                    { float w[16];
#pragma unroll
                      for (int i = 0; i < 16; ++i) w[i] = ev[i] * kp[i] * (off[i >> 2] * carry);
#pragma unroll
                      for (int s2 = 0; s2 < 2; ++s2) { v4u pw; pw.x = pk2(w[8 * s2], w[8 * s2 + 1]); pw.y = pk2(w[8 * s2 + 2], w[8 * s2 + 3]); pw.z = pk2(w[8 * s2 + 4], w[8 * s2 + 5]); pw.w = pk2(w[8 * s2 + 6], w[8 * s2 + 7]); wf[s2] = __builtin_bit_cast(bf16x8, pw); } }
                    carry *= later;
#pragma unroll
                    for (int s2 = 0; s2 < 2; ++s2) {
#pragma unroll
                        for (int m2 = 0; m2 < 2; ++m2) { const LAS unsigned char* ap = vl + (16 * s2 + 4 * h + (i16 >> 2)) * RW_PIT + (32 * m2 + dcol + 4 * (i16 & 3)) * 2;
                            const v4i16_t lo = __builtin_amdgcn_ds_read_tr16_b64_v4i16((LAS v4i16_t*)ap), hi = __builtin_amdgcn_ds_read_tr16_b64_v4i16((LAS v4i16_t*)(ap + 8 * RW_PIT));
                            const bf16x8 af = __builtin_shufflevector(lo, hi, 0, 1, 2, 3, 4, 5, 6, 7);
                            if (m2 == 0) O0 = __builtin_amdgcn_mfma_f32_32x32x16_bf16(af, wf[s2], O0, 0, 0, 0); else O1 = __builtin_amdgcn_mfma_f32_32x32x16_bf16(af, wf[s2], O1, 0, 0, 0); } }
                    if (__all(carry < 1.0e-44f)) break;
                }
#pragma unroll
                for (int q = 0; q < 4; ++q) {
                    *(GAS unsigned*)((unsigned char*)YA + (size_t)(q0 + n) * 1024 + head * 64 + 8 * q + 4 * h) = ({ int w8_ = 0; w8_ = __builtin_amdgcn_cvt_pk_fp8_f32(O0[4 * q], O0[4 * q + 1], w8_, false); w8_ = __builtin_amdgcn_cvt_pk_fp8_f32(O0[4 * q + 2], O0[4 * q + 3], w8_, true); (unsigned)w8_; });
                    *(GAS unsigned*)((unsigned char*)YA + (size_t)(q0 + n) * 1024 + head * 64 + 32 + 8 * q + 4 * h) = ({ int w8_ = 0; w8_ = __builtin_amdgcn_cvt_pk_fp8_f32(O1[4 * q], O1[4 * q + 1], w8_, false); w8_ = __builtin_amdgcn_cvt_pk_fp8_f32(O1[4 * q + 2], O1[4 * q + 3], w8_, true); (unsigned)w8_; }); }
            }
        }
        }
#endif
#endif
        REP_END(2)
    }
    SEAM(2);
    if (IN(3)) {
        LOCALS
        REP_BEGIN(3)
        constexpr int NCHB = 16; const int NRB = (int)gridDim.x - NCHB;
        gu32* rcnt = (gu32*)(args.ws + WS_CTL) + CW_RCNT;
        const bool chb = (int)blockIdx.x >= NRB; const int u_first = chb ? (int)blockIdx.x - NRB : 16 + (int)blockIdx.x, u_stride = chb ? 4096 : NRB;
        {
        const int idx = lane & 15, g = lane >> 4, mt = wave >> 1, ntb = 2 * (wave & 1);
#define RW_IMG(sl) (LDSP + RING_OFF + (sl) * RW_SLOT)
        LAS float* tot = (LAS float*)(LDSP + RING_OFF + 13 * RW_SLOT); LAS float* gam = tot + 512;
        float nl[8]; bf16 nr[8], nk[8], nv[8], na[8]; bf16 npr = 0, npk = 0, npv = 0;
#define RW_FETCH(un) { const int ch_ = ((un) & 15) * 64 + lane, tb_ = ((un) >> 4) * 64 + 8 * wave; \
            _Pragma("unroll") for (int j = 0; j < 8; ++j) { const size_t o_ = (size_t)(tb_ + j) * 1024 + ch_; nl[j] = LW[o_]; nr[j] = RR[o_]; nk[j] = RK[o_]; nv[j] = RV[o_]; na[j] = AA[o_]; } \
            if (tb_ > 0) { const size_t o_ = (size_t)(tb_ - 1) * 1024 + ch_; npr = RR[o_]; npk = RK[o_]; npv = RV[o_]; } else { npr = 0; npk = 0; npv = 0; } }
        if (u_first < 4096) RW_FETCH(u_first)
        int pub_chunk = -1;
        for (int unit = u_first; unit < 4096; unit += u_stride) {
            const int head = unit & 15, chunk = unit >> 4, t0 = chunk * 64, ch = head * 64 + lane;
            float lwv[8], cumv[8]; float cum = 0.f; float rcur[8], kcur[8], vcur[8], acur[8];
#pragma unroll
            for (int j = 0; j < 8; ++j) { lwv[j] = nl[j]; cum += lwv[j]; cumv[j] = cum; rcur[j] = bf1(nr[j]); kcur[j] = bf1(nk[j]); vcur[j] = bf1(nv[j]); acur[j] = bf1(na[j]); }
            float rp = bf1(npr), kp = bf1(npk), vp = bf1(npv);
            tot[wave * 64 + lane] = cum;
            __syncthreads();
            float off = 0.f, total = 0.f;
#pragma unroll
            for (int w2 = 0; w2 < 8; ++w2) { const float x = tot[w2 * 64 + lane]; total += x; off += (w2 < wave) ? x : 0.f; }
            const float etot = __expf(total);
            if (wave == 0) gam[lane] = etot;
            const float mur = mu[ch], muk = mu[1024 + ch], muv = mu[2048 + ch], ckk = k_k[ch], cka = k_a[ch], crk = r_k[ch];
            {
#pragma unroll
              for (int j = 0; j < 8; ++j) { const int tl = 8 * wave + j;
                const float rc = rcur[j], kc = kcur[j], vc = vcur[j], av = acur[j];
                const float rs = rc + (rp - rc) * mur, ks = kc + (kp - kc) * muk, vs = vc + (vp - vc) * muv; rp = rc; kp = kc; vp = vc;
                float kk = ks * ckk; const float nrm = wave_sum(kk * kk); kk = kk * __builtin_amdgcn_rsqf(fmaxf(nrm, 1e-24f));
                const float km = ks * (1.0f + (av - 1.0f) * cka); const float rkc = wave_sum(rs * km * crk);
                if (lane == 0) RKC[(t0 + tl) * 16 + head] = rkc;
                const float cumt = off + cumv[j], cump = cumt - lwv[j];
                const float eg = __expf(cumt), egp = __expf(cump), ig = __expf(-cumt), eb = etot * ig;
                const int bo = tl * RW_PIT + lane * 2;
                *(LAS bf16*)(RW_IMG(0) + bo) = (bf16)f2bf(-egp * kk);
                *(LAS bf16*)(RW_IMG(1) + bo) = (bf16)f2bf(ig * kk * av);
                *(LAS bf16*)(RW_IMG(2) + bo) = (bf16)f2bf(ig * km);
                *(LAS bf16*)(RW_IMG(3) + bo) = (bf16)f2bf(eg * rs);
                *(LAS bf16*)(RW_IMG(4) + bo) = (bf16)f2bf(eb * kk * av);
                *(LAS bf16*)(RW_IMG(5) + bo) = (bf16)f2bf(eb * km);
                *(LAS bf16*)(RW_IMG(6) + bo) = (bf16)f2bf(vs); } }
            asm volatile("s_waitcnt vmcnt(0)" ::: "memory");
            __syncthreads();
            if (tid == 0 && pub_chunk >= 0) __hip_atomic_fetch_add(rcnt + pub_chunk * 16, 1u, RLX_AGENT);
            if (unit + u_stride < 4096) RW_FETCH(unit + u_stride)
            const f32x4 Z4 = (f32x4){0.f, 0.f, 0.f, 0.f};
            { f32x4 c[4][2];
#pragma unroll
              for (int q = 0; q < 4; ++q) { c[q][0] = Z4; c[q][1] = Z4; }
              rw_mm2<0, 0>(RW_IMG(0), RW_IMG(1), mt, ntb, c[0][0], c[0][1], idx, g); rw_mm2<0, 0>(RW_IMG(0), RW_IMG(2), mt, ntb, c[1][0], c[1][1], idx, g);
              rw_mm2<0, 0>(RW_IMG(3), RW_IMG(1), mt, ntb, c[2][0], c[2][1], idx, g); rw_mm2<0, 0>(RW_IMG(3), RW_IMG(2), mt, ntb, c[3][0], c[3][1], idx, g);
#pragma unroll
              for (int q2 = 0; q2 < 2; ++q2) { const int n = 16 * (ntb + q2) + idx; f32x4 one = Z4;
#pragma unroll
                  for (int i = 0; i < 4; ++i) { const int m = 16 * mt + 4 * g + i; if (!(n < m)) { c[0][q2][i] = 0.f; c[1][q2][i] = 0.f; } if (!(n <= m)) { c[2][q2][i] = 0.f; c[3][q2][i] = 0.f; } one[i] = (n == m) ? 1.f : 0.f; }
                  rw_st(RW_IMG(7), mt, ntb + q2, c[0][q2], idx, g); rw_st(RW_IMG(11), mt, ntb + q2, c[0][q2] + one, idx, g); rw_st(RW_IMG(8), mt, ntb + q2, c[1][q2], idx, g);
                  rw_st(RW_IMG(9), mt, ntb + q2, c[2][q2], idx, g); rw_st(RW_IMG(10), mt, ntb + q2, c[3][q2], idx, g); } }
            __syncthreads();
            const int tmA = (0x33103322 >> (4 * wave)) & 15, tnA = (0x32101010 >> (4 * wave)) & 15; const bool kA0 = (0x3F >> wave) & 1, kA1 = (0xCF >> wave) & 1;
            const bool hasB = wave == 4 || wave == 5, kB0 = wave == 4, kB1 = wave == 5; const int tmB = wave == 4 ? 1 : 2, tnB = wave == 4 ? 0 : 2;
#define RW_TRI_P(tm, tn, k0, k1) { f32x4 pp = Z4; \
                if (k0) { const bf16x8 a_ = rw_ft(RW_IMG(7), 16 * (tm), 0, idx, g), b_ = rw_fd(RW_IMG(7), 16 * (tn), 0, idx, g); RW_MF(a_, b_, pp); } \
                if (k1) { const bf16x8 a_ = rw_ft(RW_IMG(7), 16 * (tm), 1, idx, g), b_ = rw_fd(RW_IMG(7), 16 * (tn), 1, idx, g); RW_MF(a_, b_, pp); } \
                rw_st(RW_IMG(1), tm, tn, pp, idx, g); }
            RW_TRI_P(tmA, tnA, kA0, kA1)
            if (hasB) RW_TRI_P(tmB, tnB, kB0, kB1)
#undef RW_TRI_P
            if (wave < 6) { const int um_ = (0x211000 >> (4 * wave)) & 15, un_ = (0x332321 >> (4 * wave)) & 15; rw_st(RW_IMG(12), um_, un_, Z4, idx, g); rw_st(RW_IMG(1), um_, un_, Z4, idx, g); }
            __syncthreads();
#define RW_Z22(c) { c[0][0] = Z4; c[0][1] = Z4; c[1][0] = Z4; c[1][1] = Z4; }
#define RW_LD22(c, img) { c[0][0] = rw_ld(img, mt0, nt0, idx, g); c[0][1] = rw_ld(img, mt0, nt0 + 1, idx, g); c[1][0] = rw_ld(img, mt0 + 1, nt0, idx, g); c[1][1] = rw_ld(img, mt0 + 1, nt0 + 1, idx, g); }
#define RW_ST22(img, c) { rw_st(img, mt0, nt0, c[0][0], idx, g); rw_st(img, mt0, nt0 + 1, c[0][1], idx, g); rw_st(img, mt0 + 1, nt0, c[1][0], idx, g); rw_st(img, mt0 + 1, nt0 + 1, c[1][1], idx, g); }
#define RW_STG22(fn, p, c) { fn(p, mt0, nt0, c[0][0], idx, g); fn(p, mt0, nt0 + 1, c[0][1], idx, g); fn(p, mt0 + 1, nt0, c[1][0], idx, g); fn(p, mt0 + 1, nt0 + 1, c[1][1], idx, g); }
            const int wh = wave >> 2, mt0 = 2 * ((wave >> 1) & 1), nt0 = 2 * (wave & 1);
#pragma unroll
            for (int it = 0; it < 5; ++it) {
                const int ps = (it & 1) ? 7 : 1, pd = (it & 1) ? 1 : 7, ns = (it & 1) ? 12 : 11, nd = (it & 1) ? 11 : 12;
#define RW_TRI(tm, tn, k0, k1) { f32x4 nn = rw_ld(RW_IMG(ns), tm, tn, idx, g), pp = Z4; \
                    if (k0) { const bf16x8 a_ = rw_ft(RW_IMG(ps), 16 * (tm), 0, idx, g), bn_ = rw_fd(RW_IMG(ns), 16 * (tn), 0, idx, g); RW_MF(a_, bn_, nn); if (it < 4) { const bf16x8 bp_ = rw_fd(RW_IMG(ps), 16 * (tn), 0, idx, g); RW_MF(a_, bp_, pp); } } \
                    if (k1) { const bf16x8 a_ = rw_ft(RW_IMG(ps), 16 * (tm), 1, idx, g), bn_ = rw_fd(RW_IMG(ns), 16 * (tn), 1, idx, g); RW_MF(a_, bn_, nn); if (it < 4) { const bf16x8 bp_ = rw_fd(RW_IMG(ps), 16 * (tn), 1, idx, g); RW_MF(a_, bp_, pp); } } \
                    rw_st(RW_IMG(nd), tm, tn, nn, idx, g); if (it < 4) rw_st(RW_IMG(pd), tm, tn, pp, idx, g); }
                RW_TRI(tmA, tnA, kA0, kA1)
                if (hasB) RW_TRI(tmB, tnB, kB0, kB1)
#undef RW_TRI
                __syncthreads();
            }
            if (wh == 0) { f32x4 ah[2][2]; RW_Z22(ah) rw_mm22<1, 1>(RW_IMG(0), RW_IMG(12), mt0, nt0, ah, idx, g, true, nt0 == 2); RW_ST22(RW_IMG(2), ah) }
            else { f32x4 wq[2][2]; RW_Z22(wq) rw_mm22<1, 0>(RW_IMG(12), RW_IMG(8), mt0, nt0, wq, idx, g, nt0 == 0, mt0 == 2); RW_ST22(RW_IMG(11), wq) }
            __syncthreads();
            if (wh == 0) { bf16* gt_ = GTC + (size_t)unit * 4096; bf16* tt_ = TTC + (size_t)unit * 4096;
              f32x4 gq[2][2], tq[2][2]; RW_LD22(gq, RW_IMG(3)) RW_Z22(tq)
              rw_mm22_shareA<1, 1, 1>(RW_IMG(2), RW_IMG(9), RW_IMG(4), mt0, nt0, gq, tq, idx, g, nt0 == 2);
              RW_STG22(rw_stg, gt_, gq)
#pragma unroll
              for (int a_ = 0; a_ < 2; ++a_)
#pragma unroll
                  for (int b_ = 0; b_ < 2; ++b_)
#pragma unroll
                      for (int i = 0; i < 4; ++i) { const int m = 16 * (mt0 + a_) + 4 * g + i; if (16 * (nt0 + b_) + idx == m) tq[a_][b_][i] += gam[m]; }
              RW_STG22(rw_stg_wt, tt_, tq) }
            else { f32x4 zq[2][2], xq[2][2]; RW_LD22(zq, RW_IMG(10)) RW_LD22(xq, RW_IMG(5))
              rw_mm22_shareB<1, 1, 0>(RW_IMG(9), RW_IMG(4), RW_IMG(11), mt0, nt0, zq, xq, idx, g, nt0 == 0, mt0 == 2, nt0 == 0);
              RW_ST22(RW_IMG(7), zq) RW_ST22(RW_IMG(1), xq) }
            __syncthreads();
            if (wh == 0) { bf16* yl_ = YLC + (size_t)unit * 4096; f32x4 yq[2][2]; RW_Z22(yq) rw_mm22<1, 1>(RW_IMG(6), RW_IMG(7), mt0, nt0, yq, idx, g, true, nt0 == 2); RW_STG22(rw_stg, yl_, yq) }
            else { bf16* qc_ = QC + (size_t)unit * 4096; f32x4 qq[2][2]; RW_Z22(qq) rw_mm22<1, 1>(RW_IMG(1), RW_IMG(6), mt0, nt0, qq, idx, g); RW_STG22(rw_stg_wt, qc_, qq) }
            __syncthreads();
#undef RW_Z22
#undef RW_LD22
#undef RW_ST22
#undef RW_STG22
            pub_chunk = chunk;
        }
        if (pub_chunk >= 0) { asm volatile("s_waitcnt vmcnt(0)" ::: "memory"); __syncthreads(); if (tid == 0) __hip_atomic_fetch_add(rcnt + pub_chunk * 16, 1u, RLX_AGENT); }
#undef RW_IMG
#undef RW_FETCH
        }
        if (chb) {
            typedef unsigned long long u64;
            volatile LAS unsigned* cw = (volatile LAS unsigned*)(LDSP + RING_OFF);
            LAS unsigned char* ring = LDSP + RING_OFF + 1024;
            constexpr int CH_SLOT = 2 * RW_SLOT, CH_NS = 6; constexpr unsigned CH_CAP = 1u << 24;
            if (tid < 64) cw[tid] = 0u;
            __syncthreads();
            const int head = (int)blockIdx.x - NRB;
            if (wave == 4) {
                int c = 0; unsigned spins = 0;
                while (c < 256) {
                    const int cc = c + lane; const unsigned v = cc < 256 ? __hip_atomic_load(rcnt + cc * 16, RLX_AGENT) : 0u;
                    const unsigned long long m = __ballot(v >= 16u); const int nready = m == ~0ull ? 64 : __builtin_ctzll(~m);
                    if (nready > 0) { __builtin_amdgcn_fence(__ATOMIC_ACQUIRE, "agent"); c += nready; if (lane == 0) cw[0] = (unsigned)c; spins = 0; }
                    else { __builtin_amdgcn_s_sleep(4); if (++spins > (1u << 22)) break; }
                }
            } else if (wave > 4) {
                const int L = wave - 5, lrow = lane >> 3, lc = lane & 7;
                v4u A[16], B[16];
#define LD_WAIT_RDY(c) { unsigned sp_ = 0; while ((unsigned)__builtin_amdgcn_readfirstlane((int)cw[0]) < (unsigned)(c) + 1u) { __builtin_amdgcn_s_sleep(1); if (++sp_ > CH_CAP) break; } asm volatile("" ::: "memory"); }
#define LD_WAIT_FREE(c) { if ((c) >= CH_NS) { unsigned sp_ = 0; for (;;) { const unsigned d_ = cw[16 + 6 * (lane & 3) + (c) % CH_NS]; if (__all(d_ >= (unsigned)((c) - CH_NS) + 1u)) break; __builtin_amdgcn_s_sleep(1); if (++sp_ > CH_CAP) break; } } asm volatile("" ::: "memory"); }
#define LD_LOAD(R, c) { const bf16* tt_ = TTC + (size_t)((c) * 16 + head) * 4096; const bf16* qc_ = QC + (size_t)((c) * 16 + head) * 4096; \
                  _Pragma("unroll") for (int i = 0; i < 8; ++i) { R[i] = *(const GAS v4u*)(tt_ + (8 * i + lrow) * 64 + lc * 8); R[8 + i] = *(const GAS v4u*)(qc_ + (8 * i + lrow) * 64 + lc * 8); } }
#define LD_STORE(R, c) { LAS unsigned char* sl_ = ring + ((c) % CH_NS) * CH_SLOT; \
                  _Pragma("unroll") for (int i = 0; i < 8; ++i) { *(LAS v4u*)(sl_ + (8 * i + lrow) * RW_PIT + lc * 16) = R[i]; *(LAS v4u*)(sl_ + RW_SLOT + (8 * i + lrow) * RW_PIT + lc * 16) = R[8 + i]; } \
                  LDS_WAIT(); if (lane == 0) cw[8 + (c) % CH_NS] = (unsigned)(c) + 1u; }
                LD_WAIT_RDY(L) LD_LOAD(A, L)
                for (int c = L; c < 256; c += 6) {
                    const int c1 = c + 3, c2 = c + 6;
                    if (c1 < 256) { LD_WAIT_RDY(c1) LD_LOAD(B, c1) }
                    LD_WAIT_FREE(c) LD_STORE(A, c)
                    if (c2 < 256) { LD_WAIT_RDY(c2) LD_LOAD(A, c2) }
                    if (c1 < 256) { LD_WAIT_FREE(c1) LD_STORE(B, c1) }
                }
#undef LD_WAIT_RDY
#undef LD_WAIT_FREE
#undef LD_LOAD
#undef LD_STORE
            } else {
                const int vg = wave, idx = lane & 15, g = lane >> 4;
                f32x4 S[4];
#pragma unroll
                for (int m = 0; m < 4; ++m) S[m] = (f32x4){0.f, 0.f, 0.f, 0.f};
                for (int c = 0; c < 256; ++c) {
                    const int slot = c % CH_NS, unit = c * 16 + head;
                    { unsigned sp_ = 0; while ((unsigned)__builtin_amdgcn_readfirstlane((int)cw[8 + slot]) < (unsigned)c + 1u) { __builtin_amdgcn_s_sleep(1); if (++sp_ > CH_CAP) break; } asm volatile("" ::: "memory"); }
                    const LAS unsigned char* sl_ = ring + slot * CH_SLOT;
                    u64 pq[4], pa[4][2][2];
#pragma unroll
                    for (int m = 0; m < 4; ++m) { pq[m] = *(const LAS u64*)(sl_ + RW_SLOT + (16 * vg + idx) * RW_PIT + (16 * m + 4 * g) * 2);
#pragma unroll
                        for (int ks = 0; ks < 2; ++ks) { pa[m][ks][0] = *(const LAS u64*)(sl_ + (16 * m + idx) * RW_PIT + (32 * ks + 4 * g) * 2); pa[m][ks][1] = *(const LAS u64*)(sl_ + (16 * m + idx) * RW_PIT + (32 * ks + 16 + 4 * g) * 2); } }
                    bf16x8 sf[2];
#pragma unroll
                    for (int ks = 0; ks < 2; ++ks) { v4u w; w.x = pk2(S[2 * ks][0], S[2 * ks][1]); w.y = pk2(S[2 * ks][2], S[2 * ks][3]); w.z = pk2(S[2 * ks + 1][0], S[2 * ks + 1][1]); w.w = pk2(S[2 * ks + 1][2], S[2 * ks + 1][3]);
                        sf[ks] = __builtin_bit_cast(bf16x8, w); *(GAS v4u*)(SBF + (((size_t)unit * 4 + vg) * 2 + ks) * 512 + lane * 8) = w; }
                    LDS_WAIT(); asm volatile("" ::: "memory");
                    if (lane == 0) cw[16 + 6 * vg + slot] = (unsigned)c + 1u;
#pragma unroll
                    for (int m = 0; m < 4; ++m) { const unsigned lo = (unsigned)pq[m], hi = (unsigned)(pq[m] >> 32); f32x4 acc = (f32x4){bflo(lo), bfhi(lo), bflo(hi), bfhi(hi)};
#pragma unroll
                        for (int ks = 0; ks < 2; ++ks) { const v4u aw = (v4u){(unsigned)pa[m][ks][0], (unsigned)(pa[m][ks][0] >> 32), (unsigned)pa[m][ks][1], (unsigned)(pa[m][ks][1] >> 32)};
                            acc = __builtin_amdgcn_mfma_f32_16x16x32_bf16(__builtin_bit_cast(bf16x8, aw), sf[ks], acc, 0, 0, 0); }
                        S[m] = acc; }
                }
            }
        }
        REP_END(3)
    }
    SEAM(3);
    if (IN(4)) {
        LOCALS
        REP_BEGIN(4)
        if ((vcu & 1) == 0) {
            pg8::Gemm g{XB, WIN_T + (size_t)7168 * D / 2, T, 4096, D / 2}; pg8::StaticOrder S; S.init(T, 4096, (int)gridDim.x, (int)blockIdx.x);
            pg8::EpiB16<pg8::FnGate> E{{GATE}};
            pg8::gemm_phase<pg8::EpiB16<pg8::FnGate>, pg8::StaticOrder, PG8_ALIGN, PG8_SP2, 122>(LDSP + RING_OFF, g, S, E);
        }
        REP_END(4)
    }
    if (IN(5)) {
        LOCALS
        REP_BEGIN(5)
        typedef unsigned long long u64;
        const int idx = lane & 15, g = lane >> 4;
#pragma unroll 2
        for (int task = gw; task < 16384; task += NGW) {
            const int unit = task >> 2, nt = task & 3, head = unit & 15, t = (unit >> 4) * 64 + 16 * nt + idx;
            const bf16* gt_ = GTC + (size_t)unit * 4096 + (16 * nt + idx) * 64; const bf16* yl_ = YLC + (size_t)unit * 4096 + (16 * nt + idx) * 64;
            bf16x8 bfr[2];
#pragma unroll
            for (int ks = 0; ks < 2; ++ks) { const u64 lo = *(const GAS u64*)(gt_ + 32 * ks + 4 * g), hi = *(const GAS u64*)(gt_ + 32 * ks + 16 + 4 * g);
                bfr[ks] = __builtin_bit_cast(bf16x8, (v4u){(unsigned)lo, (unsigned)(lo >> 32), (unsigned)hi, (unsigned)(hi >> 32)}); }
            f32x4 y[4]; float s1 = 0.f;
#pragma unroll
            for (int vg = 0; vg < 4; ++vg) { const u64 yw = *(const GAS u64*)(yl_ + 16 * vg + 4 * g); const unsigned lo = (unsigned)yw, hi = (unsigned)(yw >> 32); f32x4 acc = (f32x4){bflo(lo), bfhi(lo), bflo(hi), bfhi(hi)};
#pragma unroll
                for (int ks = 0; ks < 2; ++ks) { const bf16x8 af = *(const GAS bf16x8*)(SBF + (((size_t)unit * 4 + vg) * 2 + ks) * 512 + lane * 8); acc = __builtin_amdgcn_mfma_f32_16x16x32_bf16(af, bfr[ks], acc, 0, 0, 0); }
                y[vg] = acc; s1 += (acc[0] + acc[1]) + (acc[2] + acc[3]); }
            s1 += __shfl_xor(s1, 16); s1 += __shfl_xor(s1, 32); const float mean = s1 * (1.0f / 64.0f); float s2 = 0.f;
#pragma unroll
            for (int vg = 0; vg < 4; ++vg) { y[vg] = y[vg] - mean; s2 += (y[vg][0] * y[vg][0] + y[vg][1] * y[vg][1]) + (y[vg][2] * y[vg][2] + y[vg][3] * y[vg][3]); }
            s2 += __shfl_xor(s2, 16); s2 += __shfl_xor(s2, 32); const float rstd = 1.0f / sqrtf(s2 * (1.0f / 64.0f) + GN_EPS);
            const float rk = RKC[t * 16 + head];
#pragma unroll
            for (int vg = 0; vg < 4; ++vg) { const int ch = head * 64 + 16 * vg + 4 * g; const size_t o = (size_t)t * 1024 + ch;
                const f32x4 lwt = *(const GAS f32x4*)(lnx_w + ch), lbt = *(const GAS f32x4*)(lnx_b + ch), mv = *(const GAS f32x4*)(mu + 2048 + ch);
                const u64 vcw = *(const GAS u64*)(RV + o), vpw = t > 0 ? *(const GAS u64*)(RV + o - 1024) : 0ull, gw_ = 0ull; const unsigned g8_ = *(const GAS unsigned*)((const unsigned char*)GG + o); (void)gw_;
                const float vc[4] = {bflo((unsigned)vcw), bfhi((unsigned)vcw), bflo((unsigned)(vcw >> 32)), bfhi((unsigned)(vcw >> 32))};
                const float vp[4] = {bflo((unsigned)vpw), bfhi((unsigned)vpw), bflo((unsigned)(vpw >> 32)), bfhi((unsigned)(vpw >> 32))};
                typedef float f32x2g_ __attribute__((ext_vector_type(2))); const f32x2g_ glo_ = __builtin_amdgcn_cvt_pk_f32_fp8((int)g8_, false), ghi_ = __builtin_amdgcn_cvt_pk_f32_fp8((int)g8_, true); const float gg[4] = {glo_.x, glo_.y, ghi_.x, ghi_.y};
                float ov[4];
#pragma unroll
                for (int i = 0; i < 4; ++i) { const float vs = vc[i] + (vp[i] - vc[i]) * mv[i]; ov[i] = (y[vg][i] * rstd * lwt[i] + lbt[i] + rk * vs) * gg[i]; }
                *(GAS unsigned*)((unsigned char*)YB + o) = ({ int w8_ = 0; w8_ = __builtin_amdgcn_cvt_pk_fp8_f32(ov[0], ov[1], w8_, false); w8_ = __builtin_amdgcn_cvt_pk_fp8_f32(ov[2], ov[3], w8_, true); (unsigned)w8_; }); }
        }
        {
            __syncthreads();
            LAS float* scr = (LAS float*)(LDSP + RING_OFF + wave * 16384);
            constexpr int I_UA = (1024 / 64) * (D / 32), I_SQ = (D / 64) * (D / 32), I_PE = (256 / 64) * (D / 32);
            constexpr int NITEMS = 2 * I_UA + 3 * I_SQ + I_PE;
            for (int it = gw; it < NITEMS; it += NGW) {
                int r = it;
                if (r < I_UA) { p0_transpose_item8(w_up_a, 1024, D, (unsigned char*)WUA_T, 32.0f, scr, r, lane); continue; } r -= I_UA;
                if (r < I_UA) { p0_transpose_item8(w_up_b, 1024, D, (unsigned char*)WUB_T, 32.0f, scr, r, lane); continue; } r -= I_UA;
                if (r < I_SQ) { p0_transpose_item8(w_o, D, D, (unsigned char*)WO_T, 64.0f, scr, r, lane); continue; } r -= I_SQ;
                if (r < I_SQ) { p0_transpose_item(peer_wq, D, D, WQ_T, scr, r, lane); continue; } r -= I_SQ;
                if (r < I_SQ) { p0_transpose_item8(ple_wg, D, D, (unsigned char*)WPG_T, 32.0f, scr, r, lane); continue; } r -= I_SQ;
                p0_transpose_item(ple_wp, 256, D, WPE_T, scr, r, lane);
            }
            cvt_rows_bf16(p_in, PB, (size_t)T * 256 / 8, gt, NGT);
            __syncthreads();
        }
        if ((vcu & 1) != 0) {
            pg8::Gemm g{XB, WIN_T + (size_t)7168 * D / 2, T, 4096, D / 2}; pg8::StaticOrder S; S.init(T, 4096, (int)gridDim.x, (int)blockIdx.x);
            pg8::EpiB16<pg8::FnGate> E{{GATE}};
            pg8::gemm_phase<pg8::EpiB16<pg8::FnGate>, pg8::StaticOrder, PG8_ALIGN, PG8_SP2, 122>(LDSP + RING_OFF, g, S, E);
        }
        REP_END(5)
    }
    SEAM(5);
    if (IN(7)) {
        LOCALS
        REP_BEGIN(7)
        if ((vcu & 1) == 0) { cvt_rows_fp6(peer_u, UB, 16384, U_SCALE, gw, NGW, lane); cvt_rows_fp6(peer_v, VB2, 16384, V_SCALE, gw, NGW, lane); __syncthreads(); }
        { pg8::Gemm g{YA, WUA_T, T, D, 512}; pg8::StaticOrder S; S.init(T, D, (int)gridDim.x, (int)blockIdx.x);
          pg8::EpiB16<pg8::FnMix<0>> E{{GATE, MIX}};
          pg8::gemm_phase<pg8::EpiB16<pg8::FnMix<0>>, pg8::StaticOrder, PG8_ALIGN, PG8_SP2, 122>(LDSP + RING_OFF, g, S, E); }
        __syncthreads();
        { pg8::Gemm g{YB, WUB_T, T, D, 512}; pg8::StaticOrder S; S.init(T, D, (int)gridDim.x, (int)blockIdx.x);
          pg8::EpiB16<pg8::FnMixF8> E{{(const bf16*)((const unsigned char*)GATE + (size_t)T * 2048), MIX, MIX8}};
          pg8::gemm_phase<pg8::EpiB16<pg8::FnMixF8>, pg8::StaticOrder, PG8_ALIGN, PG8_SP2, 122>(LDSP + RING_OFF, g, S, E); }
        if ((vcu & 1) != 0) { cvt_rows_fp6(peer_u, UB, 16384, U_SCALE, gw, NGW, lane); cvt_rows_fp6(peer_v, VB2, 16384, V_SCALE, gw, NGW, lane); }
        REP_END(7)
    }
    SEAM(7);
    if (IN(8)) {
        LOCALS
        REP_BEGIN(8)
        pg8::Gemm g{(const bf16*)MIX8, WO_T, T, D, D / 2}; pg8::StaticOrder S; S.init(T, D, (int)gridDim.x, (int)blockIdx.x);
        pg8::EpiB16<pg8::FnWoB16> E{{x_in, (bf16*)H1, ALPHA}};
        pg8::gemm_phase<pg8::EpiB16<pg8::FnWoB16>, pg8::StaticOrder, PG8_ALIGN, PG8_SP2, 121>(LDSP + RING_OFF, g, S, E);
        REP_END(8)
    }
    SEAM(8);
    if (IN(9)) {
        LOCALS
        REP_BEGIN(9)
        for (int t = gw; t < T; t += NGW) {
            const bf16* hr = (const bf16*)H1 + (size_t)t * D + 8 * lane; float v[32]; float s = 0.f;
#pragma unroll
            for (int i = 0; i < 4; ++i) { const v4u w = *(const GAS v4u*)(hr + 512 * i);
                v[8 * i + 0] = bflo(w.x); v[8 * i + 1] = bfhi(w.x); v[8 * i + 2] = bflo(w.y); v[8 * i + 3] = bfhi(w.y); v[8 * i + 4] = bflo(w.z); v[8 * i + 5] = bfhi(w.z); v[8 * i + 6] = bflo(w.w); v[8 * i + 7] = bfhi(w.w); }
#pragma unroll
            for (int i = 0; i < 32; ++i) s += v[i];
            const float mean = wave_sum(s) * (1.0f / D); float q = 0.f;
#pragma unroll
            for (int i = 0; i < 32; ++i) { v[i] -= mean; q += v[i] * v[i]; }
            const float rstd = 1.0f / sqrtf(wave_sum(q) * (1.0f / D) + LN_EPS);
#pragma unroll
            for (int i = 0; i < 4; ++i) { const int c0 = 8 * lane + 512 * i;
                const f32x4 ga = *(const GAS f32x4*)(ln1_w + c0), gb = *(const GAS f32x4*)(ln1_w + c0 + 4), ba = *(const GAS f32x4*)(ln1_b + c0), bb = *(const GAS f32x4*)(ln1_b + c0 + 4);
                float o[8] = {v[8 * i + 0] * rstd * ga.x + ba.x, v[8 * i + 1] * rstd * ga.y + ba.y, v[8 * i + 2] * rstd * ga.z + ba.z, v[8 * i + 3] * rstd * ga.w + ba.w,
                              v[8 * i + 4] * rstd * gb.x + bb.x, v[8 * i + 5] * rstd * gb.y + bb.y, v[8 * i + 6] * rstd * gb.z + bb.z, v[8 * i + 7] * rstd * gb.w + bb.w};
                v4u w; w.x = pk2(o[0], o[1]); w.y = pk2(o[2], o[3]); w.z = pk2(o[4], o[5]); w.w = pk2(o[6], o[7]); *(GAS v4u*)(X1B + (size_t)t * D + c0) = w;
                int w0_ = 0, w1_ = 0; w0_ = __builtin_amdgcn_cvt_pk_fp8_f32(o[0], o[1], w0_, false); w0_ = __builtin_amdgcn_cvt_pk_fp8_f32(o[2], o[3], w0_, true);
                w1_ = __builtin_amdgcn_cvt_pk_fp8_f32(o[4], o[5], w1_, false); w1_ = __builtin_amdgcn_cvt_pk_fp8_f32(o[6], o[7], w1_, true);
                *(GAS unsigned long long*)(X1B8 + (size_t)t * D + c0) = (unsigned long long)(unsigned)w0_ | ((unsigned long long)(unsigned)w1_ << 32); }
        }
        REP_END(9)
    }
    SEAM(9);
    if (IN(10)) {
        LOCALS
        REP_BEGIN(10)
        { pg8::Gemm g{X1B, WQ_T, T, D, D}; pg8::StaticOrder S; S.init(T, D, (int)gridDim.x, (int)blockIdx.x);
          pg8::EpiB16<pg8::FnPlain16> E{{PQ, D}};
          pg8::gemm_phase<pg8::EpiB16<pg8::FnPlain16>, pg8::StaticOrder, PG8_ALIGN, PG8_SP2>(LDSP + RING_OFF, g, S, E); }
        REP_END(10)
    }
    SEAM(10);
    if (IN(11)) {
        LOCALS
        REP_BEGIN(11)
        { pg8::Gemm g{PB, WPE_T, T, D, 256}; pg8::StaticOrder S; S.init(T, D, (int)gridDim.x, (int)blockIdx.x);
          pg8::EpiB16<pg8::FnPlain16> E{{PE, D}};
          pg8::gemm_phase<pg8::EpiB16<pg8::FnPlain16>, pg8::StaticOrder, PG8_ALIGN, PG8_SP2>(LDSP + RING_OFF, g, S, E); }
        __syncthreads();
        { pg8::Gemm g{(const bf16*)X1B8, WPG_T, T, D, D / 2}; pg8::StaticOrder S; S.init(T, D, (int)gridDim.x, (int)blockIdx.x);
          pg8::EpiB16<pg8::FnPle> E{{PE}};
          pg8::gemm_phase<pg8::EpiB16<pg8::FnPle>, pg8::StaticOrder, PG8_ALIGN, PG8_SP2, 122>(LDSP + RING_OFF, g, S, E); }
        __syncthreads();
        LAS unsigned char* SK = LDSP + RING_OFF;
        for (int i = tid; i < 32768; i += 512) { const int row = i >> 7, d = i & 127; *(LAS bf16*)(SK + row * 272 + d * 2) = (bf16)f2bf(sub_keys[i]); }
        __syncthreads();
        {
            const int n = lane & 31, hh = lane >> 5;
            const float NEGINF = __uint_as_float(0xff800000u);
            for (int batch = gw; batch < T / 4; batch += NGW) {
                const int t = 4 * batch + (n >> 3), h = n & 7;
                float L[2][16];
#pragma unroll
                for (int c = 0; c < 2; ++c) {
                    f32x16 acc[4];
#pragma unroll
                    for (int m = 0; m < 4; ++m)
#pragma unroll
                        for (int i = 0; i < 16; ++i) acc[m][i] = 0.f;
                    bf16x8 qfr[8];
#pragma unroll
                    for (int ks = 0; ks < 8; ++ks) qfr[ks] = *(const GAS bf16x8*)(PQ + (size_t)t * D + h * 256 + c * 128 + 16 * ks + 8 * hh);
#pragma unroll
                    for (int ks = 0; ks < 8; ++ks) {
#pragma unroll
                        for (int m = 0; m < 4; ++m) { const bf16x8 kf = *(const LAS bf16x8*)(SK + (c * 128 + 32 * m + n) * 272 + (16 * ks + 8 * hh) * 2); acc[m] = __builtin_amdgcn_mfma_f32_32x32x16_bf16(kf, qfr[ks], acc[m], 0, 0, 0); }
                        __builtin_amdgcn_sched_barrier(0); }
                    float Lc[16], Gx[16];
#pragma unroll
                    for (int m = 0; m < 4; ++m) {
#pragma unroll
                        for (int i = 0; i < 16; ++i) { const float x = __uint_as_float((__float_as_uint(acc[m][i]) & 0xffffff80u) | (unsigned)(32 * m + (i & 3) + 8 * (i >> 2)) | (unsigned)(4 * hh)); if (m == 0) Lc[i] = x; else Gx[i] = x; }
                        if (m == 0) bitonic_sort16_desc(Lc); else { bitonic_sort16_desc(Gx); top16_merge_desc(Lc, Gx); } }
                    { float Pn[16];
#pragma unroll
                      for (int k = 0; k < 16; ++k) Pn[k] = __shfl_xor(Lc[k], 32);
                      top16_merge_desc(Lc, Pn); }
#pragma unroll
                    for (int k = 0; k < 16; ++k) L[c][k] = Lc[k];
                }
                float F[16];
#pragma unroll
                for (int k = 0; k < 16; ++k) F[k] = NEGINF;
#define PK_CAND(i, j) { float x = __uint_as_float((__float_as_uint(L[0][i] + L[1][j]) & 0xffffff00u) | (unsigned)(((i) << 4) | (j))); _Pragma("unroll") for (int k = 0; k < 16; ++k) { const float hi = fmaxf(x, F[k]); x = fminf(x, F[k]); F[k] = hi; } }
#define PK_ROW1(i) PK_CAND(i, 0)
#define PK_ROW2(i) PK_ROW1(i) PK_CAND(i, 1)
#define PK_ROW3(i) PK_ROW2(i) PK_CAND(i, 2)
#define PK_ROW4(i) PK_ROW3(i) PK_CAND(i, 3)
#define PK_ROW5(i) PK_ROW4(i) PK_CAND(i, 4)
#define PK_ROW8(i) PK_ROW5(i) PK_CAND(i, 5) PK_CAND(i, 6) PK_CAND(i, 7)
#define PK_ROW16(i) PK_ROW8(i) PK_CAND(i, 8) PK_CAND(i, 9) PK_CAND(i, 10) PK_CAND(i, 11) PK_CAND(i, 12) PK_CAND(i, 13) PK_CAND(i, 14) PK_CAND(i, 15)
                PK_ROW16(0) PK_ROW8(1) PK_ROW5(2) PK_ROW4(3) PK_ROW3(4) PK_ROW2(5) PK_ROW2(6) PK_ROW2(7)
                PK_ROW1(8) PK_ROW1(9) PK_ROW1(10) PK_ROW1(11) PK_ROW1(12) PK_ROW1(13) PK_ROW1(14) PK_ROW1(15)
                float ex[16]; float sum = 0.f; const float mx = __uint_as_float(__float_as_uint(F[0]) & 0xffffff00u);
#pragma unroll
                for (int k = 0; k < 16; ++k) { ex[k] = __expf(__uint_as_float(__float_as_uint(F[k]) & 0xffffff00u) - mx); sum += ex[k]; }
                const float rs = 1.0f / sum;
                int eid[16];
#pragma unroll
                for (int k = 0; k < 16; ++k) { const unsigned pay = __float_as_uint(F[k]) & 255u; const unsigned ii = pay >> 4, jj = pay & 15u; unsigned i0 = 0u, i1 = 0u;
#pragma unroll
                    for (int i = 0; i < 16; ++i) { i0 = (ii == (unsigned)i) ? (__float_as_uint(L[0][i]) & 127u) : i0; i1 = (jj == (unsigned)i) ? (__float_as_uint(L[1][i]) & 127u) : i1; }
                    eid[k] = (int)(i0 * 128u + i1); }
                if (hh == 0) {
#pragma unroll
                    for (int k4 = 0; k4 < 4; ++k4) { *(GAS v4u*)(IDX + (size_t)t * 128 + h * 16 + 4 * k4) = (v4u){(unsigned)eid[4 * k4], (unsigned)eid[4 * k4 + 1], (unsigned)eid[4 * k4 + 2], (unsigned)eid[4 * k4 + 3]};
                        *(GAS f32x4*)(PG + (size_t)t * 128 + h * 16 + 4 * k4) = (f32x4){ex[4 * k4] * rs, ex[4 * k4 + 1] * rs, ex[4 * k4 + 2] * rs, ex[4 * k4 + 3] * rs}; }
                }
            }
        }
        REP_END(11)
    }
    SEAM(11);
    if (IN(12)) {
        LOCALS
        REP_BEGIN(12)
        LAS float* actl = (LAS float*)(LDSP + RING_OFF) + wave * 128;
        LAS float* lnw = (LAS float*)(LDSP + RING_OFF + 8192); LAS float* lnb = lnw + 2048;
        *(LAS f32x4*)(lnw + 4 * tid) = *(const GAS f32x4*)(ln2_w + 4 * tid); *(LAS f32x4*)(lnb + 4 * tid) = *(const GAS f32x4*)(ln2_b + 4 * tid);
        __syncthreads();
        const int r4 = lane >> 4, c16 = lane & 15;
        for (int t = gw; t < T; t += NGW) {
            typedef unsigned long long u64;
            const int idv0 = IDX[(size_t)t * 128 + lane], idv1 = IDX[(size_t)t * 128 + 64 + lane]; const float gtv0 = PG[(size_t)t * 128 + lane], gtv1 = PG[(size_t)t * 128 + 64 + lane];
            u64 xq[32];
#pragma unroll
            for (int i = 0; i < 4; ++i)
#pragma unroll
                for (int q = 0; q < 8; ++q) xq[8 * i + q] = *(const GAS u64*)(X1B + (size_t)t * D + 256 * q + 4 * (c16 + 16 * i));
            LAS float* hraw = actl;
#define P1_LOAD(Dst, grp) { const int j_ = 4 * (grp) + r4; const int e_ = __shfl((grp) < 16 ? idv0 : idv1, j_ & 63); const GAS u64* ur_ = (const GAS u64*)(UB + (size_t)e_ * ROW6 + 24 * c16); \
                _Pragma("unroll") for (int i = 0; i < 4; ++i) { Dst[3 * i] = ur_[48 * i]; Dst[3 * i + 1] = ur_[48 * i + 1]; Dst[3 * i + 2] = ur_[48 * i + 2]; } }
#define P1_COMP(Src, grp) { float h0_ = 0.f, h1_ = 0.f; \
                _Pragma("unroll") for (int i = 0; i < 4; ++i) { const v6u_t pk_ = {(unsigned)Src[3 * i], (unsigned)(Src[3 * i] >> 32), (unsigned)Src[3 * i + 1], (unsigned)(Src[3 * i + 1] >> 32), (unsigned)Src[3 * i + 2], (unsigned)(Src[3 * i + 2] >> 32)}; \
                    const v16u_t f = __builtin_bit_cast(v16u_t, __builtin_amdgcn_cvt_scalef32_pk32_bf16_fp6(pk_, 1.0f));        \
                    _Pragma("unroll") for (int q = 0; q < 8; ++q) { const u64 xx = xq[8 * i + q]; h0_ = dot2(f[2 * q], (unsigned)xx, h0_); h1_ = dot2(f[2 * q + 1], (unsigned)(xx >> 32), h1_); } __builtin_amdgcn_sched_barrier(0); } \
                const float h_ = row16_sum(h0_ + h1_) * (1.0f / U_SCALE); if (c16 == 0) hraw[4 * (grp) + r4] = h_; }
            { u64 ua[12], ub[12];
              P1_LOAD(ua, 0)
              for (int grp = 0; grp < 32; grp += 2) { P1_LOAD(ub, grp + 1) P1_COMP(ua, grp) if (grp + 2 < 32) P1_LOAD(ua, grp + 2) P1_COMP(ub, grp + 1) } }
#undef P1_LOAD
#undef P1_COMP
            asm volatile("s_waitcnt lgkmcnt(0)" ::: "memory");
            { const float ha_ = hraw[lane], hb_ = hraw[64 + lane];
              asm volatile("s_waitcnt lgkmcnt(0)" ::: "memory");
              actl[lane] = 0.5f * ha_ * (1.0f + erff(ha_ * 0.70710678118f)) * gtv0 * (1.0f / V_SCALE); actl[64 + lane] = 0.5f * hb_ * (1.0f + erff(hb_ * 0.70710678118f)) * gtv1 * (1.0f / V_SCALE); }
            asm volatile("s_waitcnt lgkmcnt(0)" ::: "memory");
            float acc[32];
#pragma unroll
            for (int i = 0; i < 32; ++i) acc[i] = 0.f;
#define P2_LOAD(Dst, jb) { _Pragma("unroll") for (int r = 0; r < 4; ++r) { const int e_ = __builtin_amdgcn_readlane((jb) < 64 ? idv0 : idv1, ((jb) + r) & 63); const GAS u64* vr_ = (const GAS u64*)(VB2 + (size_t)e_ * ROW6 + 24 * lane); \
                Dst[3 * r] = vr_[0]; Dst[3 * r + 1] = vr_[1]; Dst[3 * r + 2] = vr_[2]; } }
#define P2_COMP(Src, jb) { const f32x4 a4_ = *(const LAS f32x4*)(actl + (jb)); \
                _Pragma("unroll") for (int r = 0; r < 4; ++r) { const v6u_t pk_ = {(unsigned)Src[3 * r], (unsigned)(Src[3 * r] >> 32), (unsigned)Src[3 * r + 1], (unsigned)(Src[3 * r + 1] >> 32), (unsigned)Src[3 * r + 2], (unsigned)(Src[3 * r + 2] >> 32)}; \
                    const v32f_t f = __builtin_amdgcn_cvt_scalef32_pk32_f32_fp6(pk_, 1.0f); const float a_ = a4_[r]; \
                    _Pragma("unroll") for (int i = 0; i < 32; ++i) acc[i] += a_ * f[i]; __builtin_amdgcn_sched_barrier(0); } }
            { u64 va[12], vb[12];
              P2_LOAD(va, 0)
              for (int jb = 0; jb < 128; jb += 8) { P2_LOAD(vb, jb + 4) P2_COMP(va, jb) if (jb + 8 < 128) P2_LOAD(va, jb + 8) P2_COMP(vb, jb + 4) } }
#undef P2_LOAD
#undef P2_COMP
            asm volatile("s_waitcnt lgkmcnt(0)" ::: "memory");
            float s1 = 0.f;
#pragma unroll
            for (int i = 0; i < 8; ++i) { const size_t o = (size_t)t * D + 256 * i + 4 * lane;
                const unsigned long long xw_ = *(const GAS unsigned long long*)(X1B + o), pw = *(const GAS unsigned long long*)(PE + o);
                acc[4 * i + 0] += ALPHA * bflo((unsigned)xw_) + bflo((unsigned)pw); acc[4 * i + 1] += ALPHA * bfhi((unsigned)xw_) + bfhi((unsigned)pw);
                acc[4 * i + 2] += ALPHA * bflo((unsigned)(xw_ >> 32)) + bflo((unsigned)(pw >> 32)); acc[4 * i + 3] += ALPHA * bfhi((unsigned)(xw_ >> 32)) + bfhi((unsigned)(pw >> 32)); }
#pragma unroll
            for (int i = 0; i < 32; ++i) s1 += acc[i];
            const float mean = wave_sum(s1) * (1.0f / D); float s2 = 0.f;
#pragma unroll
            for (int i = 0; i < 32; ++i) { acc[i] -= mean; s2 += acc[i] * acc[i]; }
            const float rstd = 1.0f / sqrtf(wave_sum(s2) * (1.0f / D) + LN_EPS);
#pragma unroll
            for (int i = 0; i < 8; ++i) { const int c0 = 256 * i + 4 * lane; const f32x4 ga = *(const LAS f32x4*)(lnw + c0), ba = *(const LAS f32x4*)(lnb + c0);
                *(GAS f32x4*)(args.out + (size_t)t * D + c0) = (f32x4){acc[4 * i + 0] * rstd * ga.x + ba.x, acc[4 * i + 1] * rstd * ga.y + ba.y, acc[4 * i + 2] * rstd * ga.z + ba.z, acc[4 * i + 3] * rstd * ga.w + ba.w}; }
        }
        REP_END(12)
    }

#ifdef DIAG_FP6
    { typedef float v32f_ __attribute__((ext_vector_type(32))); typedef float v16f_ __attribute__((ext_vector_type(16))); typedef unsigned v6u_ __attribute__((ext_vector_type(6)));
      v16f_ a_, b_; float mv_[32];
#pragma unroll
      for (int k = 0; k < 32; ++k) mv_[k] = k < 8 ? k * 0.125f : (k < 16 ? 1.f + (k - 8) * 0.125f : (k < 24 ? 2.f + (k - 16) * 0.25f : 4.f + (k - 24) * 0.5f));
#pragma unroll
      for (int k = 0; k < 16; ++k) { a_[k] = mv_[k]; b_[k] = mv_[16 + k]; }
      const v6u_ p_ = __builtin_amdgcn_cvt_scalef32_2xpk16_fp6_f32(a_, b_, 1.0f); const v32f_ o_ = __builtin_amdgcn_cvt_scalef32_pk32_f32_fp6(p_, 1.0f);
      bool id_ = true, il_ = true;
#pragma unroll
      for (int k = 0; k < 16; ++k) { id_ = id_ && (o_[k] == mv_[k]) && (o_[16 + k] == mv_[16 + k]); il_ = il_ && (o_[2 * k] == mv_[k]) && (o_[2 * k + 1] == mv_[16 + k]); }
      const float c_ = id_ ? 2.f : (il_ ? 3.f : 4.f);
      xcd_barrier(bar);
      LOCALS
      for (size_t e = gt; e < (size_t)T * D; e += NGT) args.out[e] = c_; }
#endif

#ifdef DIAG_TIME
    xcd_barrier(bar);
    { LOCALS
      const unsigned long long t0_ = __hip_atomic_load((unsigned long long*)(args.ws + WS_CTL) + 8, __ATOMIC_RELAXED, __HIP_MEMORY_SCOPE_AGENT);
      const float ms_ = (float)(__builtin_amdgcn_s_memrealtime() - t0_) * (1.0f / 100000.0f);
      float u_ = (float)DIAG_UNIT_MS; float c_ = 1.0f;
      for (int b_ = 0; b_ < 6; ++b_) { if (ms_ > u_) c_ += 1.f; u_ *= (float)DIAG_RATIO; }
      for (size_t e = gt; e < (size_t)T * D; e += NGT) args.out[e] = c_; }
#endif
#if DIAG_LAST >= 0
    xcd_barrier(bar);
    { LOCALS
      constexpr size_t N1 = (size_t)T * 1024;
      int used = 0;
#if DIAG_LAST == 1
      digest<bf16>(args.out, 0, QB, N1, gt, NGT); digest<bf16>(args.out, 1, KB, N1, gt, NGT); digest<bf16>(args.out, 2, VB, N1, gt, NGT);
      digest<bf16>(args.out, 3, RR, N1, gt, NGT); digest<bf16>(args.out, 4, RK, N1, gt, NGT); digest<bf16>(args.out, 5, RV, N1, gt, NGT); digest<bf16>(args.out, 6, RC, N1, gt, NGT); used = 7;
#elif DIAG_LAST == 2
      digest<bf16>(args.out, 0, YA, N1, gt, NGT); digest<float>(args.out, 1, LW, N1, gt, NGT); digest<bf16>(args.out, 2, AA, N1, gt, NGT); digest<bf16>(args.out, 3, GG, N1, gt, NGT); used = 4;
#elif DIAG_LAST == 3
      digest<float>(args.out, 0, YRAW, N1, gt, NGT); digest<float>(args.out, 1, RKC, (size_t)T * 16, gt, NGT); used = 2;
#elif DIAG_LAST == 4
      digest<bf16>(args.out, 0, YB, N1, gt, NGT); used = 1;
#elif DIAG_LAST == 5
      digest<bf16>(args.out, 0, GATE, 4 * N1, gt, NGT); used = 1;
#elif DIAG_LAST == 7
      digest<bf16>(args.out, 0, MIX, 2 * N1, gt, NGT); used = 1;
#elif DIAG_LAST == 8
      digest<float>(args.out, 0, H1, 2 * N1, gt, NGT); used = 1;
#elif DIAG_LAST == 9
      digest<bf16>(args.out, 0, X1B, 2 * N1, gt, NGT); used = 1;
#elif DIAG_LAST == 10
      digest<bf16>(args.out, 0, PQ, 2 * N1, gt, NGT); digest<bf16>(args.out, 1, PE, 2 * N1, gt, NGT); used = 2;
#elif DIAG_LAST == 11
      digest<int>(args.out, 0, IDX, (size_t)T * 128, gt, NGT); digest<float>(args.out, 1, PG, (size_t)T * 128, gt, NGT); digest<bf16>(args.out, 2, PE, 2 * N1, gt, NGT); used = 3;
#endif
      for (size_t e = gt + (size_t)used * 2097152; e < (size_t)T * D; e += NGT) args.out[e] = 1.0f;
    }
#endif
#undef IN
#undef SEAM
}


#ifdef DIAG_CHECK
__device__ __forceinline__ unsigned hsh(unsigned x) { x ^= x >> 16; x *= 0x7feb352dU; x ^= x >> 15; x *= 0x846ca68bU; x ^= x >> 16; return x; }
__device__ __forceinline__ void chk_acc(unsigned char* ws, int id, float ref, float got) { float* a = (float*)(ws + WS_CTL) + 1024 + 2 * id; const float d = ref - got; atomicAdd(a, d * d); atomicAdd(a + 1, ref * ref); }
__global__ void __launch_bounds__(512) mk_check(Args args) {
    extern __shared__ __attribute__((aligned(16))) unsigned char lds[];
    LOCALS
    const int id = args.pad - 1;
    if (id == 0) {
        for (size_t i = gt; i < 8192; i += NGT) { const unsigned hh = hsh((unsigned)i * 2u + 1u); const int t = (int)(hh % T), col = (int)(hsh(hh) % 7168u);
            float ref = 0.f; for (int k = 0; k < D; ++k) ref += x_in[(size_t)t * D + k] * w_in[(size_t)k * NIN + col];
            const int reg = col >> 10, c = col & 1023; const float got = bf1(QB[(size_t)reg * ((size_t)T * 1024) + (size_t)t * 1024 + c]) * (reg == 0 ? 8.f : 1.f);
            chk_acc(args.ws, 0, ref, got); }
    } else if (id == 1) {
        for (int smp = gw; smp < 256; smp += NGW) { const unsigned hh = hsh(7777u + smp); const int t = (int)(hh % T), head = (int)(hsh(hh) % 16u);
            const float q = bf1(QB[(size_t)t * 1024 + head * 64 + lane]); float o = 0.f;
            for (int sk = 0; sk < t; ++sk) { const float z = wave_sum(q * bf1(KB[(size_t)sk * 1024 + head * 64 + lane])); const float beta = 1.0f / (1.0f + expf(-z));
                o = o * (1.0f - beta) + beta * bf1(VB[(size_t)sk * 1024 + head * 64 + lane]); }
            chk_acc(args.ws, 1, o, bf1(YA[(size_t)t * 1024 + head * 64 + lane])); }
    } else if (id == 2) {
        LAS float* xs = (LAS float*)lds + wave * 3072;
        for (int smp = gw; smp < 512; smp += NGW) { const unsigned hh = hsh(991u + smp); const int t = (int)(hh % T), c = (int)(hsh(hh) % 1024u);
            for (int k = lane; k < 1024; k += 64) { const float cv = bf1(RC[(size_t)t * 1024 + k]), pv = t > 0 ? bf1(RC[(size_t)(t - 1) * 1024 + k]) : 0.f;
                xs[k] = cv + (pv - cv) * mu[3 * 1024 + k]; xs[1024 + k] = cv + (pv - cv) * mu[4 * 1024 + k]; xs[2048 + k] = cv + (pv - cv) * mu[5 * 1024 + k]; }
            asm volatile("s_waitcnt lgkmcnt(0)" ::: "memory");
            float hw = 0.f, ha = 0.f, hg0 = 0.f, hg1 = 0.f, hg2 = 0.f;
            for (int k = 0; k < 1024; ++k) { hw += xs[k] * wl1[(size_t)k * 64 + lane]; ha += xs[1024 + k] * al1[(size_t)k * 64 + lane];
                hg0 += xs[2048 + k] * gl1[(size_t)k * 160 + lane]; hg1 += xs[2048 + k] * gl1[(size_t)k * 160 + 64 + lane]; if (lane < 32) hg2 += xs[2048 + k] * gl1[(size_t)k * 160 + 128 + lane]; }
            hw = tanhf(hw); hg0 = 1.f / (1.f + expf(-hg0)); hg1 = 1.f / (1.f + expf(-hg1)); hg2 = 1.f / (1.f + expf(-hg2));
            const float wpre = w0[c] + wave_sum(hw * wl2[(size_t)lane * 1024 + c]);
            const float apre = a0[c] + wave_sum(ha * al2[(size_t)lane * 1024 + c]);
            const float gref = wave_sum(hg0 * gl2[(size_t)lane * 1024 + c] + hg1 * gl2[(size_t)(64 + lane) * 1024 + c] + (lane < 32 ? hg2 * gl2[(size_t)(128 + lane) * 1024 + c] : 0.f));
            const float sp = -wpre > 20.f ? -wpre : log1pf(expf(-wpre)); const float lwref = -expf(-sp - 0.5f); const float aref = 1.f / (1.f + expf(-apre));
            if (lane == 0) { chk_acc(args.ws, 2, lwref, LW[(size_t)t * 1024 + c]); chk_acc(args.ws, 3, aref, bf1(AA[(size_t)t * 1024 + c])); chk_acc(args.ws, 4, gref, bf1(GG[(size_t)t * 1024 + c])); }
            asm volatile("s_waitcnt lgkmcnt(0)" ::: "memory"); }
    } else if (id == 5) {
        LAS float* vs_ = (LAS float*)lds + wave * 512;
        for (int smp = gw; smp < 128; smp += NGW) { const unsigned hh = hsh(4242u + smp); const int t1 = 800 + (int)(hh % (T - 800)), head = (int)(hsh(hh) % 16u), ch = head * 64 + lane;
            float S[64];
#pragma unroll
            for (int k = 0; k < 64; ++k) S[k] = 0.f;
            float y = 0.f;
            for (int t = t1 - 768; t <= t1; ++t) { const size_t o = (size_t)t * 1024 + ch;
                const float rc = bf1(RR[o]), rp = bf1(RR[o - 1024]), kc = bf1(RK[o]), kp = bf1(RK[o - 1024]), vc = bf1(RV[o]), vp = bf1(RV[o - 1024]);
                const float rs = rc + (rp - rc) * mu[ch], ks = kc + (kp - kc) * mu[1024 + ch], vsv = vc + (vp - vc) * mu[2048 + ch];
                const float a = bf1(AA[o]); float kk = ks * k_k[ch]; const float nrm = sqrtf(wave_sum(kk * kk)); kk = kk / fmaxf(nrm, 1e-12f);
                const float km = ks * (1.0f + (a - 1.0f) * k_a[ch]);
                vs_[lane] = expf(LW[o]); vs_[64 + lane] = -kk; vs_[128 + lane] = kk * a; vs_[192 + lane] = km; vs_[256 + lane] = rs;
                asm volatile("s_waitcnt lgkmcnt(0)" ::: "memory");
                float sa = 0.f;
#pragma unroll
                for (int k = 0; k < 64; ++k) sa += S[k] * vs_[64 + k];
                y = 0.f;
#pragma unroll
                for (int k = 0; k < 64; ++k) { S[k] = S[k] * vs_[k] + sa * vs_[128 + k] + vsv * vs_[192 + k]; y += S[k] * vs_[256 + k]; }
                asm volatile("s_waitcnt lgkmcnt(0)" ::: "memory"); }
            { const size_t o = (size_t)t1 * 1024 + ch; const float mean = wave_sum(y) / 64.f; const float var = wave_sum((y - mean) * (y - mean)) / 64.f;
              const float rc = bf1(RR[o]), rp = bf1(RR[o - 1024]), kc = bf1(RK[o]), kp = bf1(RK[o - 1024]), vc = bf1(RV[o]), vp = bf1(RV[o - 1024]);
              const float rs = rc + (rp - rc) * mu[ch], ks = kc + (kp - kc) * mu[1024 + ch], vsv = vc + (vp - vc) * mu[2048 + ch];
              const float km = ks * (1.0f + (bf1(AA[o]) - 1.0f) * k_a[ch]); const float rk = wave_sum(rs * km * r_k[ch]);
              const float ref = ((y - mean) / sqrtf(var + GN_EPS) * lnx_w[ch] + lnx_b[ch] + rk * vsv) * bf1(GG[o]);
              chk_acc(args.ws, 5, ref, bf1(YB[o])); } }
    } else if (id == 6) {
        for (int smp = gw; smp < 512; smp += NGW) { const unsigned hh = hsh(31337u + smp); const int t = 1 + (int)(hh % (T - 1)), head = (int)(hsh(hh) % 16u), ch = head * 64 + lane; const size_t o = (size_t)t * 1024 + ch;
            const float rc = bf1(RR[o]), rp = bf1(RR[o - 1024]), kc = bf1(RK[o]), kp = bf1(RK[o - 1024]), vc = bf1(RV[o]), vp = bf1(RV[o - 1024]);
            const float rs = rc + (rp - rc) * mu[ch], ks = kc + (kp - kc) * mu[1024 + ch], vsv = vc + (vp - vc) * mu[2048 + ch];
            const float km = ks * (1.0f + (bf1(AA[o]) - 1.0f) * k_a[ch]); const float rk = wave_sum(rs * km * r_k[ch]);
            const float y = YRAW[o]; const float mean = wave_sum(y) / 64.f; const float var = wave_sum((y - mean) * (y - mean)) / 64.f;
            const float ref = ((y - mean) / sqrtf(var + GN_EPS) * lnx_w[ch] + lnx_b[ch] + rk * vsv) * bf1(GG[o]);
            chk_acc(args.ws, 6, ref, bf1(YB[o])); }
    } else if (id == 7) {
        for (size_t i = gt; i < 4096; i += NGT) { const unsigned hh = hsh((unsigned)i * 2u + 5u); const int t = (int)(hh % T), col = (int)(hsh(hh) % 4096u);
            float ref = 0.f; for (int k = 0; k < D; ++k) ref += x_in[(size_t)t * D + k] * w_in[(size_t)k * NIN + 7168 + col];
#ifndef DIAG_RAWGATE
            ref = 1.f / (1.f + expf(-ref));
#endif
            chk_acc(args.ws, 7, ref, bf1(GATE[(size_t)(col >> 11) * ((size_t)T * 2048) + (size_t)t * 2048 + (col & 2047)])); }
    } else if (id == 15) {
        for (size_t i = gt; i < 262144; i += NGT) { const unsigned hh = hsh((unsigned)i * 2u + 77u); const int k = (int)(hh % D), col = (int)(hsh(hh) % NIN);
            chk_acc(args.ws, col < 7168 ? 15 : 16, w_in[(size_t)k * NIN + col], bf1(WIN_T[(size_t)col * D + k])); }
    } else if (id == 17) {
        for (size_t i = gt; i < 262144; i += NGT) { const unsigned hh = hsh((unsigned)i * 2u + 177u); const size_t e = ((size_t)hh * 8191u + hsh(hh)) % ((size_t)T * D); chk_acc(args.ws, 17, x_in[e], bf1(XB[e])); }
    } else if (id == 8) {
        for (size_t i = gt; i < 4096; i += NGT) { const unsigned hh = hsh((unsigned)i * 2u + 9u); const int t = (int)(hh % T), col = (int)(hsh(hh) % 2048u);
            float ya = 0.f, yb = 0.f; for (int k = 0; k < 1024; ++k) { ya += bf1(YA[(size_t)t * 1024 + k]) * w_up_a[(size_t)k * D + col]; yb += bf1(YB[(size_t)t * 1024 + k]) * w_up_b[(size_t)k * D + col]; }
            const float ref = bf1(GATE[(size_t)t * 2048 + col]) * ya + bf1(GATE[(size_t)T * 2048 + (size_t)t * 2048 + col]) * yb; chk_acc(args.ws, 8, ref, bf1(MIX[(size_t)t * 2048 + col])); }
    } else if (id == 9) {
        for (size_t i = gt; i < 4096; i += NGT) { const unsigned hh = hsh((unsigned)i * 2u + 13u); const int t = (int)(hh % T), col = (int)(hsh(hh) % 2048u);
            float ref = 0.f; for (int k = 0; k < D; ++k) ref += bf1(MIX[(size_t)t * D + k]) * w_o[(size_t)k * D + col];
            ref += ALPHA * x_in[(size_t)t * D + col]; chk_acc(args.ws, 9, ref, H1[(size_t)t * D + col]); }
    } else if (id == 10) {
        for (size_t i = gt; i < 4096; i += NGT) { const unsigned hh = hsh((unsigned)i * 2u + 21u); const int t = (int)(hh % T), col = (int)(hsh(hh) % 2048u);
            float ref = 0.f; for (int k = 0; k < D; ++k) ref += bf1(X1B[(size_t)t * D + k]) * peer_wq[(size_t)k * D + col];
            chk_acc(args.ws, 10, ref, bf1(PQ[(size_t)t * D + col]));
            float r2 = 0.f; for (int k = 0; k < 256; ++k) r2 += p_in[(size_t)t * 256 + k] * ple_wp[(size_t)k * D + col];
            chk_acc(args.ws, 11, r2, bf1(PE[(size_t)t * D + col])); }
    } else if (id == 12) {
        for (size_t i = gt; i < 4096; i += NGT) { const unsigned hh = hsh((unsigned)i * 2u + 29u); const int t = (int)(hh % T), col = (int)(hsh(hh) % 2048u);
            float ref = 0.f; for (int k = 0; k < D; ++k) ref += bf1(X1B[(size_t)t * D + k]) * ple_wg[(size_t)k * D + col];
            float r2 = 0.f; for (int k = 0; k < 256; ++k) r2 += p_in[(size_t)t * 256 + k] * ple_wp[(size_t)k * D + col];
            chk_acc(args.ws, 12, r2 / (1.f + expf(-ref)), bf1(PE[(size_t)t * D + col])); }
        LAS float* sc = (LAS float*)lds + wave * 256;
        for (int smp = gw; smp < 512; smp += NGW) { const unsigned hh = hsh(555u + smp); const int t = (int)(hh % T), h = (int)(hsh(hh) % 8u);
            for (int r = lane; r < 256; r += 64) { const int c = r >> 7, nn = r & 127; float s = 0.f; for (int d = 0; d < 128; ++d) s += bf1(PQ[(size_t)t * D + h * 256 + c * 128 + d]) * sub_keys[(size_t)(c * 128 + nn) * 128 + d]; sc[r] = s; }
            asm volatile("s_waitcnt lgkmcnt(0)" ::: "memory");
            const int e = IDX[(size_t)t * 128 + h * 16 + (lane & 15)]; const float mys = sc[e >> 7] + sc[128 + (e & 127)];
            float mn = mys, mxv = mys;
#pragma unroll
            for (int o2 = 1; o2 < 16; o2 <<= 1) { mn = fminf(mn, __shfl_xor(mn, o2)); mxv = fmaxf(mxv, __shfl_xor(mxv, o2)); }
            float ex = expf(mys - mxv), sm = ex;
#pragma unroll
            for (int o2 = 1; o2 < 16; o2 <<= 1) sm += __shfl_xor(sm, o2);
            if (lane < 16) chk_acc(args.ws, 13, ex / sm, PG[(size_t)t * 128 + h * 16 + lane]);
            int cnt = 0; for (int pr = lane; pr < 16384; pr += 64) cnt += (sc[pr >> 7] + sc[128 + (pr & 127)] > mn + 1e-6f) ? 1 : 0;
#pragma unroll
            for (int o2 = 1; o2 < 64; o2 <<= 1) cnt += __shfl_xor(cnt, o2);
            if (lane == 0) chk_acc(args.ws, 14, 15.f, (float)cnt);
            asm volatile("s_waitcnt lgkmcnt(0)" ::: "memory"); }
    } else if (id == 98) {
        const float* a = (const float*)(args.ws + WS_CTL) + 1024; float c = 1.f; unsigned long long sel = DIAG_CHECK;
        for (int b = 4; b >= 0; --b) { const int k = (int)(sel % 100ull); sel /= 100ull; const float rel = sqrtf(a[2 * k] / fmaxf(a[2 * k + 1], 1e-30f)); if (!(rel < DIAG_TOL)) c += (float)(1 << b); }
#ifdef DIAG_LADDER
        { c = 1.f; const float rel = sqrtf(a[2 * DIAG_LADDER] / fmaxf(a[2 * DIAG_LADDER + 1], 1e-30f)); const float th[5] = {0.01f, 0.03f, 0.1f, 0.3f, 1.0f}; for (int b = 0; b < 5; ++b) if (!(rel < th[b])) c += 1.f; }
#endif
        for (size_t e = gt; e < (size_t)T * D; e += NGT) args.out[e] = c;
    }
}
#endif

extern "C" void kernel_launch(void* const* d_in, const int* in_sizes, int n_in, void* d_out, int out_size, void* d_ws, size_t ws_size, hipStream_t stream) {
    static int grid = 0;
    if (grid == 0) {
        if (n_in != 30 || in_sizes[0] != T * D || out_size != T * D || ws_size < WS_END) { fprintf(stderr, "kernel_launch: unexpected shapes / workspace (n_in %d, ws %zu); nothing launched\n", n_in, ws_size); grid = -1; return; }
        int dev = 0, cus = 0, per_cu = 0;
        if (hipGetDevice(&dev) != hipSuccess || hipDeviceGetAttribute(&cus, hipDeviceAttributeMultiprocessorCount, dev) != hipSuccess) { grid = -1; return; }
        if (hipFuncSetAttribute((const void*)mk_fwd, hipFuncAttributeMaxDynamicSharedMemorySize, LDS_BYTES) != hipSuccess) { fprintf(stderr, "kernel_launch: hipFuncSetAttribute failed\n"); grid = -1; return; }
        if (hipOccupancyMaxActiveBlocksPerMultiprocessor(&per_cu, (const void*)mk_fwd, NWAVES * 64, LDS_BYTES) != hipSuccess || per_cu < 1) fprintf(stderr, "kernel_launch: occupancy query says %d\n", per_cu);
        (void)hipGetLastError();
#ifdef DIAG_CHECK
        (void)hipFuncSetAttribute((const void*)mk_check, hipFuncAttributeMaxDynamicSharedMemorySize, 131072);
#endif
        grid = cus;
    }
    if (grid < 0) return;
    if (hipMemsetAsync((char*)d_ws + WS_CTL, 0, CTL_ZERO_BYTES, stream) != hipSuccess) return;
    Args a{};
    for (int i = 0; i < 30; ++i) a.in[i] = (const float*)d_in[i];
    a.out = (float*)d_out; a.ws = (unsigned char*)d_ws;
#if MK_ONE_LAUNCH
    a.ph_lo = 0; a.ph_hi = (DIAG_LAST >= 0) ? DIAG_LAST + 1 : NPHASE;
#ifdef DIAG_TIME
    a.ph_hi = DIAG_TIME + 1;
#endif a.li = 0;
    hipLaunchKernelGGL(mk_fwd, dim3(grid), dim3(NWAVES * 64), LDS_BYTES, stream, a);
#else
    for (int li = 0; li < NPHASE; ++li) { a.ph_lo = li; a.ph_hi = li + 1; a.li = li; a.pad = 0; hipLaunchKernelGGL(mk_fwd, dim3(grid), dim3(NWAVES * 64), LDS_BYTES, stream, a);
#ifdef DIAG_CHECK
        static const int chk_after[][2] = {{0, 15}, {1, 0}, {2, 1}, {2, 2}, {3, 18}, {4, 19}, {5, 5}, {6, 7}, {7, 8}, {8, 9}, {10, 10}, {11, 12}};
        for (auto& ca : chk_after) if (ca[0] == li) { a.pad = ca[1] + 1; hipLaunchKernelGGL(mk_check, dim3(grid), dim3(512), 131072, stream, a); }
        if (li == NPHASE - 1) { a.pad = 99; hipLaunchKernelGGL(mk_check, dim3(grid), dim3(512), 131072, stream, a); }
#endif
    }
#endif
}
```

```cpp
#define MK_ONE_LAUNCH 1
#include <hip/hip_runtime.h>
#include <cstdio>
#include <cstdint>
namespace pg8 {
#define PG8_LAS __attribute__((address_space(3)))
typedef unsigned short bf16_t;
typedef short bf16x8 __attribute__((ext_vector_type(8)));
typedef float f32x4 __attribute__((ext_vector_type(4)));
typedef unsigned u32x4 __attribute__((ext_vector_type(4)));
constexpr int BM = 256, BK = 64, HALF = 128, HTB = HALF * BK * 2  , STAGE_BYTES = 8 * HTB, NXCD = 8, WGM = 8;

__host__ __device__ __forceinline__ int lds_byte(int r, int c) { const int st = (r >> 4) * 2 + (c >> 5), rr = r & 15, cc = c & 31, ob = rr * 64 + cc * 2; return st * 1024 + (ob ^ (((ob >> 9) & 1) << 5)); }
__host__ __device__ __forceinline__ void stage_rc(int b, int& R, int& C) { const int st = b / 1024, sb = b % 1024, swz = sb ^ (((sb >> 9) & 1) << 5); R = (st >> 1) * 16 + swz / 64; C = (st & 1) * 32 + (swz % 64) / 2; }
__host__ __device__ __forceinline__ int perm32(int rho) { const int n = rho >> 4, i = rho & 15; return 8 * (i >> 2) + 4 * n + (i & 3); }

struct Unit { int pm, pn; };
struct Gemm { const bf16_t* A; const bf16_t* Bt; int M, N, K; };

struct StaticOrder {
    int nM, nN, nwg, G, c;
    __host__ __device__ void init(int M, int N, int G_, int c_) { nM = M / BM; nN = N / BM; nwg = nM * nN; G = G_; c = c_; }
    __host__ __device__ bool next(int i, Unit& u) const {
        const long L = (long)i * G + c; if (L >= nwg) return false;
        int wgid = (int)L; { const int q = nwg / NXCD, r = nwg % NXCD, xcd = wgid % NXCD, off = wgid / NXCD; wgid = (xcd < r ? xcd * (q + 1) : r * (q + 1) + (xcd - r) * q) + off; }
        const int nig = WGM * nN, gid = wgid / nig, fm = gid * WGM, gsz = (nM - fm) < WGM ? (nM - fm) : WGM;
        u.pm = fm + ((wgid % nig) % gsz); u.pn = (wgid % nig) / gsz; return true;
    }
    __device__ __forceinline__ void a_ready(const Unit&) const {}
    __device__ __forceinline__ void done(const Unit&) const {}
};

typedef float cvt_f32x2 __attribute__((ext_vector_type(2))); typedef __bf16 cvt_bf16x2 __attribute__((ext_vector_type(2)));
__device__ __forceinline__ unsigned cvt_pk_bf16(float lo, float hi) { const cvt_f32x2 v = {lo, hi}; return __builtin_bit_cast(unsigned, __builtin_convertvector(v, cvt_bf16x2)); }
typedef float f32x2 __attribute__((ext_vector_type(2)));
__device__ __forceinline__ f32x2 gelu_pk(f32x2 v) {
    const f32x2 av = __builtin_elementwise_abs(v), d = av * 0.2316418882f + 1.0f;
    f32x2 t; t.x = __builtin_amdgcn_rcpf(d.x); t.y = __builtin_amdgcn_rcpf(d.y);
    f32x2 q = t * 0.5307027145f + (-0.7265760135f); q = q * t + 0.7107068705f; q = q * t + (-0.142248368f); q = q * t + 0.127414796f; q = q * t;
    const f32x2 s = (v * v) * (-0.72134752044f);
    f32x2 e; e.x = __builtin_amdgcn_exp2f(s.x); e.y = __builtin_amdgcn_exp2f(s.y);
    const f32x2 m = v * (q * e), r = v - m;
    f32x2 o; o.x = v.x < 0.f ? m.x : r.x; o.y = v.y < 0.f ? m.y : r.y; return o;
}


__device__ __forceinline__ float bf_lo(unsigned w) { return __uint_as_float(w << 16); }
__device__ __forceinline__ float bf_hi(unsigned w) { return __uint_as_float(w & 0xffff0000u); }
__device__ __forceinline__ float fsigmoid(float x) { return __builtin_amdgcn_rcpf(1.0f + __expf(-x)); }
__device__ __forceinline__ float ftanh(float x) { return 1.0f - 2.0f * __builtin_amdgcn_rcpf(__expf(2.0f * x) + 1.0f); }
__device__ __forceinline__ float fsoftplus(float x) { return fmaxf(x, 0.f) + __logf(1.0f + __expf(-fabsf(x))); }
__device__ __forceinline__ u32x4 pack8(const f32x4& a, const f32x4& b) { u32x4 w; w.x = cvt_pk_bf16(a[0], a[1]); w.y = cvt_pk_bf16(a[2], a[3]); w.z = cvt_pk_bf16(b[0], b[1]); w.w = cvt_pk_bf16(b[2], b[3]); return w; }
__device__ __forceinline__ void unpack8(const u32x4& w, f32x4& a, f32x4& b) { a = (f32x4){bf_lo(w.x), bf_hi(w.x), bf_lo(w.y), bf_hi(w.y)}; b = (f32x4){bf_lo(w.z), bf_hi(w.z), bf_lo(w.w), bf_hi(w.w)}; }

template <class Fn> struct EpiB16 {
    static constexpr bool PERM = true, AFTER_DRAIN = false;
    Fn f;
    __device__ __forceinline__ void operator()(const f32x4 (&acc)[2][2][4][2], const Unit& u, int wr, int wc, int fr, int fq) const {
        const int row0 = u.pm * BM + wr * 64 + fr, col0 = u.pn * BM + wc * 32 + 8 * fq;
#pragma unroll
        for (int ai = 0; ai < 2; ++ai)
#pragma unroll
            for (int m = 0; m < 4; ++m)
#pragma unroll
                for (int bj = 0; bj < 2; ++bj) f(row0 + ai * HALF + m * 16, col0 + bj * HALF, acc[ai][bj][m][0], acc[ai][bj][m][1]);
    }
};
template <class Fn> struct EpiF32x {
    static constexpr bool PERM = false, AFTER_DRAIN = false;
    Fn f;
    __device__ __forceinline__ void operator()(const f32x4 (&acc)[2][2][4][2], const Unit& u, int wr, int wc, int fr, int fq) const {
        const int row0 = u.pm * BM + wr * 64 + fr, col0 = u.pn * BM + wc * 32 + 4 * fq;
#pragma unroll
        for (int ai = 0; ai < 2; ++ai)
#pragma unroll
            for (int m = 0; m < 4; ++m)
#pragma unroll
                for (int bj = 0; bj < 2; ++bj)
#pragma unroll
                    for (int n = 0; n < 2; ++n) f(row0 + ai * HALF + m * 16, col0 + bj * HALF + n * 16, acc[ai][bj][m][n]);
    }
};
constexpr int TT = 16384;
__device__ __forceinline__ unsigned long long pack8f8(const f32x4& a, const f32x4& b) { int w0_ = 0, w1_ = 0; w0_ = __builtin_amdgcn_cvt_pk_fp8_f32(a[0], a[1], w0_, false); w0_ = __builtin_amdgcn_cvt_pk_fp8_f32(a[2], a[3], w0_, true);
    w1_ = __builtin_amdgcn_cvt_pk_fp8_f32(b[0], b[1], w1_, false); w1_ = __builtin_amdgcn_cvt_pk_fp8_f32(b[2], b[3], w1_, true); return (unsigned long long)(unsigned)w0_ | ((unsigned long long)(unsigned)w1_ << 32); }
typedef float epi_f32x2 __attribute__((ext_vector_type(2)));
__device__ __forceinline__ void unpack8f8(unsigned long long w, float sc, f32x4& a, f32x4& b) { const int lo = (int)(unsigned)w, hi = (int)(unsigned)(w >> 32);
    const epi_f32x2 a0 = __builtin_amdgcn_cvt_pk_f32_fp8(lo, false), a1 = __builtin_amdgcn_cvt_pk_f32_fp8(lo, true), b0 = __builtin_amdgcn_cvt_pk_f32_fp8(hi, false), b1 = __builtin_amdgcn_cvt_pk_f32_fp8(hi, true);
    a = (f32x4){a0.x, a0.y, a1.x, a1.y} * sc; b = (f32x4){b0.x, b0.y, b1.x, b1.y} * sc; }
struct FnProj { bf16_t* base;
    __device__ __forceinline__ void operator()(int row, int col, f32x4 a, f32x4 b) const {
        const int reg = col >> 10, c = col & 1023; const float sc = reg == 0 ? 0.125f * 1.44269504088896f   : 1.0f; a = a * sc; b = b * sc;
        *(u32x4*)(base + (size_t)reg * ((size_t)TT * 1024) + (size_t)row * 1024 + c) = pack8(a, b); } };
struct FnGate { bf16_t* base;
    __device__ __forceinline__ void operator()(int row, int col, f32x4 a, f32x4 b) const {
        const int reg = col >> 11, c = col & 2047;
#pragma unroll
        for (int j = 0; j < 4; ++j) {
#ifndef DIAG_RAWGATE
            a[j] = fsigmoid(a[j]); b[j] = fsigmoid(b[j]);
#endif
        }
        a = a * 256.0f; b = b * 256.0f;
        *(unsigned long long*)((unsigned char*)base + (size_t)reg * ((size_t)TT * 2048) + (size_t)row * 2048 + c) = pack8f8(a, b); } };
struct FnLora1 { bf16_t* out; int act;
    __device__ __forceinline__ void operator()(int row, int col, f32x4 a, f32x4 b) const {
#pragma unroll
        for (int j = 0; j < 4; ++j) { if (act == 0) { a[j] = ftanh(a[j]); b[j] = ftanh(b[j]); } else if (act == 2) { a[j] = fsigmoid(a[j]); b[j] = fsigmoid(b[j]); } }
        *(u32x4*)(out + (size_t)row * 256 + col) = pack8(a, b); } };
struct FnLora2 { float* lw; bf16_t* aa; bf16_t* gg; const float* w0; const float* a0;
    __device__ __forceinline__ void operator()(int row, int col, f32x4 a, f32x4 b) const {
        const int which = col >> 10, c = col & 1023, t = row - which * TT;
        if (which == 0) { a = a + *(const f32x4*)(w0 + c); b = b + *(const f32x4*)(w0 + c + 4);
            *(f32x4*)(lw + (size_t)t * 1024 + c) = a; *(f32x4*)(lw + (size_t)t * 1024 + c + 4) = b; }
        else if (which == 1) { a = a + *(const f32x4*)(a0 + c); b = b + *(const f32x4*)(a0 + c + 4);
            *(u32x4*)(aa + (size_t)t * 1024 + c) = pack8(a, b); }
        else { *(u32x4*)(gg + (size_t)t * 1024 + c) = pack8(a, b); } } };

template <int W> struct FnLora2S { float* lw; bf16_t* aa; bf16_t* gg; const float* w0; const float* a0;
    __device__ __forceinline__ void operator()(int row, int col, f32x4 a, f32x4 b) const { const FnLora2 f{lw, aa, gg, w0, a0}; f(row + W * TT, col + W * 1024, a, b); } };
template <int ADD> struct FnMix { const bf16_t* gate; bf16_t* mix;
    __device__ __forceinline__ void operator()(int row, int col, f32x4 a, f32x4 b) const {
        const size_t o = (size_t)row * 2048 + col; f32x4 g0, g1; unpack8f8(*(const unsigned long long*)((const unsigned char*)gate + o), 1.0f / 256.0f, g0, g1); a = a * g0; b = b * g1;
        if (ADD) { f32x4 m0, m1; unpack8(*(const u32x4*)(mix + o), m0, m1); a = a + m0; b = b + m1; }
        *(u32x4*)(mix + o) = pack8(a, b); } };
struct FnMixF8 { const bf16_t* gate; const bf16_t* mixp; unsigned char* mix8;
    __device__ __forceinline__ void operator()(int row, int col, f32x4 a, f32x4 b) const {
        const size_t o = (size_t)row * 2048 + col; f32x4 g0, g1, m0, m1; unpack8f8(*(const unsigned long long*)((const unsigned char*)gate + o), 1.0f / 256.0f, g0, g1); unpack8(*(const u32x4*)(mixp + o), m0, m1); a = a * g0 + m0; b = b * g1 + m1;
        int w0_ = 0, w1_ = 0; w0_ = __builtin_amdgcn_cvt_pk_fp8_f32(a[0], a[1], w0_, false); w0_ = __builtin_amdgcn_cvt_pk_fp8_f32(a[2], a[3], w0_, true);
        w1_ = __builtin_amdgcn_cvt_pk_fp8_f32(b[0], b[1], w1_, false); w1_ = __builtin_amdgcn_cvt_pk_fp8_f32(b[2], b[3], w1_, true);
        *(unsigned long long*)(mix8 + o) = (unsigned long long)(unsigned)w0_ | ((unsigned long long)(unsigned)w1_ << 32); } };
struct FnWo { const float* x; float* h1; float alpha;
    __device__ __forceinline__ void operator()(int row, int col, f32x4 a) const {
        const size_t o = (size_t)row * 2048 + col; *(f32x4*)(h1 + o) = *(const f32x4*)(x + o) * alpha + a; } };
struct FnWoB16 { const float* x; bf16_t* h1; float alpha;
    __device__ __forceinline__ void operator()(int row, int col, f32x4 a, f32x4 b) const {
        const size_t o = (size_t)row * 2048 + col; a = a + *(const f32x4*)(x + o) * alpha; b = b + *(const f32x4*)(x + o + 4) * alpha; *(u32x4*)(h1 + o) = pack8(a, b); } };
struct FnPlain16 { bf16_t* out; int ld;
    __device__ __forceinline__ void operator()(int row, int col, f32x4 a, f32x4 b) const { *(u32x4*)(out + (size_t)row * ld + col) = pack8(a, b); } };
struct FnPle { bf16_t* pe;
    __device__ __forceinline__ void operator()(int row, int col, f32x4 a, f32x4 b) const {
        const size_t o = (size_t)row * 2048 + col; f32x4 p0, p1; unpack8(*(const u32x4*)(pe + o), p0, p1);
#pragma unroll
        for (int j = 0; j < 4; ++j) { a[j] = fsigmoid(a[j]) * p0[j]; b[j] = fsigmoid(b[j]) * p1[j]; }
        *(u32x4*)(pe + o) = pack8(a, b); } };
struct DiagOrder { int G, c;
    __device__ __forceinline__ bool next(int i, Unit& u) const { const int L = i * G + c; if (L >= 768) return false; const int which = L >> 8, r = L & 255; u.pm = which * 64 + (r & 63); u.pn = which * 4 + (r >> 6); return true; }
    __device__ __forceinline__ void a_ready(const Unit&) const {}
    __device__ __forceinline__ void done(const Unit&) const {}
};
typedef int pg8_v4i __attribute__((ext_vector_type(4))); typedef int pg8_v8i __attribute__((ext_vector_type(8)));
template <class Epi, class Sched, bool ALIGN_EPI = false, bool SP2 = false, int F8SCALE = 0>
__device__ __forceinline__ void gemm_phase(PG8_LAS unsigned char* lds, const Gemm g, const Sched& S, const Epi& E) {
    const int tid = threadIdx.x, wid = __builtin_amdgcn_readfirstlane(tid >> 6), lane = tid & 63, wr = wid >> 2, wc = wid & 3, fr = lane & 15, fq = lane >> 4;
    const int K = g.K, nt = K / BK;
    unsigned voffA[2], voffB[2];
#pragma unroll
    for (int i = 0; i < 2; ++i) { int R, C; stage_rc(tid * 16 + i * 8192, R, C); const int Rb = Epi::PERM ? ((R & ~31) + perm32(R & 31)) : R;
        voffA[i] = (unsigned)(R * K + C) * 2u; voffB[i] = (unsigned)(Rb * K + C) * 2u; }
    const size_t kstep = (size_t)(BK * 2);
    const size_t hstep = (size_t)HALF * K * 2;
    const size_t tstep = 2 * hstep;
    const unsigned ldsw = (unsigned)wid * 1024u;
    const int aoff = lds_byte(wr * 64 + fr, fq * 8), boff = lds_byte(wc * 32 + fr, fq * 8);
#define PG8_SA(b, h) (((b) * 2 + (h)) * HTB)
#define PG8_SB(b, h) ((4 + (b) * 2 + (h)) * HTB)
#define PG8_STAGE(bufoff, gbase, voff) do { _Pragma("unroll") for (int _i = 0; _i < 2; ++_i) \
        __builtin_amdgcn_global_load_lds((const unsigned*)((const char*)(gbase) + (voff)[_i]), (PG8_LAS unsigned*)(lds + (bufoff) + ldsw + _i * 8192), 16, 0, 0); } while (0)
#define PG8_LDA(dst, b, h) do { _Pragma("unroll") for (int m = 0; m < 4; ++m) dst[m] = __builtin_shufflevector(*(const PG8_LAS pg8_v4i*)(lds + PG8_SA(b, h) + aoff + m * 2048), *(const PG8_LAS pg8_v4i*)(lds + PG8_SA(b, h) + aoff + m * 2048 + 1024), 0, 1, 2, 3, 4, 5, 6, 7); } while (0)
#define PG8_LDB(dst, b, h) do { _Pragma("unroll") for (int n = 0; n < 2; ++n) dst[n] = __builtin_shufflevector(*(const PG8_LAS pg8_v4i*)(lds + PG8_SB(b, h) + boff + n * 2048), *(const PG8_LAS pg8_v4i*)(lds + PG8_SB(b, h) + boff + n * 2048 + 1024), 0, 1, 2, 3, 4, 5, 6, 7); } while (0)
#define PG8_LO(v) __builtin_bit_cast(bf16x8, __builtin_shufflevector(v, v, 0, 1, 2, 3))
#define PG8_HI(v) __builtin_bit_cast(bf16x8, __builtin_shufflevector(v, v, 4, 5, 6, 7))
#define PG8_MMA(ai, bj, At, Bt) do { __builtin_amdgcn_s_setprio(1); _Pragma("unroll") for (int m = 0; m < 4; ++m) _Pragma("unroll") for (int n = 0; n < 2; ++n) { \
        if constexpr (F8SCALE == 0) { acc[ai][bj][m][n] = __builtin_amdgcn_mfma_f32_16x16x32_bf16(PG8_LO(Bt[n]), PG8_LO(At[m]), acc[ai][bj][m][n], 0, 0, 0); \
                                      acc[ai][bj][m][n] = __builtin_amdgcn_mfma_f32_16x16x32_bf16(PG8_HI(Bt[n]), PG8_HI(At[m]), acc[ai][bj][m][n], 0, 0, 0); } \
        else asm volatile("v_mfma_scale_f32_16x16x128_f8f6f4 %0, %1, %2, %0, %3, %4 op_sel_hi:[0,0,0]" : "+v"(acc[ai][bj][m][n]) : "v"(Bt[n]), "v"(At[m]), "v"(f8_sw_), "v"(f8_sa_)); } \
        __builtin_amdgcn_s_setprio(0); } while (0)
#define PG8_WAIT_V(n) asm volatile("s_waitcnt vmcnt(" #n ")" ::: "memory")
#define PG8_WAIT_L(n) asm volatile("s_waitcnt lgkmcnt(" #n ")" ::: "memory")
#define PG8_BAR __builtin_amdgcn_s_barrier()
#define PG8_SCHED __builtin_amdgcn_sched_barrier(0)
    Unit cur, nxt; int ui = 0;
    if (!S.next(0, cur)) return;
    f32x4 acc[2][2][4][2];
#pragma unroll
    for (int a = 0; a < 2; ++a)
#pragma unroll
        for (int b = 0; b < 2; ++b)
#pragma unroll
            for (int m = 0; m < 4; ++m)
#pragma unroll
                for (int n = 0; n < 2; ++n) acc[a][b][m][n] = (f32x4){0.f, 0.f, 0.f, 0.f};
    pg8_v8i At[4], B0[2], B1[2]; const int f8_sw_ = F8SCALE * 0x01010101, f8_sa_ = 0x7f7f7f7f; (void)f8_sw_; (void)f8_sa_;
    const char* cA = (const char*)g.A + (size_t)cur.pm * tstep; const char* cB = (const char*)g.Bt + (size_t)cur.pn * tstep;
    S.a_ready(cur);
    if constexpr (SP2) {
        PG8_STAGE(PG8_SB(0, 0), cB, voffB); PG8_STAGE(PG8_SB(0, 1), cB + hstep, voffB); PG8_STAGE(PG8_SA(0, 0), cA, voffA); PG8_STAGE(PG8_SA(0, 1), cA + hstep, voffA);
        if (wr == 1) PG8_BAR;
        PG8_WAIT_V(2); PG8_BAR;
        PG8_STAGE(PG8_SB(1, 0), cB + kstep, voffB); PG8_STAGE(PG8_SA(1, 0), cA + kstep, voffA); PG8_STAGE(PG8_SB(1, 1), cB + hstep + kstep, voffB);
        PG8_WAIT_V(6); PG8_BAR;
    } else {
        PG8_STAGE(PG8_SB(0, 0), cB, voffB); PG8_STAGE(PG8_SA(0, 0), cA, voffA); PG8_STAGE(PG8_SB(0, 1), cB + hstep, voffB); PG8_STAGE(PG8_SA(0, 1), cA + hstep, voffA);
        if (wr == 1) PG8_BAR;
        PG8_WAIT_V(4); PG8_BAR;
        PG8_STAGE(PG8_SB(1, 0), cB + kstep, voffB); PG8_STAGE(PG8_SA(1, 0), cA + kstep, voffA); PG8_STAGE(PG8_SB(1, 1), cB + hstep + kstep, voffB);
        PG8_WAIT_V(6); PG8_BAR;
    }
    for (;;) {
        const bool has_next = S.next(ui + 1, nxt);
        const char* nA = has_next ? (const char*)g.A + (size_t)nxt.pm * tstep : cA; const char* nB = has_next ? (const char*)g.Bt + (size_t)nxt.pn * tstep : cB;
        for (int t = 0; t < nt; t += 2) {
            const bool last = (t == nt - 2);
            const char* a1 = cA + (size_t)(t + 1) * kstep;
            const char* a2 = last ? nA : cA + (size_t)(t + 2) * kstep; const char* b2 = last ? nB : cB + (size_t)(t + 2) * kstep;
            const char* a3 = a2 + kstep; const char* b3 = b2 + kstep;
            if (last && has_next) S.a_ready(nxt);
            if constexpr (SP2) {
            PG8_LDB(B0, 0, 0); PG8_LDB(B1, 0, 1); PG8_SCHED; PG8_LDA(At, 0, 0); PG8_STAGE(PG8_SA(1, 1), a1 + hstep, voffA);
            PG8_WAIT_V(8); PG8_WAIT_L(0); PG8_BAR; PG8_MMA(0, 0, At, B0); PG8_MMA(0, 1, At, B1); PG8_BAR; PG8_SCHED;
            PG8_LDA(At, 0, 1); PG8_STAGE(PG8_SB(0, 0), b2, voffB); PG8_STAGE(PG8_SB(0, 1), b2 + hstep, voffB); PG8_STAGE(PG8_SA(0, 0), a2, voffA);
            PG8_WAIT_V(8); PG8_WAIT_L(0); PG8_BAR; PG8_MMA(1, 0, At, B0); PG8_MMA(1, 1, At, B1); PG8_BAR; PG8_SCHED;
            PG8_LDB(B0, 1, 0); PG8_LDB(B1, 1, 1); PG8_SCHED; PG8_LDA(At, 1, 0); PG8_STAGE(PG8_SA(0, 1), a2 + hstep, voffA);
            PG8_WAIT_V(8); PG8_WAIT_L(0); PG8_BAR; PG8_MMA(0, 0, At, B0); PG8_MMA(0, 1, At, B1); PG8_BAR; PG8_SCHED;
            PG8_LDA(At, 1, 1); PG8_STAGE(PG8_SB(1, 0), b3, voffB); PG8_STAGE(PG8_SB(1, 1), b3 + hstep, voffB); PG8_STAGE(PG8_SA(1, 0), a3, voffA);
            PG8_WAIT_V(8); PG8_WAIT_L(0); PG8_BAR; PG8_MMA(1, 0, At, B0); PG8_MMA(1, 1, At, B1); PG8_BAR; PG8_SCHED;
            } else {
            PG8_LDB(B0, 0, 0); PG8_SCHED; PG8_LDA(At, 0, 0); PG8_STAGE(PG8_SA(1, 1), a1 + hstep, voffA);
            PG8_WAIT_L(8); PG8_BAR; PG8_WAIT_L(0); PG8_MMA(0, 0, At, B0); PG8_BAR; PG8_SCHED;
            PG8_LDB(B1, 0, 1); PG8_STAGE(PG8_SB(0, 0), b2, voffB);
            PG8_BAR; PG8_WAIT_L(0); PG8_MMA(0, 1, At, B1); PG8_BAR;
            PG8_LDA(At, 0, 1); PG8_STAGE(PG8_SA(0, 0), a2, voffA);
            PG8_BAR; PG8_WAIT_L(0); PG8_MMA(1, 0, At, B0); PG8_BAR; PG8_SCHED;
            PG8_STAGE(PG8_SB(0, 1), b2 + hstep, voffB);
            PG8_WAIT_V(6); PG8_BAR; PG8_MMA(1, 1, At, B1); PG8_BAR;
            PG8_LDB(B0, 1, 0); PG8_SCHED; PG8_LDA(At, 1, 0); PG8_STAGE(PG8_SA(0, 1), a2 + hstep, voffA);
            PG8_WAIT_L(8); PG8_BAR; PG8_WAIT_L(0); PG8_MMA(0, 0, At, B0); PG8_BAR; PG8_SCHED;
            PG8_LDB(B1, 1, 1); PG8_STAGE(PG8_SB(1, 0), b3, voffB);
            PG8_BAR; PG8_WAIT_L(0); PG8_MMA(0, 1, At, B1); PG8_BAR;
            PG8_LDA(At, 1, 1); PG8_STAGE(PG8_SA(1, 0), a3, voffA);
            PG8_BAR; PG8_WAIT_L(0); PG8_MMA(1, 0, At, B0); PG8_BAR; PG8_SCHED;
            PG8_STAGE(PG8_SB(1, 1), b3 + hstep, voffB);
            PG8_WAIT_V(6); PG8_BAR; PG8_MMA(1, 1, At, B1); PG8_BAR;
            }
        }
        if constexpr (ALIGN_EPI) { if (wr == 0) PG8_BAR; }
        if constexpr (!Epi::AFTER_DRAIN) { E(acc, cur, wr, wc, fr, fq); S.done(cur); }
        if (!has_next) break;
#pragma unroll
        for (int a = 0; a < 2; ++a)
#pragma unroll
            for (int b = 0; b < 2; ++b)
#pragma unroll
                for (int m = 0; m < 4; ++m)
#pragma unroll
                    for (int n = 0; n < 2; ++n) acc[a][b][m][n] = (f32x4){0.f, 0.f, 0.f, 0.f};
        cur = nxt; cA = nA; cB = nB; ++ui;
        if constexpr (ALIGN_EPI) { if (wr == 1) PG8_BAR; }
    }
    PG8_WAIT_V(0);
    if constexpr (!ALIGN_EPI) { if (wr == 0) PG8_BAR; }
    PG8_BAR;
    if constexpr (Epi::AFTER_DRAIN) { E.fused(acc, cur, wr, wc, fr, fq, lds, wid, lane); S.done(cur); }
#undef PG8_SA
#undef PG8_SB
#undef PG8_STAGE
#undef PG8_LDA
#undef PG8_LDB
#undef PG8_MMA
#undef PG8_WAIT_V
#undef PG8_WAIT_L
#undef PG8_BAR
#undef PG8_SCHED
}
}

#ifndef PG8_SP2
#define PG8_SP2 true
#endif
#ifndef PG8_ALIGN
#define PG8_ALIGN true
#endif
#define GAS __attribute__((address_space(1)))
#define LAS __attribute__((address_space(3)))
typedef unsigned short bf16;
typedef unsigned v4u __attribute__((ext_vector_type(4)));
typedef float f32x4 __attribute__((ext_vector_type(4)));
typedef short bf16x8 __attribute__((ext_vector_type(8)));
typedef GAS unsigned gu32;
typedef GAS unsigned long long gu64;
#define RLX_AGENT __ATOMIC_RELAXED, __HIP_MEMORY_SCOPE_AGENT
#define LDS_WAIT() asm volatile("s_waitcnt lgkmcnt(0)" ::: "memory")
#define VM_WAIT() asm volatile("s_waitcnt vmcnt(0)" ::: "memory")
__device__ __forceinline__ unsigned long long rt() { return __builtin_amdgcn_s_memrealtime(); }
__device__ __forceinline__ unsigned f2bf(float f) { return pg8::cvt_pk_bf16(f, f) & 0xffffu; }
__device__ __forceinline__ unsigned pk2(float lo, float hi) { return pg8::cvt_pk_bf16(lo, hi); }

#define XB_TMO      128
#define XB_XCNT(j)  (256  + 64 * (j))
#define XB_XSUB(j)  (1280 + 64 * (j))
#define XB_XGEN(j)  (2304 + 64 * (j))
#define XB_TOP      3328
#define XB_TOPGEN   3392
#define XCD_BAR_WORDS 3456
#define XB_SPIN_CAP (1u << 18)

__device__ __forceinline__ unsigned xb_ld(unsigned* p)              { return __hip_atomic_load(p, __ATOMIC_RELAXED, __HIP_MEMORY_SCOPE_AGENT); }
__device__ __forceinline__ unsigned xb_add(unsigned* p, unsigned v) { return __hip_atomic_fetch_add(p, v, __ATOMIC_RELAXED, __HIP_MEMORY_SCOPE_AGENT); }
__device__ __forceinline__ unsigned xb_xcc_id() { return (unsigned)__builtin_amdgcn_s_getreg((3 << 11) | 20) & 0xFu; }
#define XB_SPIN(cond, bar) do { unsigned _sp = 0; while (cond) { __builtin_amdgcn_s_sleep(1); \
    if ((++_sp & 255u) == 0u) { if (xb_ld(&(bar)[XB_TMO])) break; if (_sp > XB_SPIN_CAP) { atomicAdd(&(bar)[XB_TMO], 1u); break; } } } } while (0)

struct XcdBarrier {
    unsigned* bar; unsigned x;
    volatile LAS unsigned* st;
};

__device__ __forceinline__ XcdBarrier xcd_barrier_post(unsigned* bar, volatile LAS unsigned* st) {
    XcdBarrier b; b.bar = bar; b.x = xb_xcc_id(); b.st = st;
    if (threadIdx.x == 0) (void)xb_add(&bar[XB_XCNT(b.x)], 1u);
    return b;
}
__device__ __forceinline__ void xcd_barrier_complete(unsigned* bar, unsigned x, unsigned& nloc, unsigned& nx) {
    const unsigned G = gridDim.x * gridDim.y * gridDim.z;
    unsigned sum, cnt, mine, sp = 0u;
    for (;;) {
        sum = 0u; cnt = 0u; mine = 0u;
#pragma unroll
        for (unsigned j = 0; j < 16; ++j) { const unsigned c = xb_ld(&bar[XB_XCNT(j)]); sum += c; cnt += (c > 0u) ? 1u : 0u; mine = (j == x) ? c : mine; }
        if (sum == G) break;
        __builtin_amdgcn_s_sleep(1);
        if ((++sp & 255u) == 0u) { if (xb_ld(&bar[XB_TMO])) break; if (sp > XB_SPIN_CAP) { atomicAdd(&bar[XB_TMO], 1u); break; } }
    }
    nloc = mine > 0u ? mine : 1u; nx = cnt > 0u ? cnt : 1u;
}

__device__ __forceinline__ void xcd_barrier(const XcdBarrier& b) {
    asm volatile("s_waitcnt vmcnt(0)" ::: "memory");
    __syncthreads();
    if (threadIdx.x == 0) {
        unsigned* bar = b.bar;
        __builtin_amdgcn_s_waitcnt(0);
        unsigned nloc = b.st[0], nx = b.st[1];
        if (nloc == 0u) { xcd_barrier_complete(bar, b.x, nloc, nx); b.st[0] = nloc; b.st[1] = nx; }
        const unsigned old = xb_add(&bar[XB_XSUB(b.x)], 1u);
        const unsigned gen = old / nloc;
        if (old + 1u == (gen + 1u) * nloc) {
            __builtin_amdgcn_fence(__ATOMIC_RELEASE, "agent");
            asm volatile("s_waitcnt vmcnt(0)" ::: "memory");
            const unsigned og = xb_add(&bar[XB_TOP], 1u);
            const unsigned tg = og / nx;
            if (og + 1u == (tg + 1u) * nx) xb_add(&bar[XB_TOPGEN], 1u);
            else XB_SPIN(xb_ld(&bar[XB_TOPGEN]) == tg, bar);
            __builtin_amdgcn_fence(__ATOMIC_ACQUIRE, "agent");
            xb_add(&bar[XB_XGEN(b.x)], 1u);
            asm volatile("s_waitcnt vmcnt(0)" ::: "memory");
        } else {
            XB_SPIN(xb_ld(&bar[XB_XGEN(b.x)]) == gen, bar);
            __builtin_amdgcn_fence(__ATOMIC_ACQUIRE, "agent");
            asm volatile("s_waitcnt vmcnt(0)" ::: "memory");
        }
    }
    __syncthreads();
}
__device__ __forceinline__ void xcd_barrier_tail(const XcdBarrier& b) {
    if (threadIdx.x == 0) {
        unsigned* bar = b.bar;
        __builtin_amdgcn_s_waitcnt(0);
        unsigned nloc = b.st[0], nx = b.st[1];
        if (nloc == 0u) { xcd_barrier_complete(bar, b.x, nloc, nx); b.st[0] = nloc; b.st[1] = nx; }
        const unsigned old = xb_add(&bar[XB_XSUB(b.x)], 1u);
        const unsigned gen = old / nloc;
        if (old + 1u == (gen + 1u) * nloc) {
            __builtin_amdgcn_fence(__ATOMIC_RELEASE, "agent");
            asm volatile("s_waitcnt vmcnt(0)" ::: "memory");
            const unsigned og = xb_add(&bar[XB_TOP], 1u);
            const unsigned tg = og / nx;
            if (og + 1u == (tg + 1u) * nx) xb_add(&bar[XB_TOPGEN], 1u);
            else XB_SPIN(xb_ld(&bar[XB_TOPGEN]) == tg, bar);
            __builtin_amdgcn_fence(__ATOMIC_ACQUIRE, "agent");
            xb_add(&bar[XB_XGEN(b.x)], 1u);
            asm volatile("s_waitcnt vmcnt(0)" ::: "memory");
        } else {
            XB_SPIN(xb_ld(&bar[XB_XGEN(b.x)]) == gen, bar);
            __builtin_amdgcn_fence(__ATOMIC_ACQUIRE, "agent");
            asm volatile("s_waitcnt vmcnt(0)" ::: "memory");
        }
    }
    __syncthreads();
}

constexpr int NWAVES = 8;
constexpr int T = 16384, D = 2048, NIN = 11264;
constexpr float LN_EPS = 1e-5f, GN_EPS = 64e-5f, ALPHA = 1.189207115002721f;
constexpr size_t MiB = 1u << 20;
constexpr size_t WS_CTL = 0, CTL_ZERO_BYTES = 1 * MiB;
constexpr size_t WS_WIN = 1 * MiB, WS_WUA = 45 * MiB, WS_WUB = 49 * MiB, WS_WO = 53 * MiB, WS_WQ = 61 * MiB, WS_WPG = 69 * MiB, WS_WPE = 77 * MiB;
constexpr size_t WS_L1 = 78 * MiB;
constexpr size_t WS_L2 = 79 * MiB + MiB / 2;
constexpr size_t WS_PB = 81 * MiB;
constexpr size_t WS_XB = 90 * MiB;
constexpr size_t WS_PROJ = 154 * MiB;
constexpr size_t WS_Q = WS_PROJ, WS_K = WS_PROJ + 32 * MiB, WS_V = WS_PROJ + 64 * MiB, WS_RR = WS_PROJ + 96 * MiB, WS_RK = WS_PROJ + 128 * MiB, WS_RV = WS_PROJ + 160 * MiB, WS_RC = WS_PROJ + 192 * MiB;
constexpr size_t WS_YB = WS_RK;
constexpr size_t WS_QC = WS_Q, WS_GTC = WS_K, WS_YLC = WS_V, WS_TTC = WS_RC, WS_SB = WS_XB + 32 * MiB;
constexpr size_t WS_YRAW = WS_K;
constexpr size_t WS_GG = 522 * MiB;
constexpr size_t WS_DREG = 378 * MiB;
constexpr size_t WS_HID = WS_DREG;
constexpr size_t WS_XW = WS_DREG + 24 * MiB;
constexpr size_t WS_LW = WS_DREG;
constexpr size_t WS_AA = WS_DREG + 64 * MiB;
constexpr size_t WS_GATE = WS_DREG;
constexpr size_t WS_MIX = WS_XB, WS_PQ = WS_XB;
constexpr size_t WS_MIX8 = WS_Q;
constexpr size_t WS_X1B8 = 378 * MiB;
constexpr size_t WS_H1 = 186 * MiB;
constexpr size_t WS_X1 = 314 * MiB;
constexpr size_t WS_X1B = 442 * MiB;
constexpr size_t WS_PE = 154 * MiB;
constexpr size_t WS_YA = 506 * MiB;
constexpr size_t WS_IDX = 506 * MiB, WS_PG = 514 * MiB;
constexpr size_t WS_UB = 314 * MiB, WS_VB = 346 * MiB;
constexpr float U_SCALE = 64.0f, V_SCALE = 2.0f;
constexpr int ROW6 = 1536;
constexpr size_t WS_RKC = 538 * MiB;
constexpr size_t WS_END = 539 * MiB;
constexpr int CW_BAR = 4096, CW_RCNT = 16384;
constexpr int RING_OFF = 0, RING_BYTES = 131072, LDSCTL_OFF = RING_BYTES, MISC_OFF = LDSCTL_OFF + 320, LDS_BYTES = 147456;
constexpr int NPHASE = 13;
#ifndef MK_ONE_LAUNCH
#define MK_ONE_LAUNCH 0
#endif

struct Frame {
    LAS unsigned char* lds; volatile LAS unsigned* MISC; gu32* ctl;
    int tid, lane, wave, vcu, G;
};
template <int CTRL> __device__ __forceinline__ float dpp_addc(float x) { return x + __builtin_bit_cast(float, __builtin_amdgcn_mov_dpp(__builtin_bit_cast(int, x), CTRL, 0xf, 0xf, true)); }
__device__ __forceinline__ float row16_sum(float x) { x = dpp_addc<0xB1>(x); x = dpp_addc<0x4E>(x); x = dpp_addc<0x141>(x); x = dpp_addc<0x140>(x); return x; }
__device__ __forceinline__ float wave_sum(float v) {
    v = row16_sum(v);
    const float a = __builtin_bit_cast(float, __builtin_amdgcn_readlane(__builtin_bit_cast(int, v), 0)), b = __builtin_bit_cast(float, __builtin_amdgcn_readlane(__builtin_bit_cast(int, v), 16));
    const float c = __builtin_bit_cast(float, __builtin_amdgcn_readlane(__builtin_bit_cast(int, v), 32)), d = __builtin_bit_cast(float, __builtin_amdgcn_readlane(__builtin_bit_cast(int, v), 48));
    return (a + b) + (c + d);
}
__device__ __forceinline__ float wave_max(float v) {
#pragma unroll
    for (int o = 1; o < 64; o <<= 1) v = fmaxf(v, __shfl_xor(v, o));
    return v;
}
__device__ __forceinline__ float bflo(unsigned w) { return __uint_as_float(w << 16); }
__device__ __forceinline__ float bfhi(unsigned w) { return __uint_as_float(w & 0xffff0000u); }
__device__ __forceinline__ float bf1(bf16 b) { return __uint_as_float(((unsigned)b) << 16); }
typedef __attribute__((ext_vector_type(2))) __bf16 bf16x2_t;
typedef float f32x16 __attribute__((ext_vector_type(16)));
__device__ __forceinline__ float dot2(unsigned a, unsigned b, float c) { return __builtin_amdgcn_fdot2_f32_bf16(__builtin_bit_cast(bf16x2_t, a), __builtin_bit_cast(bf16x2_t, b), c, false); }
__device__ __forceinline__ float rdlane(float v, int l) { return __builtin_bit_cast(float, __builtin_amdgcn_readlane(__builtin_bit_cast(int, v), l)); }
__device__ __forceinline__ int rdlanei(int v, int l) { return __builtin_amdgcn_readlane(v, l); }

__device__ __forceinline__ void p0_transpose_item(const float* W, int K, int N, bf16* WT, LAS float* scr, int item, int lane) {
    const int nblk = N / 32, kb = item / nblk, nb = item % nblk, k0 = 64 * kb, n0 = 32 * nb;
#pragma unroll 8
    for (int i = 0; i < 32; ++i) { const int kk = 2 * i + (lane >> 5); scr[kk * 33 + (lane & 31)] = W[(size_t)(k0 + kk) * N + n0 + (lane & 31)]; }
    LDS_WAIT(); asm volatile("" ::: "memory");
    const int c = lane & 7;
#pragma unroll
    for (int j = 0; j < 4; ++j) { const int n = (lane >> 3) + 8 * j; const LAS float* s = scr + (8 * c) * 33 + n;
        v4u o; o.x = pk2(s[0 * 33], s[1 * 33]); o.y = pk2(s[2 * 33], s[3 * 33]); o.z = pk2(s[4 * 33], s[5 * 33]); o.w = pk2(s[6 * 33], s[7 * 33]);
        *(GAS v4u*)(WT + (size_t)(n0 + n) * K + k0 + 8 * c) = o; }
    LDS_WAIT(); asm volatile("" ::: "memory");
}
__device__ __forceinline__ void p0_transpose_item8(const float* W, int K, int N, unsigned char* WT, float scale, LAS float* scr, int item, int lane) {
    const int nblk = N / 32, kb = item / nblk, nb = item % nblk, k0 = 64 * kb, n0 = 32 * nb;
#pragma unroll 8
    for (int i = 0; i < 32; ++i) { const int kk = 2 * i + (lane >> 5); scr[kk * 33 + (lane & 31)] = W[(size_t)(k0 + kk) * N + n0 + (lane & 31)] * scale; }
    LDS_WAIT(); asm volatile("" ::: "memory");
    const int c = lane & 7;
#pragma unroll
    for (int j = 0; j < 4; ++j) { const int n = (lane >> 3) + 8 * j; const LAS float* s = scr + (8 * c) * 33 + n;
        int w0_ = 0, w1_ = 0; w0_ = __builtin_amdgcn_cvt_pk_fp8_f32(s[0 * 33], s[1 * 33], w0_, false); w0_ = __builtin_amdgcn_cvt_pk_fp8_f32(s[2 * 33], s[3 * 33], w0_, true);
        w1_ = __builtin_amdgcn_cvt_pk_fp8_f32(s[4 * 33], s[5 * 33], w1_, false); w1_ = __builtin_amdgcn_cvt_pk_fp8_f32(s[6 * 33], s[7 * 33], w1_, true);
        *(GAS unsigned long long*)(WT + (size_t)(n0 + n) * K + k0 + 8 * c) = (unsigned long long)(unsigned)w0_ | ((unsigned long long)(unsigned)w1_ << 32); }
    LDS_WAIT(); asm volatile("" ::: "memory");
}
__device__ __forceinline__ void cvt_rows_bf16(const float* src, bf16* dst, size_t n8, size_t i0, size_t stride) {
    for (size_t i = i0; i < n8; i += stride) { const f32x4 a = ((const GAS f32x4*)src)[2 * i], b = ((const GAS f32x4*)src)[2 * i + 1];
        v4u o; o.x = pk2(a.x, a.y); o.y = pk2(a.z, a.w); o.z = pk2(b.x, b.y); o.w = pk2(b.z, b.w); ((GAS v4u*)dst)[i] = o; }
}


typedef short v4i16_t __attribute__((ext_vector_type(4)));
constexpr int RW_PIT = 144, RW_SLOT = 64 * RW_PIT;
__device__ __forceinline__ bf16x8 rw_fd(const LAS unsigned char* img, int r0, int ks, int idx, int g) { return *(const LAS bf16x8*)(img + (r0 + idx) * RW_PIT + (32 * ks + 8 * g) * 2); }
__device__ __forceinline__ bf16x8 rw_ft(const LAS unsigned char* img, int c0, int ks, int idx, int g) {
    const LAS unsigned char* a = img + (32 * ks + 8 * g + (idx >> 2)) * RW_PIT + (c0 + 4 * (idx & 3)) * 2;
    const v4i16_t lo = __builtin_amdgcn_ds_read_tr16_b64_v4i16((LAS v4i16_t*)a), hi = __builtin_amdgcn_ds_read_tr16_b64_v4i16((LAS v4i16_t*)(a + 4 * RW_PIT));
    return __builtin_shufflevector(lo, hi, 0, 1, 2, 3, 4, 5, 6, 7); }
template <int MX, int MY> __device__ __forceinline__ void rw_mm2(const LAS unsigned char* X, const LAS unsigned char* Y, int mt, int ntb, f32x4& c0, f32x4& c1, int idx, int g) {
#pragma unroll
    for (int ks = 0; ks < 2; ++ks) {
        const bf16x8 a = MX ? rw_ft(X, 16 * mt, ks, idx, g) : rw_fd(X, 16 * mt, ks, idx, g);
        const bf16x8 b0 = MY ? rw_ft(Y, 16 * ntb, ks, idx, g) : rw_fd(Y, 16 * ntb, ks, idx, g);
        const bf16x8 b1 = MY ? rw_ft(Y, 16 * ntb + 16, ks, idx, g) : rw_fd(Y, 16 * ntb + 16, ks, idx, g);
        c0 = __builtin_amdgcn_mfma_f32_16x16x32_bf16(a, b0, c0, 0, 0, 0); c1 = __builtin_amdgcn_mfma_f32_16x16x32_bf16(a, b1, c1, 0, 0, 0); }
}
template <int MX, int MY, int MZ> __device__ __forceinline__ void rw_mm2_shareA(const LAS unsigned char* X, const LAS unsigned char* Y, const LAS unsigned char* Z, int mt, int ntb, f32x4& c0, f32x4& c1, f32x4& d0, f32x4& d1, int idx, int g) {
#pragma unroll
    for (int ks = 0; ks < 2; ++ks) {
        const bf16x8 a = MX ? rw_ft(X, 16 * mt, ks, idx, g) : rw_fd(X, 16 * mt, ks, idx, g);
        const bf16x8 y0 = MY ? rw_ft(Y, 16 * ntb, ks, idx, g) : rw_fd(Y, 16 * ntb, ks, idx, g), y1 = MY ? rw_ft(Y, 16 * ntb + 16, ks, idx, g) : rw_fd(Y, 16 * ntb + 16, ks, idx, g);
        const bf16x8 z0 = MZ ? rw_ft(Z, 16 * ntb, ks, idx, g) : rw_fd(Z, 16 * ntb, ks, idx, g), z1 = MZ ? rw_ft(Z, 16 * ntb + 16, ks, idx, g) : rw_fd(Z, 16 * ntb + 16, ks, idx, g);
        c0 = __builtin_amdgcn_mfma_f32_16x16x32_bf16(a, y0, c0, 0, 0, 0); c1 = __builtin_amdgcn_mfma_f32_16x16x32_bf16(a, y1, c1, 0, 0, 0);
        d0 = __builtin_amdgcn_mfma_f32_16x16x32_bf16(a, z0, d0, 0, 0, 0); d1 = __builtin_amdgcn_mfma_f32_16x16x32_bf16(a, z1, d1, 0, 0, 0); }
}
template <int MX, int MW, int MY> __device__ __forceinline__ void rw_mm2_shareB(const LAS unsigned char* X, const LAS unsigned char* W, const LAS unsigned char* Y, int mt, int ntb, f32x4& c0, f32x4& c1, f32x4& d0, f32x4& d1, int idx, int g) {
#pragma unroll
    for (int ks = 0; ks < 2; ++ks) {
        const bf16x8 a = MX ? rw_ft(X, 16 * mt, ks, idx, g) : rw_fd(X, 16 * mt, ks, idx, g), w = MW ? rw_ft(W, 16 * mt, ks, idx, g) : rw_fd(W, 16 * mt, ks, idx, g);
        const bf16x8 y0 = MY ? rw_ft(Y, 16 * ntb, ks, idx, g) : rw_fd(Y, 16 * ntb, ks, idx, g), y1 = MY ? rw_ft(Y, 16 * ntb + 16, ks, idx, g) : rw_fd(Y, 16 * ntb + 16, ks, idx, g);
        c0 = __builtin_amdgcn_mfma_f32_16x16x32_bf16(a, y0, c0, 0, 0, 0); c1 = __builtin_amdgcn_mfma_f32_16x16x32_bf16(a, y1, c1, 0, 0, 0);
        d0 = __builtin_amdgcn_mfma_f32_16x16x32_bf16(w, y0, d0, 0, 0, 0); d1 = __builtin_amdgcn_mfma_f32_16x16x32_bf16(w, y1, d1, 0, 0, 0); }
}
#define RW_FR(M, img, r0, ks) ((M) ? rw_ft(img, r0, ks, idx, g) : rw_fd(img, r0, ks, idx, g))
#define RW_MF(a, b, c) c = __builtin_amdgcn_mfma_f32_16x16x32_bf16(a, b, c, 0, 0, 0)
template <int MX, int MY> __device__ __forceinline__ void rw_mm22(const LAS unsigned char* X, const LAS unsigned char* Y, int mt0, int nt0, f32x4 (&c)[2][2], int idx, int g, bool k0 = true, bool k1 = true) {
#pragma unroll
    for (int ks = 0; ks < 2; ++ks) if (ks == 0 ? k0 : k1) { const bf16x8 a0 = RW_FR(MX, X, 16 * mt0, ks), a1 = RW_FR(MX, X, 16 * mt0 + 16, ks), b0 = RW_FR(MY, Y, 16 * nt0, ks), b1 = RW_FR(MY, Y, 16 * nt0 + 16, ks);
        RW_MF(a0, b0, c[0][0]); RW_MF(a0, b1, c[0][1]); RW_MF(a1, b0, c[1][0]); RW_MF(a1, b1, c[1][1]); }
}
template <int MX, int MY, int MZ> __device__ __forceinline__ void rw_mm22_shareA(const LAS unsigned char* X, const LAS unsigned char* Y, const LAS unsigned char* Z, int mt0, int nt0, f32x4 (&c)[2][2], f32x4 (&d)[2][2], int idx, int g, bool cy1 = true) {
#pragma unroll
    for (int ks = 0; ks < 2; ++ks) { const bf16x8 a0 = RW_FR(MX, X, 16 * mt0, ks), a1 = RW_FR(MX, X, 16 * mt0 + 16, ks), z0 = RW_FR(MZ, Z, 16 * nt0, ks), z1 = RW_FR(MZ, Z, 16 * nt0 + 16, ks);
        if (ks == 0 || cy1) { const bf16x8 y0 = RW_FR(MY, Y, 16 * nt0, ks), y1 = RW_FR(MY, Y, 16 * nt0 + 16, ks); RW_MF(a0, y0, c[0][0]); RW_MF(a0, y1, c[0][1]); RW_MF(a1, y0, c[1][0]); RW_MF(a1, y1, c[1][1]); }
        RW_MF(a0, z0, d[0][0]); RW_MF(a0, z1, d[0][1]); RW_MF(a1, z0, d[1][0]); RW_MF(a1, z1, d[1][1]); }
}
template <int MX, int MW, int MY> __device__ __forceinline__ void rw_mm22_shareB(const LAS unsigned char* X, const LAS unsigned char* W, const LAS unsigned char* Y, int mt0, int nt0, f32x4 (&c)[2][2], f32x4 (&d)[2][2], int idx, int g, bool cx0 = true, bool cx1 = true, bool dw0 = true) {
#pragma unroll
    for (int ks = 0; ks < 2; ++ks) { const bool cx = ks == 0 ? cx0 : cx1, dw = ks == 0 ? dw0 : true;
        if (cx || dw) { const bf16x8 y0 = RW_FR(MY, Y, 16 * nt0, ks), y1 = RW_FR(MY, Y, 16 * nt0 + 16, ks);
            if (cx) { const bf16x8 a0 = RW_FR(MX, X, 16 * mt0, ks), a1 = RW_FR(MX, X, 16 * mt0 + 16, ks); RW_MF(a0, y0, c[0][0]); RW_MF(a0, y1, c[0][1]); RW_MF(a1, y0, c[1][0]); RW_MF(a1, y1, c[1][1]); }
            if (dw) { const bf16x8 w0 = RW_FR(MW, W, 16 * mt0, ks), w1 = RW_FR(MW, W, 16 * mt0 + 16, ks); RW_MF(w0, y0, d[0][0]); RW_MF(w0, y1, d[0][1]); RW_MF(w1, y0, d[1][0]); RW_MF(w1, y1, d[1][1]); } } }
}
__device__ __forceinline__ void rw_st(LAS unsigned char* E, int mt, int nt, const f32x4& c, int idx, int g) {
    *(LAS unsigned long long*)(E + (16 * nt + idx) * RW_PIT + (16 * mt + 4 * g) * 2) = (unsigned long long)pk2(c[0], c[1]) | ((unsigned long long)pk2(c[2], c[3]) << 32); }
__device__ __forceinline__ f32x4 rw_ld(const LAS unsigned char* E, int mt, int nt, int idx, int g) {
    const unsigned long long w = *(const LAS unsigned long long*)(E + (16 * nt + idx) * RW_PIT + (16 * mt + 4 * g) * 2); const unsigned lo = (unsigned)w, hi = (unsigned)(w >> 32);
    return (f32x4){bflo(lo), bfhi(lo), bflo(hi), bfhi(hi)}; }
__device__ __forceinline__ void rw_stg_wt(bf16* E, int mt, int nt, const f32x4& c, int idx, int g) {
    __hip_atomic_store((gu64*)(E + (16 * nt + idx) * 64 + 16 * mt + 4 * g), (unsigned long long)pk2(c[0], c[1]) | ((unsigned long long)pk2(c[2], c[3]) << 32), RLX_AGENT); }
__device__ __forceinline__ void rw_stg(bf16* E, int mt, int nt, const f32x4& c, int idx, int g) {
    *(GAS unsigned long long*)(E + (16 * nt + idx) * 64 + 16 * mt + 4 * g) = (unsigned long long)pk2(c[0], c[1]) | ((unsigned long long)pk2(c[2], c[3]) << 32); }

__device__ __forceinline__ void bitonic_merge16_desc(float (&v)[16]) {
#pragma unroll
    for (int j = 8; j > 0; j >>= 1)
#pragma unroll
        for (int i = 0; i < 16; ++i) { const int l = i ^ j; if (l > i) { const float hi = fmaxf(v[i], v[l]), lo = fminf(v[i], v[l]); v[i] = hi; v[l] = lo; } }
}
__device__ __forceinline__ void bitonic_sort16_desc(float (&v)[16]) {
#pragma unroll
    for (int k = 2; k <= 16; k <<= 1)
#pragma unroll
        for (int j = k >> 1; j > 0; j >>= 1)
#pragma unroll
            for (int i = 0; i < 16; ++i) { const int l = i ^ j; if (l > i) { const float hi = fmaxf(v[i], v[l]), lo = fminf(v[i], v[l]); const bool desc = (i & k) == 0; v[i] = desc ? hi : lo; v[l] = desc ? lo : hi; } }
}
__device__ __forceinline__ void top16_merge_desc(float (&a)[16], const float (&b)[16]) {
#pragma unroll
    for (int i = 0; i < 16; ++i) a[i] = fmaxf(a[i], b[15 - i]);
    bitonic_merge16_desc(a);
}

#ifndef P4_VARIANT
#define P4_VARIANT 0
#endif
#ifndef P4_ALIGN
#define P4_ALIGN PG8_ALIGN
#endif
#ifndef P4_SP2
#define P4_SP2 PG8_SP2
#endif
#ifndef DIAG_TOL
#define DIAG_TOL 0.03f
#endif
#ifndef REPEAT_SUB
#define REPEAT_SUB 0
#endif
#ifndef REPEAT_PHASE
#define REPEAT_PHASE -1
#endif
#define REP_BEGIN(k) for (int rep_ = 0; rep_ < ((REPEAT_PHASE) == (k) ? 2 : 1); ++rep_) {
#define REP_END(k) if ((REPEAT_PHASE) == (k) && rep_ == 0) xcd_barrier(bar); }
#ifndef DIAG_RATIO
#define DIAG_RATIO 2.0
#endif
#ifndef DIAG_UNIT_MS
#define DIAG_UNIT_MS 10
#endif
#ifndef DIAG_LAST
#define DIAG_LAST -1
#endif
template <class TT_> __device__ __forceinline__ float dg_val(const TT_* p, size_t i);
template <> __device__ __forceinline__ float dg_val<float>(const float* p, size_t i) { return p[i]; }
template <> __device__ __forceinline__ float dg_val<bf16>(const bf16* p, size_t i) { return bf1(p[i]); }
template <> __device__ __forceinline__ float dg_val<int>(const int* p, size_t i) { return (float)p[i] * (1.0f / 1024.0f); }
template <class TT_> __device__ __forceinline__ void digest(float* out, int slot, const TT_* buf, size_t n, size_t gt, size_t NGT) {
    constexpr size_t M = (size_t)1024 * 2048;
    for (size_t e = gt; e < M; e += NGT) { float s = 0.f; for (size_t j = e; j < n; j += M) s += dg_val<TT_>(buf, j); out[(size_t)slot * M + e] = s; }
}

__device__ __forceinline__ void cvt_rows_fp8(const float* src, unsigned char* dst, size_t n16, float scale, size_t i0, size_t stride) {
    for (size_t i = i0; i < n16; i += stride) { v4u o;
#pragma unroll
        for (int q = 0; q < 4; ++q) { const f32x4 a = ((const GAS f32x4*)src)[4 * i + q] * scale; int w = 0; w = __builtin_amdgcn_cvt_pk_fp8_f32(a.x, a.y, w, false); w = __builtin_amdgcn_cvt_pk_fp8_f32(a.z, a.w, w, true); o[q] = (unsigned)w; }
        ((GAS v4u*)dst)[i] = o; }
}

typedef unsigned v16u_t __attribute__((ext_vector_type(16))); typedef float v32f_t __attribute__((ext_vector_type(32))); typedef float v16f_t __attribute__((ext_vector_type(16))); typedef unsigned v6u_t __attribute__((ext_vector_type(6)));
__device__ __forceinline__ void cvt_rows_fp6(const float* src, unsigned char* dst, int nrows, float scale, int gw, int ngw, int lane) {
    for (int row = gw; row < nrows; row += ngw) { v16f_t a, b;
#pragma unroll
        for (int q = 0; q < 8; ++q) { const f32x4 v = *(const GAS f32x4*)(src + (size_t)row * 2048 + 256 * q + 4 * lane) * scale; a[2 * q] = v.x; b[2 * q] = v.y; a[2 * q + 1] = v.z; b[2 * q + 1] = v.w; }
        const v6u_t p = __builtin_amdgcn_cvt_scalef32_2xpk16_fp6_f32(a, b, 1.0f); GAS unsigned long long* d = (GAS unsigned long long*)(dst + (size_t)row * 1536 + 24 * lane);
        d[0] = (unsigned long long)p[0] | ((unsigned long long)p[1] << 32); d[1] = (unsigned long long)p[2] | ((unsigned long long)p[3] << 32); d[2] = (unsigned long long)p[4] | ((unsigned long long)p[5] << 32); }
}
__device__ __forceinline__ void cvt_rows_fp6_span(const float* vsrc, unsigned char* vdst, float vscale, const float* usrc, unsigned char* udst, float uscale, int r0, int r1, int wid, int nw, int lane) {
    for (int rb = r0 + wid; rb < r1; rb += 4 * nw) {
        f32x4 ld[4][8];
#pragma unroll
        for (int k = 0; k < 4; ++k) { const int r = rb + k * nw; const bool on = r < r1, isv = r < 16384; const int row = isv ? r : r - 16384; const float* src = isv ? vsrc : usrc;
#pragma unroll
            for (int q = 0; q < 8; ++q) ld[k][q] = on ? *(const GAS f32x4*)(src + (size_t)row * 2048 + 256 * q + 4 * lane) : (f32x4){0.f, 0.f, 0.f, 0.f}; }
#pragma unroll
        for (int k = 0; k < 4; ++k) { const int r = rb + k * nw; const bool on = r < r1, isv = r < 16384; const int row = isv ? r : r - 16384; unsigned char* dst = isv ? vdst : udst; const float scale = isv ? vscale : uscale; v16f_t a, b;
#pragma unroll
            for (int q = 0; q < 8; ++q) { const f32x4 v = ld[k][q] * scale; a[2 * q] = v.x; b[2 * q] = v.y; a[2 * q + 1] = v.z; b[2 * q + 1] = v.w; }
            const v6u_t p = __builtin_amdgcn_cvt_scalef32_2xpk16_fp6_f32(a, b, 1.0f); GAS unsigned long long* d = (GAS unsigned long long*)(dst + (size_t)row * 1536 + 24 * lane);
            if (on) { d[0] = (unsigned long long)p[0] | ((unsigned long long)p[1] << 32); d[1] = (unsigned long long)p[2] | ((unsigned long long)p[3] << 32); d[2] = (unsigned long long)p[4] | ((unsigned long long)p[5] << 32); } }
    }
}
__device__ __forceinline__ v32f_t ld_fp6x32(const unsigned char* p) { const GAS unsigned long long* q = (const GAS unsigned long long*)p; const unsigned long long w0 = q[0], w1 = q[1], w2 = q[2];
    const v6u_t v = {(unsigned)w0, (unsigned)(w0 >> 32), (unsigned)w1, (unsigned)(w1 >> 32), (unsigned)w2, (unsigned)(w2 >> 32)}; return __builtin_amdgcn_cvt_scalef32_pk32_f32_fp6(v, 1.0f); }

struct Args { const float* in[30]; float* out; unsigned char* ws; int ph_lo, ph_hi, li, pad; };

__global__ void __launch_bounds__(NWAVES * 64, 2) mk_fwd(Args args) {
    extern __shared__ __attribute__((aligned(16))) unsigned char lds[];
    for (int u = threadIdx.x; u < (LDS_BYTES - LDSCTL_OFF) / 4; u += NWAVES * 64) ((LAS unsigned*)((LAS unsigned char*)lds + LDSCTL_OFF))[u] = 0u;
    __syncthreads();
    XcdBarrier bar; bar.bar = (unsigned*)(args.ws + WS_CTL) + CW_BAR; bar.x = 0; bar.st = nullptr;
    if (MK_ONE_LAUNCH) bar = xcd_barrier_post((unsigned*)(args.ws + WS_CTL) + CW_BAR, (volatile LAS unsigned*)((LAS unsigned char*)lds + MISC_OFF) + 8);
    const int lo = args.ph_lo, hi = args.ph_hi;
#ifdef DIAG_TIME
    if (blockIdx.x == 0 && threadIdx.x == 0) { const unsigned long long t0_ = __builtin_amdgcn_s_memrealtime(); ((unsigned long long*)(args.ws + WS_CTL))[8] = t0_; }
#endif
#ifndef PHMASK
#define PHMASK 0xffffffffu
#endif
#define IN(k) (((PHMASK >> (k)) & 1u) && lo <= (k) && (k) < hi)
#define SEAM(k) do { if (IN(k) && IN((k) + 1)) xcd_barrier(bar); } while (0)
#define SEAMW(k, ...) do { if (IN(k) && IN((k) + 1)) { asm volatile("s_waitcnt vmcnt(0)" ::: "memory"); __syncthreads(); \
        if (threadIdx.x >= 64) { const int lane = threadIdx.x & 63, swave = __builtin_amdgcn_readfirstlane((int)(threadIdx.x >> 6)); const int G_ = gridDim.x, bx_ = blockIdx.x, vcu = (G_ % 8 == 0) ? (bx_ % 8) * (G_ / 8) + bx_ / 8 : bx_; \
            const int wid = vcu * 7 + swave - 1, NW = G_ * 7; (void)lane; (void)wid; (void)NW; __VA_ARGS__ } \
        xcd_barrier_tail(bar); } } while (0)
#define SH_TRANSPOSE(s) { LAS float* scr = (LAS float*)(LDSP + RING_OFF + swave * 16384); \
            constexpr int I_UA = (1024 / 64) * (D / 32), I_SQ = (D / 64) * (D / 32), I_PE = (256 / 64) * (D / 32), NITEMS = 2 * I_UA + 3 * I_SQ + I_PE, SL = (NITEMS + 4) / 5;   \
            for (int it = (s) * SL + wid; it < ((s) + 1) * SL && it < NITEMS; it += NW) { int r = it; \
                if (r < I_UA) { p0_transpose_item8(w_up_a, 1024, D, (unsigned char*)WUA_T, 32.0f, scr, r, lane); continue; } r -= I_UA; \
                if (r < I_UA) { p0_transpose_item8(w_up_b, 1024, D, (unsigned char*)WUB_T, 32.0f, scr, r, lane); continue; } r -= I_UA; \
                if (r < I_SQ) { p0_transpose_item8(w_o, D, D, (unsigned char*)WO_T, 64.0f, scr, r, lane); continue; } r -= I_SQ; \
                if (r < I_SQ) { p0_transpose_item(peer_wq, D, D, WQ_T, scr, r, lane); continue; } r -= I_SQ; \
                if (r < I_SQ) { p0_transpose_item8(ple_wg, D, D, (unsigned char*)WPG_T, 32.0f, scr, r, lane); continue; } r -= I_SQ; \
                p0_transpose_item(ple_wp, 256, D, WPE_T, scr, r, lane); } }
#define SH_TABLES(r0, r1) cvt_rows_fp6_span(peer_v, VB2, V_SCALE, peer_u, UB, U_SCALE, r0, r1, wid, NW, lane);
#define LOCALS const int tid = threadIdx.x, lane = tid & 63, wave = __builtin_amdgcn_readfirstlane(tid >> 6); const int G_ = gridDim.x, bx_ = blockIdx.x, vcu = (G_ % 8 == 0) ? (bx_ % 8) * (G_ / 8) + bx_ / 8 : bx_; \
    const int gw = vcu * NWAVES + wave, NGW = G_ * NWAVES; const size_t gt = (size_t)vcu * 512 + tid, NGT = (size_t)G_ * 512; (void)lane; (void)gw; (void)NGW; (void)gt; (void)NGT;
#define LDSP ((LAS unsigned char*)lds)
#define x_in (args.in[0])
#define p_in (args.in[1])
#define w_in (args.in[2])
#define mu (args.in[3])
#define w0 (args.in[4])
#define wl1 (args.in[5])
#define wl2 (args.in[6])
#define a0 (args.in[7])
#define al1 (args.in[8])
#define al2 (args.in[9])
#define gl1 (args.in[10])
#define gl2 (args.in[11])
#define k_k (args.in[12])
#define k_a (args.in[13])
#define r_k (args.in[14])
#define lnx_w (args.in[15])
#define lnx_b (args.in[16])
#define w_up_a (args.in[17])
#define w_up_b (args.in[18])
#define w_o (args.in[19])
#define ln1_w (args.in[20])
#define ln1_b (args.in[21])
#define peer_wq (args.in[22])
#define sub_keys (args.in[23])
#define peer_u (args.in[24])
#define peer_v (args.in[25])
#define ple_wg (args.in[26])
#define ple_wp (args.in[27])
#define ln2_w (args.in[28])
#define ln2_b (args.in[29])
#define WIN_T ((bf16*)(args.ws + WS_WIN))
#define WUA_T ((bf16*)(args.ws + WS_WUA))
#define WUB_T ((bf16*)(args.ws + WS_WUB))
#define WO_T ((bf16*)(args.ws + WS_WO))
#define WQ_T ((bf16*)(args.ws + WS_WQ))
#define WPG_T ((bf16*)(args.ws + WS_WPG))
#define WPE_T ((bf16*)(args.ws + WS_WPE))
#define L1_T ((bf16*)(args.ws + WS_L1))
#define L2_T ((bf16*)(args.ws + WS_L2))
#define PB ((bf16*)(args.ws + WS_PB))
#define XB ((bf16*)(args.ws + WS_XB))
#define QB ((bf16*)(args.ws + WS_Q))
#define KB ((bf16*)(args.ws + WS_K))
#define VB ((bf16*)(args.ws + WS_V))
#define RR ((bf16*)(args.ws + WS_RR))
#define RK ((bf16*)(args.ws + WS_RK))
#define RV ((bf16*)(args.ws + WS_RV))
#define RC ((bf16*)(args.ws + WS_RC))
#define YA ((bf16*)(args.ws + WS_YA))
#define YB ((bf16*)(args.ws + WS_YB))
#define YRAW ((float*)(args.ws + WS_YRAW))
#define QC ((bf16*)(args.ws + WS_QC))
#define GTC ((bf16*)(args.ws + WS_GTC))
#define YLC ((bf16*)(args.ws + WS_YLC))
#define TTC ((bf16*)(args.ws + WS_TTC))
#define SBF ((bf16*)(args.ws + WS_SB))
#define MIX8 ((unsigned char*)(args.ws + WS_MIX8))
#define X1B8 ((unsigned char*)(args.ws + WS_X1B8))
#define UB ((unsigned char*)(args.ws + WS_UB))
#define VB2 ((unsigned char*)(args.ws + WS_VB))
#define GG ((bf16*)(args.ws + WS_GG))
#define HID ((bf16*)(args.ws + WS_HID))
#define XW ((bf16*)(args.ws + WS_XW))
#define LW ((float*)(args.ws + WS_LW))
#define AA ((bf16*)(args.ws + WS_AA))
#define GATE ((bf16*)(args.ws + WS_GATE))
#define MIX ((bf16*)(args.ws + WS_MIX))
#define PQ ((bf16*)(args.ws + WS_PQ))
#define H1 ((float*)(args.ws + WS_H1))
#define X1 ((float*)(args.ws + WS_X1))
#define X1B ((bf16*)(args.ws + WS_X1B))
#define PE ((bf16*)(args.ws + WS_PE))
#define IDX ((int*)(args.ws + WS_IDX))
#define PG ((float*)(args.ws + WS_PG))
#define RKC ((float*)(args.ws + WS_RKC))
    if (IN(0)) {
        LOCALS
        LAS float* scr = (LAS float*)(LDSP + RING_OFF + wave * 16384);
        constexpr int I_IN = (D / 64) * (NIN / 32), I_UA = (1024 / 64) * (D / 32), I_SQ = (D / 64) * (D / 32), I_PE = (256 / 64) * (D / 32);
        for (int it = gw; it < I_IN; it += NGW) p0_transpose_item8(w_in, D, NIN, (unsigned char*)WIN_T, 32.0f, scr, it, lane);
        for (size_t i = gt; i < (size_t)2 * 294912; i += NGT) {
            if (i < 294912) { const int j = (int)(i & 7), ln = (int)(i >> 3) & 63, ks = (int)(i >> 9) & 63, m = (int)(i >> 15); const int row = m * 32 + (ln & 31), col = ks * 16 + 8 * (ln >> 5) + j;
                const float v = row < 64 ? wl1[(size_t)col * 64 + row] : (row < 128 ? al1[(size_t)col * 64 + (row - 64)] : gl1[(size_t)col * 160 + (row - 128)]);
                L1_T[i] = (bf16)f2bf(v); }
            else { const int e = (int)(i - 294912); float v;
                if (e < 131072) { const int e2 = e & 65535, jj = e2 & 7, ln = (e2 >> 3) & 63, sx = (e2 >> 9) & 3, ct = e2 >> 11; const int c = ct * 32 + (ln & 31), jh = 16 * sx + 8 * (jj >> 2) + 4 * (ln >> 5) + (jj & 3);
                    v = (e < 65536 ? wl2 : al2)[(size_t)jh * 1024 + c]; }
                else { const int e2 = e - 131072, jj = e2 & 7, ln = (e2 >> 3) & 63, rest = e2 >> 9, sx = rest % 10, ct = rest / 10; const int c = ct * 32 + (ln & 31), jh = 16 * sx + 8 * (jj >> 2) + 4 * (ln >> 5) + (jj & 3);
                    v = gl2[(size_t)jh * 1024 + c]; }
                L2_T[e] = (bf16)f2bf(v); }
        }
        cvt_rows_fp8(x_in, (unsigned char*)XB, (size_t)T * D / 16, 1.0f, gt, NGT);
    }
    SEAMW(0, SH_TRANSPOSE(0));
    if (IN(1)) {
        LOCALS
        REP_BEGIN(1)
        pg8::Gemm g{XB, WIN_T, T, 7168, D / 2}; pg8::StaticOrder S; S.init(T, 7168, (int)gridDim.x, (int)blockIdx.x);
        pg8::EpiB16<pg8::FnProj> E{{QB}};
        pg8::gemm_phase<pg8::EpiB16<pg8::FnProj>, pg8::StaticOrder, PG8_ALIGN, PG8_SP2, 122>(LDSP + RING_OFF, g, S, E);
        REP_END(1)
    }
    SEAMW(1, SH_TRANSPOSE(1) cvt_rows_bf16(p_in, PB, (size_t)T * 256 / 8, (size_t)wid * 64 + lane, (size_t)NW * 64););
    if (IN(2)) {
        LOCALS
        REP_BEGIN(2)
        if ((int)gridDim.x == T / 64) {
        { volatile LAS unsigned* lb = (volatile LAS unsigned*)(LDSP + RING_OFF + 130048);
          volatile LAS unsigned* aq = lb + 1;
          if (tid < 4) lb[tid] = 0u;
          __syncthreads();
#define LB4() { asm volatile("s_waitcnt lgkmcnt(0)" ::: "memory"); lbe += 4u; if (lane == 0) __hip_atomic_fetch_add((LAS unsigned*)(LDSP + RING_OFF + 130048), 1u, __ATOMIC_RELAXED, __HIP_MEMORY_SCOPE_WORKGROUP); while ((unsigned)__builtin_amdgcn_readfirstlane((int)*lb) < lbe) __builtin_amdgcn_s_sleep(0); asm volatile("" ::: "memory"); }
          if (wave >= 4) {
        {
            typedef unsigned long long u64;
            LAS unsigned char* hl = LDSP + RING_OFF + 73728;
            LAS unsigned char* cst = LDSP + RING_OFF;
            const int w4 = wave & 3, n = lane & 31, h = lane >> 5; unsigned lbe = 0u;
            const int m0 = w4 == 0 ? 0 : (w4 == 1 ? 2 : (w4 == 2 ? 4 : 7)), cnt = w4 == 2 ? 3 : 2, xsel = w4 < 2 ? w4 : 2;
            { const int pair = (int)blockIdx.x;
                const int tb = 64 * pair;
                f32x16 Ca[3], Cb[3];
#pragma unroll
                for (int m = 0; m < 3; ++m)
#pragma unroll
                    for (int i = 0; i < 16; ++i) { Ca[m][i] = 0.f; Cb[m][i] = 0.f; }
#pragma unroll 1
                for (int kh = 0; kh < 2; ++kh) {
                    for (int i = tid - 256; i < 65 * 64; i += 256) { const int row = i >> 6, c16 = i & 63; const int tr = tb - 1 + row;
                        const v4u v = tr >= 0 ? *(const GAS v4u*)(RC + (size_t)tr * 1024 + kh * 512 + c16 * 8) : (v4u){0u, 0u, 0u, 0u};
                        *(LAS v4u*)(cst + row * 1040 + c16 * 16) = v; }
                    LB4()
#pragma unroll 8
                    for (int k2 = 0; k2 < 32; ++k2) {
                        const int ks = kh * 32 + k2, k0 = ks * 16 + 8 * h, kl = k2 * 16 + 8 * h;
                        const GAS f32x4* mm = (const GAS f32x4*)(mu + (3 + xsel) * 1024 + k0); const f32x4 ma = mm[0], mb = mm[1];
                        const float mv[8] = {ma.x, ma.y, ma.z, ma.w, mb.x, mb.y, mb.z, mb.w};
                        const GAS bf16x8* af = (const GAS bf16x8*)(L1_T + ((size_t)m0 * 64 + ks) * 512) + lane;
                        const bf16x8 f0 = af[0], f1 = af[64 * 64], f2 = cnt == 3 ? af[2 * 64 * 64] : f0;
#pragma unroll
                        for (int tl = 0; tl < 2; ++tl) {
                            const v4u cv = *(const LAS v4u*)(cst + (32 * tl + n + 1) * 1040 + kl * 2), pv = *(const LAS v4u*)(cst + (32 * tl + n) * 1040 + kl * 2);
                            const float c[8] = {bflo(cv.x), bfhi(cv.x), bflo(cv.y), bfhi(cv.y), bflo(cv.z), bfhi(cv.z), bflo(cv.w), bfhi(cv.w)};
                            const float p[8] = {bflo(pv.x), bfhi(pv.x), bflo(pv.y), bfhi(pv.y), bflo(pv.z), bfhi(pv.z), bflo(pv.w), bfhi(pv.w)};
                            float o[8];
#pragma unroll
                            for (int j = 0; j < 8; ++j) o[j] = c[j] + (p[j] - c[j]) * mv[j];
                            v4u xw_; xw_.x = pk2(o[0], o[1]); xw_.y = pk2(o[2], o[3]); xw_.z = pk2(o[4], o[5]); xw_.w = pk2(o[6], o[7]); const bf16x8 xf = __builtin_bit_cast(bf16x8, xw_);
                            if (tl == 0) { Ca[0] = __builtin_amdgcn_mfma_f32_32x32x16_bf16(f0, xf, Ca[0], 0, 0, 0); Ca[1] = __builtin_amdgcn_mfma_f32_32x32x16_bf16(f1, xf, Ca[1], 0, 0, 0); if (cnt == 3) Ca[2] = __builtin_amdgcn_mfma_f32_32x32x16_bf16(f2, xf, Ca[2], 0, 0, 0); }
                            else { Cb[0] = __builtin_amdgcn_mfma_f32_32x32x16_bf16(f0, xf, Cb[0], 0, 0, 0); Cb[1] = __builtin_amdgcn_mfma_f32_32x32x16_bf16(f1, xf, Cb[1], 0, 0, 0); if (cnt == 3) Cb[2] = __builtin_amdgcn_mfma_f32_32x32x16_bf16(f2, xf, Cb[2], 0, 0, 0); }
                        }
                    }
                    LB4()
                }
#define LX_ACT(C, tl_) { _Pragma("unroll") for (int m = 0; m < 3; ++m) if (m < cnt) { \
                    _Pragma("unroll") for (int s2 = 0; s2 < 2; ++s2) { float v[8]; \
                        _Pragma("unroll") for (int j = 0; j < 8; ++j) { const float x = C[m][8 * s2 + j]; v[j] = w4 == 0 ? pg8::ftanh(x) : (w4 == 1 ? x : pg8::fsigmoid(x)); } \
                        v4u w; w.x = pk2(v[0], v[1]); w.y = pk2(v[2], v[3]); w.z = pk2(v[4], v[5]); w.w = pk2(v[6], v[7]); \
                        *(LAS v4u*)(hl + (((tl_) * 18 + 2 * (m0 + m) + s2) * 64 + lane) * 16) = w; } } }
                LX_ACT(Ca, 0) LX_ACT(Cb, 1)
#undef LX_ACT
                LB4()
                if (lane == 0) lb[2] = 1u;
                LB4()
            }
        }
          }
          {
        {
            LAS unsigned char* vl = wave < 4 ? LDSP + RING_OFF + 110592 + wave * 4608 : LDSP + RING_OFF + (wave - 4) * 4608;
            const int n = lane & 31, h = lane >> 5, i16 = lane & 15, dcol = 16 * ((lane >> 4) & 1);
            for (;;) {
                unsigned s_ = 0u; if (lane == 0) s_ = __hip_atomic_fetch_add((LAS unsigned*)(LDSP + RING_OFF + 130052), 1u, __ATOMIC_RELAXED, __HIP_MEMORY_SCOPE_WORKGROUP); s_ = (unsigned)__builtin_amdgcn_readfirstlane((int)s_);
                if (s_ >= 32u) break;
                const int task = vcu * 8 + (int)(s_ & 7u) + NGW * (int)(s_ >> 3);
                const int head = task & 15, q0 = (task >> 4) * 32;
                bf16x8 qf[4];
#pragma unroll
                for (int ks = 0; ks < 4; ++ks) qf[ks] = *(const GAS bf16x8*)(QB + (size_t)(q0 + n) * 1024 + head * 64 + 16 * ks + 8 * h);
                f32x16 O0, O1;
#pragma unroll
                for (int i = 0; i < 16; ++i) { O0[i] = 0.f; O1[i] = 0.f; }
                float carry = 1.f;
                bf16x8 kf[4]; v4u vv[4];
#pragma unroll
                for (int ks = 0; ks < 4; ++ks) kf[ks] = *(const GAS bf16x8*)(KB + (size_t)(q0 + n) * 1024 + head * 64 + 16 * ks + 8 * h);
#pragma unroll
                for (int i = 0; i < 4; ++i) vv[i] = *(const GAS v4u*)(VB + (size_t)(q0 + n) * 1024 + head * 64 + 32 * h + 8 * i);
                { const int kt = q0;
                    f32x16 S;
#pragma unroll
                    for (int i = 0; i < 16; ++i) S[i] = 0.f;
#pragma unroll
                    for (int ks = 0; ks < 4; ++ks) S = __builtin_amdgcn_mfma_f32_32x32x16_bf16(kf[ks], qf[ks], S, 0, 0, 0);
#pragma unroll
                    for (int i = 0; i < 4; ++i) *(LAS v4u*)(vl + n * RW_PIT + (32 * h + 8 * i) * 2) = vv[i];
                    { const int ktn = kt >= 32 ? kt - 32 : 0;
#pragma unroll
                      for (int ks = 0; ks < 4; ++ks) kf[ks] = *(const GAS bf16x8*)(KB + (size_t)(ktn + n) * 1024 + head * 64 + 16 * ks + 8 * h);
#pragma unroll
                      for (int i = 0; i < 4; ++i) vv[i] = *(const GAS v4u*)(VB + (size_t)(ktn + n) * 1024 + head * 64 + 32 * h + 8 * i); }
                    float kp[16], ev[16], G[4], Gp[4];
#pragma unroll
                    for (int i = 0; i < 16; ++i) { const float z = fminf(S[i], 115.f); const bool valid = (kt + (i & 3) + 8 * (i >> 2) + 4 * h) < (q0 + n); const float e = __builtin_amdgcn_exp2f(z); const float k = __builtin_amdgcn_rcpf(1.0f + e); kp[i] = valid ? k : 1.f; ev[i] = valid ? e : 0.f; }
#pragma unroll
                    for (int q = 0; q < 4; ++q) { kp[4 * q + 2] *= kp[4 * q + 3]; kp[4 * q + 1] *= kp[4 * q + 2]; kp[4 * q] *= kp[4 * q + 1]; G[q] = kp[4 * q]; }
#pragma unroll
                    for (int q = 0; q < 4; ++q) Gp[q] = __shfl_xor(G[q], 32);
                    float off[4]; float later = 1.f;
#pragma unroll
                    for (int q = 3; q >= 0; --q) { off[q] = later * (h == 0 ? Gp[q] : 1.f); later *= G[q] * Gp[q]; }
                    bf16x8 wf[2];
                    { float w[16];
#pragma unroll
                      for (int i = 0; i < 16; ++i) w[i] = ev[i] * kp[i] * (off[i >> 2] * carry);
#pragma unroll
                      for (int s2 = 0; s2 < 2; ++s2) { v4u pw; pw.x = pk2(w[8 * s2], w[8 * s2 + 1]); pw.y = pk2(w[8 * s2 + 2], w[8 * s2 + 3]); pw.z = pk2(w[8 * s2 + 4], w[8 * s2 + 5]); pw.w = pk2(w[8 * s2 + 6], w[8 * s2 + 7]); wf[s2] = __builtin_bit_cast(bf16x8, pw); } }
                    carry *= later;
#pragma unroll
                    for (int s2 = 0; s2 < 2; ++s2) {
#pragma unroll
                        for (int m2 = 0; m2 < 2; ++m2) { const LAS unsigned char* ap = vl + (16 * s2 + 4 * h + (i16 >> 2)) * RW_PIT + (32 * m2 + dcol + 4 * (i16 & 3)) * 2;
                            const v4i16_t lo = __builtin_amdgcn_ds_read_tr16_b64_v4i16((LAS v4i16_t*)ap), hi = __builtin_amdgcn_ds_read_tr16_b64_v4i16((LAS v4i16_t*)(ap + 8 * RW_PIT));
                            const bf16x8 af = __builtin_shufflevector(lo, hi, 0, 1, 2, 3, 4, 5, 6, 7);
                            if (m2 == 0) O0 = __builtin_amdgcn_mfma_f32_32x32x16_bf16(af, wf[s2], O0, 0, 0, 0); else O1 = __builtin_amdgcn_mfma_f32_32x32x16_bf16(af, wf[s2], O1, 0, 0, 0); } }
                }
                if (!__all(carry < 1.0e-44f))
                for (int kt = q0 - 32; kt >= 0; kt -= 32) {
                    f32x16 S;
#pragma unroll
                    for (int i = 0; i < 16; ++i) S[i] = 0.f;
#pragma unroll
                    for (int ks = 0; ks < 4; ++ks) S = __builtin_amdgcn_mfma_f32_32x32x16_bf16(kf[ks], qf[ks], S, 0, 0, 0);
#pragma unroll
                    for (int i = 0; i < 4; ++i) *(LAS v4u*)(vl + n * RW_PIT + (32 * h + 8 * i) * 2) = vv[i];
                    { const int ktn = kt >= 32 ? kt - 32 : 0;
#pragma unroll
                      for (int ks = 0; ks < 4; ++ks) kf[ks] = *(const GAS bf16x8*)(KB + (size_t)(ktn + n) * 1024 + head * 64 + 16 * ks + 8 * h);
#pragma unroll
                      for (int i = 0; i < 4; ++i) vv[i] = *(const GAS v4u*)(VB + (size_t)(ktn + n) * 1024 + head * 64 + 32 * h + 8 * i); }
                    float kp[16], ev[16], G[4], Gp[4];
#pragma unroll
                    for (int i = 0; i < 16; ++i) { const float z = fminf(S[i], 115.f); const bool valid = true; const float e = __builtin_amdgcn_exp2f(z); const float k = __builtin_amdgcn_rcpf(1.0f + e); kp[i] = valid ? k : 1.f; ev[i] = valid ? e : 0.f; }
#pragma unroll
                    for (int q = 0; q < 4; ++q) { kp[4 * q + 2] *= kp[4 * q + 3]; kp[4 * q + 1] *= kp[4 * q + 2]; kp[4 * q] *= kp[4 * q + 1]; G[q] = kp[4 * q]; }
#pragma unroll
                    for (int q = 0; q < 4; ++q) Gp[q] = __shfl_xor(G[q], 32);
                    float off[4]; float later = 1.f;
#pragma unroll
                    for (int q = 3; q >= 0; --q) { off[q] = later * (h == 0 ? Gp[q] : 1.f); later *= G[q] * Gp[q]; }
                    bf16x8 wf[2];
                    { float w[16];
#pragma unroll
                      for (int i = 0; i < 16; ++i) w[i] = ev[i] * kp[i] * (off[i >> 2] * carry);
#pragma unroll
                      for (int s2 = 0; s2 < 2; ++s2) { v4u pw; pw.x = pk2(w[8 * s2], w[8 * s2 + 1]); pw.y = pk2(w[8 * s2 + 2], w[8 * s2 + 3]); pw.z = pk2(w[8 * s2 + 4], w[8 * s2 + 5]); pw.w = pk2(w[8 * s2 + 6], w[8 * s2 + 7]); wf[s2] = __builtin_bit_cast(bf16x8, pw); } }
                    carry *= later;
#pragma unroll
                    for (int s2 = 0; s2 < 2; ++s2) {
#pragma unroll
                        for (int m2 = 0; m2 < 2; ++m2) { const LAS unsigned char* ap = vl + (16 * s2 + 4 * h + (i16 >> 2)) * RW_PIT + (32 * m2 + dcol + 4 * (i16 & 3)) * 2;
                            const v4i16_t lo = __builtin_amdgcn_ds_read_tr16_b64_v4i16((LAS v4i16_t*)ap), hi = __builtin_amdgcn_ds_read_tr16_b64_v4i16((LAS v4i16_t*)(ap + 8 * RW_PIT));
                            const bf16x8 af = __builtin_shufflevector(lo, hi, 0, 1, 2, 3, 4, 5, 6, 7);
                            if (m2 == 0) O0 = __builtin_amdgcn_mfma_f32_32x32x16_bf16(af, wf[s2], O0, 0, 0, 0); else O1 = __builtin_amdgcn_mfma_f32_32x32x16_bf16(af, wf[s2], O1, 0, 0, 0); } }
                    if (__all(carry < 1.0e-44f)) break;
                }
#pragma unroll
                for (int q = 0; q < 4; ++q) {
                    *(GAS unsigned*)((unsigned char*)YA + (size_t)(q0 + n) * 1024 + head * 64 + 8 * q + 4 * h) = ({ int w8_ = 0; w8_ = __builtin_amdgcn_cvt_pk_fp8_f32(O0[4 * q], O0[4 * q + 1], w8_, false); w8_ = __builtin_amdgcn_cvt_pk_fp8_f32(O0[4 * q + 2], O0[4 * q + 3], w8_, true); (unsigned)w8_; });
                    *(GAS unsigned*)((unsigned char*)YA + (size_t)(q0 + n) * 1024 + head * 64 + 32 + 8 * q + 4 * h) = ({ int w8_ = 0; w8_ = __builtin_amdgcn_cvt_pk_fp8_f32(O1[4 * q], O1[4 * q + 1], w8_, false); w8_ = __builtin_amdgcn_cvt_pk_fp8_f32(O1[4 * q + 2], O1[4 * q + 3], w8_, true); (unsigned)w8_; }); }
            }
        }
          }
          {
            typedef unsigned long long u64;
            LAS unsigned char* hl = LDSP + RING_OFF + 73728; const int n = lane & 31, h = lane >> 5; const int pair = (int)blockIdx.x;
            while ((unsigned)__builtin_amdgcn_readfirstlane((int)lb[2]) == 0u) __builtin_amdgcn_s_sleep(1);
            asm volatile("" ::: "memory");
                for (;;) {
                    unsigned c_ = 0u; if (lane == 0) c_ = __hip_atomic_fetch_add((LAS unsigned*)(LDSP + RING_OFF + 130060), 1u, __ATOMIC_RELAXED, __HIP_MEMORY_SCOPE_WORKGROUP); c_ = (unsigned)__builtin_amdgcn_readfirstlane((int)c_);
                    if (c_ >= 32u) break;
                    const int ct = (int)c_;
                    const GAS bf16x8* fw = (const GAS bf16x8*)(L2_T + (size_t)ct * 4 * 512) + lane; const GAS bf16x8* fa = (const GAS bf16x8*)(L2_T + 65536 + (size_t)ct * 4 * 512) + lane;
                    const GAS bf16x8* fg = (const GAS bf16x8*)(L2_T + 131072 + (size_t)ct * 10 * 512) + lane;
                    bf16x8 wfr[18];
#pragma unroll
                    for (int s2 = 0; s2 < 4; ++s2) { wfr[s2] = fw[64 * s2]; wfr[4 + s2] = fa[64 * s2]; }
#pragma unroll
                    for (int s2 = 0; s2 < 10; ++s2) wfr[8 + s2] = fg[64 * s2];
#pragma unroll 1
                    for (int tl = 0; tl < 2; ++tl) {
                        const int tt_ = (2 * pair + tl) * 32 + n;
                        f32x16 Yw, Ya, Yg;
#pragma unroll
                        for (int i = 0; i < 16; ++i) { Yw[i] = 0.f; Ya[i] = 0.f; Yg[i] = 0.f; }
#pragma unroll
                        for (int s2 = 0; s2 < 4; ++s2) { Yw = __builtin_amdgcn_mfma_f32_32x32x16_bf16(wfr[s2], *(const LAS bf16x8*)(hl + ((tl * 18 + s2) * 64 + lane) * 16), Yw, 0, 0, 0);
                            Ya = __builtin_amdgcn_mfma_f32_32x32x16_bf16(wfr[4 + s2], *(const LAS bf16x8*)(hl + ((tl * 18 + 4 + s2) * 64 + lane) * 16), Ya, 0, 0, 0); }
#pragma unroll
                        for (int s2 = 0; s2 < 10; ++s2) Yg = __builtin_amdgcn_mfma_f32_32x32x16_bf16(wfr[8 + s2], *(const LAS bf16x8*)(hl + ((tl * 18 + 8 + s2) * 64 + lane) * 16), Yg, 0, 0, 0);
#pragma unroll
                        for (int q = 0; q < 4; ++q) { const int c0 = ct * 32 + 8 * q + 4 * h;
                            const f32x4 wb = *(const GAS f32x4*)(w0 + c0), ab = *(const GAS f32x4*)(a0 + c0); f32x4 lwv; float av[4], gv[4];
#pragma unroll
                            for (int j = 0; j < 4; ++j) { lwv[j] = -__expf(-pg8::fsoftplus(-(wb[j] + Yw[4 * q + j])) - 0.5f); av[j] = pg8::fsigmoid(ab[j] + Ya[4 * q + j]); gv[j] = Yg[4 * q + j]; }
                            *(GAS f32x4*)(LW + (size_t)tt_ * 1024 + c0) = lwv;
                            *(GAS u64*)(AA + (size_t)tt_ * 1024 + c0) = (u64)pk2(av[0], av[1]) | ((u64)pk2(av[2], av[3]) << 32);
                            { int w8_ = 0; w8_ = __builtin_amdgcn_cvt_pk_fp8_f32(gv[0], gv[1], w8_, false); w8_ = __builtin_amdgcn_cvt_pk_fp8_f32(gv[2], gv[3], w8_, true); *(GAS unsigned*)((unsigned char*)GG + (size_t)tt_ * 1024 + c0) = (unsigned)w8_; } }
                    }
                }
          }
#undef LB4
        }
        } else {
#ifndef SKIP_LORA
        for (int rl_ = 0; rl_ < (REPEAT_SUB == 1 ? 2 : 1); ++rl_) {
        {
            typedef unsigned long long u64;
            LAS unsigned char* hl = LDSP + RING_OFF + 73728;
            LAS unsigned char* cst = LDSP + RING_OFF;
            const int w4 = wave & 3, half = wave >> 2, n = lane & 31, h = lane >> 5;
            const int m0 = w4 == 0 ? 0 : (w4 == 1 ? 2 : (w4 == 2 ? 4 : 7)), cnt = w4 == 2 ? 3 : 2, xsel = w4 < 2 ? w4 : 2;
            for (int pair = (int)blockIdx.x; pair < T / 64; pair += (int)gridDim.x) {
                const int tb = 64 * pair;
                f32x16 Ca[3], Cb[3];
#pragma unroll
                for (int m = 0; m < 3; ++m)
#pragma unroll
                    for (int i = 0; i < 16; ++i) { Ca[m][i] = 0.f; Cb[m][i] = 0.f; }
#pragma unroll 1
                for (int kh = 0; kh < 2; ++kh) {
                    for (int i = tid; i < 65 * 64; i += 512) { const int row = i >> 6, c16 = i & 63; const int tr = tb - 1 + row;
                        const v4u v = tr >= 0 ? *(const GAS v4u*)(RC + (size_t)tr * 1024 + kh * 512 + c16 * 8) : (v4u){0u, 0u, 0u, 0u};
                        *(LAS v4u*)(cst + row * 1040 + c16 * 16) = v; }
                    __syncthreads();
#pragma unroll 2
                    for (int k2 = 16 * half; k2 < 16 * half + 16; ++k2) {
                        const int ks = kh * 32 + k2, k0 = ks * 16 + 8 * h, kl = k2 * 16 + 8 * h;
                        const GAS f32x4* mm = (const GAS f32x4*)(mu + (3 + xsel) * 1024 + k0); const f32x4 ma = mm[0], mb = mm[1];
                        const float mv[8] = {ma.x, ma.y, ma.z, ma.w, mb.x, mb.y, mb.z, mb.w};
                        const GAS bf16x8* af = (const GAS bf16x8*)(L1_T + ((size_t)m0 * 64 + ks) * 512) + lane;
                        const bf16x8 f0 = af[0], f1 = af[64 * 64], f2 = cnt == 3 ? af[2 * 64 * 64] : f0;
#pragma unroll
                        for (int tl = 0; tl < 2; ++tl) {
                            const v4u cv = *(const LAS v4u*)(cst + (32 * tl + n + 1) * 1040 + kl * 2), pv = *(const LAS v4u*)(cst + (32 * tl + n) * 1040 + kl * 2);
                            const float c[8] = {bflo(cv.x), bfhi(cv.x), bflo(cv.y), bfhi(cv.y), bflo(cv.z), bfhi(cv.z), bflo(cv.w), bfhi(cv.w)};
                            const float p[8] = {bflo(pv.x), bfhi(pv.x), bflo(pv.y), bfhi(pv.y), bflo(pv.z), bfhi(pv.z), bflo(pv.w), bfhi(pv.w)};
                            float o[8];
#pragma unroll
                            for (int j = 0; j < 8; ++j) o[j] = c[j] + (p[j] - c[j]) * mv[j];
                            v4u xw_; xw_.x = pk2(o[0], o[1]); xw_.y = pk2(o[2], o[3]); xw_.z = pk2(o[4], o[5]); xw_.w = pk2(o[6], o[7]); const bf16x8 xf = __builtin_bit_cast(bf16x8, xw_);
                            if (tl == 0) { Ca[0] = __builtin_amdgcn_mfma_f32_32x32x16_bf16(f0, xf, Ca[0], 0, 0, 0); Ca[1] = __builtin_amdgcn_mfma_f32_32x32x16_bf16(f1, xf, Ca[1], 0, 0, 0); if (cnt == 3) Ca[2] = __builtin_amdgcn_mfma_f32_32x32x16_bf16(f2, xf, Ca[2], 0, 0, 0); }
                            else { Cb[0] = __builtin_amdgcn_mfma_f32_32x32x16_bf16(f0, xf, Cb[0], 0, 0, 0); Cb[1] = __builtin_amdgcn_mfma_f32_32x32x16_bf16(f1, xf, Cb[1], 0, 0, 0); if (cnt == 3) Cb[2] = __builtin_amdgcn_mfma_f32_32x32x16_bf16(f2, xf, Cb[2], 0, 0, 0); }
                        }
                    }
                    __syncthreads();
                }
                { LAS unsigned char* px = LDSP + RING_OFF;
#define LX_EXPORT(C) { _Pragma("unroll") for (int m = 0; m < 3; ++m) if (m < cnt) { _Pragma("unroll") for (int q = 0; q < 4; ++q) *(LAS f32x4*)(px + ((((half * 9 + m0 + m) * 4 + q) * 64 + lane) * 16)) = (f32x4){C[m][4 * q], C[m][4 * q + 1], C[m][4 * q + 2], C[m][4 * q + 3]}; } }
#define LX_FINISH(C) { _Pragma("unroll") for (int m = 0; m < 3; ++m) if (m < cnt) { _Pragma("unroll") for (int q = 0; q < 4; ++q) { const f32x4 v_ = *(const LAS f32x4*)(px + (((((1 - half) * 9 + m0 + m) * 4 + q) * 64 + lane) * 16)); C[m][4 * q] += v_[0]; C[m][4 * q + 1] += v_[1]; C[m][4 * q + 2] += v_[2]; C[m][4 * q + 3] += v_[3]; } \
                    _Pragma("unroll") for (int s2 = 0; s2 < 2; ++s2) { float v[8]; \
                        _Pragma("unroll") for (int j = 0; j < 8; ++j) { const float x = C[m][8 * s2 + j]; v[j] = w4 == 0 ? pg8::ftanh(x) : (w4 == 1 ? x : pg8::fsigmoid(x)); } \
                        v4u w; w.x = pk2(v[0], v[1]); w.y = pk2(v[2], v[3]); w.z = pk2(v[4], v[5]); w.w = pk2(v[6], v[7]); \
                        *(LAS v4u*)(hl + ((half * 18 + 2 * (m0 + m) + s2) * 64 + lane) * 16) = w; } } }
                  if (half == 0) LX_EXPORT(Cb) else LX_EXPORT(Ca)
                  __syncthreads();
                  if (half == 0) LX_FINISH(Ca) else LX_FINISH(Cb)
#undef LX_EXPORT
#undef LX_FINISH
                }
                __syncthreads();
#pragma unroll 1
                for (int c4 = 0; c4 < 4; ++c4) {
                    const int ct = w4 * 8 + 4 * half + c4;
                    const GAS bf16x8* fw = (const GAS bf16x8*)(L2_T + (size_t)ct * 4 * 512) + lane; const GAS bf16x8* fa = (const GAS bf16x8*)(L2_T + 65536 + (size_t)ct * 4 * 512) + lane;
                    const GAS bf16x8* fg = (const GAS bf16x8*)(L2_T + 131072 + (size_t)ct * 10 * 512) + lane;
                    bf16x8 wfr[18];
#pragma unroll
                    for (int s2 = 0; s2 < 4; ++s2) { wfr[s2] = fw[64 * s2]; wfr[4 + s2] = fa[64 * s2]; }
#pragma unroll
                    for (int s2 = 0; s2 < 10; ++s2) wfr[8 + s2] = fg[64 * s2];
#pragma unroll 1
                    for (int tl = 0; tl < 2; ++tl) {
                        const int tt_ = (2 * pair + tl) * 32 + n;
                        f32x16 Yw, Ya, Yg;
#pragma unroll
                        for (int i = 0; i < 16; ++i) { Yw[i] = 0.f; Ya[i] = 0.f; Yg[i] = 0.f; }
#pragma unroll
                        for (int s2 = 0; s2 < 4; ++s2) { Yw = __builtin_amdgcn_mfma_f32_32x32x16_bf16(wfr[s2], *(const LAS bf16x8*)(hl + ((tl * 18 + s2) * 64 + lane) * 16), Yw, 0, 0, 0);
                            Ya = __builtin_amdgcn_mfma_f32_32x32x16_bf16(wfr[4 + s2], *(const LAS bf16x8*)(hl + ((tl * 18 + 4 + s2) * 64 + lane) * 16), Ya, 0, 0, 0); }
#pragma unroll
                        for (int s2 = 0; s2 < 10; ++s2) Yg = __builtin_amdgcn_mfma_f32_32x32x16_bf16(wfr[8 + s2], *(const LAS bf16x8*)(hl + ((tl * 18 + 8 + s2) * 64 + lane) * 16), Yg, 0, 0, 0);
#pragma unroll
                        for (int q = 0; q < 4; ++q) { const int c0 = ct * 32 + 8 * q + 4 * h;
                            const f32x4 wb = *(const GAS f32x4*)(w0 + c0), ab = *(const GAS f32x4*)(a0 + c0); f32x4 lwv; float av[4], gv[4];
#pragma unroll
                            for (int j = 0; j < 4; ++j) { lwv[j] = -__expf(-pg8::fsoftplus(-(wb[j] + Yw[4 * q + j])) - 0.5f); av[j] = pg8::fsigmoid(ab[j] + Ya[4 * q + j]); gv[j] = Yg[4 * q + j]; }
                            *(GAS f32x4*)(LW + (size_t)tt_ * 1024 + c0) = lwv;
                            *(GAS u64*)(AA + (size_t)tt_ * 1024 + c0) = (u64)pk2(av[0], av[1]) | ((u64)pk2(av[2], av[3]) << 32);
                            { int w8_ = 0; w8_ = __builtin_amdgcn_cvt_pk_fp8_f32(gv[0], gv[1], w8_, false); w8_ = __builtin_amdgcn_cvt_pk_fp8_f32(gv[2], gv[3], w8_, true); *(GAS unsigned*)((unsigned char*)GG + (size_t)tt_ * 1024 + c0) = (unsigned)w8_; } }
                    }
                }
                __syncthreads();
            }
        }
        if (REPEAT_SUB == 1) __syncthreads(); }
#endif
#ifndef SKIP_ATTN
        for (int ra_ = 0; ra_ < (REPEAT_SUB == 2 ? 2 : 1); ++ra_) {
        {
            LAS unsigned char* vl = LDSP + RING_OFF + wave * 4608;
            const int n = lane & 31, h = lane >> 5, i16 = lane & 15, dcol = 16 * ((lane >> 4) & 1);
            for (int task = gw; task < 16 * (T / 32); task += NGW) {
                const int head = task & 15, q0 = (task >> 4) * 32;
                bf16x8 qf[4];
#pragma unroll
                for (int ks = 0; ks < 4; ++ks) qf[ks] = *(const GAS bf16x8*)(QB + (size_t)(q0 + n) * 1024 + head * 64 + 16 * ks + 8 * h);
                f32x16 O0, O1;
#pragma unroll
                for (int i = 0; i < 16; ++i) { O0[i] = 0.f; O1[i] = 0.f; }
                float carry = 1.f;
                bf16x8 kf[4]; v4u vv[4];
#pragma unroll
                for (int ks = 0; ks < 4; ++ks) kf[ks] = *(const GAS bf16x8*)(KB + (size_t)(q0 + n) * 1024 + head * 64 + 16 * ks + 8 * h);
#pragma unroll
                for (int i = 0; i < 4; ++i) vv[i] = *(const GAS v4u*)(VB + (size_t)(q0 + n) * 1024 + head * 64 + 32 * h + 8 * i);
                { const int kt = q0;
                    f32x16 S;
#pragma unroll
                    for (int i = 0; i < 16; ++i) S[i] = 0.f;
#pragma unroll
                    for (int ks = 0; ks < 4; ++ks) S = __builtin_amdgcn_mfma_f32_32x32x16_bf16(kf[ks], qf[ks], S, 0, 0, 0);
#pragma unroll
                    for (int i = 0; i < 4; ++i) *(LAS v4u*)(vl + n * RW_PIT + (32 * h + 8 * i) * 2) = vv[i];
                    { const int ktn = kt >= 32 ? kt - 32 : 0;
#pragma unroll
                      for (int ks = 0; ks < 4; ++ks) kf[ks] = *(const GAS bf16x8*)(KB + (size_t)(ktn + n) * 1024 + head * 64 + 16 * ks + 8 * h);
#pragma unroll
                      for (int i = 0; i < 4; ++i) vv[i] = *(const GAS v4u*)(VB + (size_t)(ktn + n) * 1024 + head * 64 + 32 * h + 8 * i); }
                    float kp[16], ev[16], G[4], Gp[4];
#pragma unroll
                    for (int i = 0; i < 16; ++i) { const float z = fminf(S[i], 115.f); const bool valid = (kt + (i & 3) + 8 * (i >> 2) + 4 * h) < (q0 + n); const float e = __builtin_amdgcn_exp2f(z); const float k = __builtin_amdgcn_rcpf(1.0f + e); kp[i] = valid ? k : 1.f; ev[i] = valid ? e : 0.f; }
#pragma unroll
                    for (int q = 0; q < 4; ++q) { kp[4 * q + 2] *= kp[4 * q + 3]; kp[4 * q + 1] *= kp[4 * q + 2]; kp[4 * q] *= kp[4 * q + 1]; G[q] = kp[4 * q]; }
#pragma unroll
                    for (int q = 0; q < 4; ++q) Gp[q] = __shfl_xor(G[q], 32);
                    float off[4]; float later = 1.f;
#pragma unroll
                    for (int q = 3; q >= 0; --q) { off[q] = later * (h == 0 ? Gp[q] : 1.f); later *= G[q] * Gp[q]; }
                    bf16x8 wf[2];
                    { float w[16];
#pragma unroll
                      for (int i = 0; i < 16; ++i) w[i] = ev[i] * kp[i] * (off[i >> 2] * carry);
#pragma unroll
                      for (int s2 = 0; s2 < 2; ++s2) { v4u pw; pw.x = pk2(w[8 * s2], w[8 * s2 + 1]); pw.y = pk2(w[8 * s2 + 2], w[8 * s2 + 3]); pw.z = pk2(w[8 * s2 + 4], w[8 * s2 + 5]); pw.w = pk2(w[8 * s2 + 6], w[8 * s2 + 7]); wf[s2] = __builtin_bit_cast(bf16x8, pw); } }
                    carry *= later;
#pragma unroll
                    for (int s2 = 0; s2 < 2; ++s2) {
#pragma unroll
                        for (int m2 = 0; m2 < 2; ++m2) { const LAS unsigned char* ap = vl + (16 * s2 + 4 * h + (i16 >> 2)) * RW_PIT + (32 * m2 + dcol + 4 * (i16 & 3)) * 2;
                            const v4i16_t lo = __builtin_amdgcn_ds_read_tr16_b64_v4i16((LAS v4i16_t*)ap), hi = __builtin_amdgcn_ds_read_tr16_b64_v4i16((LAS v4i16_t*)(ap + 8 * RW_PIT));
                            const bf16x8 af = __builtin_shufflevector(lo, hi, 0, 1, 2, 3, 4, 5, 6, 7);
                            if (m2 == 0) O0 = __builtin_amdgcn_mfma_f32_32x32x16_bf16(af, wf[s2], O0, 0, 0, 0); else O1 = __builtin_amdgcn_mfma_f32_32x32x16_bf16(af, wf[s2], O1, 0, 0, 0); } }
                }
                if (!__all(carry < 1.0e-44f))
                for (int kt = q0 - 32; kt >= 0; kt -= 32) {
                    f32x16 S;
#pragma unroll
                    for (int i = 0; i < 16; ++i) S[i] = 0.f;
#pragma unroll
                    for (int ks = 0; ks < 4; ++ks) S = __builtin_amdgcn_mfma_f32_32x32x16_bf16(kf[ks], qf[ks], S, 0, 0, 0);
#pragma unroll
                    for (int i = 0; i < 4; ++i) *(LAS v4u*)(vl + n * RW_PIT + (32 * h + 8 * i) * 2) = vv[i];
                    { const int ktn = kt >= 32 ? kt - 32 : 0;
#pragma unroll
                      for (int ks = 0; ks < 4; ++ks) kf[ks] = *(const GAS bf16x8*)(KB + (size_t)(ktn + n) * 1024 + head * 64 + 16 * ks + 8 * h);
#pragma unroll
                      for (int i = 0; i < 4; ++i) vv[i] = *(const GAS v4u*)(VB + (size_t)(ktn + n) * 1024 + head * 64 + 32 * h + 8 * i); }
                    float kp[16], ev[16], G[4], Gp[4];
#pragma unroll
                    for (int i = 0; i < 16; ++i) { const float z = fminf(S[i], 115.f); const bool valid = true; const float e = __builtin_amdgcn_exp2f(z); const float k = __builtin_amdgcn_rcpf(1.0f + e); kp[i] = valid ? k : 1.f; ev[i] = valid ? e : 0.f; }
#pragma unroll
                    for (int q = 0; q < 4; ++q) { kp[4 * q + 2] *= kp[4 * q + 3]; kp[4 * q + 1] *= kp[4 * q + 2]; kp[4 * q] *= kp[4 * q + 1]; G[q] = kp[4 * q]; }
#pragma unroll
                    for (int q = 0; q < 4; ++q) Gp[q] = __shfl_xor(G[q], 32);
                    float off[4]; float later = 1.f;
#pragma unroll
                    for (int q = 3; q >= 0; --q) { off[q] = later * (h == 0 ? Gp[q] : 1.f); later *= G[q] * Gp[q]; }
                    bf16x8 wf[2];
                    { float w[16];
#pragma unroll
                      for (int i = 0; i < 16; ++i) w[i] = ev[i] * kp[i] * (off[i >> 2] * carry);
#pragma unroll
                      for (int s2 = 0; s2 < 2; ++s2) { v4u pw; pw.x = pk2(w[8 * s2], w[8 * s2 + 1]); pw.y = pk2(w[8 * s2 + 2], w[8 * s2 + 3]); pw.z = pk2(w[8 * s2 + 4], w[8 * s2 + 5]); pw.w = pk2(w[8 * s2 + 6], w[8 * s2 + 7]); wf[s2] = __builtin_bit_cast(bf16x8, pw); } }
                    carry *= later;
#pragma unroll
                    for (int s2 = 0; s2 < 2; ++s2) {
#pragma unroll
                        for (int m2 = 0; m2 < 2; ++m2) { const LAS unsigned char* ap = vl + (16 * s2 + 4 * h + (i16 >> 2)) * RW_PIT + (32 * m2 + dcol + 4 * (i16 & 3)) * 2;
                            const v4i16_t lo = __builtin_amdgcn_ds_read_tr16_b64_v4i16((LAS v4i16_t*)ap), hi = __builtin_amdgcn_ds_read_tr16_b64_v4i16((LAS v4i16_t*)(ap + 8 * RW_PIT));
                            const bf16x8 af = __builtin_shufflevector(lo, hi, 0, 1, 2, 3, 4, 5, 6, 7);
                            if (m2 == 0) O0 = __builtin_amdgcn_mfma_f32_32x32x16_bf16(af, wf[s2], O0, 0, 0, 0); else O1 = __builtin_amdgcn_mfma_f32_32x32x16_bf16(af, wf[s2], O1, 0, 0, 0); } }
                    if (__all(carry < 1.0e-44f)) break;
                }
#pragma unroll
                for (int q = 0; q < 4; ++q) {
                    *(GAS unsigned*)((unsigned char*)YA + (size_t)(q0 + n) * 1024 + head * 64 + 8 * q + 4 * h) = ({ int w8_ = 0; w8_ = __builtin_amdgcn_cvt_pk_fp8_f32(O0[4 * q], O0[4 * q + 1], w8_, false); w8_ = __builtin_amdgcn_cvt_pk_fp8_f32(O0[4 * q + 2], O0[4 * q + 3], w8_, true); (unsigned)w8_; });
                    *(GAS unsigned*)((unsigned char*)YA + (size_t)(q0 + n) * 1024 + head * 64 + 32 + 8 * q + 4 * h) = ({ int w8_ = 0; w8_ = __builtin_amdgcn_cvt_pk_fp8_f32(O1[4 * q], O1[4 * q + 1], w8_, false); w8_ = __builtin_amdgcn_cvt_pk_fp8_f32(O1[4 * q + 2], O1[4 * q + 3], w8_, true); (unsigned)w8_; }); }
            }
        }
        }
#endif
        }
        REP_END(2)
    }
    SEAMW(2, SH_TRANSPOSE(2));
    if (IN(3)) {
        LOCALS
        REP_BEGIN(3)
        constexpr int NCHB = 16; const int NRB = (int)gridDim.x - NCHB;
        gu32* rcnt = (gu32*)(args.ws + WS_CTL) + CW_RCNT;
        const bool chb = (int)blockIdx.x >= NRB; const int u_first = chb ? (int)blockIdx.x - NRB : 16 + (int)blockIdx.x, u_stride = chb ? 4096 : NRB;
        {
        const int idx = lane & 15, g = lane >> 4, mt = wave >> 1, ntb = 2 * (wave & 1);
#define RW_IMG(sl) (LDSP + RING_OFF + (sl) * RW_SLOT)
        LAS float* tot = (LAS float*)(LDSP + RING_OFF + 13 * RW_SLOT); LAS float* gam = tot + 512;
        float nl[8]; bf16 nr[8], nk[8], nv[8], na[8]; bf16 npr = 0, npk = 0, npv = 0;
#define RW_FETCH(un) { const int ch_ = ((un) & 15) * 64 + lane, tb_ = ((un) >> 4) * 64 + 8 * wave; \
            _Pragma("unroll") for (int j = 0; j < 8; ++j) { const size_t o_ = (size_t)(tb_ + j) * 1024 + ch_; nl[j] = LW[o_]; nr[j] = RR[o_]; nk[j] = RK[o_]; nv[j] = RV[o_]; na[j] = AA[o_]; } \
            if (tb_ > 0) { const size_t o_ = (size_t)(tb_ - 1) * 1024 + ch_; npr = RR[o_]; npk = RK[o_]; npv = RV[o_]; } else { npr = 0; npk = 0; npv = 0; } }
        if (u_first < 4096) RW_FETCH(u_first)
        int pub_chunk = -1;
        for (int unit = u_first; unit < 4096; unit += u_stride) {
            const int head = unit & 15, chunk = unit >> 4, t0 = chunk * 64, ch = head * 64 + lane;
            float lwv[8], cumv[8]; float cum = 0.f; float rcur[8], kcur[8], vcur[8], acur[8];
#pragma unroll
            for (int j = 0; j < 8; ++j) { lwv[j] = nl[j]; cum += lwv[j]; cumv[j] = cum; rcur[j] = bf1(nr[j]); kcur[j] = bf1(nk[j]); vcur[j] = bf1(nv[j]); acur[j] = bf1(na[j]); }
            float rp = bf1(npr), kp = bf1(npk), vp = bf1(npv);
            tot[wave * 64 + lane] = cum;
            __syncthreads();
            float off = 0.f, total = 0.f;
#pragma unroll
            for (int w2 = 0; w2 < 8; ++w2) { const float x = tot[w2 * 64 + lane]; total += x; off += (w2 < wave) ? x : 0.f; }
            const float etot = __expf(total);
            if (wave == 0) gam[lane] = etot;
            const float mur = mu[ch], muk = mu[1024 + ch], muv = mu[2048 + ch], ckk = k_k[ch], cka = k_a[ch], crk = r_k[ch];
            {
#pragma unroll
              for (int j = 0; j < 8; ++j) { const int tl = 8 * wave + j;
                const float rc = rcur[j], kc = kcur[j], vc = vcur[j], av = acur[j];
                const float rs = rc + (rp - rc) * mur, ks = kc + (kp - kc) * muk, vs = vc + (vp - vc) * muv; rp = rc; kp = kc; vp = vc;
                float kk = ks * ckk; const float nrm = wave_sum(kk * kk); kk = kk * __builtin_amdgcn_rsqf(fmaxf(nrm, 1e-24f));
                const float km = ks * (1.0f + (av - 1.0f) * cka); const float rkc = wave_sum(rs * km * crk);
                if (lane == 0) RKC[(t0 + tl) * 16 + head] = rkc;
                const float cumt = off + cumv[j], cump = cumt - lwv[j];
                const float eg = __expf(cumt), egp = __expf(cump), ig = __expf(-cumt), eb = etot * ig;
                const int bo = tl * RW_PIT + lane * 2;
                *(LAS bf16*)(RW_IMG(0) + bo) = (bf16)f2bf(-egp * kk);
                *(LAS bf16*)(RW_IMG(1) + bo) = (bf16)f2bf(ig * kk * av);
                *(LAS bf16*)(RW_IMG(2) + bo) = (bf16)f2bf(ig * km);
                *(LAS bf16*)(RW_IMG(3) + bo) = (bf16)f2bf(eg * rs);
                *(LAS bf16*)(RW_IMG(4) + bo) = (bf16)f2bf(eb * kk * av);
                *(LAS bf16*)(RW_IMG(5) + bo) = (bf16)f2bf(eb * km);
                *(LAS bf16*)(RW_IMG(6) + bo) = (bf16)f2bf(vs); } }
            asm volatile("s_waitcnt vmcnt(0)" ::: "memory");
            __syncthreads();
            if (tid == 0 && pub_chunk >= 0) __hip_atomic_fetch_add(rcnt + pub_chunk * 16, 1u, RLX_AGENT);
            if (unit + u_stride < 4096) RW_FETCH(unit + u_stride)
            const f32x4 Z4 = (f32x4){0.f, 0.f, 0.f, 0.f};
            { f32x4 c[4][2];
#pragma unroll
              for (int q = 0; q < 4; ++q) { c[q][0] = Z4; c[q][1] = Z4; }
              rw_mm2<0, 0>(RW_IMG(0), RW_IMG(1), mt, ntb, c[0][0], c[0][1], idx, g); rw_mm2<0, 0>(RW_IMG(0), RW_IMG(2), mt, ntb, c[1][0], c[1][1], idx, g);
              rw_mm2<0, 0>(RW_IMG(3), RW_IMG(1), mt, ntb, c[2][0], c[2][1], idx, g); rw_mm2<0, 0>(RW_IMG(3), RW_IMG(2), mt, ntb, c[3][0], c[3][1], idx, g);
#pragma unroll
              for (int q2 = 0; q2 < 2; ++q2) { const int n = 16 * (ntb + q2) + idx; f32x4 one = Z4;
#pragma unroll
                  for (int i = 0; i < 4; ++i) { const int m = 16 * mt + 4 * g + i; if (!(n < m)) { c[0][q2][i] = 0.f; c[1][q2][i] = 0.f; } if (!(n <= m)) { c[2][q2][i] = 0.f; c[3][q2][i] = 0.f; } one[i] = (n == m) ? 1.f : 0.f; }
                  rw_st(RW_IMG(7), mt, ntb + q2, c[0][q2], idx, g); rw_st(RW_IMG(11), mt, ntb + q2, c[0][q2] + one, idx, g); rw_st(RW_IMG(8), mt, ntb + q2, c[1][q2], idx, g);
                  rw_st(RW_IMG(9), mt, ntb + q2, c[2][q2], idx, g); rw_st(RW_IMG(10), mt, ntb + q2, c[3][q2], idx, g); } }
            __syncthreads();
            const int tmA = (0x33103322 >> (4 * wave)) & 15, tnA = (0x32101010 >> (4 * wave)) & 15; const bool kA0 = (0x3F >> wave) & 1, kA1 = (0xCF >> wave) & 1;
            const bool hasB = wave == 4 || wave == 5, kB0 = wave == 4, kB1 = wave == 5; const int tmB = wave == 4 ? 1 : 2, tnB = wave == 4 ? 0 : 2;
#define RW_TRI_P(tm, tn, k0, k1) { f32x4 pp = Z4; \
                if (k0) { const bf16x8 a_ = rw_ft(RW_IMG(7), 16 * (tm), 0, idx, g), b_ = rw_fd(RW_IMG(7), 16 * (tn), 0, idx, g); RW_MF(a_, b_, pp); } \
                if (k1) { const bf16x8 a_ = rw_ft(RW_IMG(7), 16 * (tm), 1, idx, g), b_ = rw_fd(RW_IMG(7), 16 * (tn), 1, idx, g); RW_MF(a_, b_, pp); } \
                rw_st(RW_IMG(1), tm, tn, pp, idx, g); }
            RW_TRI_P(tmA, tnA, kA0, kA1)
            if (hasB) RW_TRI_P(tmB, tnB, kB0, kB1)
#undef RW_TRI_P
            if (wave < 6) { const int um_ = (0x211000 >> (4 * wave)) & 15, un_ = (0x332321 >> (4 * wave)) & 15; rw_st(RW_IMG(12), um_, un_, Z4, idx, g); rw_st(RW_IMG(1), um_, un_, Z4, idx, g); }
            __syncthreads();
#define RW_Z22(c) { c[0][0] = Z4; c[0][1] = Z4; c[1][0] = Z4; c[1][1] = Z4; }
#define RW_LD22(c, img) { c[0][0] = rw_ld(img, mt0, nt0, idx, g); c[0][1] = rw_ld(img, mt0, nt0 + 1, idx, g); c[1][0] = rw_ld(img, mt0 + 1, nt0, idx, g); c[1][1] = rw_ld(img, mt0 + 1, nt0 + 1, idx, g); }
#define RW_ST22(img, c) { rw_st(img, mt0, nt0, c[0][0], idx, g); rw_st(img, mt0, nt0 + 1, c[0][1], idx, g); rw_st(img, mt0 + 1, nt0, c[1][0], idx, g); rw_st(img, mt0 + 1, nt0 + 1, c[1][1], idx, g); }
#define RW_STG22(fn, p, c) { fn(p, mt0, nt0, c[0][0], idx, g); fn(p, mt0, nt0 + 1, c[0][1], idx, g); fn(p, mt0 + 1, nt0, c[1][0], idx, g); fn(p, mt0 + 1, nt0 + 1, c[1][1], idx, g); }
            const int wh = wave >> 2, mt0 = 2 * ((wave >> 1) & 1), nt0 = 2 * (wave & 1);
#pragma unroll
            for (int it = 0; it < 5; ++it) {
                const int ps = (it & 1) ? 7 : 1, pd = (it & 1) ? 1 : 7, ns = (it & 1) ? 12 : 11, nd = (it & 1) ? 11 : 12;
#define RW_TRI(tm, tn, k0, k1) { f32x4 nn = rw_ld(RW_IMG(ns), tm, tn, idx, g), pp = Z4; \
                    if (k0) { const bf16x8 a_ = rw_ft(RW_IMG(ps), 16 * (tm), 0, idx, g), bn_ = rw_fd(RW_IMG(ns), 16 * (tn), 0, idx, g); RW_MF(a_, bn_, nn); if (it < 4) { const bf16x8 bp_ = rw_fd(RW_IMG(ps), 16 * (tn), 0, idx, g); RW_MF(a_, bp_, pp); } } \
                    if (k1) { const bf16x8 a_ = rw_ft(RW_IMG(ps), 16 * (tm), 1, idx, g), bn_ = rw_fd(RW_IMG(ns), 16 * (tn), 1, idx, g); RW_MF(a_, bn_, nn); if (it < 4) { const bf16x8 bp_ = rw_fd(RW_IMG(ps), 16 * (tn), 1, idx, g); RW_MF(a_, bp_, pp); } } \
                    rw_st(RW_IMG(nd), tm, tn, nn, idx, g); if (it < 4) rw_st(RW_IMG(pd), tm, tn, pp, idx, g); }
                RW_TRI(tmA, tnA, kA0, kA1)
                if (hasB) RW_TRI(tmB, tnB, kB0, kB1)
#undef RW_TRI
                __syncthreads();
            }
            if (wh == 0) { f32x4 ah[2][2]; RW_Z22(ah) rw_mm22<1, 1>(RW_IMG(0), RW_IMG(12), mt0, nt0, ah, idx, g, true, nt0 == 2); RW_ST22(RW_IMG(2), ah) }
            else { f32x4 wq[2][2]; RW_Z22(wq) rw_mm22<1, 0>(RW_IMG(12), RW_IMG(8), mt0, nt0, wq, idx, g, nt0 == 0, mt0 == 2); RW_ST22(RW_IMG(11), wq) }
            __syncthreads();
            if (wh == 0) { bf16* gt_ = GTC + (size_t)unit * 4096; bf16* tt_ = TTC + (size_t)unit * 4096;
              f32x4 gq[2][2], tq[2][2]; RW_LD22(gq, RW_IMG(3)) RW_Z22(tq)
              rw_mm22_shareA<1, 1, 1>(RW_IMG(2), RW_IMG(9), RW_IMG(4), mt0, nt0, gq, tq, idx, g, nt0 == 2);
              RW_STG22(rw_stg, gt_, gq)
#pragma unroll
              for (int a_ = 0; a_ < 2; ++a_)
#pragma unroll
                  for (int b_ = 0; b_ < 2; ++b_)
#pragma unroll
                      for (int i = 0; i < 4; ++i) { const int m = 16 * (mt0 + a_) + 4 * g + i; if (16 * (nt0 + b_) + idx == m) tq[a_][b_][i] += gam[m]; }
              RW_STG22(rw_stg_wt, tt_, tq) }
            else { f32x4 zq[2][2], xq[2][2]; RW_LD22(zq, RW_IMG(10)) RW_LD22(xq, RW_IMG(5))
              rw_mm22_shareB<1, 1, 0>(RW_IMG(9), RW_IMG(4), RW_IMG(11), mt0, nt0, zq, xq, idx, g, nt0 == 0, mt0 == 2, nt0 == 0);
              RW_ST22(RW_IMG(7), zq) RW_ST22(RW_IMG(1), xq) }
            __syncthreads();
            if (wh == 0) { bf16* yl_ = YLC + (size_t)unit * 4096; f32x4 yq[2][2]; RW_Z22(yq) rw_mm22<1, 1>(RW_IMG(6), RW_IMG(7), mt0, nt0, yq, idx, g, true, nt0 == 2); RW_STG22(rw_stg, yl_, yq) }
            else { bf16* qc_ = QC + (size_t)unit * 4096; f32x4 qq[2][2]; RW_Z22(qq) rw_mm22<1, 1>(RW_IMG(1), RW_IMG(6), mt0, nt0, qq, idx, g); RW_STG22(rw_stg_wt, qc_, qq) }
            __syncthreads();
#undef RW_Z22
#undef RW_LD22
#undef RW_ST22
#undef RW_STG22
            pub_chunk = chunk;
        }
        if (pub_chunk >= 0) { asm volatile("s_waitcnt vmcnt(0)" ::: "memory"); __syncthreads(); if (tid == 0) __hip_atomic_fetch_add(rcnt + pub_chunk * 16, 1u, RLX_AGENT); }
#undef RW_IMG
#undef RW_FETCH
        }
        if (chb) {
            typedef unsigned long long u64;
            volatile LAS unsigned* cw = (volatile LAS unsigned*)(LDSP + RING_OFF);
            LAS unsigned char* ring = LDSP + RING_OFF + 1024;
            constexpr int CH_SLOT = 2 * RW_SLOT, CH_NS = 6; constexpr unsigned CH_CAP = 1u << 24;
            if (tid < 64) cw[tid] = 0u;
            __syncthreads();
            const int head = (int)blockIdx.x - NRB;
            if (wave == 4) {
                int c = 0; unsigned spins = 0;
                while (c < 256) {
                    const int cc = c + lane; const unsigned v = cc < 256 ? __hip_atomic_load(rcnt + cc * 16, RLX_AGENT) : 0u;
                    const unsigned long long m = __ballot(v >= 16u); const int nready = m == ~0ull ? 64 : __builtin_ctzll(~m);
                    if (nready > 0) { __builtin_amdgcn_fence(__ATOMIC_ACQUIRE, "agent"); c += nready; if (lane == 0) cw[0] = (unsigned)c; spins = 0; }
                    else { __builtin_amdgcn_s_sleep(4); if (++spins > (1u << 22)) break; }
                }
            } else if (wave > 4) {
                const int L = wave - 5, lrow = lane >> 3, lc = lane & 7;
                v4u A[16], B[16];
#define LD_WAIT_RDY(c) { unsigned sp_ = 0; while ((unsigned)__builtin_amdgcn_readfirstlane((int)cw[0]) < (unsigned)(c) + 1u) { __builtin_amdgcn_s_sleep(1); if (++sp_ > CH_CAP) break; } asm volatile("" ::: "memory"); }
#define LD_WAIT_FREE(c) { if ((c) >= CH_NS) { unsigned sp_ = 0; for (;;) { const unsigned d_ = cw[16 + 6 * (lane & 3) + (c) % CH_NS]; if (__all(d_ >= (unsigned)((c) - CH_NS) + 1u)) break; __builtin_amdgcn_s_sleep(1); if (++sp_ > CH_CAP) break; } } asm volatile("" ::: "memory"); }
#define LD_LOAD(R, c) { const bf16* tt_ = TTC + (size_t)((c) * 16 + head) * 4096; const bf16* qc_ = QC + (size_t)((c) * 16 + head) * 4096; \
                  _Pragma("unroll") for (int i = 0; i < 8; ++i) { R[i] = *(const GAS v4u*)(tt_ + (8 * i + lrow) * 64 + lc * 8); R[8 + i] = *(const GAS v4u*)(qc_ + (8 * i + lrow) * 64 + lc * 8); } }
#define LD_STORE(R, c) { LAS unsigned char* sl_ = ring + ((c) % CH_NS) * CH_SLOT; \
                  _Pragma("unroll") for (int i = 0; i < 8; ++i) { *(LAS v4u*)(sl_ + (8 * i + lrow) * RW_PIT + lc * 16) = R[i]; *(LAS v4u*)(sl_ + RW_SLOT + (8 * i + lrow) * RW_PIT + lc * 16) = R[8 + i]; } \
                  LDS_WAIT(); if (lane == 0) cw[8 + (c) % CH_NS] = (unsigned)(c) + 1u; }
                LD_WAIT_RDY(L) LD_LOAD(A, L)
                for (int c = L; c < 256; c += 6) {
                    const int c1 = c + 3, c2 = c + 6;
                    if (c1 < 256) { LD_WAIT_RDY(c1) LD_LOAD(B, c1) }
                    LD_WAIT_FREE(c) LD_STORE(A, c)
                    if (c2 < 256) { LD_WAIT_RDY(c2) LD_LOAD(A, c2) }
                    if (c1 < 256) { LD_WAIT_FREE(c1) LD_STORE(B, c1) }
                }
#undef LD_WAIT_RDY
#undef LD_WAIT_FREE
#undef LD_LOAD
#undef LD_STORE
            } else {
                const int vg = wave, idx = lane & 15, g = lane >> 4;
                f32x4 S[4];
#pragma unroll
                for (int m = 0; m < 4; ++m) S[m] = (f32x4){0.f, 0.f, 0.f, 0.f};
                for (int c = 0; c < 256; ++c) {
                    const int slot = c % CH_NS, unit = c * 16 + head;
                    { unsigned sp_ = 0; while ((unsigned)__builtin_amdgcn_readfirstlane((int)cw[8 + slot]) < (unsigned)c + 1u) { __builtin_amdgcn_s_sleep(1); if (++sp_ > CH_CAP) break; } asm volatile("" ::: "memory"); }
                    const LAS unsigned char* sl_ = ring + slot * CH_SLOT;
                    u64 pq[4], pa[4][2][2];
#pragma unroll
                    for (int m = 0; m < 4; ++m) { pq[m] = *(const LAS u64*)(sl_ + RW_SLOT + (16 * vg + idx) * RW_PIT + (16 * m + 4 * g) * 2);
#pragma unroll
                        for (int ks = 0; ks < 2; ++ks) { pa[m][ks][0] = *(const LAS u64*)(sl_ + (16 * m + idx) * RW_PIT + (32 * ks + 4 * g) * 2); pa[m][ks][1] = *(const LAS u64*)(sl_ + (16 * m + idx) * RW_PIT + (32 * ks + 16 + 4 * g) * 2); } }
                    bf16x8 sf[2];
#pragma unroll
                    for (int ks = 0; ks < 2; ++ks) { v4u w; w.x = pk2(S[2 * ks][0], S[2 * ks][1]); w.y = pk2(S[2 * ks][2], S[2 * ks][3]); w.z = pk2(S[2 * ks + 1][0], S[2 * ks + 1][1]); w.w = pk2(S[2 * ks + 1][2], S[2 * ks + 1][3]);
                        sf[ks] = __builtin_bit_cast(bf16x8, w); *(GAS v4u*)(SBF + (((size_t)unit * 4 + vg) * 2 + ks) * 512 + lane * 8) = w; }
                    LDS_WAIT(); asm volatile("" ::: "memory");
                    if (lane == 0) cw[16 + 6 * vg + slot] = (unsigned)c + 1u;
#pragma unroll
                    for (int m = 0; m < 4; ++m) { const unsigned lo = (unsigned)pq[m], hi = (unsigned)(pq[m] >> 32); f32x4 acc = (f32x4){bflo(lo), bfhi(lo), bflo(hi), bfhi(hi)};
#pragma unroll
                        for (int ks = 0; ks < 2; ++ks) { const v4u aw = (v4u){(unsigned)pa[m][ks][0], (unsigned)(pa[m][ks][0] >> 32), (unsigned)pa[m][ks][1], (unsigned)(pa[m][ks][1] >> 32)};
                            acc = __builtin_amdgcn_mfma_f32_16x16x32_bf16(__builtin_bit_cast(bf16x8, aw), sf[ks], acc, 0, 0, 0); }
                        S[m] = acc; }
                }
            }
        }
        REP_END(3)
    }
    SEAMW(3, SH_TRANSPOSE(3));
    if (IN(4)) {
        LOCALS
        REP_BEGIN(4)
        if ((vcu & 1) == 0) {
            pg8::Gemm g{XB, WIN_T + (size_t)7168 * D / 2, T, 4096, D / 2}; pg8::StaticOrder S; S.init(T, 4096, (int)gridDim.x, (int)blockIdx.x);
            pg8::EpiB16<pg8::FnGate> E{{GATE}};
            pg8::gemm_phase<pg8::EpiB16<pg8::FnGate>, pg8::StaticOrder, PG8_ALIGN, PG8_SP2, 122>(LDSP + RING_OFF, g, S, E);
        }
        REP_END(4)
    }
    if (IN(5)) {
        LOCALS
        REP_BEGIN(5)
        typedef unsigned long long u64;
        const int idx = lane & 15, g = lane >> 4;
#pragma unroll 2
        for (int task = gw; task < 16384; task += NGW) {
            const int unit = task >> 2, nt = task & 3, head = unit & 15, t = (unit >> 4) * 64 + 16 * nt + idx;
            const bf16* gt_ = GTC + (size_t)unit * 4096 + (16 * nt + idx) * 64; const bf16* yl_ = YLC + (size_t)unit * 4096 + (16 * nt + idx) * 64;
            bf16x8 bfr[2];
#pragma unroll
            for (int ks = 0; ks < 2; ++ks) { const u64 lo = *(const GAS u64*)(gt_ + 32 * ks + 4 * g), hi = *(const GAS u64*)(gt_ + 32 * ks + 16 + 4 * g);
                bfr[ks] = __builtin_bit_cast(bf16x8, (v4u){(unsigned)lo, (unsigned)(lo >> 32), (unsigned)hi, (unsigned)(hi >> 32)}); }
            f32x4 y[4]; float s1 = 0.f;
#pragma unroll
            for (int vg = 0; vg < 4; ++vg) { const u64 yw = *(const GAS u64*)(yl_ + 16 * vg + 4 * g); const unsigned lo = (unsigned)yw, hi = (unsigned)(yw >> 32); f32x4 acc = (f32x4){bflo(lo), bfhi(lo), bflo(hi), bfhi(hi)};
#pragma unroll
                for (int ks = 0; ks < 2; ++ks) { const bf16x8 af = *(const GAS bf16x8*)(SBF + (((size_t)unit * 4 + vg) * 2 + ks) * 512 + lane * 8); acc = __builtin_amdgcn_mfma_f32_16x16x32_bf16(af, bfr[ks], acc, 0, 0, 0); }
                y[vg] = acc; s1 += (acc[0] + acc[1]) + (acc[2] + acc[3]); }
            s1 += __shfl_xor(s1, 16); s1 += __shfl_xor(s1, 32); const float mean = s1 * (1.0f / 64.0f); float s2 = 0.f;
#pragma unroll
            for (int vg = 0; vg < 4; ++vg) { y[vg] = y[vg] - mean; s2 += (y[vg][0] * y[vg][0] + y[vg][1] * y[vg][1]) + (y[vg][2] * y[vg][2] + y[vg][3] * y[vg][3]); }
            s2 += __shfl_xor(s2, 16); s2 += __shfl_xor(s2, 32); const float rstd = 1.0f / sqrtf(s2 * (1.0f / 64.0f) + GN_EPS);
            const float rk = RKC[t * 16 + head];
#pragma unroll
            for (int vg = 0; vg < 4; ++vg) { const int ch = head * 64 + 16 * vg + 4 * g; const size_t o = (size_t)t * 1024 + ch;
                const f32x4 lwt = *(const GAS f32x4*)(lnx_w + ch), lbt = *(const GAS f32x4*)(lnx_b + ch), mv = *(const GAS f32x4*)(mu + 2048 + ch);
                const u64 vcw = *(const GAS u64*)(RV + o), vpw = t > 0 ? *(const GAS u64*)(RV + o - 1024) : 0ull, gw_ = 0ull; const unsigned g8_ = *(const GAS unsigned*)((const unsigned char*)GG + o); (void)gw_;
                const float vc[4] = {bflo((unsigned)vcw), bfhi((unsigned)vcw), bflo((unsigned)(vcw >> 32)), bfhi((unsigned)(vcw >> 32))};
                const float vp[4] = {bflo((unsigned)vpw), bfhi((unsigned)vpw), bflo((unsigned)(vpw >> 32)), bfhi((unsigned)(vpw >> 32))};
                typedef float f32x2g_ __attribute__((ext_vector_type(2))); const f32x2g_ glo_ = __builtin_amdgcn_cvt_pk_f32_fp8((int)g8_, false), ghi_ = __builtin_amdgcn_cvt_pk_f32_fp8((int)g8_, true); const float gg[4] = {glo_.x, glo_.y, ghi_.x, ghi_.y};
                float ov[4];
#pragma unroll
                for (int i = 0; i < 4; ++i) { const float vs = vc[i] + (vp[i] - vc[i]) * mv[i]; ov[i] = (y[vg][i] * rstd * lwt[i] + lbt[i] + rk * vs) * gg[i]; }
                *(GAS unsigned*)((unsigned char*)YB + o) = ({ int w8_ = 0; w8_ = __builtin_amdgcn_cvt_pk_fp8_f32(ov[0], ov[1], w8_, false); w8_ = __builtin_amdgcn_cvt_pk_fp8_f32(ov[2], ov[3], w8_, true); (unsigned)w8_; }); }
        }
        if ((vcu & 1) != 0) {
            pg8::Gemm g{XB, WIN_T + (size_t)7168 * D / 2, T, 4096, D / 2}; pg8::StaticOrder S; S.init(T, 4096, (int)gridDim.x, (int)blockIdx.x);
            pg8::EpiB16<pg8::FnGate> E{{GATE}};
            pg8::gemm_phase<pg8::EpiB16<pg8::FnGate>, pg8::StaticOrder, PG8_ALIGN, PG8_SP2, 122>(LDSP + RING_OFF, g, S, E);
        }
        REP_END(5)
    }
    SEAMW(5, SH_TRANSPOSE(4) SH_TABLES(0, 4096));
    if (IN(7)) {
        LOCALS
        REP_BEGIN(7)
        { pg8::Gemm g{YA, WUA_T, T, D, 512}; pg8::StaticOrder S; S.init(T, D, (int)gridDim.x, (int)blockIdx.x);
          pg8::EpiB16<pg8::FnMix<0>> E{{GATE, MIX}};
          pg8::gemm_phase<pg8::EpiB16<pg8::FnMix<0>>, pg8::StaticOrder, PG8_ALIGN, PG8_SP2, 122>(LDSP + RING_OFF, g, S, E); }
        __syncthreads();
        { pg8::Gemm g{YB, WUB_T, T, D, 512}; pg8::StaticOrder S; S.init(T, D, (int)gridDim.x, (int)blockIdx.x);
          pg8::EpiB16<pg8::FnMixF8> E{{(const bf16*)((const unsigned char*)GATE + (size_t)T * 2048), MIX, MIX8}};
          pg8::gemm_phase<pg8::EpiB16<pg8::FnMixF8>, pg8::StaticOrder, PG8_ALIGN, PG8_SP2, 122>(LDSP + RING_OFF, g, S, E); }
        REP_END(7)
    }
    SEAMW(7, SH_TABLES(4096, 11264));
    if (IN(8)) {
        LOCALS
        REP_BEGIN(8)
        pg8::Gemm g{(const bf16*)MIX8, WO_T, T, D, D / 2}; pg8::StaticOrder S; S.init(T, D, (int)gridDim.x, (int)blockIdx.x);
        pg8::EpiB16<pg8::FnWoB16> E{{x_in, (bf16*)H1, ALPHA}};
        pg8::gemm_phase<pg8::EpiB16<pg8::FnWoB16>, pg8::StaticOrder, PG8_ALIGN, PG8_SP2, 121>(LDSP + RING_OFF, g, S, E);
        REP_END(8)
    }
    SEAMW(8, SH_TABLES(11264, 18432));
    if (IN(9)) {
        LOCALS
        REP_BEGIN(9)
        v4u nrow_[4];
        if (gw < T) {
#pragma unroll
            for (int i = 0; i < 4; ++i) nrow_[i] = *(const GAS v4u*)((const bf16*)H1 + (size_t)gw * D + 8 * lane + 512 * i); }
        for (int t = gw; t < T; t += NGW) {
            float v[32]; float s = 0.f; v4u crow_[4];
#pragma unroll
            for (int i = 0; i < 4; ++i) crow_[i] = nrow_[i];
            if (t + NGW < T) {
#pragma unroll
                for (int i = 0; i < 4; ++i) nrow_[i] = *(const GAS v4u*)((const bf16*)H1 + (size_t)(t + NGW) * D + 8 * lane + 512 * i); }
#pragma unroll
            for (int i = 0; i < 4; ++i) { const v4u w = crow_[i];
                v[8 * i + 0] = bflo(w.x); v[8 * i + 1] = bfhi(w.x); v[8 * i + 2] = bflo(w.y); v[8 * i + 3] = bfhi(w.y); v[8 * i + 4] = bflo(w.z); v[8 * i + 5] = bfhi(w.z); v[8 * i + 6] = bflo(w.w); v[8 * i + 7] = bfhi(w.w); }
#pragma unroll
            for (int i = 0; i < 32; ++i) s += v[i];
            const float mean = wave_sum(s) * (1.0f / D); float q = 0.f;
#pragma unroll
            for (int i = 0; i < 32; ++i) { v[i] -= mean; q += v[i] * v[i]; }
            const float rstd = 1.0f / sqrtf(wave_sum(q) * (1.0f / D) + LN_EPS);
#pragma unroll
            for (int i = 0; i < 4; ++i) { const int c0 = 8 * lane + 512 * i;
                const f32x4 ga = *(const GAS f32x4*)(ln1_w + c0), gb = *(const GAS f32x4*)(ln1_w + c0 + 4), ba = *(const GAS f32x4*)(ln1_b + c0), bb = *(const GAS f32x4*)(ln1_b + c0 + 4);
                float o[8] = {v[8 * i + 0] * rstd * ga.x + ba.x, v[8 * i + 1] * rstd * ga.y + ba.y, v[8 * i + 2] * rstd * ga.z + ba.z, v[8 * i + 3] * rstd * ga.w + ba.w,
                              v[8 * i + 4] * rstd * gb.x + bb.x, v[8 * i + 5] * rstd * gb.y + bb.y, v[8 * i + 6] * rstd * gb.z + bb.z, v[8 * i + 7] * rstd * gb.w + bb.w};
                v4u w; w.x = pk2(o[0], o[1]); w.y = pk2(o[2], o[3]); w.z = pk2(o[4], o[5]); w.w = pk2(o[6], o[7]); *(GAS v4u*)(X1B + (size_t)t * D + c0) = w;
                int w0_ = 0, w1_ = 0; w0_ = __builtin_amdgcn_cvt_pk_fp8_f32(o[0], o[1], w0_, false); w0_ = __builtin_amdgcn_cvt_pk_fp8_f32(o[2], o[3], w0_, true);
                w1_ = __builtin_amdgcn_cvt_pk_fp8_f32(o[4], o[5], w1_, false); w1_ = __builtin_amdgcn_cvt_pk_fp8_f32(o[6], o[7], w1_, true);
                *(GAS unsigned long long*)(X1B8 + (size_t)t * D + c0) = (unsigned long long)(unsigned)w0_ | ((unsigned long long)(unsigned)w1_ << 32); }
        }
        REP_END(9)
    }
    SEAMW(9, SH_TABLES(18432, 25600));
    if (IN(10)) {
        LOCALS
        REP_BEGIN(10)
        { pg8::Gemm g{X1B, WQ_T, T, D, D}; pg8::StaticOrder S; S.init(T, D, (int)gridDim.x, (int)blockIdx.x);
          pg8::EpiB16<pg8::FnPlain16> E{{PQ, D}};
          pg8::gemm_phase<pg8::EpiB16<pg8::FnPlain16>, pg8::StaticOrder, PG8_ALIGN, PG8_SP2>(LDSP + RING_OFF, g, S, E); }
        REP_END(10)
    }
    SEAMW(10, SH_TABLES(25600, 32768));
    if (IN(11)) {
        LOCALS
        REP_BEGIN(11)
        { pg8::Gemm g{PB, WPE_T, T, D, 256}; pg8::StaticOrder S; S.init(T, D, (int)gridDim.x, (int)blockIdx.x);
          pg8::EpiB16<pg8::FnPlain16> E{{PE, D}};
          pg8::gemm_phase<pg8::EpiB16<pg8::FnPlain16>, pg8::StaticOrder, PG8_ALIGN, PG8_SP2>(LDSP + RING_OFF, g, S, E); }
        __syncthreads();
        { pg8::Gemm g{(const bf16*)X1B8, WPG_T, T, D, D / 2}; pg8::StaticOrder S; S.init(T, D, (int)gridDim.x, (int)blockIdx.x);
          pg8::EpiB16<pg8::FnPle> E{{PE}};
          pg8::gemm_phase<pg8::EpiB16<pg8::FnPle>, pg8::StaticOrder, PG8_ALIGN, PG8_SP2, 122>(LDSP + RING_OFF, g, S, E); }
        __syncthreads();
        LAS unsigned char* SK = LDSP + RING_OFF;
        for (int i = tid; i < 32768; i += 512) { const int row = i >> 7, d = i & 127; *(LAS bf16*)(SK + row * 272 + d * 2) = (bf16)f2bf(sub_keys[i]); }
        __syncthreads();
        {
            const int n = lane & 31, hh = lane >> 5;
            const float NEGINF = __uint_as_float(0xff800000u);
            for (int batch = gw; batch < T / 4; batch += NGW) {
                const int t = 4 * batch + (n >> 3), h = n & 7;
                float L[2][16];
#pragma unroll
                for (int c = 0; c < 2; ++c) {
                    f32x16 acc[4];
#pragma unroll
                    for (int m = 0; m < 4; ++m)
#pragma unroll
                        for (int i = 0; i < 16; ++i) acc[m][i] = 0.f;
                    bf16x8 qfr[8];
#pragma unroll
                    for (int ks = 0; ks < 8; ++ks) qfr[ks] = *(const GAS bf16x8*)(PQ + (size_t)t * D + h * 256 + c * 128 + 16 * ks + 8 * hh);
#pragma unroll
                    for (int ks = 0; ks < 8; ++ks) {
#pragma unroll
                        for (int m = 0; m < 4; ++m) { const bf16x8 kf = *(const LAS bf16x8*)(SK + (c * 128 + 32 * m + n) * 272 + (16 * ks + 8 * hh) * 2); acc[m] = __builtin_amdgcn_mfma_f32_32x32x16_bf16(kf, qfr[ks], acc[m], 0, 0, 0); }
                        __builtin_amdgcn_sched_barrier(0); }
                    float Lc[16], Gx[16];
#pragma unroll
                    for (int m = 0; m < 4; ++m) {
#pragma unroll
                        for (int i = 0; i < 16; ++i) { const float x = __uint_as_float((__float_as_uint(acc[m][i]) & 0xffffff80u) | (unsigned)(32 * m + (i & 3) + 8 * (i >> 2)) | (unsigned)(4 * hh)); if (m == 0) Lc[i] = x; else Gx[i] = x; }
                        if (m == 0) bitonic_sort16_desc(Lc); else { bitonic_sort16_desc(Gx); top16_merge_desc(Lc, Gx); } }
                    { float Pn[16];
#pragma unroll
                      for (int k = 0; k < 16; ++k) Pn[k] = __shfl_xor(Lc[k], 32);
                      top16_merge_desc(Lc, Pn); }
#pragma unroll
                    for (int k = 0; k < 16; ++k) L[c][k] = Lc[k];
                }
                float F[16];
#pragma unroll
                for (int k = 0; k < 16; ++k) F[k] = NEGINF;
#define PK_CAND(i, j) { float x = __uint_as_float((__float_as_uint(L[0][i] + L[1][j]) & 0xffffff00u) | (unsigned)(((i) << 4) | (j))); _Pragma("unroll") for (int k = 0; k < 16; ++k) { const float hi = fmaxf(x, F[k]); x = fminf(x, F[k]); F[k] = hi; } }
#define PK_ROW1(i) PK_CAND(i, 0)
#define PK_ROW2(i) PK_ROW1(i) PK_CAND(i, 1)
#define PK_ROW3(i) PK_ROW2(i) PK_CAND(i, 2)
#define PK_ROW4(i) PK_ROW3(i) PK_CAND(i, 3)
#define PK_ROW5(i) PK_ROW4(i) PK_CAND(i, 4)
#define PK_ROW8(i) PK_ROW5(i) PK_CAND(i, 5) PK_CAND(i, 6) PK_CAND(i, 7)
#define PK_ROW16(i) PK_ROW8(i) PK_CAND(i, 8) PK_CAND(i, 9) PK_CAND(i, 10) PK_CAND(i, 11) PK_CAND(i, 12) PK_CAND(i, 13) PK_CAND(i, 14) PK_CAND(i, 15)
                PK_ROW16(0) PK_ROW8(1) PK_ROW5(2) PK_ROW4(3) PK_ROW3(4) PK_ROW2(5) PK_ROW2(6) PK_ROW2(7)
                PK_ROW1(8) PK_ROW1(9) PK_ROW1(10) PK_ROW1(11) PK_ROW1(12) PK_ROW1(13) PK_ROW1(14) PK_ROW1(15)
                float ex[16]; float sum = 0.f; const float mx = __uint_as_float(__float_as_uint(F[0]) & 0xffffff00u);
#pragma unroll
                for (int k = 0; k < 16; ++k) { ex[k] = __expf(__uint_as_float(__float_as_uint(F[k]) & 0xffffff00u) - mx); sum += ex[k]; }
                const float rs = 1.0f / sum;
                int eid[16];
#pragma unroll
                for (int k = 0; k < 16; ++k) { const unsigned pay = __float_as_uint(F[k]) & 255u; const unsigned ii = pay >> 4, jj = pay & 15u; unsigned i0 = 0u, i1 = 0u;
#pragma unroll
                    for (int i = 0; i < 16; ++i) { i0 = (ii == (unsigned)i) ? (__float_as_uint(L[0][i]) & 127u) : i0; i1 = (jj == (unsigned)i) ? (__float_as_uint(L[1][i]) & 127u) : i1; }
                    eid[k] = (int)(i0 * 128u + i1); }
                if (hh == 0) {
#pragma unroll
                    for (int k4 = 0; k4 < 4; ++k4) { *(GAS v4u*)(IDX + (size_t)t * 128 + h * 16 + 4 * k4) = (v4u){(unsigned)eid[4 * k4], (unsigned)eid[4 * k4 + 1], (unsigned)eid[4 * k4 + 2], (unsigned)eid[4 * k4 + 3]};
                        *(GAS f32x4*)(PG + (size_t)t * 128 + h * 16 + 4 * k4) = (f32x4){ex[4 * k4] * rs, ex[4 * k4 + 1] * rs, ex[4 * k4 + 2] * rs, ex[4 * k4 + 3] * rs}; }
                }
            }
        }
        REP_END(11)
    }
    SEAM(11);
    if (IN(12)) {
        LOCALS
        REP_BEGIN(12)
        LAS float* actw = (LAS float*)(LDSP + RING_OFF) + wave * 1024;
        LAS float* lnw = (LAS float*)(LDSP + RING_OFF + 98304); LAS float* lnb = lnw + 2048;
        *(LAS f32x4*)(lnw + 4 * tid) = *(const GAS f32x4*)(ln2_w + 4 * tid); *(LAS f32x4*)(lnb + 4 * tid) = *(const GAS f32x4*)(ln2_b + 4 * tid);
        __syncthreads();
        const int r4 = lane >> 4, c16 = lane & 15;
#pragma unroll 1
        for (int tb0_ = vcu * NWAVES, git_ = 0; tb0_ < T; tb0_ += 8 * NGW, ++git_) { const int t0 = tb0_ + wave;
#ifndef PEER_NSL
#define PEER_NSL 4
#define PEER_SLSH 12
#endif
#pragma unroll 1
        for (int sl = 0; sl < PEER_NSL; ++sl) {
#pragma unroll 1
        for (int t = t0, k_ = 0; t < T && k_ < 8; t += NGW, ++k_) {
            typedef unsigned long long u64;
            LAS float* hraw = actw + k_ * 128;
            const int lane_o1_ = lane;
            int lane_c1_ = lane_o1_; asm volatile("" : "+v"(lane_c1_));
            const int lane = lane_c1_; const int r4 = lane >> 4, c16 = lane & 15;
            const int idv0 = IDX[(size_t)t * 128 + lane], idv1 = IDX[(size_t)t * 128 + 64 + lane];
            u64 xq[32];
#pragma unroll
            for (int i = 0; i < 4; ++i)
#pragma unroll
                for (int q = 0; q < 8; ++q) xq[8 * i + q] = *(const GAS u64*)(X1B + (size_t)t * D + 256 * q + 4 * (c16 + 16 * i));
            u64 m0 = __ballot(((unsigned)idv0 >> PEER_SLSH) == (unsigned)sl), m1 = __ballot(((unsigned)idv1 >> PEER_SLSH) == (unsigned)sl);
#define P1_POP(Q, C) { if (m0) { Q = __builtin_ctzll(m0); m0 &= m0 - 1; ++C; } else if (m1) { Q = 64 + __builtin_ctzll(m1); m1 &= m1 - 1; ++C; } }
#define P1_NEXT(JR, NV) { int q0_ = 0, c_ = 0; P1_POP(q0_, c_) int q1_ = q0_, q2_ = q0_, q3_ = q0_; if (c_ == 1) P1_POP(q1_, c_) if (c_ == 2) P1_POP(q2_, c_) if (c_ == 3) P1_POP(q3_, c_) \
                JR = r4 == 0 ? q0_ : (r4 == 1 ? q1_ : (r4 == 2 ? q2_ : q3_)); NV = c_; }
#define P1_LOAD(Dst, jr) { const int ea_ = __shfl(idv0, (jr) & 63), eb_ = __shfl(idv1, (jr) & 63); const int e_ = (jr) < 64 ? ea_ : eb_;        const GAS u64* ur_ = (const GAS u64*)(UB + (size_t)e_ * ROW6 + 24 * c16); \
                _Pragma("unroll") for (int i = 0; i < 4; ++i) { Dst[3 * i] = ur_[48 * i]; Dst[3 * i + 1] = ur_[48 * i + 1]; Dst[3 * i + 2] = ur_[48 * i + 2]; } }
#define P1_COMP(Src, jr, nv) { float h0_ = 0.f, h1_ = 0.f; \
                _Pragma("unroll") for (int i = 0; i < 4; ++i) { const v6u_t pk_ = {(unsigned)Src[3 * i], (unsigned)(Src[3 * i] >> 32), (unsigned)Src[3 * i + 1], (unsigned)(Src[3 * i + 1] >> 32), (unsigned)Src[3 * i + 2], (unsigned)(Src[3 * i + 2] >> 32)}; \
                    const v16u_t f = __builtin_bit_cast(v16u_t, __builtin_amdgcn_cvt_scalef32_pk32_bf16_fp6(pk_, 1.0f));        \
                    _Pragma("unroll") for (int q = 0; q < 8; ++q) { const u64 xx = xq[8 * i + q]; h0_ = dot2(f[2 * q], (unsigned)xx, h0_); h1_ = dot2(f[2 * q + 1], (unsigned)(xx >> 32), h1_); } __builtin_amdgcn_sched_barrier(0); } \
                const float h_ = row16_sum(h0_ + h1_) * (1.0f / U_SCALE); if (c16 == 0 && r4 < (nv)) hraw[jr] = h_; }
            { u64 ua[12], ub[12]; int jrA = 0, nvA = 0, jrB = 0, nvB = 0;
              P1_NEXT(jrA, nvA) if (nvA) P1_LOAD(ua, jrA)
              while (nvA) {
                  P1_NEXT(jrB, nvB) if (nvB) P1_LOAD(ub, jrB)
                  P1_COMP(ua, jrA, nvA)
                  if (!nvB) break;
                  P1_NEXT(jrA, nvA) if (nvA) P1_LOAD(ua, jrA)
                  P1_COMP(ub, jrB, nvB)
              } }
#undef P1_POP
#undef P1_NEXT
#undef P1_LOAD
#undef P1_COMP
        }
        }
        asm volatile("s_waitcnt lgkmcnt(0)" ::: "memory");
#pragma unroll 1
        for (int t = t0, k_ = 0; t < T && k_ < 8; t += NGW, ++k_) {
            const int lane_o2_ = lane; int lane_c2_ = lane_o2_; asm volatile("" : "+v"(lane_c2_)); const int lane = lane_c2_;
            LAS float* actl = actw + k_ * 128; const float gtv0 = PG[(size_t)t * 128 + lane], gtv1 = PG[(size_t)t * 128 + 64 + lane];
            const float ha_ = actl[lane], hb_ = actl[64 + lane];
            const int ida_ = IDX[(size_t)t * 128 + lane], idb_ = IDX[(size_t)t * 128 + 64 + lane];
            int posa_ = 0, posb_ = 0;
            { const unsigned ba_ = (unsigned)ida_ >> 10, bb_ = (unsigned)idb_ >> 10; int base_ = 0;
#pragma unroll
              for (unsigned b = 0; b < 16; ++b) { const unsigned long long ma_ = __ballot(ba_ == b), mb_ = __ballot(bb_ == b); const int ca_ = __builtin_popcountll(ma_);
                  const int ra_ = (int)__builtin_amdgcn_mbcnt_hi((unsigned)(ma_ >> 32), __builtin_amdgcn_mbcnt_lo((unsigned)ma_, 0u)), rb_ = (int)__builtin_amdgcn_mbcnt_hi((unsigned)(mb_ >> 32), __builtin_amdgcn_mbcnt_lo((unsigned)mb_, 0u));
                  if (ba_ == b) posa_ = base_ + ra_; if (bb_ == b) posb_ = base_ + ca_ + rb_; base_ += ca_ + __builtin_popcountll(mb_); } }
            asm volatile("s_waitcnt lgkmcnt(0)" ::: "memory");
            LAS unsigned short* idl = (LAS unsigned short*)(LDSP + RING_OFF + 114688) + wave * 1024 + k_ * 128;
            actl[posa_] = 0.5f * ha_ * (1.0f + erff(ha_ * 0.70710678118f)) * gtv0 * (1.0f / V_SCALE); actl[posb_] = 0.5f * hb_ * (1.0f + erff(hb_ * 0.70710678118f)) * gtv1 * (1.0f / V_SCALE);
            idl[posa_] = (unsigned short)ida_; idl[posb_] = (unsigned short)idb_;
        }
        asm volatile("s_waitcnt lgkmcnt(0)" ::: "memory");
        { __syncthreads();
          if (tid == 0) { gu32* xc_ = (gu32*)(args.ws + WS_CTL) + 24576 + bar.x * 16; const unsigned nl_ = bar.st[0], tg_ = nl_ * (unsigned)(git_ + 1); __hip_atomic_fetch_add(xc_, 1u, RLX_AGENT);
              unsigned sp_ = 0; while (__hip_atomic_load(xc_, RLX_AGENT) < tg_) { __builtin_amdgcn_s_sleep(2); if (++sp_ > (1u << 22)) break; } }
          __syncthreads(); }
        unsigned long long va[12], vb[12]; bool pre_ = false;
#pragma unroll 1
        for (int k_ = 0; k_ < 8; ++k_) { const int t = t0 + k_ * NGW;
            __syncthreads();
            if (t >= T) continue;
            typedef unsigned long long u64;
            LAS float* actl = actw + k_ * 128;
            const int lane_o_ = lane;
            int lane_c_ = lane_o_; asm volatile("" : "+v"(lane_c_));
            const int lane = lane_c_;
            const LAS unsigned short* idl = (const LAS unsigned short*)(LDSP + RING_OFF + 114688) + wave * 1024 + k_ * 128;
            const int idv0 = idl[lane], idv1 = idl[64 + lane];
            float acc[32];
#pragma unroll
            for (int i = 0; i < 32; ++i) acc[i] = 0.f;
            LAS unsigned char* erow = LDSP + RING_OFF + 32768 + wave * 8192;
#pragma unroll
            for (int i = 0; i < 4; ++i) { __builtin_amdgcn_global_load_lds((const GAS unsigned*)((const unsigned char*)(X1B + (size_t)t * D) + 1024 * i + 16 * lane), (LAS unsigned*)(erow + 1024 * i), 16, 0, 0);
                __builtin_amdgcn_global_load_lds((const GAS unsigned*)((const unsigned char*)(PE + (size_t)t * D) + 1024 * i + 16 * lane), (LAS unsigned*)(erow + 4096 + 1024 * i), 16, 0, 0); }
#define P2_LOADX(Dst, jb, I0, I1) { _Pragma("unroll") for (int r = 0; r < 4; ++r) { const int e_ = __builtin_amdgcn_readlane((jb) < 64 ? I0 : I1, ((jb) + r) & 63); const GAS u64* vr_ = (const GAS u64*)(VB2 + (size_t)e_ * ROW6 + 24 * lane); \
                Dst[3 * r] = vr_[0]; Dst[3 * r + 1] = vr_[1]; Dst[3 * r + 2] = vr_[2]; } }
#define P2_COMP(Src, jb) { const f32x4 a4_ = *(const LAS f32x4*)(actl + (jb)); \
                _Pragma("unroll") for (int r = 0; r < 4; ++r) { const v6u_t pk_ = {(unsigned)Src[3 * r], (unsigned)(Src[3 * r] >> 32), (unsigned)Src[3 * r + 1], (unsigned)(Src[3 * r + 1] >> 32), (unsigned)Src[3 * r + 2], (unsigned)(Src[3 * r + 2] >> 32)}; \
                    const v32f_t f = __builtin_amdgcn_cvt_scalef32_pk32_f32_fp6(pk_, 1.0f); const float a_ = a4_[r]; \
                    _Pragma("unroll") for (int i = 0; i < 32; ++i) acc[i] += a_ * f[i]; __builtin_amdgcn_sched_barrier(0); } }
#define P2_LOAD(Dst, jb) P2_LOADX(Dst, jb, idv0, idv1)
            { if (!pre_) P2_LOAD(va, 0)
              for (int jb = 0; jb < 128; jb += 8) { P2_LOAD(vb, jb + 4) P2_COMP(va, jb) if (jb + 8 < 128) P2_LOAD(va, jb + 8) P2_COMP(vb, jb + 4) } }
            pre_ = (k_ + 1 < 8) && (t + NGW < T);
            if (pre_) { const int nid0_ = idl[128 + lane], nid1_ = idl[128 + 64 + lane];
                P2_LOADX(va, 0, nid0_, nid1_)
                asm volatile("s_waitcnt vmcnt(12) lgkmcnt(0)" ::: "memory"); }
            else asm volatile("s_waitcnt vmcnt(0) lgkmcnt(0)" ::: "memory");
#undef P2_LOAD
#undef P2_LOADX
#undef P2_COMP
            float s1 = 0.f;
#pragma unroll
            for (int i = 0; i < 8; ++i) {
                const unsigned long long xw_ = *(const LAS unsigned long long*)(erow + 512 * i + 8 * lane), pw = *(const LAS unsigned long long*)(erow + 4096 + 512 * i + 8 * lane);
                acc[4 * i + 0] += ALPHA * bflo((unsigned)xw_) + bflo((unsigned)pw); acc[4 * i + 1] += ALPHA * bfhi((unsigned)xw_) + bfhi((unsigned)pw);
                acc[4 * i + 2] += ALPHA * bflo((unsigned)(xw_ >> 32)) + bflo((unsigned)(pw >> 32)); acc[4 * i + 3] += ALPHA * bfhi((unsigned)(xw_ >> 32)) + bfhi((unsigned)(pw >> 32)); }
#pragma unroll
            for (int i = 0; i < 32; ++i) s1 += acc[i];
            const float mean = wave_sum(s1) * (1.0f / D); float s2 = 0.f;
#pragma unroll
            for (int i = 0; i < 32; ++i) { acc[i] -= mean; s2 += acc[i] * acc[i]; }
            const float rstd = 1.0f / sqrtf(wave_sum(s2) * (1.0f / D) + LN_EPS);
#pragma unroll
            for (int i = 0; i < 8; ++i) { const int c0 = 256 * i + 4 * lane; const f32x4 ga = *(const LAS f32x4*)(lnw + c0), ba = *(const LAS f32x4*)(lnb + c0);
                *(GAS f32x4*)(args.out + (size_t)t * D + c0) = (f32x4){acc[4 * i + 0] * rstd * ga.x + ba.x, acc[4 * i + 1] * rstd * ga.y + ba.y, acc[4 * i + 2] * rstd * ga.z + ba.z, acc[4 * i + 3] * rstd * ga.w + ba.w}; }
                }
        }
        REP_END(12)
    }

#ifdef DIAG_FP6
    { typedef float v32f_ __attribute__((ext_vector_type(32))); typedef float v16f_ __attribute__((ext_vector_type(16))); typedef unsigned v6u_ __attribute__((ext_vector_type(6)));
      v16f_ a_, b_; float mv_[32];
#pragma unroll
      for (int k = 0; k < 32; ++k) mv_[k] = k < 8 ? k * 0.125f : (k < 16 ? 1.f + (k - 8) * 0.125f : (k < 24 ? 2.f + (k - 16) * 0.25f : 4.f + (k - 24) * 0.5f));
#pragma unroll
      for (int k = 0; k < 16; ++k) { a_[k] = mv_[k]; b_[k] = mv_[16 + k]; }
      const v6u_ p_ = __builtin_amdgcn_cvt_scalef32_2xpk16_fp6_f32(a_, b_, 1.0f); const v32f_ o_ = __builtin_amdgcn_cvt_scalef32_pk32_f32_fp6(p_, 1.0f);
      bool id_ = true, il_ = true;
#pragma unroll
      for (int k = 0; k < 16; ++k) { id_ = id_ && (o_[k] == mv_[k]) && (o_[16 + k] == mv_[16 + k]); il_ = il_ && (o_[2 * k] == mv_[k]) && (o_[2 * k + 1] == mv_[16 + k]); }
      const float c_ = id_ ? 2.f : (il_ ? 3.f : 4.f);
      xcd_barrier(bar);
      LOCALS
      for (size_t e = gt; e < (size_t)T * D; e += NGT) args.out[e] = c_; }
#endif

#ifdef DIAG_TIME
    xcd_barrier(bar);
    { LOCALS
      const unsigned long long t0_ = __hip_atomic_load((unsigned long long*)(args.ws + WS_CTL) + 8, __ATOMIC_RELAXED, __HIP_MEMORY_SCOPE_AGENT);
      const float ms_ = (float)(__builtin_amdgcn_s_memrealtime() - t0_) * (1.0f / 100000.0f);
      float u_ = (float)DIAG_UNIT_MS; float c_ = 1.0f;
      for (int b_ = 0; b_ < 6; ++b_) { if (ms_ > u_) c_ += 1.f; u_ *= (float)DIAG_RATIO; }
      for (size_t e = gt; e < (size_t)T * D; e += NGT) args.out[e] = c_; }
#endif
#if DIAG_LAST >= 0
    xcd_barrier(bar);
    { LOCALS
      constexpr size_t N1 = (size_t)T * 1024;
      int used = 0;
#if DIAG_LAST == 1
      digest<bf16>(args.out, 0, QB, N1, gt, NGT); digest<bf16>(args.out, 1, KB, N1, gt, NGT); digest<bf16>(args.out, 2, VB, N1, gt, NGT);
      digest<bf16>(args.out, 3, RR, N1, gt, NGT); digest<bf16>(args.out, 4, RK, N1, gt, NGT); digest<bf16>(args.out, 5, RV, N1, gt, NGT); digest<bf16>(args.out, 6, RC, N1, gt, NGT); used = 7;
#elif DIAG_LAST == 2
      digest<bf16>(args.out, 0, YA, N1, gt, NGT); digest<float>(args.out, 1, LW, N1, gt, NGT); digest<bf16>(args.out, 2, AA, N1, gt, NGT); digest<bf16>(args.out, 3, GG, N1, gt, NGT); used = 4;
#elif DIAG_LAST == 3
      digest<float>(args.out, 0, YRAW, N1, gt, NGT); digest<float>(args.out, 1, RKC, (size_t)T * 16, gt, NGT); used = 2;
#elif DIAG_LAST == 4
      digest<bf16>(args.out, 0, YB, N1, gt, NGT); used = 1;
#elif DIAG_LAST == 5
      digest<bf16>(args.out, 0, GATE, 4 * N1, gt, NGT); used = 1;
#elif DIAG_LAST == 7
      digest<bf16>(args.out, 0, MIX, 2 * N1, gt, NGT); used = 1;
#elif DIAG_LAST == 8
      digest<float>(args.out, 0, H1, 2 * N1, gt, NGT); used = 1;
#elif DIAG_LAST == 9
      digest<bf16>(args.out, 0, X1B, 2 * N1, gt, NGT); used = 1;
#elif DIAG_LAST == 10
      digest<bf16>(args.out, 0, PQ, 2 * N1, gt, NGT); digest<bf16>(args.out, 1, PE, 2 * N1, gt, NGT); used = 2;
#elif DIAG_LAST == 11
      digest<int>(args.out, 0, IDX, (size_t)T * 128, gt, NGT); digest<float>(args.out, 1, PG, (size_t)T * 128, gt, NGT); digest<bf16>(args.out, 2, PE, 2 * N1, gt, NGT); used = 3;
#endif
      for (size_t e = gt + (size_t)used * 2097152; e < (size_t)T * D; e += NGT) args.out[e] = 1.0f;
    }
#endif
#undef IN
#undef SEAM
#undef SEAMW
#undef SH_TRANSPOSE
#undef SH_TABLES
}


#ifdef DIAG_CHECK
__device__ __forceinline__ unsigned hsh(unsigned x) { x ^= x >> 16; x *= 0x7feb352dU; x ^= x >> 15; x *= 0x846ca68bU; x ^= x >> 16; return x; }
__device__ __forceinline__ void chk_acc(unsigned char* ws, int id, float ref, float got) { float* a = (float*)(ws + WS_CTL) + 1024 + 2 * id; const float d = ref - got; atomicAdd(a, d * d); atomicAdd(a + 1, ref * ref); }
__global__ void __launch_bounds__(512) mk_check(Args args) {
    extern __shared__ __attribute__((aligned(16))) unsigned char lds[];
    LOCALS
    const int id = args.pad - 1;
    if (id == 0) {
        for (size_t i = gt; i < 8192; i += NGT) { const unsigned hh = hsh((unsigned)i * 2u + 1u); const int t = (int)(hh % T), col = (int)(hsh(hh) % 7168u);
            float ref = 0.f; for (int k = 0; k < D; ++k) ref += x_in[(size_t)t * D + k] * w_in[(size_t)k * NIN + col];
            const int reg = col >> 10, c = col & 1023; const float got = bf1(QB[(size_t)reg * ((size_t)T * 1024) + (size_t)t * 1024 + c]) * (reg == 0 ? 8.f : 1.f);
            chk_acc(args.ws, 0, ref, got); }
    } else if (id == 1) {
        for (int smp = gw; smp < 256; smp += NGW) { const unsigned hh = hsh(7777u + smp); const int t = (int)(hh % T), head = (int)(hsh(hh) % 16u);
            const float q = bf1(QB[(size_t)t * 1024 + head * 64 + lane]); float o = 0.f;
            for (int sk = 0; sk < t; ++sk) { const float z = wave_sum(q * bf1(KB[(size_t)sk * 1024 + head * 64 + lane])); const float beta = 1.0f / (1.0f + expf(-z));
                o = o * (1.0f - beta) + beta * bf1(VB[(size_t)sk * 1024 + head * 64 + lane]); }
            chk_acc(args.ws, 1, o, bf1(YA[(size_t)t * 1024 + head * 64 + lane])); }
    } else if (id == 2) {
        LAS float* xs = (LAS float*)lds + wave * 3072;
        for (int smp = gw; smp < 512; smp += NGW) { const unsigned hh = hsh(991u + smp); const int t = (int)(hh % T), c = (int)(hsh(hh) % 1024u);
            for (int k = lane; k < 1024; k += 64) { const float cv = bf1(RC[(size_t)t * 1024 + k]), pv = t > 0 ? bf1(RC[(size_t)(t - 1) * 1024 + k]) : 0.f;
                xs[k] = cv + (pv - cv) * mu[3 * 1024 + k]; xs[1024 + k] = cv + (pv - cv) * mu[4 * 1024 + k]; xs[2048 + k] = cv + (pv - cv) * mu[5 * 1024 + k]; }
            asm volatile("s_waitcnt lgkmcnt(0)" ::: "memory");
            float hw = 0.f, ha = 0.f, hg0 = 0.f, hg1 = 0.f, hg2 = 0.f;
            for (int k = 0; k < 1024; ++k) { hw += xs[k] * wl1[(size_t)k * 64 + lane]; ha += xs[1024 + k] * al1[(size_t)k * 64 + lane];
                hg0 += xs[2048 + k] * gl1[(size_t)k * 160 + lane]; hg1 += xs[2048 + k] * gl1[(size_t)k * 160 + 64 + lane]; if (lane < 32) hg2 += xs[2048 + k] * gl1[(size_t)k * 160 + 128 + lane]; }
            hw = tanhf(hw); hg0 = 1.f / (1.f + expf(-hg0)); hg1 = 1.f / (1.f + expf(-hg1)); hg2 = 1.f / (1.f + expf(-hg2));
            const float wpre = w0[c] + wave_sum(hw * wl2[(size_t)lane * 1024 + c]);
            const float apre = a0[c] + wave_sum(ha * al2[(size_t)lane * 1024 + c]);
            const float gref = wave_sum(hg0 * gl2[(size_t)lane * 1024 + c] + hg1 * gl2[(size_t)(64 + lane) * 1024 + c] + (lane < 32 ? hg2 * gl2[(size_t)(128 + lane) * 1024 + c] : 0.f));
            const float sp = -wpre > 20.f ? -wpre : log1pf(expf(-wpre)); const float lwref = -expf(-sp - 0.5f); const float aref = 1.f / (1.f + expf(-apre));
            if (lane == 0) { chk_acc(args.ws, 2, lwref, LW[(size_t)t * 1024 + c]); chk_acc(args.ws, 3, aref, bf1(AA[(size_t)t * 1024 + c])); chk_acc(args.ws, 4, gref, bf1(GG[(size_t)t * 1024 + c])); }
            asm volatile("s_waitcnt lgkmcnt(0)" ::: "memory"); }
    } else if (id == 5) {
        LAS float* vs_ = (LAS float*)lds + wave * 512;
        for (int smp = gw; smp < 128; smp += NGW) { const unsigned hh = hsh(4242u + smp); const int t1 = 800 + (int)(hh % (T - 800)), head = (int)(hsh(hh) % 16u), ch = head * 64 + lane;
            float S[64];
#pragma unroll
            for (int k = 0; k < 64; ++k) S[k] = 0.f;
            float y = 0.f;
            for (int t = t1 - 768; t <= t1; ++t) { const size_t o = (size_t)t * 1024 + ch;
                const float rc = bf1(RR[o]), rp = bf1(RR[o - 1024]), kc = bf1(RK[o]), kp = bf1(RK[o - 1024]), vc = bf1(RV[o]), vp = bf1(RV[o - 1024]);
                const float rs = rc + (rp - rc) * mu[ch], ks = kc + (kp - kc) * mu[1024 + ch], vsv = vc + (vp - vc) * mu[2048 + ch];
                const float a = bf1(AA[o]); float kk = ks * k_k[ch]; const float nrm = sqrtf(wave_sum(kk * kk)); kk = kk / fmaxf(nrm, 1e-12f);
                const float km = ks * (1.0f + (a - 1.0f) * k_a[ch]);
                vs_[lane] = expf(LW[o]); vs_[64 + lane] = -kk; vs_[128 + lane] = kk * a; vs_[192 + lane] = km; vs_[256 + lane] = rs;
                asm volatile("s_waitcnt lgkmcnt(0)" ::: "memory");
                float sa = 0.f;
#pragma unroll
                for (int k = 0; k < 64; ++k) sa += S[k] * vs_[64 + k];
                y = 0.f;
#pragma unroll
                for (int k = 0; k < 64; ++k) { S[k] = S[k] * vs_[k] + sa * vs_[128 + k] + vsv * vs_[192 + k]; y += S[k] * vs_[256 + k]; }
                asm volatile("s_waitcnt lgkmcnt(0)" ::: "memory"); }
            { const size_t o = (size_t)t1 * 1024 + ch; const float mean = wave_sum(y) / 64.f; const float var = wave_sum((y - mean) * (y - mean)) / 64.f;
              const float rc = bf1(RR[o]), rp = bf1(RR[o - 1024]), kc = bf1(RK[o]), kp = bf1(RK[o - 1024]), vc = bf1(RV[o]), vp = bf1(RV[o - 1024]);
              const float rs = rc + (rp - rc) * mu[ch], ks = kc + (kp - kc) * mu[1024 + ch], vsv = vc + (vp - vc) * mu[2048 + ch];
              const float km = ks * (1.0f + (bf1(AA[o]) - 1.0f) * k_a[ch]); const float rk = wave_sum(rs * km * r_k[ch]);
              const float ref = ((y - mean) / sqrtf(var + GN_EPS) * lnx_w[ch] + lnx_b[ch] + rk * vsv) * bf1(GG[o]);
              chk_acc(args.ws, 5, ref, bf1(YB[o])); } }
    } else if (id == 6) {
        for (int smp = gw; smp < 512; smp += NGW) { const unsigned hh = hsh(31337u + smp); const int t = 1 + (int)(hh % (T - 1)), head = (int)(hsh(hh) % 16u), ch = head * 64 + lane; const size_t o = (size_t)t * 1024 + ch;
            const float rc = bf1(RR[o]), rp = bf1(RR[o - 1024]), kc = bf1(RK[o]), kp = bf1(RK[o - 1024]), vc = bf1(RV[o]), vp = bf1(RV[o - 1024]);
            const float rs = rc + (rp - rc) * mu[ch], ks = kc + (kp - kc) * mu[1024 + ch], vsv = vc + (vp - vc) * mu[2048 + ch];
            const float km = ks * (1.0f + (bf1(AA[o]) - 1.0f) * k_a[ch]); const float rk = wave_sum(rs * km * r_k[ch]);
            const float y = YRAW[o]; const float mean = wave_sum(y) / 64.f; const float var = wave_sum((y - mean) * (y - mean)) / 64.f;
            const float ref = ((y - mean) / sqrtf(var + GN_EPS) * lnx_w[ch] + lnx_b[ch] + rk * vsv) * bf1(GG[o]);
            chk_acc(args.ws, 6, ref, bf1(YB[o])); }
    } else if (id == 7) {
        for (size_t i = gt; i < 4096; i += NGT) { const unsigned hh = hsh((unsigned)i * 2u + 5u); const int t = (int)(hh % T), col = (int)(hsh(hh) % 4096u);
            float ref = 0.f; for (int k = 0; k < D; ++k) ref += x_in[(size_t)t * D + k] * w_in[(size_t)k * NIN + 7168 + col];
#ifndef DIAG_RAWGATE
            ref = 1.f / (1.f + expf(-ref));
#endif
            chk_acc(args.ws, 7, ref, bf1(GATE[(size_t)(col >> 11) * ((size_t)T * 2048) + (size_t)t * 2048 + (col & 2047)])); }
    } else if (id == 15) {
        for (size_t i = gt; i < 262144; i += NGT) { const unsigned hh = hsh((unsigned)i * 2u + 77u); const int k = (int)(hh % D), col = (int)(hsh(hh) % NIN);
            chk_acc(args.ws, col < 7168 ? 15 : 16, w_in[(size_t)k * NIN + col], bf1(WIN_T[(size_t)col * D + k])); }
    } else if (id == 17) {
        for (size_t i = gt; i < 262144; i += NGT) { const unsigned hh = hsh((unsigned)i * 2u + 177u); const size_t e = ((size_t)hh * 8191u + hsh(hh)) % ((size_t)T * D); chk_acc(args.ws, 17, x_in[e], bf1(XB[e])); }
    } else if (id == 8) {
        for (size_t i = gt; i < 4096; i += NGT) { const unsigned hh = hsh((unsigned)i * 2u + 9u); const int t = (int)(hh % T), col = (int)(hsh(hh) % 2048u);
            float ya = 0.f, yb = 0.f; for (int k = 0; k < 1024; ++k) { ya += bf1(YA[(size_t)t * 1024 + k]) * w_up_a[(size_t)k * D + col]; yb += bf1(YB[(size_t)t * 1024 + k]) * w_up_b[(size_t)k * D + col]; }
            const float ref = bf1(GATE[(size_t)t * 2048 + col]) * ya + bf1(GATE[(size_t)T * 2048 + (size_t)t * 2048 + col]) * yb; chk_acc(args.ws, 8, ref, bf1(MIX[(size_t)t * 2048 + col])); }
    } else if (id == 9) {
        for (size_t i = gt; i < 4096; i += NGT) { const unsigned hh = hsh((unsigned)i * 2u + 13u); const int t = (int)(hh % T), col = (int)(hsh(hh) % 2048u);
            float ref = 0.f; for (int k = 0; k < D; ++k) ref += bf1(MIX[(size_t)t * D + k]) * w_o[(size_t)k * D + col];
            ref += ALPHA * x_in[(size_t)t * D + col]; chk_acc(args.ws, 9, ref, H1[(size_t)t * D + col]); }
    } else if (id == 10) {
        for (size_t i = gt; i < 4096; i += NGT) { const unsigned hh = hsh((unsigned)i * 2u + 21u); const int t = (int)(hh % T), col = (int)(hsh(hh) % 2048u);
            float ref = 0.f; for (int k = 0; k < D; ++k) ref += bf1(X1B[(size_t)t * D + k]) * peer_wq[(size_t)k * D + col];
            chk_acc(args.ws, 10, ref, bf1(PQ[(size_t)t * D + col]));
            float r2 = 0.f; for (int k = 0; k < 256; ++k) r2 += p_in[(size_t)t * 256 + k] * ple_wp[(size_t)k * D + col];
            chk_acc(args.ws, 11, r2, bf1(PE[(size_t)t * D + col])); }
    } else if (id == 12) {
        for (size_t i = gt; i < 4096; i += NGT) { const unsigned hh = hsh((unsigned)i * 2u + 29u); const int t = (int)(hh % T), col = (int)(hsh(hh) % 2048u);
            float ref = 0.f; for (int k = 0; k < D; ++k) ref += bf1(X1B[(size_t)t * D + k]) * ple_wg[(size_t)k * D + col];
            float r2 = 0.f; for (int k = 0; k < 256; ++k) r2 += p_in[(size_t)t * 256 + k] * ple_wp[(size_t)k * D + col];
            chk_acc(args.ws, 12, r2 / (1.f + expf(-ref)), bf1(PE[(size_t)t * D + col])); }
        LAS float* sc = (LAS float*)lds + wave * 256;
        for (int smp = gw; smp < 512; smp += NGW) { const unsigned hh = hsh(555u + smp); const int t = (int)(hh % T), h = (int)(hsh(hh) % 8u);
            for (int r = lane; r < 256; r += 64) { const int c = r >> 7, nn = r & 127; float s = 0.f; for (int d = 0; d < 128; ++d) s += bf1(PQ[(size_t)t * D + h * 256 + c * 128 + d]) * sub_keys[(size_t)(c * 128 + nn) * 128 + d]; sc[r] = s; }
            asm volatile("s_waitcnt lgkmcnt(0)" ::: "memory");
            const int e = IDX[(size_t)t * 128 + h * 16 + (lane & 15)]; const float mys = sc[e >> 7] + sc[128 + (e & 127)];
            float mn = mys, mxv = mys;
#pragma unroll
            for (int o2 = 1; o2 < 16; o2 <<= 1) { mn = fminf(mn, __shfl_xor(mn, o2)); mxv = fmaxf(mxv, __shfl_xor(mxv, o2)); }
            float ex = expf(mys - mxv), sm = ex;
#pragma unroll
            for (int o2 = 1; o2 < 16; o2 <<= 1) sm += __shfl_xor(sm, o2);
            if (lane < 16) chk_acc(args.ws, 13, ex / sm, PG[(size_t)t * 128 + h * 16 + lane]);
            int cnt = 0; for (int pr = lane; pr < 16384; pr += 64) cnt += (sc[pr >> 7] + sc[128 + (pr & 127)] > mn + 1e-6f) ? 1 : 0;
#pragma unroll
            for (int o2 = 1; o2 < 64; o2 <<= 1) cnt += __shfl_xor(cnt, o2);
            if (lane == 0) chk_acc(args.ws, 14, 15.f, (float)cnt);
            asm volatile("s_waitcnt lgkmcnt(0)" ::: "memory"); }
    } else if (id == 98) {
        const float* a = (const float*)(args.ws + WS_CTL) + 1024; float c = 1.f; unsigned long long sel = DIAG_CHECK;
        for (int b = 4; b >= 0; --b) { const int k = (int)(sel % 100ull); sel /= 100ull; const float rel = sqrtf(a[2 * k] / fmaxf(a[2 * k + 1], 1e-30f)); if (!(rel < DIAG_TOL)) c += (float)(1 << b); }
#ifdef DIAG_LADDER
        { c = 1.f; const float rel = sqrtf(a[2 * DIAG_LADDER] / fmaxf(a[2 * DIAG_LADDER + 1], 1e-30f)); const float th[5] = {0.01f, 0.03f, 0.1f, 0.3f, 1.0f}; for (int b = 0; b < 5; ++b) if (!(rel < th[b])) c += 1.f; }
#endif
        for (size_t e = gt; e < (size_t)T * D; e += NGT) args.out[e] = c;
    }
}
#endif

extern "C" void kernel_launch(void* const* d_in, const int* in_sizes, int n_in, void* d_out, int out_size, void* d_ws, size_t ws_size, hipStream_t stream) {
    static int grid = 0;
    if (grid == 0) {
        if (n_in != 30 || in_sizes[0] != T * D || out_size != T * D || ws_size < WS_END) { fprintf(stderr, "kernel_launch: unexpected shapes / workspace (n_in %d, ws %zu); nothing launched\n", n_in, ws_size); grid = -1; return; }
        int dev = 0, cus = 0, per_cu = 0;
        if (hipGetDevice(&dev) != hipSuccess || hipDeviceGetAttribute(&cus, hipDeviceAttributeMultiprocessorCount, dev) != hipSuccess) { grid = -1; return; }
        if (hipFuncSetAttribute((const void*)mk_fwd, hipFuncAttributeMaxDynamicSharedMemorySize, LDS_BYTES) != hipSuccess) { fprintf(stderr, "kernel_launch: hipFuncSetAttribute failed\n"); grid = -1; return; }
        if (hipOccupancyMaxActiveBlocksPerMultiprocessor(&per_cu, (const void*)mk_fwd, NWAVES * 64, LDS_BYTES) != hipSuccess || per_cu < 1) fprintf(stderr, "kernel_launch: occupancy query says %d\n", per_cu);
        (void)hipGetLastError();
#ifdef DIAG_CHECK
        (void)hipFuncSetAttribute((const void*)mk_check, hipFuncAttributeMaxDynamicSharedMemorySize, 131072);
#endif
        grid = cus;
    }
    if (grid < 0) return;
    if (hipMemsetAsync((char*)d_ws + WS_CTL, 0, CTL_ZERO_BYTES, stream) != hipSuccess) return;
    Args a{};
    for (int i = 0; i < 30; ++i) a.in[i] = (const float*)d_in[i];
    a.out = (float*)d_out; a.ws = (unsigned char*)d_ws;
#if MK_ONE_LAUNCH
    a.ph_lo = 0; a.ph_hi = (DIAG_LAST >= 0) ? DIAG_LAST + 1 : NPHASE;
#ifdef DIAG_TIME
    a.ph_hi = DIAG_TIME + 1;
#endif a.li = 0;
    hipLaunchKernelGGL(mk_fwd, dim3(grid), dim3(NWAVES * 64), LDS_BYTES, stream, a);
#else
    for (int li = 0; li < NPHASE; ++li) { a.ph_lo = li; a.ph_hi = li + 1; a.li = li; a.pad = 0; hipLaunchKernelGGL(mk_fwd, dim3(grid), dim3(NWAVES * 64), LDS_BYTES, stream, a);
#ifdef DIAG_CHECK
        static const int chk_after[][2] = {{0, 15}, {1, 0}, {2, 1}, {2, 2}, {3, 18}, {4, 19}, {5, 5}, {6, 7}, {7, 8}, {8, 9}, {10, 10}, {11, 12}};
        for (auto& ca : chk_after) if (ca[0] == li) { a.pad = ca[1] + 1; hipLaunchKernelGGL(mk_check, dim3(grid), dim3(512), 131072, stream, a); }
        if (li == NPHASE - 1) { a.pad = 99; hipLaunchKernelGGL(mk_check, dim3(grid), dim3(512), 131072, stream, a); }
#endif
    }
#endif
}
```
